# Optimizing an MI355X kernel written in HIP

```python
import math
import jax
import jax.numpy as jnp
from jax import lax
import numpy as np

D_MODEL = 1024
BATCH = 2
SEQ = 16384
DEPTH = 2

GRID_W = 64
CTX_LEN = 256
EPS = 1e-6

POOL_WINDOWS = (2, 4, 8, 16)
POOL_GROUP = 64
POOL_WIDTH = POOL_GROUP * len(POOL_WINDOWS)

MLA_HEADS = 8
MLA_NOPE = 64
MLA_ROPE = 32
MLA_QK = MLA_NOPE + MLA_ROPE
MLA_V = 64
MLA_Q_RANK = 384
MLA_KV_RANK = 256
MLA_WIDTH = MLA_HEADS * MLA_V
MLA_SCALE = MLA_QK ** -0.5
ROPE_BASE = 10000.0
Q_BLOCK = 128

ML_HEADS = 4
ML_DK = 64
ML_DV = 64
ML_WIDTH = ML_HEADS * ML_DV
ML_CHUNK = 64
NEG_INIT = -1e30

MIX_WIDTH = POOL_WIDTH + MLA_WIDTH + ML_WIDTH

IN_SIZES = (POOL_WIDTH, MLA_Q_RANK, MLA_KV_RANK, MLA_ROPE, ML_WIDTH, ML_WIDTH, ML_WIDTH, ML_WIDTH, 4 * ML_HEADS)
IN_WIDTH = 1968

PEER_HEADS = 8
PEER_KEYS = 128
PEER_EXPERTS = PEER_KEYS * PEER_KEYS
PEER_DKEY = 256
PEER_TOPK = 16
PEER_BLOCK = 128

kernel_name = "hybrid_pool_mla_mlstm_peer_dit"


def rms_norm(x, gain):
    xf = x.astype(jnp.float32)
    y = xf * lax.rsqrt(jnp.mean(xf * xf, axis=-1, keepdims=True) + EPS)
    return (y * gain.astype(jnp.float32)).astype(x.dtype)


def modulate(x, gain, shift, scale):
    return rms_norm(x, gain) * (1 + scale) + shift


def ada_mod(cond, w, b):
    m = jax.nn.silu(cond) @ w + b
    return [t[:, None, :] for t in jnp.split(m, 6, axis=-1)]


def split_columns(z):
    parts, start = [], 0
    for size in IN_SIZES:
        parts.append(z[..., start:start + size])
        start += size
    return parts


def axial_rope_tables(n):
    n_rows = n // GRID_W
    row = jnp.repeat(jnp.arange(n_rows), GRID_W, total_repeat_length=n).astype(jnp.float32)
    col = (jnp.arange(n) % GRID_W).astype(jnp.float32)
    per_axis = MLA_ROPE // 2
    freqs = ROPE_BASE ** (-jnp.arange(0, per_axis, 2, dtype=jnp.float32) / per_axis)
    ang = jnp.concatenate([row[:, None] * freqs, col[:, None] * freqs], axis=-1)
    return jnp.cos(ang), jnp.sin(ang)


def apply_rope(x, cos, sin):
    half = MLA_ROPE // 2
    c = cos[None, :, None, :]
    s = sin[None, :, None, :]
    x1, x2 = x[..., :half], x[..., half:]
    return jnp.concatenate([x1 * c - x2 * s, x2 * c + x1 * s], axis=-1).astype(x.dtype)


def centred_pool_minus_self(u):
    L = u.shape[1]
    uf = u.astype(jnp.float32)
    cs = jnp.concatenate([jnp.zeros_like(uf[:, :1]), jnp.cumsum(uf, axis=1)], axis=1)
    t = jnp.arange(L)
    outs = []
    for g, w in enumerate(POOL_WINDOWS):
        lo_c, hi_c = g * POOL_GROUP, (g + 1) * POOL_GROUP
        csg = cs[..., lo_c:hi_c]
        lo = jnp.clip(t - w // 2, 0, L)
        hi = jnp.clip(t + w // 2, 0, L)
        win_sum = jnp.take(csg, hi, axis=1) - jnp.take(csg, lo, axis=1)
        cnt = (hi - lo).astype(jnp.float32)[None, :, None]
        outs.append(win_sum / cnt - uf[..., lo_c:hi_c])
    return jnp.concatenate(outs, axis=-1).astype(u.dtype)


def pool_mixer(u, w_pool, scale):
    B, L, _ = u.shape
    d = centred_pool_minus_self(u).reshape(B, L, len(POOL_WINDOWS), POOL_GROUP)
    y = jnp.einsum('blgc,gce->blge', d, w_pool).reshape(B, L, POOL_WIDTH)
    return y * scale


def mla_qkv(zq, zkv, zkr, q_a_norm, kv_a_norm, w_uq, w_ukv, q_gain, k_gain, rope):
    B, L, _ = zq.shape
    q = (rms_norm(zq, q_a_norm) @ w_uq).reshape(B, L, MLA_HEADS, MLA_QK)
    kv = (rms_norm(zkv, kv_a_norm) @ w_ukv).reshape(B, L, MLA_HEADS, MLA_NOPE + MLA_V)
    k_rope = jnp.broadcast_to(zkr[:, :, None, :], (B, L, MLA_HEADS, MLA_ROPE))
    k = jnp.concatenate([kv[..., :MLA_NOPE], k_rope], axis=-1)
    v = kv[..., MLA_NOPE:]
    q = rms_norm(q, q_gain)
    k = rms_norm(k, k_gain)
    if rope is not None:
        cos, sin = rope
        q = jnp.concatenate([q[..., :MLA_NOPE], apply_rope(q[..., MLA_NOPE:], cos, sin)], axis=-1)
        k = jnp.concatenate([k[..., :MLA_NOPE], apply_rope(k[..., MLA_NOPE:], cos, sin)], axis=-1)
    return q, k, v


def attend(q, k, v):
    s = jnp.einsum('bqhd,bkhd->bhqk', q, k).astype(jnp.float32) * MLA_SCALE
    p = jax.nn.softmax(s, axis=-1).astype(v.dtype)
    return jnp.einsum('bhqk,bkhd->bqhd', p, v)


def blocked_attention(q, k, v):
    B, L, H, D = q.shape
    nb = L // Q_BLOCK
    qb = q.reshape(B, nb, Q_BLOCK, H, D).swapaxes(0, 1)
    out = lax.map(lambda qq: attend(qq, k, v), qb)
    return out.swapaxes(0, 1).reshape(B, L, H, v.shape[-1])


def zero_state(B):
    return (jnp.zeros((B, ML_HEADS, ML_DV, ML_DK), jnp.float32),
            jnp.zeros((B, ML_HEADS, ML_DK), jnp.float32),
            jnp.full((B, ML_HEADS), NEG_INIT, jnp.float32))


def mlstm_scan(q, k, v, log_i, log_f, state):
    B, L, H, _ = q.shape
    nc = L // ML_CHUNK

    def chunks(a):
        a = a.astype(jnp.float32)
        return a.reshape((B, nc, ML_CHUNK) + a.shape[2:]).swapaxes(0, 1)

    causal = jnp.tril(jnp.ones((ML_CHUNK, ML_CHUNK), dtype=bool))

    def step(carry, inp):
        C, n, m = carry
        qc, kc, vc, ic, fc = inp
        b = jnp.cumsum(fc, axis=1).swapaxes(1, 2)
        ih = ic.swapaxes(1, 2)
        dmat = b[..., :, None] - b[..., None, :] + ih[..., None, :]
        dmat = jnp.where(causal, dmat, -jnp.inf)
        inter = b + m[..., None]
        m_j = jnp.maximum(inter, dmat.max(axis=-1))
        w_inter = jnp.exp(inter - m_j)
        qk = jnp.einsum('bjhd,bshd->bhjs', qc, kc) * jnp.exp(dmat - m_j[..., None])
        num = (jnp.einsum('bhjs,bshv->bjhv', qk, vc)
               + jnp.einsum('bhvd,bjhd->bjhv', C, qc) * w_inter.swapaxes(1, 2)[..., None])
        den = qk.sum(axis=-1) + w_inter * jnp.einsum('bhd,bjhd->bhj', n, qc)
        denom = jnp.maximum(jnp.abs(den), jnp.exp(-m_j)).swapaxes(1, 2)[..., None]
        h = num / denom
        b_last = b[..., -1]
        dec = b_last[..., None] - b + ih
        m_new = jnp.maximum(b_last + m, dec.max(axis=-1))
        w_prev = jnp.exp(b_last + m - m_new)
        w_s = jnp.exp(dec - m_new[..., None])
        C_new = w_prev[..., None, None] * C + jnp.einsum('bhs,bshv,bshd->bhvd', w_s, vc, kc)
        n_new = w_prev[..., None] * n + jnp.einsum('bhs,bshd->bhd', w_s, kc)
        return (C_new, n_new, m_new), h

    final, hs = lax.scan(step, state, (chunks(q), chunks(k), chunks(v), chunks(log_i), chunks(log_f)))
    return hs.swapaxes(0, 1).reshape(B, L, H, v.shape[-1]), final


def mlstm_inputs(zq, zk, zv, zg, gate_bias):
    B, L, _ = zq.shape
    q = zq.reshape(B, L, ML_HEADS, ML_DK) * (ML_DK ** -0.5)
    k = zk.reshape(B, L, ML_HEADS, ML_DK)
    v = zv.reshape(B, L, ML_HEADS, ML_DV)
    g = (zg + gate_bias).astype(jnp.float32)
    i_f, f_f, i_b, f_b = jnp.split(g, 4, axis=-1)
    return q, k, v, (i_f, jax.nn.log_sigmoid(f_f)), (i_b, jax.nn.log_sigmoid(f_b))


def mlstm_bidir(q, k, v, gates_f, gates_b, st_f, st_b):
    h_f, st_f = mlstm_scan(q, k, v, gates_f[0], gates_f[1], st_f)
    flip = lambda a: jnp.flip(a, axis=1)
    h_b, st_b = mlstm_scan(flip(q), flip(k), flip(v), flip(gates_b[0]), flip(gates_b[1]), st_b)
    return (h_f + flip(h_b)).astype(q.dtype), st_f, st_b


def mlstm_out(h, o_pre, gain):
    B, L = h.shape[:2]
    o = jax.nn.sigmoid(o_pre).reshape(B, L, ML_HEADS, ML_DV)
    return (rms_norm(h, gain) * o).reshape(B, L, ML_WIDTH)


def peer_ffn(h, w_q, subkeys, u_tab, v_tab):
    B, L, D = h.shape
    hb_all = h.reshape((B * L) // PEER_BLOCK, PEER_BLOCK, D)

    def block(hb):
        P = hb.shape[0]
        q = (hb @ w_q).reshape(P, PEER_HEADS, 2, PEER_DKEY // 2)
        s = jnp.einsum('phcd,hcnd->phcn', q, subkeys).astype(jnp.float32)
        top_v, top_i = lax.top_k(s, PEER_TOPK)
        cand = top_v[:, :, 0, :, None] + top_v[:, :, 1, None, :]
        best, flat = lax.top_k(cand.reshape(P, PEER_HEADS, PEER_TOPK * PEER_TOPK), PEER_TOPK)
        i1 = jnp.take_along_axis(top_i[:, :, 0, :], flat // PEER_TOPK, axis=-1)
        i2 = jnp.take_along_axis(top_i[:, :, 1, :], flat % PEER_TOPK, axis=-1)
        expert = i1 * PEER_KEYS + i2
        g = jax.nn.softmax(best, axis=-1)
        a = jax.nn.gelu(jnp.einsum('pd,phkd->phk', hb, u_tab[expert]).astype(jnp.float32), approximate=False)
        w = (g * a).astype(hb.dtype)
        return jnp.einsum('phk,phkd->pd', w, v_tab[expert])

    return lax.map(block, hb_all).reshape(B, L, D)


def setup_inputs(seed: int = 0) -> dict:
    key = jax.random.key(seed)
    ks = jax.random.split(key, 32)
    nrm = lambda k, shape, s: jax.random.normal(k, shape, jnp.float32) * s
    D = D_MODEL
    i_bias = nrm(ks[20], (DEPTH, 2, ML_HEADS), 0.1)
    f_bias = 3.0 + nrm(ks[21], (DEPTH, 2, ML_HEADS), 0.5)
    gate_bias = jnp.stack([i_bias[:, 0], f_bias[:, 0], i_bias[:, 1], f_bias[:, 1]], axis=1).reshape(DEPTH, 4 * ML_HEADS)
    return {
        "x": nrm(ks[0], (BATCH, SEQ, D), 1.0),
        "c": nrm(ks[1], (BATCH, D), 1.0),
        "ctx": nrm(ks[2], (BATCH, CTX_LEN, D), 1.0),
        "c_ctx": nrm(ks[3], (D,), 1.0),
        "norm1_gain": 1.0 + nrm(ks[4], (DEPTH, D), 0.1),
        "norm2_gain": 1.0 + nrm(ks[5], (DEPTH, D), 0.1),
        "w_ada": nrm(ks[6], (DEPTH, D, 6 * D), 0.5 * D ** -0.5),
        "b_ada": nrm(ks[7], (DEPTH, 6 * D), 0.02),
        "w_in": nrm(ks[8], (DEPTH, D, IN_WIDTH), D ** -0.5),
        "pool_w": nrm(ks[9], (DEPTH, len(POOL_WINDOWS), POOL_GROUP, POOL_GROUP), POOL_GROUP ** -0.5),
        "pool_scale": 1.0 + nrm(ks[10], (DEPTH, POOL_WIDTH), 0.1),
        "mla_q_norm": 1.0 + nrm(ks[11], (DEPTH, MLA_Q_RANK), 0.1),
        "mla_kv_norm": 1.0 + nrm(ks[12], (DEPTH, MLA_KV_RANK), 0.1),
        "w_uq": nrm(ks[13], (DEPTH, MLA_Q_RANK, MLA_HEADS * MLA_QK), MLA_Q_RANK ** -0.5),
        "w_ukv": nrm(ks[14], (DEPTH, MLA_KV_RANK, MLA_HEADS * (MLA_NOPE + MLA_V)), MLA_KV_RANK ** -0.5),
        "q_norm": 1.0 + nrm(ks[15], (DEPTH, MLA_QK), 0.1),
        "k_norm": 1.0 + nrm(ks[16], (DEPTH, MLA_QK), 0.1),
        "ml_gate_bias": gate_bias,
        "ml_out_norm": 1.0 + nrm(ks[17], (DEPTH, ML_HEADS, ML_DV), 0.1),
        "w_out": nrm(ks[18], (DEPTH, MIX_WIDTH, D), MIX_WIDTH ** -0.5),
        "peer_wq": nrm(ks[19], (DEPTH, D, PEER_HEADS * PEER_DKEY), D ** -0.5),
        "peer_subkeys": nrm(ks[22], (DEPTH, PEER_HEADS, 2, PEER_KEYS, PEER_DKEY // 2), (PEER_DKEY // 2) ** -0.5),
        "peer_u": nrm(ks[23], (DEPTH, PEER_EXPERTS, D), D ** -0.5),
        "peer_v": nrm(ks[24], (DEPTH, PEER_EXPERTS, D), 1.0),
    }


def reference(x, c, ctx, c_ctx, norm1_gain, norm2_gain, w_ada, b_ada, w_in, pool_w, pool_scale,
              mla_q_norm, mla_kv_norm, w_uq, w_ukv, q_norm, k_norm, ml_gate_bias, ml_out_norm, w_out,
              peer_wq, peer_subkeys, peer_u, peer_v):
    B, S, _ = x.shape
    rope = axial_rope_tables(S)
    x_ctx = ctx
    for l in range(DEPTH):
        last = l == DEPTH - 1
        sh_a, sc_a, g_a, sh_f, sc_f, g_f = ada_mod(c, w_ada[l], b_ada[l])
        csh_a, csc_a, cg_a, csh_f, csc_f, cg_f = ada_mod(c_ctx[None], w_ada[l], b_ada[l])

        zc = split_columns(modulate(x_ctx, norm1_gain[l], csh_a, csc_a) @ w_in[l])
        qc, kc, vc = mla_qkv(zc[1], zc[2], zc[3], mla_q_norm[l], mla_kv_norm[l], w_uq[l], w_ukv[l],
                             q_norm[l], k_norm[l], None)
        mq, mk, mv, gf, gb = mlstm_inputs(zc[4], zc[5], zc[6], zc[8], ml_gate_bias[l])
        h_mc, st_f, st_b = mlstm_bidir(mq, mk, mv, gf, gb, zero_state(B), zero_state(B))
        if not last:
            pool_c = pool_mixer(zc[0], pool_w[l], pool_scale[l])
            attn_c = attend(qc, kc, vc).reshape(B, CTX_LEN, MLA_WIDTH)
            ml_c = mlstm_out(h_mc, zc[7], ml_out_norm[l])
            mix_c = jnp.concatenate([pool_c, attn_c, ml_c], axis=-1) @ w_out[l]
            x_ctx_new = x_ctx + cg_a * mix_c
            x_ctx_new = x_ctx_new + cg_f * peer_ffn(modulate(x_ctx_new, norm2_gain[l], csh_f, csc_f),
                                                    peer_wq[l], peer_subkeys[l], peer_u[l], peer_v[l])

        z = split_columns(modulate(x, norm1_gain[l], sh_a, sc_a) @ w_in[l])
        pool_x = pool_mixer(z[0], pool_w[l], pool_scale[l])
        q, k, v = mla_qkv(z[1], z[2], z[3], mla_q_norm[l], mla_kv_norm[l], w_uq[l], w_ukv[l],
                          q_norm[l], k_norm[l], rope)
        k_all = jnp.concatenate([k, kc], axis=1)
        v_all = jnp.concatenate([v, vc], axis=1)
        attn_x = blocked_attention(q, k_all, v_all).reshape(B, S, MLA_WIDTH)
        mq, mk, mv, gf, gb = mlstm_inputs(z[4], z[5], z[6], z[8], ml_gate_bias[l])
        h_m, _, _ = mlstm_bidir(mq, mk, mv, gf, gb, st_f, st_b)
        ml_x = mlstm_out(h_m, z[7], ml_out_norm[l])
        mix = jnp.concatenate([pool_x, attn_x, ml_x], axis=-1) @ w_out[l]
        x = x + g_a * mix
        x = x + g_f * peer_ffn(modulate(x, norm2_gain[l], sh_f, sc_f),
                               peer_wq[l], peer_subkeys[l], peer_u[l], peer_v[l])
        if not last:
            x_ctx = x_ctx_new
    return x
```

```cpp
#include <hip/hip_runtime.h>
#include <cstdio>
#include <cstdint>

namespace pg8 {
#define PG8_LAS __attribute__((address_space(3)))
typedef unsigned short bf16_t;
typedef short bf16x8 __attribute__((ext_vector_type(8)));
typedef float f32x4 __attribute__((ext_vector_type(4)));
typedef unsigned u32x4 __attribute__((ext_vector_type(4)));
constexpr int BM = 256, BK = 64, HALF = 128, HTB = HALF * BK * 2  , STAGE_BYTES = 8 * HTB, NXCD = 8, WGM = 8;

__host__ __device__ __forceinline__ int lds_byte(int r, int c) { const int st = (r >> 4) * 2 + (c >> 5), rr = r & 15, cc = c & 31, ob = rr * 64 + cc * 2; return st * 1024 + (ob ^ (((ob >> 9) & 1) << 5)); }
__host__ __device__ __forceinline__ void stage_rc(int b, int& R, int& C) { const int st = b / 1024, sb = b % 1024, swz = sb ^ (((sb >> 9) & 1) << 5); R = (st >> 1) * 16 + swz / 64; C = (st & 1) * 32 + (swz % 64) / 2; }
__host__ __device__ __forceinline__ int perm32(int rho) { const int n = rho >> 4, i = rho & 15; return 8 * (i >> 2) + 4 * n + (i & 3); }

struct Unit { int pm, pn; };
struct Gemm { const bf16_t* A; const bf16_t* Bt; int M, N, K; };

struct StaticOrder {
    int nM, nN, nwg, G, c;
    __host__ __device__ void init(int M, int N, int G_, int c_) { nM = M / BM; nN = N / BM; nwg = nM * nN; G = G_; c = c_; }
    __host__ __device__ bool next(int i, Unit& u) const {
        const long L = (long)i * G + c; if (L >= nwg) return false;
        int wgid = (int)L; { const int q = nwg / NXCD, r = nwg % NXCD, xcd = wgid % NXCD, off = wgid / NXCD; wgid = (xcd < r ? xcd * (q + 1) : r * (q + 1) + (xcd - r) * q) + off; }
        const int nig = WGM * nN, gid = wgid / nig, fm = gid * WGM, gsz = (nM - fm) < WGM ? (nM - fm) : WGM;
        u.pm = fm + ((wgid % nig) % gsz); u.pn = (wgid % nig) / gsz; return true;
    }
    __device__ __forceinline__ void a_ready(const Unit&) const {}
    __device__ __forceinline__ void done(const Unit&) const {}
};

__device__ __forceinline__ unsigned cvt_pk_bf16(float lo, float hi) { unsigned r; asm volatile("v_cvt_pk_bf16_f32 %0, %1, %2" : "=v"(r) : "v"(lo), "v"(hi)); return r; }
typedef float f32x2 __attribute__((ext_vector_type(2)));
__device__ __forceinline__ f32x2 gelu_pk(f32x2 v) {
    const f32x2 av = __builtin_elementwise_abs(v), d = av * 0.2316418882f + 1.0f;
    f32x2 t; t.x = __builtin_amdgcn_rcpf(d.x); t.y = __builtin_amdgcn_rcpf(d.y);
    f32x2 q = t * 0.5307027145f + (-0.7265760135f); q = q * t + 0.7107068705f; q = q * t + (-0.142248368f); q = q * t + 0.127414796f; q = q * t;
    const f32x2 s = (v * v) * (-0.72134752044f);
    f32x2 e; e.x = __builtin_amdgcn_exp2f(s.x); e.y = __builtin_amdgcn_exp2f(s.y);
    const f32x2 m = v * (q * e), r = v - m;
    f32x2 o; o.x = v.x < 0.f ? m.x : r.x; o.y = v.y < 0.f ? m.y : r.y; return o;
}

template <int ACT  > struct EpiBf16 {
    static constexpr bool PERM = true, AFTER_DRAIN = false; static_assert(ACT == 0 || ACT == 1, "EpiBf16: ACT is 0 (none) or 1 (gelu_pk)");
    bf16_t* O; int ldc; const float* bias; int split_cols; size_t split_stride; float scale0;
    __device__ __forceinline__ void operator()(const f32x4 (&acc)[2][2][4][2], const Unit& u, int wr, int wc, int fr, int fq) const {
        const int row0 = u.pm * BM + wr * 64 + fr; int colt = u.pn * BM; bf16_t* base = O;
        float sc = 1.f; if (split_cols) { const int t = colt / split_cols; base += (size_t)t * split_stride; colt -= t * split_cols; if (t == 0) sc = scale0; }
        const int col0 = colt + wc * 32 + 8 * fq, bcol0 = u.pn * BM + wc * 32 + 8 * fq;
        f32x4 bv[2][2];
#pragma unroll
        for (int bj = 0; bj < 2; ++bj)
#pragma unroll
            for (int n = 0; n < 2; ++n) bv[bj][n] = bias ? *(const f32x4*)(bias + bcol0 + bj * HALF + 4 * n) : (f32x4){0.f, 0.f, 0.f, 0.f};
#pragma unroll
        for (int ai = 0; ai < 2; ++ai)
#pragma unroll
            for (int m = 0; m < 4; ++m) { bf16_t* rowp = base + (size_t)(row0 + ai * HALF + m * 16) * ldc + col0;
#pragma unroll
                for (int bj = 0; bj < 2; ++bj) { f32x4 v0 = acc[ai][bj][m][0] + bv[bj][0], v1 = acc[ai][bj][m][1] + bv[bj][1];
                    if (ACT == 1) { f32x2 a = gelu_pk((f32x2){v0[0], v0[1]}), b = gelu_pk((f32x2){v0[2], v0[3]}), c = gelu_pk((f32x2){v1[0], v1[1]}), d = gelu_pk((f32x2){v1[2], v1[3]});
                        v0 = (f32x4){a.x, a.y, b.x, b.y}; v1 = (f32x4){c.x, c.y, d.x, d.y}; }
                    v0 = v0 * sc; v1 = v1 * sc; u32x4 w; w.x = cvt_pk_bf16(v0[0], v0[1]); w.y = cvt_pk_bf16(v0[2], v0[3]); w.z = cvt_pk_bf16(v1[0], v1[1]); w.w = cvt_pk_bf16(v1[2], v1[3]);
                    *(u32x4*)(rowp + bj * HALF) = w; } }
    }
};


struct EpiResGate {
    static constexpr bool PERM = false, AFTER_DRAIN = false;
    const float* base_lat; const float* base_ctx; float* out_lat; float* out_ctx; const float* gate;
    int goff;
    __device__ __forceinline__ void operator()(const f32x4 (&acc)[2][2][4][2], const Unit& u, int wr, int wc, int fr, int fq) const {
        const int rowt = u.pm * BM; const bool lat = rowt < 32768;
        const int nsel = lat ? (rowt >> 14) : 2;
        const float* bs = lat ? base_lat + (size_t)rowt * 1024 : base_ctx + (size_t)(rowt - 32768) * 1024;
        float* os = lat ? out_lat + (size_t)rowt * 1024 : out_ctx + (size_t)(rowt - 32768) * 1024;
        const float* gv = gate + nsel * 6144 + goff;
        const int rl = wr * 64 + fr, col0 = u.pn * BM + wc * 32 + 4 * fq;
        f32x4 g[2][2];
#pragma unroll
        for (int bj = 0; bj < 2; ++bj)
#pragma unroll
            for (int n = 0; n < 2; ++n) g[bj][n] = *(const f32x4*)(gv + col0 + bj * HALF + n * 16);
#pragma unroll
        for (int ai = 0; ai < 2; ++ai)
#pragma unroll
            for (int m = 0; m < 4; ++m) { const size_t ro = (size_t)(rl + ai * HALF + m * 16) * 1024 + col0;
#pragma unroll
                for (int bj = 0; bj < 2; ++bj)
#pragma unroll
                    for (int n = 0; n < 2; ++n) { const f32x4 b = *(const f32x4*)(bs + ro + bj * HALF + n * 16); *(f32x4*)(os + ro + bj * HALF + n * 16) = b + g[bj][n] * acc[ai][bj][m][n]; } }
    }
};

template <class Epi, class Sched, bool ALIGN_EPI = false, bool SP2 = false>
__device__ __forceinline__ void gemm_phase(PG8_LAS unsigned char* lds, const Gemm g, const Sched& S, const Epi& E) {
    int tid_l = threadIdx.x; asm volatile("" : "+v"(tid_l));
    const int tid = tid_l, wid = __builtin_amdgcn_readfirstlane(tid >> 6), lane = tid & 63, wr = wid >> 2, wc = wid & 3, fr = lane & 15, fq = lane >> 4;
    const int K = g.K, nt = K / BK;
    unsigned voffA[2], voffB[2];
#pragma unroll
    for (int i = 0; i < 2; ++i) { int R, C; stage_rc(tid * 16 + i * 8192, R, C); const int Rb = Epi::PERM ? ((R & ~31) + perm32(R & 31)) : R;
        voffA[i] = (unsigned)(R * K + C) * 2u; voffB[i] = (unsigned)(Rb * K + C) * 2u; }
    const size_t kstep = (size_t)(BK * 2);
    const size_t hstep = (size_t)HALF * K * 2;
    const size_t tstep = 2 * hstep;
    const unsigned ldsw = (unsigned)wid * 1024u;
    const int aoff = lds_byte(wr * 64 + fr, fq * 8), boff = lds_byte(wc * 32 + fr, fq * 8);
#define PG8_SA(b, h) (((b) * 2 + (h)) * HTB)
#define PG8_SB(b, h) ((4 + (b) * 2 + (h)) * HTB)
#define PG8_STAGE(bufoff, gbase, voff) do { _Pragma("unroll") for (int _i = 0; _i < 2; ++_i) \
        __builtin_amdgcn_global_load_lds((const unsigned*)((const char*)(gbase) + (voff)[_i]), (PG8_LAS unsigned*)(lds + (bufoff) + ldsw + _i * 8192), 16, 0, 0); } while (0)
#define PG8_LDA(dst, b, h) do { _Pragma("unroll") for (int m = 0; m < 4; ++m) _Pragma("unroll") for (int k = 0; k < 2; ++k) dst[m][k] = *(const PG8_LAS bf16x8*)(lds + PG8_SA(b, h) + aoff + m * 2048 + k * 1024); } while (0)
#define PG8_LDB(dst, b, h) do { _Pragma("unroll") for (int n = 0; n < 2; ++n) _Pragma("unroll") for (int k = 0; k < 2; ++k) dst[n][k] = *(const PG8_LAS bf16x8*)(lds + PG8_SB(b, h) + boff + n * 2048 + k * 1024); } while (0)
#define PG8_MMA(ai, bj, At, Bt) do { __builtin_amdgcn_s_setprio(1); _Pragma("unroll") for (int m = 0; m < 4; ++m) _Pragma("unroll") for (int n = 0; n < 2; ++n) _Pragma("unroll") for (int k = 0; k < 2; ++k) \
        acc[ai][bj][m][n] = __builtin_amdgcn_mfma_f32_16x16x32_bf16(Bt[n][k], At[m][k], acc[ai][bj][m][n], 0, 0, 0); __builtin_amdgcn_s_setprio(0); } while (0)
#define PG8_WAIT_V(n) asm volatile("s_waitcnt vmcnt(" #n ")" ::: "memory")
#define PG8_WAIT_L(n) asm volatile("s_waitcnt lgkmcnt(" #n ")" ::: "memory")
#define PG8_BAR __builtin_amdgcn_s_barrier()
#define PG8_SCHED __builtin_amdgcn_sched_barrier(0)
    Unit cur, nxt; int ui = 0;
    if (!S.next(0, cur)) return;
    f32x4 acc[2][2][4][2];
#pragma unroll
    for (int a = 0; a < 2; ++a)
#pragma unroll
        for (int b = 0; b < 2; ++b)
#pragma unroll
            for (int m = 0; m < 4; ++m)
#pragma unroll
                for (int n = 0; n < 2; ++n) acc[a][b][m][n] = (f32x4){0.f, 0.f, 0.f, 0.f};
    bf16x8 At[4][2], B0[2][2], B1[2][2];
    const char* cA = (const char*)g.A + (size_t)cur.pm * tstep; const char* cB = (const char*)g.Bt + (size_t)cur.pn * tstep;
    S.a_ready(cur);
    if constexpr (SP2) {
        PG8_STAGE(PG8_SB(0, 0), cB, voffB); PG8_STAGE(PG8_SB(0, 1), cB + hstep, voffB); PG8_STAGE(PG8_SA(0, 0), cA, voffA); PG8_STAGE(PG8_SA(0, 1), cA + hstep, voffA);
        if (wr == 1) PG8_BAR;
        PG8_WAIT_V(2); PG8_BAR;
        PG8_STAGE(PG8_SB(1, 0), cB + kstep, voffB); PG8_STAGE(PG8_SA(1, 0), cA + kstep, voffA); PG8_STAGE(PG8_SB(1, 1), cB + hstep + kstep, voffB);
        PG8_WAIT_V(6); PG8_BAR;
    } else {
        PG8_STAGE(PG8_SB(0, 0), cB, voffB); PG8_STAGE(PG8_SA(0, 0), cA, voffA); PG8_STAGE(PG8_SB(0, 1), cB + hstep, voffB); PG8_STAGE(PG8_SA(0, 1), cA + hstep, voffA);
        if (wr == 1) PG8_BAR;
        PG8_WAIT_V(4); PG8_BAR;
        PG8_STAGE(PG8_SB(1, 0), cB + kstep, voffB); PG8_STAGE(PG8_SA(1, 0), cA + kstep, voffA); PG8_STAGE(PG8_SB(1, 1), cB + hstep + kstep, voffB);
        PG8_WAIT_V(6); PG8_BAR;
    }
    for (;;) {
        const bool has_next = S.next(ui + 1, nxt);
        const char* nA = has_next ? (const char*)g.A + (size_t)nxt.pm * tstep : cA; const char* nB = has_next ? (const char*)g.Bt + (size_t)nxt.pn * tstep : cB;
        for (int t = 0; t < nt; t += 2) {
            const bool last = (t == nt - 2);
            const char* a1 = cA + (size_t)(t + 1) * kstep;
            const char* a2 = last ? nA : cA + (size_t)(t + 2) * kstep; const char* b2 = last ? nB : cB + (size_t)(t + 2) * kstep;
            const char* a3 = a2 + kstep; const char* b3 = b2 + kstep;
            if (last && has_next) S.a_ready(nxt);
            if constexpr (SP2) {
            PG8_LDB(B0, 0, 0); PG8_LDB(B1, 0, 1); PG8_SCHED; PG8_LDA(At, 0, 0); PG8_STAGE(PG8_SA(1, 1), a1 + hstep, voffA);
            PG8_WAIT_V(8); PG8_WAIT_L(0); PG8_BAR; PG8_MMA(0, 0, At, B0); PG8_MMA(0, 1, At, B1); PG8_BAR; PG8_SCHED;
            PG8_LDA(At, 0, 1); PG8_STAGE(PG8_SB(0, 0), b2, voffB); PG8_STAGE(PG8_SB(0, 1), b2 + hstep, voffB); PG8_STAGE(PG8_SA(0, 0), a2, voffA);
            PG8_WAIT_V(8); PG8_WAIT_L(0); PG8_BAR; PG8_MMA(1, 0, At, B0); PG8_MMA(1, 1, At, B1); PG8_BAR; PG8_SCHED;
            PG8_LDB(B0, 1, 0); PG8_LDB(B1, 1, 1); PG8_SCHED; PG8_LDA(At, 1, 0); PG8_STAGE(PG8_SA(0, 1), a2 + hstep, voffA);
            PG8_WAIT_V(8); PG8_WAIT_L(0); PG8_BAR; PG8_MMA(0, 0, At, B0); PG8_MMA(0, 1, At, B1); PG8_BAR; PG8_SCHED;
            PG8_LDA(At, 1, 1); PG8_STAGE(PG8_SB(1, 0), b3, voffB); PG8_STAGE(PG8_SB(1, 1), b3 + hstep, voffB); PG8_STAGE(PG8_SA(1, 0), a3, voffA);
            PG8_WAIT_V(8); PG8_WAIT_L(0); PG8_BAR; PG8_MMA(1, 0, At, B0); PG8_MMA(1, 1, At, B1); PG8_BAR; PG8_SCHED;
            } else {
            PG8_LDB(B0, 0, 0); PG8_SCHED; PG8_LDA(At, 0, 0); PG8_STAGE(PG8_SA(1, 1), a1 + hstep, voffA);
            PG8_WAIT_L(8); PG8_BAR; PG8_WAIT_L(0); PG8_MMA(0, 0, At, B0); PG8_BAR; PG8_SCHED;
            PG8_LDB(B1, 0, 1); PG8_STAGE(PG8_SB(0, 0), b2, voffB);
            PG8_BAR; PG8_WAIT_L(0); PG8_MMA(0, 1, At, B1); PG8_BAR;
            PG8_LDA(At, 0, 1); PG8_STAGE(PG8_SA(0, 0), a2, voffA);
            PG8_BAR; PG8_WAIT_L(0); PG8_MMA(1, 0, At, B0); PG8_BAR; PG8_SCHED;
            PG8_STAGE(PG8_SB(0, 1), b2 + hstep, voffB);
            PG8_WAIT_V(6); PG8_BAR; PG8_MMA(1, 1, At, B1); PG8_BAR;
            PG8_LDB(B0, 1, 0); PG8_SCHED; PG8_LDA(At, 1, 0); PG8_STAGE(PG8_SA(0, 1), a2 + hstep, voffA);
            PG8_WAIT_L(8); PG8_BAR; PG8_WAIT_L(0); PG8_MMA(0, 0, At, B0); PG8_BAR; PG8_SCHED;
            PG8_LDB(B1, 1, 1); PG8_STAGE(PG8_SB(1, 0), b3, voffB);
            PG8_BAR; PG8_WAIT_L(0); PG8_MMA(0, 1, At, B1); PG8_BAR;
            PG8_LDA(At, 1, 1); PG8_STAGE(PG8_SA(1, 0), a3, voffA);
            PG8_BAR; PG8_WAIT_L(0); PG8_MMA(1, 0, At, B0); PG8_BAR; PG8_SCHED;
            PG8_STAGE(PG8_SB(1, 1), b3 + hstep, voffB);
            PG8_WAIT_V(6); PG8_BAR; PG8_MMA(1, 1, At, B1); PG8_BAR;
            }
        }
        if constexpr (ALIGN_EPI) { if (wr == 0) PG8_BAR; }
        if constexpr (!Epi::AFTER_DRAIN) { E(acc, cur, wr, wc, fr, fq); S.done(cur); }
        if (!has_next) break;
#pragma unroll
        for (int a = 0; a < 2; ++a)
#pragma unroll
            for (int b = 0; b < 2; ++b)
#pragma unroll
                for (int m = 0; m < 4; ++m)
#pragma unroll
                    for (int n = 0; n < 2; ++n) acc[a][b][m][n] = (f32x4){0.f, 0.f, 0.f, 0.f};
        cur = nxt; cA = nA; cB = nB; ++ui;
        if constexpr (ALIGN_EPI) { if (wr == 1) PG8_BAR; }
    }
    PG8_WAIT_V(0);
    if constexpr (!ALIGN_EPI) { if (wr == 0) PG8_BAR; }
    PG8_BAR;
    if constexpr (Epi::AFTER_DRAIN) { E.fused(acc, cur, wr, wc, fr, fq, lds, wid, lane); S.done(cur); }
#undef PG8_SA
#undef PG8_SB
#undef PG8_STAGE
#undef PG8_LDA
#undef PG8_LDB
#undef PG8_MMA
#undef PG8_WAIT_V
#undef PG8_WAIT_L
#undef PG8_BAR
#undef PG8_SCHED
}
}

constexpr int DM = 1024, NB = 2, SEQ = 16384, CTXL = 256, RL = NB * SEQ, RC = NB * CTXL, RT = RL + RC;
constexpr int NKT = (SEQ + CTXL) / 64;
constexpr int KT_BYTES = 64 * 128, VT_BYTES = 64 * 128;
constexpr int NCH = 260, CSTF = 4160;
constexpr float EPS = 1e-6f;
constexpr float QSCALE = 0.10206207261596577f * 1.4426950408889634f;
constexpr int NPH_L = 13, NPHASES = 1 + 2 * NPH_L;


constexpr size_t MiB = 1u << 20;
constexpr size_t WS_CTL = 0, CTL_ZERO_BYTES = 64 * 1024;
constexpr size_t WS_WIN = 1 * MiB, WS_WUQ = 9 * MiB, WS_WUKV = 11 * MiB, WS_WOUT = 12 * MiB, WS_WPQ = 16 * MiB, WS_SUBK = 24 * MiB;
constexpr size_t WS_MOD = 25 * MiB, WS_ROPE = 25 * MiB + 256 * 1024, WS_SC = 25 * MiB + 512 * 1024, WS_MS = WS_SC + 64 * 1024;
constexpr size_t WS_CTXS = 26 * MiB, WS_G = 28 * MiB, WS_KR = 31 * MiB, WS_TABU = 34 * MiB, WS_TABV = 66 * MiB;
constexpr size_t WS_ZA = 98 * MiB, WS_ZB = 163 * MiB, WS_Q = WS_ZA, WS_PQ = WS_ZA;
constexpr size_t WS_XN = 228 * MiB, WS_QA = WS_XN, WS_KVA = 253 * MiB, WS_VT = WS_XN;
constexpr size_t WS_MIX = 293 * MiB, WS_R66 = 358 * MiB, WS_KVRAW = WS_R66, WS_CST = WS_R66, WS_EID = WS_R66, WS_GATE = WS_R66 + 17 * MiB;
constexpr size_t WS_KN = 425 * MiB, WS_Q8 = 458 * MiB, WS_MODP = 491 * MiB, WS_END = 493 * MiB;
static_assert(WS_QA + (size_t)RT * 384 * 2 <= WS_KVA && WS_KVA + (size_t)RT * 256 * 2 <= WS_MIX, "QA/KVA inside the XN region");
static_assert(WS_VT + (size_t)NB * 8 * NKT * VT_BYTES <= WS_MIX, "Vt inside the XN region");
static_assert(WS_CST + (size_t)16 * NCH * CSTF * 4 <= WS_KN && WS_KVRAW + (size_t)RT * 1024 * 2 <= WS_KN, "R66 region");
static_assert(WS_KN + (size_t)NB * 8 * NKT * KT_BYTES <= WS_Q8 && WS_Q8 + (size_t)RT * 1024 <= WS_MODP, "Kn / Q8 regions");
static_assert(WS_G + (size_t)RT * 16 * 4 <= WS_KR && WS_KR + (size_t)RT * 32 * 2 <= WS_TABU, "G/KR");
constexpr int CW_BAR = 1024;

constexpr int LDS_BYTES = 147456, MISC_OFF = 143360;

#define LAS __attribute__((address_space(3)))
typedef unsigned short bf16;
typedef short bf16x8 __attribute__((ext_vector_type(8)));
typedef float f32x4 __attribute__((ext_vector_type(4)));
typedef float f32x16 __attribute__((ext_vector_type(16)));
typedef unsigned u32x4 __attribute__((ext_vector_type(4)));
typedef unsigned u32x2 __attribute__((ext_vector_type(2)));
#define LDS_WAIT() asm volatile("s_waitcnt lgkmcnt(0)" ::: "memory")

typedef float f32x2_t __attribute__((ext_vector_type(2))); typedef __bf16 bf16x2_t __attribute__((ext_vector_type(2)));
__device__ __forceinline__ unsigned pk2(float lo, float hi) { f32x2_t v = {lo, hi}; bf16x2_t b = __builtin_convertvector(v, bf16x2_t); return __builtin_bit_cast(unsigned, b); }
__device__ __forceinline__ unsigned f2bf(float f) { return pk2(f, 0.f) & 0xffffu; }
__device__ __forceinline__ float bflo(unsigned w) { return __builtin_bit_cast(float, w << 16); }
__device__ __forceinline__ float bfhi(unsigned w) { return __builtin_bit_cast(float, w & 0xffff0000u); }
__device__ __forceinline__ float bf2f(bf16 v) { return __builtin_bit_cast(float, (unsigned)v << 16); }
__device__ __forceinline__ float shfl_idx(float v, int srclane) { return __builtin_bit_cast(float, __builtin_amdgcn_ds_bpermute(srclane << 2, __builtin_bit_cast(int, v))); }
__device__ __forceinline__ int shfl_idx(int v, int srclane) { return __builtin_amdgcn_ds_bpermute(srclane << 2, v); }
#define DPP_ADD(v, ctrl) (v) += __builtin_bit_cast(float, __builtin_amdgcn_update_dpp(0, __builtin_bit_cast(int, (v)), (ctrl), 0xf, 0xf, true))
__device__ __forceinline__ float wave_sum(float v, int lane) {
    (void)lane;
    DPP_ADD(v, 0xB1);
    DPP_ADD(v, 0x4E);
    DPP_ADD(v, 0x141);
    DPP_ADD(v, 0x140);
    const int b = __builtin_bit_cast(int, v);
    return (__builtin_bit_cast(float, __builtin_amdgcn_readlane(b, 0)) + __builtin_bit_cast(float, __builtin_amdgcn_readlane(b, 16))) +
           (__builtin_bit_cast(float, __builtin_amdgcn_readlane(b, 32)) + __builtin_bit_cast(float, __builtin_amdgcn_readlane(b, 48)));
}
__device__ __forceinline__ float wave_max(float v, int lane) {
#pragma unroll
    for (int o = 1; o < 64; o <<= 1) v = fmaxf(v, shfl_idx(v, lane ^ o));
    return v;
}
__device__ __forceinline__ int crow(int g, int hh) { return (g & 3) + 8 * (g >> 2) + 4 * hh; }
__device__ __forceinline__ bf16x8 pack8(float a0, float a1, float a2, float a3, float a4, float a5, float a6, float a7) {
    u32x4 w; w.x = pk2(a0, a1); w.y = pk2(a2, a3); w.z = pk2(a4, a5); w.w = pk2(a6, a7); return __builtin_bit_cast(bf16x8, w);
}
__device__ __forceinline__ float gelu_f(float v) {
    const float av = fabsf(v), d = av * 0.2316418882f + 1.0f; const float t = __builtin_amdgcn_rcpf(d);
    float q = t * 0.5307027145f + (-0.7265760135f); q = q * t + 0.7107068705f; q = q * t + (-0.142248368f); q = q * t + 0.127414796f; q = q * t;
    const float e = __builtin_amdgcn_exp2f(v * v * (-0.72134752044f));
    const float mm = v * (q * e); return v < 0.f ? mm : v - mm;
}
#define MFMA32(a, b, c) __builtin_amdgcn_mfma_f32_32x32x16_bf16((a), (b), (c), 0, 0, 0)
#define ML_ZERO16 (f32x16){0.f, 0.f, 0.f, 0.f, 0.f, 0.f, 0.f, 0.f, 0.f, 0.f, 0.f, 0.f, 0.f, 0.f, 0.f, 0.f}

#define XB_TMO      128
#define XB_XCNT(j)  (256  + 64 * (j))
#define XB_XSUB(j)  (1280 + 64 * (j))
#define XB_XGEN(j)  (2304 + 64 * (j))
#define XB_TOP      3328
#define XB_TOPGEN   3392
#define XCD_BAR_WORDS 3456
#define XB_SPIN_CAP (1u << 18)
__device__ __forceinline__ unsigned xb_ld(unsigned* p)              { return __hip_atomic_load(p, __ATOMIC_RELAXED, __HIP_MEMORY_SCOPE_AGENT); }
__device__ __forceinline__ unsigned xb_add(unsigned* p, unsigned v) { return __hip_atomic_fetch_add(p, v, __ATOMIC_RELAXED, __HIP_MEMORY_SCOPE_AGENT); }
__device__ __forceinline__ unsigned xb_xcc_id() { return (unsigned)__builtin_amdgcn_s_getreg((3 << 11) | 20) & 0xFu; }
#define XB_SPIN(cond, bar) do { unsigned _sp = 0; while (cond) { __builtin_amdgcn_s_sleep(1); \
    if ((++_sp & 255u) == 0u) { if (xb_ld(&(bar)[XB_TMO])) break; if (_sp > XB_SPIN_CAP) { atomicAdd(&(bar)[XB_TMO], 1u); break; } } } } while (0)
struct XcdBarrier { unsigned* bar; unsigned x; volatile LAS unsigned* st; };
__device__ __forceinline__ XcdBarrier xcd_barrier_post(unsigned* bar, volatile LAS unsigned* st) {
    XcdBarrier b; b.bar = bar; b.x = xb_xcc_id(); b.st = st;
    if (threadIdx.x == 0) (void)xb_add(&bar[XB_XCNT(b.x)], 1u);
    return b;
}
__device__ __forceinline__ void xcd_barrier_complete(unsigned* bar, unsigned x, unsigned& nloc, unsigned& nx) {
    const unsigned G = gridDim.x * gridDim.y * gridDim.z;
    unsigned sum, cnt, mine, sp = 0u;
    for (;;) {
        sum = 0u; cnt = 0u; mine = 0u;
#pragma unroll
        for (unsigned j = 0; j < 16; ++j) { const unsigned c = xb_ld(&bar[XB_XCNT(j)]); sum += c; cnt += (c > 0u) ? 1u : 0u; mine = (j == x) ? c : mine; }
        if (sum == G) break;
        __builtin_amdgcn_s_sleep(1);
        if ((++sp & 255u) == 0u) { if (xb_ld(&bar[XB_TMO])) break; if (sp > XB_SPIN_CAP) { atomicAdd(&bar[XB_TMO], 1u); break; } }
    }
    nloc = mine > 0u ? mine : 1u; nx = cnt > 0u ? cnt : 1u;
}
__device__ __forceinline__ void xcd_barrier(const XcdBarrier& b) {
    asm volatile("s_waitcnt vmcnt(0)" ::: "memory");
    __syncthreads();
    if (threadIdx.x == 0) {
        unsigned* bar = b.bar;
        __builtin_amdgcn_s_waitcnt(0);
        unsigned nloc = b.st[0], nx = b.st[1];
        if (nloc == 0u) { xcd_barrier_complete(bar, b.x, nloc, nx); b.st[0] = nloc; b.st[1] = nx; }
        const unsigned old = xb_add(&bar[XB_XSUB(b.x)], 1u);
        const unsigned gen = old / nloc;
        if (old + 1u == (gen + 1u) * nloc) {
            __builtin_amdgcn_fence(__ATOMIC_RELEASE, "agent");
            asm volatile("s_waitcnt vmcnt(0)" ::: "memory");
            const unsigned og = xb_add(&bar[XB_TOP], 1u);
            const unsigned tg = og / nx;
            if (og + 1u == (tg + 1u) * nx) xb_add(&bar[XB_TOPGEN], 1u);
            else XB_SPIN(xb_ld(&bar[XB_TOPGEN]) == tg, bar);
            __builtin_amdgcn_fence(__ATOMIC_ACQUIRE, "agent");
            xb_add(&bar[XB_XGEN(b.x)], 1u);
            asm volatile("s_waitcnt vmcnt(0)" ::: "memory");
        } else {
            XB_SPIN(xb_ld(&bar[XB_XGEN(b.x)]) == gen, bar);
            __builtin_amdgcn_fence(__ATOMIC_ACQUIRE, "agent");
            asm volatile("s_waitcnt vmcnt(0)" ::: "memory");
        }
    }
    __syncthreads();
}

struct Args { const float* in[24]; float* out; unsigned char* ws; int ph_lo, ph_hi; };
#define CAS __attribute__((address_space(4)))
typedef const CAS unsigned char* karg_t;
struct KA { karg_t p;
    __device__ __forceinline__ const float* in(int k) const { return *(const float* const CAS*)(p + 8 * k); }
    __device__ __forceinline__ float* out() const { return *(float* const CAS*)(p + 192); }
    __device__ __forceinline__ unsigned char* ws() const { return *(unsigned char* const CAS*)(p + 200); }
    __device__ __forceinline__ int ph_lo() const { return *(const int CAS*)(p + 208); }
    __device__ __forceinline__ int ph_hi() const { return *(const int CAS*)(p + 212); }
};
static_assert(sizeof(Args) == 216, "Args layout");
__device__ __forceinline__ KA ka_fresh() { KA a; a.p = (karg_t)__builtin_amdgcn_kernarg_segment_ptr(); asm volatile("" : "+s"(a.p)); return a; }
struct Ctx {
    LAS unsigned char* lds;
    int tid, lane, wave, G, bid;
};
__device__ __forceinline__ Ctx ctx_fresh() {
    extern __shared__ __attribute__((aligned(16))) unsigned char lds_raw[];
    Ctx C; C.lds = (LAS unsigned char*)lds_raw; int t = threadIdx.x; asm volatile("" : "+v"(t));
    C.tid = t; C.lane = t & 63; C.wave = __builtin_amdgcn_readfirstlane(t >> 6); C.G = gridDim.x; C.bid = blockIdx.x; return C;
}
__device__ __forceinline__ const float* stream_in(const KA& A, const Ctx& C, int l, int row) {
    if (row < RL) return (l == 0 ? A.in(0) : (const float*)A.out()) + (size_t)row * DM;
    return (l == 0 ? A.in(2) : (const float*)(A.ws() + WS_CTXS)) + (size_t)(row - RL) * DM;
}
__device__ __forceinline__ float* stream_out(const KA& A, const Ctx& C, int row) {
    if (row < RL) return A.out() + (size_t)row * DM;
    return (float*)(A.ws() + WS_CTXS) + (size_t)(row - RL) * DM;
}

__device__ __forceinline__ void p0_transpose_item(const float* W, int K, int N, bf16* WT, int n0, int dst_row0, LAS float* scr, int kb, int lane) {
    const int k0 = 64 * kb;
#pragma unroll 8
    for (int i = 0; i < 32; ++i) { const int kk = 2 * i + (lane >> 5); const int n = n0 + (lane & 31); scr[kk * 33 + (lane & 31)] = (n < N) ? W[(size_t)(k0 + kk) * N + n] : 0.f; }
    LDS_WAIT(); asm volatile("" ::: "memory");
    const int c = lane & 7;
#pragma unroll
    for (int j = 0; j < 4; ++j) { const int n = (lane >> 3) + 8 * j; const LAS float* s = scr + (8 * c) * 33 + n;
        u32x4 o; o.x = pk2(s[0 * 33], s[1 * 33]); o.y = pk2(s[2 * 33], s[3 * 33]); o.z = pk2(s[4 * 33], s[5 * 33]); o.w = pk2(s[6 * 33], s[7 * 33]);
        *(u32x4*)(WT + (size_t)(dst_row0 + n) * K + k0 + 8 * c) = o; }
    LDS_WAIT(); asm volatile("" ::: "memory");
}
__device__ __forceinline__ void p0_poolw_item(const float* Win, const float* Wp, bf16* WT, LAS float* scr, int kb, int nb, int lane) {
    const int k0 = 64 * kb, g = nb >> 1, e = (nb & 1) * 32 + (lane & 31);
    float wc[64];
#pragma unroll
    for (int c = 0; c < 64; ++c) wc[c] = Wp[((size_t)g * 64 + c) * 64 + e];
#pragma unroll 2
    for (int i = 0; i < 32; ++i) { const int kk = 2 * i + (lane >> 5); const float* wr = Win + (size_t)(k0 + kk) * 1968 + g * 64; float a = 0.f;
#pragma unroll
        for (int c4 = 0; c4 < 16; ++c4) { const f32x4 x = *(const f32x4*)(wr + 4 * c4); a += x.x * wc[4 * c4] + x.y * wc[4 * c4 + 1] + x.z * wc[4 * c4 + 2] + x.w * wc[4 * c4 + 3]; }
        scr[kk * 33 + (lane & 31)] = a; }
    LDS_WAIT(); asm volatile("" ::: "memory");
    const int c = lane & 7;
#pragma unroll
    for (int j = 0; j < 4; ++j) { const int n = (lane >> 3) + 8 * j; const LAS float* sp = scr + (8 * c) * 33 + n;
        u32x4 o; o.x = pk2(sp[0 * 33], sp[1 * 33]); o.y = pk2(sp[2 * 33], sp[3 * 33]); o.z = pk2(sp[4 * 33], sp[5 * 33]); o.w = pk2(sp[6 * 33], sp[7 * 33]);
        *(u32x4*)(WT + (size_t)(32 * nb + n) * DM + k0 + 8 * c) = o; }
    LDS_WAIT(); asm volatile("" ::: "memory");
}
__device__ __forceinline__ void phase_prologue() {
    const KA A = ka_fresh(); const Ctx C = ctx_fresh();
    LAS float* scr = (LAS float*)(C.lds + C.wave * 16384);
    const int gw = C.bid * 8 + C.wave, NGW = C.G * 8, lane = C.lane;
    float* MODP = (float*)(A.ws() + WS_MODP);
    for (int it = gw; it < 2 * 96 * 8; it += NGW) {
        const int ks = it & 7, l = (it >> 3) / 96, j = ((it >> 3) % 96) * 64 + lane;
        const float* W = A.in(6) + ((size_t)l * DM + ks * 128) * 6144 + j;
        const float* c01 = A.in(1) + ks * 128; const float* c2p = A.in(3) + ks * 128;
        float a0 = 0.f, a1 = 0.f, a2 = 0.f;
#pragma unroll 16
        for (int k = 0; k < 128; ++k) {
            const float w = W[(size_t)k * 6144];
            const float c0 = c01[k], c1 = c01[DM + k], c2 = c2p[k];
            a0 += (c0 / (1.f + __expf(-c0))) * w; a1 += (c1 / (1.f + __expf(-c1))) * w; a2 += (c2 / (1.f + __expf(-c2))) * w;
        }
        float* mp = MODP + ((size_t)(l * 8 + ks) * 3) * 6144 + j;
        mp[0] = a0; mp[6144] = a1; mp[2 * 6144] = a2;
    }
    constexpr int I_IN = 16 * 64, I_UQ = 6 * 24, I_UKV = 4 * 32, I_OUT = 16 * 32, I_PQ = 16 * 64, I_L = I_IN + I_UQ + I_UKV + I_OUT + I_PQ;
    for (int it = gw; it < 2 * I_L; it += NGW) {
        const int l = it / I_L; int r = it % I_L;
        if (r < I_IN) {
            const int kb = r / 64, nb = r % 64;
            if (nb < 8) { p0_poolw_item(A.in(8) + (size_t)l * DM * 1968, A.in(9) + (size_t)l * 4 * 64 * 64, (bf16*)(A.ws() + WS_WIN) + (size_t)l * 2048 * DM, scr, kb, nb, lane); continue; }
            const int dst = nb < 29 ? 32 * nb : (nb < 61 ? 96 + 32 * nb : (nb == 61 ? 928 : (nb == 62 ? 960 : 992)));
            const int n0 = nb < 62 ? 32 * nb : 4096;
            p0_transpose_item(A.in(8) + (size_t)l * DM * 1968, DM, 1968, (bf16*)(A.ws() + WS_WIN) + (size_t)l * 2048 * DM, n0, dst, scr, kb, lane); continue; }
        r -= I_IN;
        if (r < I_UQ) { const int kb = r / 24, nb = r % 24; p0_transpose_item(A.in(13) + (size_t)l * 384 * 768, 384, 768, (bf16*)(A.ws() + WS_WUQ) + (size_t)l * 768 * 384, 32 * nb, 32 * nb, scr, kb, lane); continue; }
        r -= I_UQ;
        if (r < I_UKV) { const int kb = r / 32, nb = r % 32; p0_transpose_item(A.in(14) + (size_t)l * 256 * 1024, 256, 1024, (bf16*)(A.ws() + WS_WUKV) + (size_t)l * 1024 * 256, 32 * nb, 32 * nb, scr, kb, lane); continue; }
        r -= I_UKV;
        if (r < I_OUT) { const int kb = r / 32, nb = r % 32; p0_transpose_item(A.in(19) + (size_t)l * DM * DM, DM, DM, (bf16*)(A.ws() + WS_WOUT) + (size_t)l * DM * DM, 32 * nb, 32 * nb, scr, kb, lane); continue; }
        r -= I_OUT;
        { const int kb = r / 64, nb = r % 64; p0_transpose_item(A.in(20) + (size_t)l * DM * 2048, DM, 2048, (bf16*)(A.ws() + WS_WPQ) + (size_t)l * 2048 * DM, 32 * nb, 32 * nb, scr, kb, lane); }
    }
    const int gt = C.bid * 512 + C.tid, NT = C.G * 512;
    { const float* s = A.in(21); bf16* d = (bf16*)(A.ws() + WS_SUBK);
      for (int i = gt; i < 2 * 8 * 2 * 128 * 128 / 4; i += NT) { const f32x4 v = *(const f32x4*)(s + 4 * (size_t)i); u32x2 o; o.x = pk2(v.x, v.y); o.y = pk2(v.z, v.w); *(u32x2*)(d + 4 * (size_t)i) = o; } }
    { float* rp = (float*)(A.ws() + WS_ROPE);
      for (int i = gt; i < 256 * 8; i += NT) { const int p = i >> 3, f = i & 7;
          const float fr[8] = {1.0f, 0.31622776601683794f, 0.1f, 0.031622776601683794f, 0.01f, 0.0031622776601683794f, 0.001f, 0.00031622776601683794f};
          float fq = fr[0];
#pragma unroll
          for (int q = 1; q < 8; ++q) fq = (f == q) ? fr[q] : fq;
          const float ang = (float)p * fq;
          const double rev = (double)ang * 0.15915494309189535; const float fracr = (float)(rev - floor(rev));
          rp[2 * i] = __builtin_amdgcn_cosf(fracr); rp[2 * i + 1] = __builtin_amdgcn_sinf(fracr); } }
}

__device__ __forceinline__ void phase_modreduce() {
    const KA A = ka_fresh(); const Ctx C = ctx_fresh();
    const int gt = C.bid * 512 + C.tid, NT = C.G * 512;
    const float* MODP = (const float*)(A.ws() + WS_MODP); float* MOD = (float*)(A.ws() + WS_MOD);
    for (int i = gt; i < 2 * 3 * 6144; i += NT) { const int l = i / (3 * 6144), rem = i % (3 * 6144), j = rem % 6144;
        float a = A.in(7)[l * 6144 + j];
#pragma unroll
        for (int ks = 0; ks < 8; ++ks) a += MODP[((size_t)(l * 8 + ks) * 3) * 6144 + rem];
        MOD[i] = a; }
}
__device__ __forceinline__ void phase_norm(int l, int which) {
    const KA A = ka_fresh(); const Ctx C = ctx_fresh();
    const int gw = C.bid * 8 + C.wave, NGW = C.G * 8, lane = C.lane;
    const float* gain = A.in(which ? 5 : 4) + l * DM;
    const float* MOD = (const float*)(A.ws() + WS_MOD);
    bf16* XN = (bf16*)(A.ws() + WS_XN);
    const int nrows = (which == 1 && l == 1) ? RL : RT;
    for (int row = gw; row < nrows; row += NGW) {
        const float* xr = (which == 0) ? stream_in(A, C, l, row) : (const float*)stream_out(A, C, row);
        const int nsel = row < RL ? (row >> 14) : 2;
        const float* md = MOD + (l * 3 + nsel) * 6144 + which * 3072;
        f32x4 v[4]; float ss = 0.f;
#pragma unroll
        for (int i = 0; i < 4; ++i) { v[i] = *(const f32x4*)(xr + 4 * lane + 256 * i); ss += (v[i].x * v[i].x + v[i].y * v[i].y) + (v[i].z * v[i].z + v[i].w * v[i].w); }
        const float rs = 1.0f / sqrtf(wave_sum(ss, lane) * (1.f / DM) + EPS);
#pragma unroll
        for (int i = 0; i < 4; ++i) { const int j = 4 * lane + 256 * i;
            const f32x4 g = *(const f32x4*)(gain + j), sh = *(const f32x4*)(md + j), sc = *(const f32x4*)(md + 1024 + j);
            const f32x4 y = v[i] * rs * g * (sc + 1.0f) + sh;
            u32x2 o; o.x = pk2(y.x, y.y); o.y = pk2(y.z, y.w); *(u32x2*)(XN + (size_t)row * DM + j) = o; }
    }
}
constexpr float U_SCALE = 48.f, V_SCALE = 1.5f;
constexpr int TROW = 768;
struct __attribute__((packed, aligned(4))) U3 { unsigned a, b, c; };
__device__ __forceinline__ unsigned q_e2m3(float x) {
    const unsigned sg = (__builtin_bit_cast(unsigned, x) >> 31) << 5;
    const float a = fminf(fabsf(x), 7.5f);
    const float t = a * (a < 2.f ? 8.f : (a < 4.f ? 4.f : 2.f));
    return sg | ((unsigned)__builtin_rintf(t) + (a < 2.f ? 0u : (a < 4.f ? 8u : 16u)));
}
__device__ __forceinline__ void phase_tables(int l) {
    const KA A = ka_fresh(); const Ctx C = ctx_fresh();
    const size_t gt = (size_t)C.bid * 512 + C.tid, NT = (size_t)C.G * 512;
    const size_t n16 = (size_t)16384 * 1024 / 16;
#pragma unroll
    for (int w = 0; w < 2; ++w) {
        const float* s = A.in(22 + w) + (size_t)l * 16384 * 1024; unsigned char* d = A.ws() + (w ? WS_TABV : WS_TABU);
        const float sc = w ? V_SCALE : U_SCALE;
        for (size_t i = gt; i < n16; i += NT) {
            unsigned c[16];
#pragma unroll
            for (int q = 0; q < 4; ++q) { const f32x4 x = *(const f32x4*)(s + 16 * i + 4 * q);
                c[4 * q] = q_e2m3(x.x * sc); c[4 * q + 1] = q_e2m3(x.y * sc); c[4 * q + 2] = q_e2m3(x.z * sc); c[4 * q + 3] = q_e2m3(x.w * sc); }
            U3 o;
            o.a = c[0] | (c[1] << 6) | (c[2] << 12) | (c[3] << 18) | (c[4] << 24) | (c[5] << 30);
            o.b = (c[5] >> 2) | (c[6] << 4) | (c[7] << 10) | (c[8] << 16) | (c[9] << 22) | (c[10] << 28);
            o.c = (c[10] >> 4) | (c[11] << 2) | (c[12] << 8) | (c[13] << 14) | (c[14] << 20) | (c[15] << 26);
            *(U3*)(d + 12 * i) = o; }
    }
}

__device__ __forceinline__ void phase_post(int l) {
    const KA A = ka_fresh(); const Ctx C = ctx_fresh();
    const bf16* ZA = (const bf16*)(A.ws() + WS_ZA);
    bf16* MIX = (bf16*)(A.ws() + WS_MIX); bf16* QA = (bf16*)(A.ws() + WS_QA); bf16* KVA = (bf16*)(A.ws() + WS_KVA); bf16* KR = (bf16*)(A.ws() + WS_KR);
    float* GT = (float*)(A.ws() + WS_G);
    LAS float* U = (LAS float*)C.lds;
    const int tid = C.tid, lane = C.lane;
    for (int unit = C.bid; unit < RT / 32; unit += C.G) {
        const int r0 = unit * 32;
        int seq0, L;
        if (r0 < RL) { seq0 = (r0 >> 14) << 14; L = SEQ; } else { seq0 = RL + (((r0 - RL) >> 8) << 8); L = CTXL; }
        const int t0 = r0 - seq0;
        for (int idx = tid; idx < 48 * 32; idx += 512) { const int rr = idx >> 5, c8 = idx & 31; const int t = t0 - 8 + rr;
            u32x4 v = {0u, 0u, 0u, 0u};
            if (t >= 0 && t < L) v = *(const u32x4*)(ZA + (size_t)(seq0 + t) * 1024 + c8 * 8);
            LAS float* d = U + rr * 256 + c8 * 8;
            d[0] = bflo(v.x); d[1] = bfhi(v.x); d[2] = bflo(v.y); d[3] = bfhi(v.y); d[4] = bflo(v.z); d[5] = bfhi(v.z); d[6] = bflo(v.w); d[7] = bfhi(v.w); }
        __syncthreads();
        { const int ch = tid & 255, half = tid >> 8, hw = __builtin_amdgcn_readfirstlane(1 << (ch >> 6));
          const float sc = A.in(10)[l * 256 + ch];
          for (int i = half * 16; i < half * 16 + 16; ++i) { const int t = t0 + i; const int lo = max(t - hw, 0), hi = min(t + hw, L);
              float sm = 0.f; for (int tt = lo; tt < hi; ++tt) sm += U[(tt - t0 + 8) * 256 + ch];
              const float dv = sm / (float)(hi - lo) - U[(i + 8) * 256 + ch];
              MIX[(size_t)(r0 + i) * 1024 + ch] = (bf16)f2bf(dv * sc); } }
#pragma unroll
        for (int q = 0; q < 4; ++q) { const int row = r0 + C.wave * 4 + q; const bf16* za = ZA + (size_t)row * 1024;
            { float x[6]; float ss = 0.f;
#pragma unroll
              for (int i = 0; i < 3; ++i) { const unsigned w = *(const unsigned*)(za + 256 + 2 * lane + 128 * i); x[2 * i] = bflo(w); x[2 * i + 1] = bfhi(w); ss += x[2 * i] * x[2 * i] + x[2 * i + 1] * x[2 * i + 1]; }
              const float rs = 1.0f / sqrtf(wave_sum(ss, lane) * (1.f / 384.f) + EPS); const float* gq = A.in(11) + l * 384;
#pragma unroll
              for (int i = 0; i < 3; ++i) { const int j = 2 * lane + 128 * i; *(unsigned*)(QA + (size_t)row * 384 + j) = pk2(x[2 * i] * rs * gq[j], x[2 * i + 1] * rs * gq[j + 1]); } }
            { const u32x2 w = *(const u32x2*)(za + 640 + 4 * lane);
              const float x0 = bflo(w.x), x1 = bfhi(w.x), x2 = bflo(w.y), x3 = bfhi(w.y);
              const float rs = 1.0f / sqrtf(wave_sum(x0 * x0 + x1 * x1 + x2 * x2 + x3 * x3, lane) * (1.f / 256.f) + EPS); const float* gk = A.in(12) + l * 256 + 4 * lane;
              u32x2 o; o.x = pk2(x0 * rs * gk[0], x1 * rs * gk[1]); o.y = pk2(x2 * rs * gk[2], x3 * rs * gk[3]); *(u32x2*)(KVA + (size_t)row * 256 + 4 * lane) = o; }
            if (lane < 16) *(unsigned*)(KR + (size_t)row * 32 + 2 * lane) = *(const unsigned*)(za + 896 + 2 * lane);
            if (lane < 16) { float gv = bf2f(za[928 + lane]) + A.in(17)[l * 16 + lane];
                if ((lane >> 2) & 1) gv = fminf(gv, 0.f) - log1pf(__expf(-fabsf(gv)));
                GT[(size_t)row * 16 + lane] = gv; }
        }
        __syncthreads();
    }
}

__device__ __forceinline__ unsigned fp8x4(float a, float b, float c, float d) {
    a = __builtin_amdgcn_fmed3f(a, -448.f, 448.f); b = __builtin_amdgcn_fmed3f(b, -448.f, 448.f); c = __builtin_amdgcn_fmed3f(c, -448.f, 448.f); d = __builtin_amdgcn_fmed3f(d, -448.f, 448.f);
    int w = __builtin_amdgcn_cvt_pk_fp8_f32(a, b, 0, false); w = __builtin_amdgcn_cvt_pk_fp8_f32(c, d, w, true); return (unsigned)w;
}
__device__ __forceinline__ void qk_head(const bf16* src_lo, const bf16* src_hi, unsigned char* dst, int sw, const float* gn, bool rot, const float (&cs)[16], const float (&sn)[16], float oscale) {
    float ss = 0.f;
#pragma unroll 4
    for (int i = 0; i < 8; ++i) { const u32x4 w = *(const u32x4*)(src_lo + 8 * i);
        ss += (bflo(w.x) * bflo(w.x) + bfhi(w.x) * bfhi(w.x)) + (bflo(w.y) * bflo(w.y) + bfhi(w.y) * bfhi(w.y)) + (bflo(w.z) * bflo(w.z) + bfhi(w.z) * bfhi(w.z)) + (bflo(w.w) * bflo(w.w) + bfhi(w.w) * bfhi(w.w)); }
    u32x4 wr[4];
#pragma unroll
    for (int i = 0; i < 4; ++i) { wr[i] = *(const u32x4*)(src_hi + 8 * i); const u32x4 w = wr[i];
        ss += (bflo(w.x) * bflo(w.x) + bfhi(w.x) * bfhi(w.x)) + (bflo(w.y) * bflo(w.y) + bfhi(w.y) * bfhi(w.y)) + (bflo(w.z) * bflo(w.z) + bfhi(w.z) * bfhi(w.z)) + (bflo(w.w) * bflo(w.w) + bfhi(w.w) * bfhi(w.w)); }
    const float rs = oscale / sqrtf(ss * (1.f / 96.f) + EPS);
    __builtin_amdgcn_sched_barrier(0);
#pragma unroll 1
    for (int i = 0; i < 8; ++i) {
        const u32x4 w = *(const u32x4*)(src_lo + 8 * i); const f32x4 g0 = *(const f32x4*)(gn + 8 * i), g1 = *(const f32x4*)(gn + 8 * i + 4);
        u32x2 o; o.x = fp8x4(bflo(w.x) * rs * g0.x, bfhi(w.x) * rs * g0.y, bflo(w.y) * rs * g0.z, bfhi(w.y) * rs * g0.w);
        o.y = fp8x4(bflo(w.z) * rs * g1.x, bfhi(w.z) * rs * g1.y, bflo(w.w) * rs * g1.z, bfhi(w.w) * rs * g1.w);
        *(u32x2*)(dst + ((((i >> 1) ^ sw) << 4) + ((i & 1) << 3))) = o; }
    __builtin_amdgcn_sched_barrier(0);
#pragma unroll
    for (int i = 0; i < 2; ++i) {
        const u32x4 p = wr[i], q = wr[2 + i];
        const f32x4 ga = *(const f32x4*)(gn + 64 + 8 * i), gb = *(const f32x4*)(gn + 64 + 8 * i + 4), gc = *(const f32x4*)(gn + 80 + 8 * i), gd = *(const f32x4*)(gn + 80 + 8 * i + 4);
        float y1[8], y2[8];
        y1[0] = bflo(p.x) * rs * ga.x; y1[1] = bfhi(p.x) * rs * ga.y; y1[2] = bflo(p.y) * rs * ga.z; y1[3] = bfhi(p.y) * rs * ga.w; y1[4] = bflo(p.z) * rs * gb.x; y1[5] = bfhi(p.z) * rs * gb.y; y1[6] = bflo(p.w) * rs * gb.z; y1[7] = bfhi(p.w) * rs * gb.w;
        y2[0] = bflo(q.x) * rs * gc.x; y2[1] = bfhi(q.x) * rs * gc.y; y2[2] = bflo(q.y) * rs * gc.z; y2[3] = bfhi(q.y) * rs * gc.w; y2[4] = bflo(q.z) * rs * gd.x; y2[5] = bfhi(q.z) * rs * gd.y; y2[6] = bflo(q.w) * rs * gd.z; y2[7] = bfhi(q.w) * rs * gd.w;
        if (rot) {
#pragma unroll
            for (int j = 0; j < 8; ++j) { const float a = y1[j] * cs[8 * i + j] - y2[j] * sn[8 * i + j], bb = y2[j] * cs[8 * i + j] + y1[j] * sn[8 * i + j]; y1[j] = a; y2[j] = bb; }
        }
        u32x2 o; o.x = fp8x4(y1[0], y1[1], y1[2], y1[3]); o.y = fp8x4(y1[4], y1[5], y1[6], y1[7]); *(u32x2*)(dst + (((4 ^ sw) << 4) + (i << 3))) = o;
        u32x2 o2; o2.x = fp8x4(y2[0], y2[1], y2[2], y2[3]); o2.y = fp8x4(y2[4], y2[5], y2[6], y2[7]); *(u32x2*)(dst + (((5 ^ sw) << 4) + (i << 3))) = o2;
    }
    { u32x4 z; z.x = 0u; z.y = 0u; z.z = 0u; z.w = 0u; *(u32x4*)(dst + ((6 ^ sw) << 4)) = z; *(u32x4*)(dst + ((7 ^ sw) << 4)) = z; }
    __builtin_amdgcn_sched_barrier(0);
}
__device__ __forceinline__ void phase_qknorm(int l) {
    const KA A = ka_fresh(); const Ctx C = ctx_fresh();
    const int gw = C.bid * 8 + C.wave, NGW = C.G * 8, lane = C.lane;
    const bf16* Q = (const bf16*)(A.ws() + WS_Q); const bf16* KV = (const bf16*)(A.ws() + WS_KVRAW); const bf16* KR = (const bf16*)(A.ws() + WS_KR);
    unsigned char* KN = A.ws() + WS_KN; unsigned char* VT = A.ws() + WS_VT;
    const float* rope = (const float*)(A.ws() + WS_ROPE);
    const float* qg = A.in(15) + l * 96; const float* kg = A.in(16) + l * 96;
    for (int u = gw; u < (RT / 64) * 8; u += NGW) {
        const int h = u & 7, tl = u >> 3, row0 = tl * 64, row = row0 + lane;
        const bool lat = row0 < RL; int b, t0;
        if (lat) { b = row0 >> 14; t0 = row0 & (SEQ - 1); } else { b = (row0 - RL) >> 8; t0 = (row0 - RL) & 255; }
        const int ktile = lat ? (t0 >> 6) : (SEQ + t0) >> 6;
        float cs[16], sn[16];
#pragma unroll
        for (int i = 0; i < 16; ++i) { cs[i] = 1.f; sn[i] = 0.f; }
        if (lat) {
#pragma unroll
            for (int i = 0; i < 16; ++i) { const int p = (i < 8) ? (t0 >> 6) : lane; const float* rp = rope + (p * 8 + (i & 7)) * 2; cs[i] = rp[0]; sn[i] = rp[1]; }
        }
        { const bf16* qp = Q + (size_t)row * 768 + h * 96;
          qk_head(qp, qp + 64, A.ws() + WS_Q8 + (size_t)row * 1024 + h * 128, 0, qg, lat, cs, sn, QSCALE); }
        const bf16* kvp = KV + (size_t)row * 1024 + h * 128;
        qk_head(kvp, KR + (size_t)row * 32, KN + ((size_t)(b * 8 + h) * NKT + ktile) * KT_BYTES + lane * 128, (lane >> 1) & 7, kg, lat, cs, sn, 1.0f);
        { const int kap = lane & 15; const int pos = (lane & ~15) + 8 * ((kap >> 2) & 1) + 4 * (kap >> 3) + (kap & 3);
          bf16* vd = (bf16*)(VT + ((size_t)(b * 8 + h) * NKT + ktile) * VT_BYTES);
          const int pa = pos >> 3, pb = pos & 7;
#pragma unroll 1
          for (int i = 0; i < 8; ++i) { const u32x4 vv = *(const u32x4*)(kvp + 64 + 8 * i);
#pragma unroll
              for (int e = 0; e < 8; ++e) { const int d = 8 * i + e; const unsigned wd = (e >> 1) == 0 ? vv.x : ((e >> 1) == 1 ? vv.y : ((e >> 1) == 2 ? vv.z : vv.w)); const bf16 val = (bf16)((e & 1) ? (wd >> 16) : (wd & 0xffffu));
                  vd[(unsigned)(d * 64 + ((pa ^ ((d >> 1) & 7)) << 3) + pb)] = val; } } }
    }
}

__device__ __forceinline__ int ml_row(int b, int dir, int j, int s) {
    if (j < 4) { const int p = 64 * j + s; return RL + b * CTXL + (dir ? CTXL - 1 - p : p); }
    const int p = 64 * (j - 4) + s; return b * SEQ + (dir ? SEQ - 1 - p : p);
}
__device__ __forceinline__ void phase_ml_local() {
    const KA A = ka_fresh(); const Ctx C = ctx_fresh();
    const int gw = C.bid * 8 + C.wave, NGW = C.G * 8, lane = C.lane, r = lane & 31, hh = lane >> 5;
    const bf16* ZB = (const bf16*)(A.ws() + WS_ZB); const float* GT = (const float*)(A.ws() + WS_G);
    float* CST = (float*)(A.ws() + WS_CST); float* SC = (float*)(A.ws() + WS_SC);
    for (int u = gw; u < 16 * NCH; u += NGW) {
        const int sq = u / NCH, j = u % NCH, b = sq >> 3, h = (sq >> 1) & 3, dir = sq & 1;
        const int rowl = ml_row(b, dir, j, lane);
        const float gi = GT[(size_t)rowl * 16 + dir * 8 + h], lf = GT[(size_t)rowl * 16 + dir * 8 + 4 + h];
        float bs = lf;
#pragma unroll
        for (int o = 1; o < 64; o <<= 1) { const float tv = shfl_idx(bs, lane - o); if (lane >= o) bs += tv; }
        const float blast = shfl_idx(bs, 63);
        const float dec = blast + gi - bs;
        const float mloc = wave_max(dec, lane);
        const float w = __expf(dec - mloc);
        const int row0 = ml_row(b, dir, j, 0), rstep = dir ? -1 : 1;
        f32x16 acc[2][2];
#pragma unroll
        for (int vb = 0; vb < 2; ++vb)
#pragma unroll
            for (int db = 0; db < 2; ++db) acc[vb][db] = ML_ZERO16;
        float nacc0 = 0.f, nacc1 = 0.f;
#pragma unroll
        for (int st = 0; st < 4; ++st) {
            float ws[8]; unsigned rofs[8];
#pragma unroll
            for (int jj = 0; jj < 8; ++jj) { const int sidx = 16 * st + 8 * hh + jj; ws[jj] = shfl_idx(w, sidx); rofs[jj] = (unsigned)((row0 + rstep * sidx) * 1024 + h * 64 + r); }
            bf16x8 Af[2], Bf[2];
#pragma unroll
            for (int blk = 0; blk < 2; ++blk) {
                float kx[8];
#pragma unroll
                for (int jj = 0; jj < 8; ++jj) { kx[jj] = bf2f(ZB[rofs[jj] + 256 + 32 * blk]); Bf[blk][jj] = (short)ZB[rofs[jj] + 256 + 32 * blk]; }
                if (blk == 0) {
#pragma unroll
                    for (int jj = 0; jj < 8; ++jj) nacc0 += ws[jj] * kx[jj]; }
                else {
#pragma unroll
                    for (int jj = 0; jj < 8; ++jj) nacc1 += ws[jj] * kx[jj]; }
                float vx[8];
#pragma unroll
                for (int jj = 0; jj < 8; ++jj) vx[jj] = bf2f(ZB[rofs[jj] + 512 + 32 * blk]) * ws[jj];
                Af[blk] = pack8(vx[0], vx[1], vx[2], vx[3], vx[4], vx[5], vx[6], vx[7]);
            }
#pragma unroll
            for (int vb = 0; vb < 2; ++vb)
#pragma unroll
                for (int db = 0; db < 2; ++db) acc[vb][db] = MFMA32(Af[vb], Bf[db], acc[vb][db]);
            __builtin_amdgcn_sched_barrier(0);
        }
        float* cp = CST + (size_t)u * CSTF;
#pragma unroll
        for (int vb = 0; vb < 2; ++vb)
#pragma unroll
            for (int db = 0; db < 2; ++db)
#pragma unroll
                for (int g = 0; g < 16; ++g) cp[(32 * vb + crow(g, hh)) * 64 + 32 * db + r] = acc[vb][db][g];
        nacc0 += shfl_idx(nacc0, lane ^ 32); nacc1 += shfl_idx(nacc1, lane ^ 32);
        if (hh == 0) { cp[4096 + r] = nacc0; cp[4096 + 32 + r] = nacc1; }
        if (lane == 0) { SC[u * 2] = mloc; SC[u * 2 + 1] = blast; }
    }
}
__device__ __forceinline__ void phase_ml_scan() {
    const KA A = ka_fresh(); const Ctx C = ctx_fresh();
    const int gt = C.bid * 512 + C.tid, NT = C.G * 512;
    float* CST = (float*)(A.ws() + WS_CST); const float* SC = (const float*)(A.ws() + WS_SC); float* MS = (float*)(A.ws() + WS_MS);
    for (int e = gt; e < 16 * CSTF; e += NT) {
        const int sq = e / CSTF, el = e % CSTF;
        float* base = CST + (size_t)sq * NCH * CSTF + el;
        float cv = 0.f, m = -1e30f;
#pragma unroll 1
        for (int j0 = 0; j0 < NCH; j0 += 10) {
            float loc[10]; f32x2_t sc[10];
#pragma unroll
            for (int u = 0; u < 10; ++u) { loc[u] = base[(size_t)(j0 + u) * CSTF]; sc[u] = *(const f32x2_t*)(SC + (sq * NCH + j0 + u) * 2); }
#pragma unroll
            for (int u = 0; u < 10; ++u) {
                base[(size_t)(j0 + u) * CSTF] = cv;
                if (el == 0) MS[sq * NCH + j0 + u] = m;
                const float mn = fmaxf(sc[u].y + m, sc[u].x);
                cv = __expf(sc[u].y + m - mn) * cv + __expf(sc[u].x - mn) * loc[u]; m = mn;
            }
        }
    }
}
template <int DIR>
__device__ __forceinline__ void ml_sblock(f32x16& S, float& den, const bf16* ZB, const bf16x8 (&Qf)[4], int sb, int base_row, int h, int r, int hh, int jl, float a, float Mj) {
    S = ML_ZERO16;
    const int sr = 32 * sb + r; const int rows = base_row + (DIR ? 63 - sr : sr);
#pragma unroll
    for (int st = 0; st < 4; ++st) { const bf16x8 Kf = *(const bf16x8*)(ZB + (unsigned)(rows * 1024 + 256 + h * 64 + st * 16 + hh * 8)); S = MFMA32(Kf, Qf[st], S); }
#pragma unroll
    for (int g = 0; g < 16; ++g) { const int s = 32 * sb + crow(g, hh); const float as = shfl_idx(a, s);
        const float p = (s <= jl) ? S[g] * 0.125f * __expf(as - Mj) : 0.f; S[g] = p; den += p; }
}
template <int DIR>
__device__ __forceinline__ void ml_pv(f32x16& O, const f32x16& S, const bf16* ZB, int sb, int base_row, int h, int v, int hh) {
#pragma unroll
    for (int st2 = 0; st2 < 2; ++st2) {
        bf16x8 VA;
#pragma unroll
        for (int jj = 0; jj < 8; ++jj) { const int s = 32 * sb + 16 * st2 + 8 * (jj >> 2) + 4 * hh + (jj & 3); const int rows = base_row + (DIR ? 63 - s : s);
            VA[jj] = (short)ZB[(unsigned)(rows * 1024 + 512 + h * 64 + v)]; }
        const bf16x8 PB = pack8(S[8 * st2 + 0], S[8 * st2 + 1], S[8 * st2 + 2], S[8 * st2 + 3], S[8 * st2 + 4], S[8 * st2 + 5], S[8 * st2 + 6], S[8 * st2 + 7]);
        O = MFMA32(VA, PB, O);
        __builtin_amdgcn_sched_barrier(0);
    }
}
template <int DIR>
__device__ __forceinline__ void ml_out_dir(const KA& A, const Ctx& C, LAS float* H, int b, int h, int c, int base_row, int lane) {
    const bf16* ZB = (const bf16*)(A.ws() + WS_ZB); const float* GT = (const float*)(A.ws() + WS_G);
    const float* CST = (const float*)(A.ws() + WS_CST); const float* MS = (const float*)(A.ws() + WS_MS);
    const int r = lane & 31, hh = lane >> 5;
    const int j = DIR ? (c < 4 ? 3 - c : 263 - c) : c;
    const int sq = (b * 4 + h) * 2 + DIR;
    const float* Cp = CST + ((size_t)sq * NCH + j) * CSTF;
    const float m0 = MS[sq * NCH + j];
    const int rowl = base_row + (DIR ? 63 - lane : lane);
    const float gi = GT[(size_t)rowl * 16 + DIR * 8 + h], lf = GT[(size_t)rowl * 16 + DIR * 8 + 4 + h];
    float bs = lf;
#pragma unroll
    for (int o = 1; o < 64; o <<= 1) { const float tv = shfl_idx(bs, lane - o); if (lane >= o) bs += tv; }
    const float a = gi - bs;
    float pm = a;
#pragma unroll
    for (int o = 1; o < 64; o <<= 1) { const float tv = shfl_idx(pm, lane - o); if (lane >= o) pm = fmaxf(pm, tv); }
#pragma unroll 1
    for (int jb = 0; jb < 2; ++jb) {
        const int jl = 32 * jb + r;
        const float bj = shfl_idx(bs, jl), Mj = fmaxf(m0, shfl_idx(pm, jl));
        const int rowj = base_row + (DIR ? 63 - jl : jl);
        const int tok = DIR ? 63 - jl : jl;
        bf16x8 Qf[4];
#pragma unroll
        for (int st = 0; st < 4; ++st) Qf[st] = *(const bf16x8*)(ZB + (unsigned)(rowj * 1024 + h * 64 + st * 16 + hh * 8));
        f32x16 S0, S1 = ML_ZERO16; float den = 0.f;
        ml_sblock<DIR>(S0, den, ZB, Qf, 0, base_row, h, r, hh, jl, a, Mj);
        if (jb == 1) ml_sblock<DIR>(S1, den, ZB, Qf, 1, base_row, h, r, hh, jl, a, Mj);
        den += shfl_idx(den, lane ^ 32);
        const float wi = __expf(m0 - Mj) * 0.125f;
        float nq = 0.f;
#pragma unroll
        for (int st = 0; st < 4; ++st) { const f32x4 n0 = *(const f32x4*)(Cp + 4096 + st * 16 + hh * 8), n1 = *(const f32x4*)(Cp + 4096 + st * 16 + hh * 8 + 4);
            const u32x4 qw = __builtin_bit_cast(u32x4, Qf[st]);
            nq += n0.x * bflo(qw.x) + n0.y * bfhi(qw.x) + n0.z * bflo(qw.y) + n0.w * bfhi(qw.y) + n1.x * bflo(qw.z) + n1.y * bfhi(qw.z) + n1.z * bflo(qw.w) + n1.w * bfhi(qw.w); }
        nq += shfl_idx(nq, lane ^ 32);
        den += wi * nq;
        const float inv = 1.0f / fmaxf(fabsf(den), __expf(-(bj + Mj)));
#pragma unroll 1
        for (int vb = 0; vb < 2; ++vb) {
            const int v = 32 * vb + r;
            f32x16 O = ML_ZERO16;
            ml_pv<DIR>(O, S0, ZB, 0, base_row, h, v, hh);
            if (jb == 1) ml_pv<DIR>(O, S1, ZB, 1, base_row, h, v, hh);
            f32x16 I = ML_ZERO16;
#pragma unroll
            for (int st = 0; st < 4; ++st) { const float* cr = Cp + (size_t)v * 64 + st * 16 + hh * 8; const f32x4 c0 = *(const f32x4*)cr, c1 = *(const f32x4*)(cr + 4);
                const bf16x8 CA = pack8(c0.x, c0.y, c0.z, c0.w, c1.x, c1.y, c1.z, c1.w); I = MFMA32(CA, Qf[st], I); __builtin_amdgcn_sched_barrier(0); }
#pragma unroll
            for (int g = 0; g < 16; ++g) { const float hv = (O[g] + wi * I[g]) * inv; const int idx = (32 * vb + crow(g, hh)) * 65 + tok;
                if (DIR == 1) H[idx] = hv; else H[idx] += hv; }
        }
    }
}
__device__ __forceinline__ void phase_ml_out(int l) {
    const KA A = ka_fresh(); const Ctx C = ctx_fresh();
    const int gw = C.bid * 8 + C.wave, NGW = C.G * 8, lane = C.lane;
    const bf16* ZB = (const bf16*)(A.ws() + WS_ZB); bf16* MIX = (bf16*)(A.ws() + WS_MIX);
    LAS float* H = (LAS float*)(C.lds + C.wave * 16640);
    const int c_lo = (l == 1) ? 4 : 0, ncu = NCH - c_lo;
    for (int u = gw; u < 8 * ncu; u += NGW) {
        const int c = c_lo + u % ncu, bh = u / ncu, h = bh & 3, b = bh >> 2;
        const int base_row = c < 4 ? RL + b * CTXL + 64 * c : b * SEQ + 64 * (c - 4);
        ml_out_dir<1>(A, C, H, b, h, c, base_row, lane);
        LDS_WAIT(); asm volatile("" ::: "memory");
        ml_out_dir<0>(A, C, H, b, h, c, base_row, lane);
        LDS_WAIT(); asm volatile("" ::: "memory");
        float ss = 0.f;
#pragma unroll 8
        for (int v = 0; v < 64; ++v) { const float x = H[v * 65 + lane]; ss += x * x; }
        const float rs = 1.0f / sqrtf(ss * (1.f / 64.f) + EPS);
        const float gnv = A.in(18)[l * 256 + h * 64 + lane];
#pragma unroll 4
        for (int t = 0; t < 64; ++t) {
            const float rst = __builtin_bit_cast(float, __builtin_amdgcn_readlane(__builtin_bit_cast(int, rs), t));
            const size_t off = (size_t)(base_row + t) * 1024 + 768 + h * 64 + lane;
            const float o = bf2f(ZB[off]); const float sg = 1.0f / (1.0f + __expf(-o));
            MIX[off] = (bf16)f2bf(H[lane * 65 + t] * rst * gnv * sg);
        }
        LDS_WAIT(); asm volatile("" ::: "memory");
    }
}

__device__ __forceinline__ void glds16s(unsigned voff, const unsigned char* sbase, unsigned lds_dst) {
    unsigned keep;
    asm volatile("s_mov_b32 %0, m0\n\ts_mov_b32 m0, %3\n\ts_nop 0\n\tglobal_load_lds_dwordx4 %1, %2\n\ts_mov_b32 m0, %0" : "=&s"(keep) : "v"(voff), "s"(sbase), "s"(lds_dst) : "memory");
}
#define ATT_WAIT_BAR(N) asm volatile("s_waitcnt vmcnt(" #N ") lgkmcnt(0)\n\ts_barrier" ::: "memory")
constexpr int ATT_SLOT = 16384, ATT_NS = 6;
typedef int i32x8 __attribute__((ext_vector_type(8)));
#define MFMA8(a, b, c) __builtin_amdgcn_mfma_scale_f32_32x32x64_f8f6f4((a), (b), (c), 0, 0, 0, 127, 0, 127)
template <bool FIXEDREF>
__device__ __forceinline__ void attn_unit(const KA& A, const Ctx& C, int bh, int qrow0, int tile_lo, int ntiles) {
    int lane_ = C.lane; asm volatile("" : "+v"(lane_));
    const int lane = lane_, r = lane & 31, hh = lane >> 5, h = bh & 7;
    bf16* MIX = (bf16*)(A.ws() + WS_MIX);
    LAS unsigned char* lds = C.lds;
    const unsigned lds0 = (unsigned)(uintptr_t)lds;
    const int qrow = qrow0 + C.wave * 32 + r;
    const unsigned char* kg = A.ws() + WS_KN + ((size_t)bh * NKT + tile_lo) * KT_BYTES;
    const unsigned char* vg = A.ws() + WS_VT + ((size_t)bh * NKT + tile_lo) * VT_BYTES;
    const unsigned vo0 = (unsigned)(C.wave * 1024 + lane * 16);
    const unsigned d0 = lds0 + C.wave * 1024, d1 = d0 + 8192;
    int islot = 0;
#define ATT_ISSUE() do { const unsigned so_ = (unsigned)islot * ATT_SLOT; islot = (islot == ATT_NS - 1) ? 0 : islot + 1; \
        glds16s(vo0, kg, (unsigned)__builtin_amdgcn_readfirstlane(d0 + so_)); glds16s(vo0, vg, (unsigned)__builtin_amdgcn_readfirstlane(d1 + so_)); \
        kg += KT_BYTES; vg += VT_BYTES; } while (0)
    ATT_ISSUE(); ATT_ISSUE(); ATT_ISSUE();
    i32x8 qf[2];
    { const unsigned char* q8 = A.ws() + WS_Q8 + (size_t)qrow * 1024 + h * 128 + hh * 32;
#pragma unroll
      for (int st = 0; st < 2; ++st) { const u32x4 a = *(const u32x4*)(q8 + st * 64), b = *(const u32x4*)(q8 + st * 64 + 16);
          qf[st] = (i32x8){(int)a.x, (int)a.y, (int)a.z, (int)a.w, (int)b.x, (int)b.y, (int)b.z, (int)b.w}; } }
    f32x16 o0 = (f32x16){0.f, 0.f, 0.f, 0.f, 0.f, 0.f, 0.f, 0.f, 0.f, 0.f, 0.f, 0.f, 0.f, 0.f, 0.f, 0.f}, o1 = o0;
    float m = 0.f, lsum = 0.f;
    constexpr float THR = 8.f;
    const int ksw = (r >> 1) & 7;
    int cslot = 0, nslot = 1;
#define ATT_ADV() do { cslot = nslot; nslot = (nslot == ATT_NS - 1) ? 0 : nslot + 1; } while (0)
#define ATT_QKT(P0, P1, sl) do { const LAS unsigned char* Kb_ = lds + (sl) * ATT_SLOT + r * 128; P0 = ML_ZERO16; P1 = ML_ZERO16; \
        _Pragma("unroll") for (int st = 0; st < 2; ++st) { \
            const u32x4 a_ = *(const LAS u32x4*)(Kb_ + (((st * 4 + hh * 2) ^ ksw) << 4)), b_ = *(const LAS u32x4*)(Kb_ + (((st * 4 + hh * 2 + 1) ^ ksw) << 4)); \
            const u32x4 c_ = *(const LAS u32x4*)(Kb_ + 4096 + (((st * 4 + hh * 2) ^ ksw) << 4)), d_ = *(const LAS u32x4*)(Kb_ + 4096 + (((st * 4 + hh * 2 + 1) ^ ksw) << 4)); \
            P0 = MFMA8(((i32x8){(int)a_.x, (int)a_.y, (int)a_.z, (int)a_.w, (int)b_.x, (int)b_.y, (int)b_.z, (int)b_.w}), qf[st], P0); \
            P1 = MFMA8(((i32x8){(int)c_.x, (int)c_.y, (int)c_.z, (int)c_.w, (int)d_.x, (int)d_.y, (int)d_.z, (int)d_.w}), qf[st], P1); } } while (0)
#define ATT_H1(C0, C1, N0, N1, tt) do { \
        const bool more_ = (tt) + 1 < ntiles; \
        if ((tt) + 3 < ntiles) ATT_ISSUE(); \
        if (more_) ATT_QKT(N0, N1, nslot); \
        if (!FIXEDREF) { \
        float ta_ = __builtin_fmaxf(__builtin_fmaxf(C0[0], C0[1]), C0[2]), tb_ = __builtin_fmaxf(__builtin_fmaxf(C0[3], C0[4]), C0[5]), tc_ = __builtin_fmaxf(__builtin_fmaxf(C1[0], C1[1]), C1[2]), td_ = __builtin_fmaxf(__builtin_fmaxf(C1[3], C1[4]), C1[5]);     \
        _Pragma("unroll") for (int g = 6; g < 16; g += 2) { ta_ = __builtin_fmaxf(__builtin_fmaxf(ta_, C0[g]), C0[g + 1]); tc_ = __builtin_fmaxf(__builtin_fmaxf(tc_, C1[g]), C1[g + 1]); } \
        float tm_ = __builtin_fmaxf(__builtin_fmaxf(ta_, tb_), __builtin_fmaxf(tc_, td_)); \
        { const auto rr_ = __builtin_amdgcn_permlane32_swap(__builtin_bit_cast(unsigned, tm_), __builtin_bit_cast(unsigned, tm_), false, false);     \
          tm_ = __builtin_fmaxf(__builtin_bit_cast(float, rr_[0]), __builtin_bit_cast(float, rr_[1])); } \
        if ((tt) == 0) m = tm_;                             \
        else if (__any(tm_ - m > THR)) {                    \
            const float mn_ = __builtin_fmaxf(tm_, m), alpha_ = __builtin_amdgcn_exp2f(m - mn_); m = mn_; lsum *= alpha_; \
            _Pragma("unroll") for (int g = 0; g < 16; ++g) { o0[g] *= alpha_; o1[g] *= alpha_; } \
        } } } while (0)
#define ATT_H2(C0, C1, sl) do { \
        if (!FIXEDREF) { _Pragma("unroll") for (int g = 0; g < 16; ++g) { C0[g] -= m; C1[g] -= m; } } \
        float pa_ = 0.f, pb2_ = 0.f, pc_ = 0.f, pd_ = 0.f;                                      \
        _Pragma("unroll") for (int g = 0; g < 16; g += 2) { C0[g] = __builtin_amdgcn_exp2f(C0[g]); C0[g + 1] = __builtin_amdgcn_exp2f(C0[g + 1]); C1[g] = __builtin_amdgcn_exp2f(C1[g]); C1[g + 1] = __builtin_amdgcn_exp2f(C1[g + 1]); \
            pa_ += C0[g]; pb2_ += C0[g + 1]; pc_ += C1[g]; pd_ += C1[g + 1]; } \
        lsum += (pa_ + pb2_) + (pc_ + pd_); \
        bf16x8 pb_[2][2]; \
        pb_[0][0] = pack8(C0[0], C0[1], C0[2], C0[3], C0[4], C0[5], C0[6], C0[7]); pb_[0][1] = pack8(C0[8], C0[9], C0[10], C0[11], C0[12], C0[13], C0[14], C0[15]); \
        pb_[1][0] = pack8(C1[0], C1[1], C1[2], C1[3], C1[4], C1[5], C1[6], C1[7]); pb_[1][1] = pack8(C1[8], C1[9], C1[10], C1[11], C1[12], C1[13], C1[14], C1[15]); \
        const LAS unsigned char* Vb_ = lds + (sl) * ATT_SLOT + KT_BYTES; \
        _Pragma("unroll") for (int db = 0; db < 2; ++db) { \
            const int d_ = db * 32 + r, sw_ = (d_ >> 1) & 7; const LAS unsigned char* vrow_ = Vb_ + d_ * 128; \
            _Pragma("unroll") for (int kb = 0; kb < 2; ++kb) _Pragma("unroll") for (int s2 = 0; s2 < 2; ++s2) { \
                const bf16x8 va_ = *(const LAS bf16x8*)(vrow_ + (((kb * 4 + s2 * 2 + hh) ^ sw_) << 4)); \
                if (db == 0) o0 = MFMA32(va_, pb_[kb][s2], o0); else o1 = MFMA32(va_, pb_[kb][s2], o1); } } \
    } while (0)
#define ATT_SYNC(tt) do { if ((tt) + 2 < ntiles) ATT_WAIT_BAR(2); else ATT_WAIT_BAR(0); } while (0)
    f32x16 sA0, sA1, sB0, sB1;
    ATT_WAIT_BAR(4);
    ATT_QKT(sA0, sA1, 0);
    if (C.wave < 4) {
#pragma unroll 1
        for (int t = 0; t < ntiles; t += 2) {
            if (t + 1 < ntiles) ATT_SYNC(t);
            ATT_H1(sA0, sA1, sB0, sB1, t); ATT_H2(sA0, sA1, cslot); ATT_ADV();
            if (t + 2 < ntiles) ATT_SYNC(t + 1);
            ATT_H1(sB0, sB1, sA0, sA1, t + 1); ATT_H2(sB0, sB1, cslot); ATT_ADV();
        }
    } else {
        ATT_SYNC(0);
        ATT_H1(sA0, sA1, sB0, sB1, 0);
#pragma unroll 1
        for (int t = 1; t + 1 < ntiles; t += 2) {
            ATT_SYNC(t);
            ATT_H2(sA0, sA1, cslot); ATT_ADV(); ATT_H1(sB0, sB1, sA0, sA1, t);
            ATT_SYNC(t + 1);
            ATT_H2(sB0, sB1, cslot); ATT_ADV(); ATT_H1(sA0, sA1, sB0, sB1, t + 1);
        }
        ATT_H2(sA0, sA1, cslot); ATT_ADV(); ATT_H1(sB0, sB1, sA0, sA1, ntiles - 1);
        ATT_H2(sB0, sB1, cslot); ATT_ADV();
    }
#undef ATT_QKT
#undef ATT_H1
#undef ATT_H2
#undef ATT_SYNC
#undef ATT_ADV
    asm volatile("s_waitcnt lgkmcnt(0)\n\ts_barrier" ::: "memory");
#undef ATT_ISSUE
    lsum += shfl_idx(lsum, lane ^ 32);
    const float inv = 1.0f / lsum;
    { LAS bf16* stg = (LAS bf16*)(lds + ATT_NS * ATT_SLOT + C.wave * 4352);
#pragma unroll
      for (int g = 0; g < 16; ++g) { const int d = crow(g, hh); stg[r * 68 + d] = (bf16)f2bf(o0[g] * inv); stg[r * 68 + 32 + d] = (bf16)f2bf(o1[g] * inv); }
      LDS_WAIT(); asm volatile("" ::: "memory");
      bf16* ob = MIX + (size_t)(qrow0 + C.wave * 32) * 1024 + 256 + h * 64;
#pragma unroll
      for (int i = 0; i < 4; ++i) { const int row = i * 8 + (lane >> 3), ch = lane & 7;
          const u32x2 a = *(const LAS u32x2*)(stg + row * 68 + ch * 8), b = *(const LAS u32x2*)(stg + row * 68 + ch * 8 + 4);
          u32x4 v; v.x = a.x; v.y = a.y; v.z = b.x; v.w = b.y; *(u32x4*)(ob + (size_t)row * 1024 + ch * 8) = v; }
      LDS_WAIT(); asm volatile("" ::: "memory"); }
}
__device__ __forceinline__ void phase_attn(int l) {
    const KA A = ka_fresh(); const Ctx C = ctx_fresh();
    const int G = C.G;
    bool fixedref;
    { const int lane = C.lane; const float* qg = A.in(15) + l * 96; const float* kg = A.in(16) + l * 96;
      const float gq = wave_max(fmaxf(fabsf(qg[lane]), lane < 32 ? fabsf(qg[64 + lane]) : 0.f), lane), gk = wave_max(fmaxf(fabsf(kg[lane]), lane < 32 ? fabsf(kg[64 + lane]) : 0.f), lane);
      fixedref = (96.f * QSCALE * gq * gk) < 100.f; }
    for (int u = C.bid; u < 1024 + (l == 1 ? 0 : 16); u += G) {
        if (u < 1024) {
            int pair, qb;
            if (G == 256) { const int vcu = u & 255, rnd = u >> 8; pair = 2 * (vcu & 7) + (rnd >> 1); qb = (vcu >> 3) + 32 * (rnd & 1); }
            else { pair = u >> 6; qb = u & 63; }
            if (fixedref) attn_unit<true>(A, C, pair, (pair >> 3) * SEQ + qb * 256, 0, NKT); else attn_unit<false>(A, C, pair, (pair >> 3) * SEQ + qb * 256, 0, NKT);
        } else { const int pair = u - 1024;
            if (fixedref) attn_unit<true>(A, C, pair, RL + (pair >> 3) * CTXL, NKT - 4, 4); else attn_unit<false>(A, C, pair, RL + (pair >> 3) * CTXL, NKT - 4, 4); }
    }
}

__device__ __forceinline__ int f2key(float f) { const int b = __builtin_bit_cast(int, f); return b ^ ((b >> 31) & 0x7fffffff); }
__device__ __forceinline__ float key2f(int k) { return __builtin_bit_cast(float, k ^ ((k >> 31) & 0x7fffffff)); }
__device__ __forceinline__ void topk_ins(int (&lst)[16], int v) {
#pragma unroll
    for (int i = 0; i < 16; ++i) { const int hi = max(lst[i], v); v = min(lst[i], v); lst[i] = hi; }
}
__device__ __forceinline__ void bitonic_sort16_desc(int (&a)[16]) {
#pragma unroll
    for (int k = 2; k <= 16; k <<= 1)
#pragma unroll
        for (int j = k >> 1; j > 0; j >>= 1)
#pragma unroll
            for (int i = 0; i < 16; ++i) { const int p = i ^ j;
                if (p > i) { const int hi = max(a[i], a[p]), lo = min(a[i], a[p]); const bool desc = ((i & k) == 0) || (k == 16); a[i] = desc ? hi : lo; a[p] = desc ? lo : hi; } }
}
__device__ __forceinline__ void merge16_desc(int (&lst)[16], const int (&nw)[16]) {
#pragma unroll
    for (int i = 0; i < 16; ++i) lst[i] = max(lst[i], nw[15 - i]);
#pragma unroll
    for (int j = 8; j > 0; j >>= 1)
#pragma unroll
        for (int i = 0; i < 16; ++i) { const int p = i ^ j; if (p > i) { const int hi = max(lst[i], lst[p]), lo = min(lst[i], lst[p]); lst[i] = hi; lst[p] = lo; } }
}
__device__ __forceinline__ void topk_half(int (&lst)[16], const bf16* qp, const bf16* skp, int hh, int lane) {
    bf16x8 bq[8];
#pragma unroll
    for (int st = 0; st < 8; ++st) bq[st] = *(const bf16x8*)(qp + st * 16);
#pragma unroll
    for (int i = 0; i < 16; ++i) lst[i] = f2key(-3.0e38f);
    bf16x8 an[8];
#pragma unroll
    for (int st = 0; st < 8; ++st) an[st] = *(const bf16x8*)(skp + st * 16);
#pragma unroll 1
    for (int blk = 0; blk < 4; ++blk) {
        f32x16 acc = (f32x16){0.f, 0.f, 0.f, 0.f, 0.f, 0.f, 0.f, 0.f, 0.f, 0.f, 0.f, 0.f, 0.f, 0.f, 0.f, 0.f};
#pragma unroll
        for (int st = 0; st < 8; ++st) acc = MFMA32(an[st], bq[st], acc);
        if (blk < 3) {
#pragma unroll
            for (int st = 0; st < 8; ++st) an[st] = *(const bf16x8*)(skp + (blk + 1) * 32 * 128 + st * 16); }
        int nk[16];
#pragma unroll
        for (int g = 0; g < 16; ++g) { const unsigned n = (unsigned)(blk * 32 + crow(g, hh));
            const float sv = acc[g];
            nk[g] = f2key(__builtin_bit_cast(float, (__builtin_bit_cast(unsigned, sv) & ~127u) | n)); }
        bitonic_sort16_desc(nk);
        merge16_desc(lst, nk);
    }
    int oth[16];
#pragma unroll
    for (int i = 0; i < 16; ++i) oth[i] = shfl_idx(lst[i], lane ^ 32);
    merge16_desc(lst, oth);
}
__device__ __forceinline__ void phase_topk(int l) {
    const KA A = ka_fresh(); const Ctx C = ctx_fresh();
    const int gw = C.bid * 8 + C.wave, NGW = C.G * 8, lane = C.lane, r = lane & 31, hh = lane >> 5;
    const bf16* PQ = (const bf16*)(A.ws() + WS_PQ); const bf16* SK = (const bf16*)(A.ws() + WS_SUBK);
    int* EID = (int*)(A.ws() + WS_EID); float* GATE = (float*)(A.ws() + WS_GATE);
    const int nrows = (l == 1) ? RL : RT;
    for (int unit = gw; unit < (nrows / 32) * 8; unit += NGW) {
        const int h = unit & 7, r0 = (unit >> 3) * 32; const size_t row = (size_t)(r0 + r);
        int L[2][16];
        topk_half(L[0], PQ + row * 2048 + h * 256 + hh * 8, SK + ((size_t)((l * 8 + h) * 2 + 0) * 128 + r) * 128 + hh * 8, hh, lane);
        __builtin_amdgcn_sched_barrier(0);
        topk_half(L[1], PQ + row * 2048 + h * 256 + 128 + hh * 8, SK + ((size_t)((l * 8 + h) * 2 + 1) * 128 + r) * 128 + hh * 8, hh, lane);
        __builtin_amdgcn_sched_barrier(0);
        int best[16];
#pragma unroll
        for (int j = 0; j < 16; ++j) best[j] = f2key(__builtin_bit_cast(float, (__builtin_bit_cast(unsigned, key2f(L[0][0]) + key2f(L[1][j])) & ~255u) | (unsigned)j));
#pragma unroll
        for (int i = 1; i < 16; ++i)
#pragma unroll
            for (int j = 0; j < 16; ++j)
                if ((i + 1) * (j + 1) <= 16) topk_ins(best, f2key(__builtin_bit_cast(float, (__builtin_bit_cast(unsigned, key2f(L[0][i]) + key2f(L[1][j])) & ~255u) | (unsigned)(i * 16 + j))));
        float ev[16]; float esum = 0.f;
        const float mx = __builtin_bit_cast(float, __builtin_bit_cast(unsigned, key2f(best[0])) & ~255u);
#pragma unroll
        for (int k = 0; k < 16; ++k) { ev[k] = __expf(__builtin_bit_cast(float, __builtin_bit_cast(unsigned, key2f(best[k])) & ~255u) - mx); esum += ev[k]; }
        const float einv = 1.0f / esum;
#pragma unroll
        for (int k = 0; k < 8; ++k) {
            const int b_lo = best[k], b_hi = best[k + 8]; const float e_lo = ev[k], e_hi = ev[k + 8];
            const int bk = hh ? b_hi : b_lo; const float gk = (hh ? e_hi : e_lo) * einv;
            const unsigned code = __builtin_bit_cast(unsigned, key2f(bk)) & 255u;
            const unsigned ci = code >> 4, cj = code & 15u; unsigned n0 = 0u, n1 = 0u;
#pragma unroll
            for (int i = 0; i < 16; ++i) { n0 = (ci == (unsigned)i) ? (__builtin_bit_cast(unsigned, key2f(L[0][i])) & 127u) : n0; n1 = (cj == (unsigned)i) ? (__builtin_bit_cast(unsigned, key2f(L[1][i])) & 127u) : n1; }
            EID[row * 128 + h * 16 + hh * 8 + k] = (int)(n0 * 128u + n1); GATE[row * 128 + h * 16 + hh * 8 + k] = gk;
        }
    }
}
typedef float f32x2v __attribute__((ext_vector_type(2)));
typedef unsigned u32x6 __attribute__((ext_vector_type(6)));
typedef float f32x32 __attribute__((ext_vector_type(32)));
#define FFN_NB 4
__device__ __forceinline__ void phase_ffn(int l) {
    const KA A = ka_fresh(); const Ctx C = ctx_fresh();
    const int gw = C.bid * 8 + C.wave, NGW = C.G * 8, lane = C.lane;
    const bf16* XN = (const bf16*)(A.ws() + WS_XN); const unsigned char* TU = A.ws() + WS_TABU; const unsigned char* TV = A.ws() + WS_TABV;
    const int* EID = (const int*)(A.ws() + WS_EID); const float* GATE = (const float*)(A.ws() + WS_GATE);
    const float* MOD = (const float*)(A.ws() + WS_MOD);
    const int nrows = (l == 1) ? RL : RT;
    for (int row = gw; row < nrows; row += NGW) {
        float hv[16];
        { const u32x4 a = *(const u32x4*)(XN + (size_t)row * DM + lane * 16), b = *(const u32x4*)(XN + (size_t)row * DM + lane * 16 + 8);
          hv[0] = bflo(a.x); hv[1] = bfhi(a.x); hv[2] = bflo(a.y); hv[3] = bfhi(a.y); hv[4] = bflo(a.z); hv[5] = bfhi(a.z); hv[6] = bflo(a.w); hv[7] = bfhi(a.w);
          hv[8] = bflo(b.x); hv[9] = bfhi(b.x); hv[10] = bflo(b.y); hv[11] = bfhi(b.y); hv[12] = bflo(b.z); hv[13] = bfhi(b.z); hv[14] = bflo(b.w); hv[15] = bfhi(b.w); }
        float out[16];
#pragma unroll
        for (int i = 0; i < 16; ++i) out[i] = 0.f;
        const int idA = EID[(size_t)row * 128 + lane], idB = EID[(size_t)row * 128 + 64 + lane]; const float gtA = GATE[(size_t)row * 128 + lane], gtB = GATE[(size_t)row * 128 + 64 + lane];
#define FFN_LOAD(UU, VV, GK, e0) do { _Pragma("unroll") for (int k = 0; k < FFN_NB; ++k) { const int ee_ = (e0) + k; \
            const int id_ = __builtin_amdgcn_readlane(ee_ < 64 ? idA : idB, ee_ & 63); GK[k] = __builtin_bit_cast(float, __builtin_amdgcn_readlane(__builtin_bit_cast(int, ee_ < 64 ? gtA : gtB), ee_ & 63)); \
            UU[k] = *(const U3*)(TU + (size_t)id_ * TROW + lane * 12); VV[k] = *(const U3*)(TV + (size_t)id_ * TROW + lane * 12); } } while (0)
          \
#define FFN_COMP(UU, VV, GK) do { _Pragma("unroll") for (int k = 0; k < FFN_NB; k += 2) { \
            const u32x6 us_ = {UU[k].a, UU[k].b, UU[k].c, UU[k + 1].a, UU[k + 1].b, UU[k + 1].c}; \
            const f32x32 uf_ = __builtin_amdgcn_cvt_scalef32_pk32_f32_fp6(us_, 1.0f); \
            float d0_ = 0.f, d1_ = 0.f; \
            _Pragma("unroll") for (int i = 0; i < 16; ++i) { d0_ += hv[i] * uf_[i]; d1_ += hv[i] * uf_[16 + i]; } \
            d0_ = wave_sum(d0_, lane) * (1.0f / U_SCALE); d1_ = wave_sum(d1_, lane) * (1.0f / U_SCALE); \
            const float w0_ = GK[k] * gelu_f(d0_) * (1.0f / V_SCALE), w1_ = GK[k + 1] * gelu_f(d1_) * (1.0f / V_SCALE); \
            const u32x6 vs_ = {VV[k].a, VV[k].b, VV[k].c, VV[k + 1].a, VV[k + 1].b, VV[k + 1].c}; \
            const f32x32 vf_ = __builtin_amdgcn_cvt_scalef32_pk32_f32_fp6(vs_, 1.0f); \
            _Pragma("unroll") for (int i = 0; i < 16; ++i) out[i] += w0_ * vf_[i] + w1_ * vf_[16 + i]; } } while (0)
        U3 uA[FFN_NB], vA[FFN_NB], uB[FFN_NB], vB[FFN_NB]; float gA[FFN_NB], gB[FFN_NB];
        FFN_LOAD(uA, vA, gA, 0);
#pragma unroll 1
        for (int e = 0; e < 128; e += 2 * FFN_NB) {
            FFN_LOAD(uB, vB, gB, e + FFN_NB);
            FFN_COMP(uA, vA, gA);
            if (e + 2 * FFN_NB < 128) FFN_LOAD(uA, vA, gA, e + 2 * FFN_NB);
            FFN_COMP(uB, vB, gB);
        }
#undef FFN_LOAD
#undef FFN_COMP
        const int nsel = row < RL ? (row >> 14) : 2;
        const float* gf = MOD + (l * 3 + nsel) * 6144 + 5 * 1024;
        float* xr = stream_out(A, C, row);
#pragma unroll
        for (int q = 0; q < 4; ++q) { const int j = lane * 16 + q * 4;
            const f32x4 x = *(const f32x4*)(xr + j); f32x4 g = *(const f32x4*)(gf + j);
            f32x4 o; o.x = x.x + g.x * out[q * 4 + 0]; o.y = x.y + g.y * out[q * 4 + 1]; o.z = x.z + g.z * out[q * 4 + 2]; o.w = x.w + g.w * out[q * 4 + 3];
            *(f32x4*)(xr + j) = o; }
    }
}

template <class Epi>
__device__ __forceinline__ void run_gemm(const pg8::bf16_t* Amat, const pg8::bf16_t* Bt, int N, int K, const Epi& E, int M = RT) {
    const Ctx C = ctx_fresh();
    pg8::Gemm g{Amat, Bt, M, N, K}; pg8::StaticOrder S; S.init(M, N, C.G, C.bid);
    pg8::gemm_phase<Epi, pg8::StaticOrder, true, true>(C.lds, g, S, E);
}
__device__ __forceinline__ void seam() {
    const KA A = ka_fresh(); const Ctx C = ctx_fresh();
    XcdBarrier b; b.bar = (unsigned*)(A.ws() + WS_CTL) + CW_BAR; b.x = xb_xcc_id(); b.st = (volatile LAS unsigned*)(C.lds + MISC_OFF) + 8;
    xcd_barrier(b);
}
#define IN(k) (lo <= (k) && (k) < hi)
#define SEAM(k) do { if (IN(k) && IN((k) + 1)) seam(); } while (0)
template <int l>
__device__ __forceinline__ void layer_body(const int lo, const int hi) {
        const int p0 = 1 + NPH_L * l;
        if (IN(p0 + 0)) { phase_norm(l, 0); phase_tables(l); }
        SEAM(p0 + 0);
        if (IN(p0 + 1)) {
            const KA A = ka_fresh(); unsigned char* ws = A.ws();
            pg8::EpiBf16<0> E{(pg8::bf16_t*)(ws + WS_ZA), 1024, nullptr, 1024, (size_t)(WS_ZB - WS_ZA) / 2, 1.f};
            run_gemm(( const pg8::bf16_t*)(ws + WS_XN), (const pg8::bf16_t*)(ws + WS_WIN) + (size_t)l * 2048 * DM, 2048, DM, E);
        }
        SEAM(p0 + 1);
        if (IN(p0 + 2)) phase_post(l);
        SEAM(p0 + 2);
        if (IN(p0 + 3)) {
#pragma unroll 1
            for (int gi = 0; gi < 2; ++gi) {
                const KA A = ka_fresh(); unsigned char* ws = A.ws();
                const int N = gi ? 1024 : 768, K = gi ? 256 : 384;
                pg8::EpiBf16<0> E{(pg8::bf16_t*)(ws + (gi ? WS_KVRAW : WS_Q)), N, nullptr, 0, 0, 1.f};
                run_gemm((const pg8::bf16_t*)(ws + (gi ? WS_KVA : WS_QA)), (const pg8::bf16_t*)(ws + (gi ? WS_WUKV : WS_WUQ)) + (size_t)l * N * K, N, K, E);
            }
        }
        SEAM(p0 + 3);
        if (IN(p0 + 4)) phase_qknorm(l);
        SEAM(p0 + 4);
        if (IN(p0 + 5)) phase_ml_local();
        SEAM(p0 + 5);
        if (IN(p0 + 6)) phase_ml_scan();
        SEAM(p0 + 6);
        if (IN(p0 + 7)) {
            phase_ml_out(l);
            __syncthreads();
            phase_attn(l);
        }
        SEAM(p0 + 7);
        if (IN(p0 + 8)) {
            const KA A = ka_fresh(); unsigned char* ws = A.ws();
            pg8::EpiResGate E{l == 0 ? A.in(0) : (const float*)A.out(), l == 0 ? A.in(2) : (const float*)(ws + WS_CTXS), A.out(), (float*)(ws + WS_CTXS), (const float*)(ws + WS_MOD) + (size_t)l * 3 * 6144, 2 * 1024};
            run_gemm((const pg8::bf16_t*)(ws + WS_MIX), (const pg8::bf16_t*)(ws + WS_WOUT) + (size_t)l * DM * DM, DM, DM, E, l == 1 ? RL : RT);
        }
        SEAM(p0 + 8);
        if (IN(p0 + 9)) phase_norm(l, 1);
        SEAM(p0 + 9);

        if (IN(p0 + 10)) {
            const KA A = ka_fresh(); unsigned char* ws = A.ws();
            pg8::EpiBf16<0> E{(pg8::bf16_t*)(ws + WS_PQ), 2048, nullptr, 0, 0, 1.f};
            run_gemm((const pg8::bf16_t*)(ws + WS_XN), (const pg8::bf16_t*)(ws + WS_WPQ) + (size_t)l * 2048 * DM, 2048, DM, E, l == 1 ? RL : RT);
        }
        SEAM(p0 + 10);
                if (IN(p0 + 11)) phase_topk(l);
        SEAM(p0 + 11);
        if (IN(p0 + 12)) phase_ffn(l);
        if (l == 0) SEAM(p0 + 12);
    }
__global__ void __launch_bounds__(512, 2) mk_fwd(Args unused_args) {
    { const KA A = ka_fresh(); const Ctx C = ctx_fresh();
      volatile LAS unsigned* MISC = (volatile LAS unsigned*)(C.lds + MISC_OFF);
      if (C.tid < 64) MISC[C.tid] = 0u;
      __syncthreads();
      (void)xcd_barrier_post((unsigned*)(A.ws() + WS_CTL) + CW_BAR, MISC + 8); }
    int lo, hi;
    { const KA A = ka_fresh(); lo = A.ph_lo(); hi = A.ph_hi(); }
    if (IN(0)) phase_prologue();
    if (IN(0)) { if (lo == 0 && hi == NPHASES) seam(); }
    if (IN(0) && lo == 0 && hi == NPHASES) phase_modreduce();
    SEAM(0);
    layer_body<0>(lo, hi);
    layer_body<1>(lo, hi);
#undef IN
#undef SEAM
}

extern "C" void kernel_launch(void* const* d_in, const int* in_sizes, int n_in, void* d_out, int out_size, void* d_ws, size_t ws_size, hipStream_t stream) {
    static int grid = 0;
    if (grid == 0) {
        if (n_in != 24 || out_size != RL * DM || ws_size < WS_END) { fprintf(stderr, "kernel_launch: unexpected shapes (n_in %d, out %d, ws %zu)\n", n_in, out_size, ws_size); grid = -1; return; }
        int dev = 0, cus = 0, per_cu = 0;
        if (hipGetDevice(&dev) != hipSuccess || hipDeviceGetAttribute(&cus, hipDeviceAttributeMultiprocessorCount, dev) != hipSuccess) { grid = -1; return; }
        if (hipFuncSetAttribute((const void*)mk_fwd, hipFuncAttributeMaxDynamicSharedMemorySize, LDS_BYTES) != hipSuccess) { fprintf(stderr, "kernel_launch: hipFuncSetAttribute failed\n"); grid = -1; return; }
        if (hipOccupancyMaxActiveBlocksPerMultiprocessor(&per_cu, (const void*)mk_fwd, 512, LDS_BYTES) != hipSuccess || per_cu < 1) { fprintf(stderr, "kernel_launch: occupancy query says %d\n", per_cu); per_cu = 1; }
        (void)hipGetLastError();
        grid = cus;
    }
    if (grid < 0) return;
    (void)hipMemsetAsync((char*)d_ws + WS_CTL, 0, CTL_ZERO_BYTES, stream);
    Args a{};
    for (int i = 0; i < 24; ++i) a.in[i] = (const float*)d_in[i];
    a.out = (float*)d_out; a.ws = (unsigned char*)d_ws;
    a.ph_lo = 0; a.ph_hi = NPHASES;
    hipLaunchKernelGGL(mk_fwd, dim3(grid), dim3(512), LDS_BYTES, stream, a);
}
```

```cpp
#include <hip/hip_runtime.h>
#include <cstdio>
#include <cstdint>

namespace pg8 {
#define PG8_LAS __attribute__((address_space(3)))
typedef unsigned short bf16_t;
typedef short bf16x8 __attribute__((ext_vector_type(8)));
typedef float f32x4 __attribute__((ext_vector_type(4)));
typedef unsigned u32x4 __attribute__((ext_vector_type(4)));
constexpr int BM = 256, BK = 64, HALF = 128, HTB = HALF * BK * 2  , STAGE_BYTES = 8 * HTB, NXCD = 8, WGM = 8;

__host__ __device__ __forceinline__ int lds_byte(int r, int c) { const int st = (r >> 4) * 2 + (c >> 5), rr = r & 15, cc = c & 31, ob = rr * 64 + cc * 2; return st * 1024 + (ob ^ (((ob >> 9) & 1) << 5)); }
__host__ __device__ __forceinline__ void stage_rc(int b, int& R, int& C) { const int st = b / 1024, sb = b % 1024, swz = sb ^ (((sb >> 9) & 1) << 5); R = (st >> 1) * 16 + swz / 64; C = (st & 1) * 32 + (swz % 64) / 2; }
__host__ __device__ __forceinline__ int perm32(int rho) { const int n = rho >> 4, i = rho & 15; return 8 * (i >> 2) + 4 * n + (i & 3); }

struct Unit { int pm, pn; };
struct Gemm { const bf16_t* A; const bf16_t* Bt; int M, N, K; };

struct StaticOrder {
    int nM, nN, nwg, G, c;
    __host__ __device__ void init(int M, int N, int G_, int c_) { nM = M / BM; nN = N / BM; nwg = nM * nN; G = G_; c = c_; }
    __host__ __device__ bool next(int i, Unit& u) const {
        const long L = (long)i * G + c; if (L >= nwg) return false;
        int wgid = (int)L; { const int q = nwg / NXCD, r = nwg % NXCD, xcd = wgid % NXCD, off = wgid / NXCD; wgid = (xcd < r ? xcd * (q + 1) : r * (q + 1) + (xcd - r) * q) + off; }
        const int nig = WGM * nN, gid = wgid / nig, fm = gid * WGM, gsz = (nM - fm) < WGM ? (nM - fm) : WGM;
        u.pm = fm + ((wgid % nig) % gsz); u.pn = (wgid % nig) / gsz; return true;
    }
    __device__ __forceinline__ void a_ready(const Unit&) const {}
    __device__ __forceinline__ void done(const Unit&) const {}
};

__device__ __forceinline__ unsigned cvt_pk_bf16(float lo, float hi) { unsigned r; asm volatile("v_cvt_pk_bf16_f32 %0, %1, %2" : "=v"(r) : "v"(lo), "v"(hi)); return r; }
typedef float f32x2 __attribute__((ext_vector_type(2)));
__device__ __forceinline__ f32x2 gelu_pk(f32x2 v) {
    const f32x2 av = __builtin_elementwise_abs(v), d = av * 0.2316418882f + 1.0f;
    f32x2 t; t.x = __builtin_amdgcn_rcpf(d.x); t.y = __builtin_amdgcn_rcpf(d.y);
    f32x2 q = t * 0.5307027145f + (-0.7265760135f); q = q * t + 0.7107068705f; q = q * t + (-0.142248368f); q = q * t + 0.127414796f; q = q * t;
    const f32x2 s = (v * v) * (-0.72134752044f);
    f32x2 e; e.x = __builtin_amdgcn_exp2f(s.x); e.y = __builtin_amdgcn_exp2f(s.y);
    const f32x2 m = v * (q * e), r = v - m;
    f32x2 o; o.x = v.x < 0.f ? m.x : r.x; o.y = v.y < 0.f ? m.y : r.y; return o;
}

template <int ACT  > struct EpiBf16 {
    static constexpr bool PERM = true, AFTER_DRAIN = false; static_assert(ACT == 0 || ACT == 1, "EpiBf16: ACT is 0 (none) or 1 (gelu_pk)");
    bf16_t* O; int ldc; const float* bias; int split_cols; size_t split_stride; float scale0;
    __device__ __forceinline__ void operator()(const f32x4 (&acc)[2][2][4][2], const Unit& u, int wr, int wc, int fr, int fq) const {
        const int row0 = u.pm * BM + wr * 64 + fr; int colt = u.pn * BM; bf16_t* base = O;
        float sc = 1.f; if (split_cols) { const int t = colt / split_cols; base += (size_t)t * split_stride; colt -= t * split_cols; if (t == 0) sc = scale0; }
        const int col0 = colt + wc * 32 + 8 * fq, bcol0 = u.pn * BM + wc * 32 + 8 * fq;
        f32x4 bv[2][2];
#pragma unroll
        for (int bj = 0; bj < 2; ++bj)
#pragma unroll
            for (int n = 0; n < 2; ++n) bv[bj][n] = bias ? *(const f32x4*)(bias + bcol0 + bj * HALF + 4 * n) : (f32x4){0.f, 0.f, 0.f, 0.f};
#pragma unroll
        for (int ai = 0; ai < 2; ++ai)
#pragma unroll
            for (int m = 0; m < 4; ++m) { bf16_t* rowp = base + (size_t)(row0 + ai * HALF + m * 16) * ldc + col0;
#pragma unroll
                for (int bj = 0; bj < 2; ++bj) { f32x4 v0 = acc[ai][bj][m][0] + bv[bj][0], v1 = acc[ai][bj][m][1] + bv[bj][1];
                    if (ACT == 1) { f32x2 a = gelu_pk((f32x2){v0[0], v0[1]}), b = gelu_pk((f32x2){v0[2], v0[3]}), c = gelu_pk((f32x2){v1[0], v1[1]}), d = gelu_pk((f32x2){v1[2], v1[3]});
                        v0 = (f32x4){a.x, a.y, b.x, b.y}; v1 = (f32x4){c.x, c.y, d.x, d.y}; }
                    v0 = v0 * sc; v1 = v1 * sc; u32x4 w; w.x = cvt_pk_bf16(v0[0], v0[1]); w.y = cvt_pk_bf16(v0[2], v0[3]); w.z = cvt_pk_bf16(v1[0], v1[1]); w.w = cvt_pk_bf16(v1[2], v1[3]);
                    *(u32x4*)(rowp + bj * HALF) = w; } }
    }
};


struct EpiResGate {
    static constexpr bool PERM = false, AFTER_DRAIN = false;
    const float* base_lat; const float* base_ctx; float* out_lat; float* out_ctx; const float* gate;
    int goff;
    __device__ __forceinline__ void operator()(const f32x4 (&acc)[2][2][4][2], const Unit& u, int wr, int wc, int fr, int fq) const {
        const int rowt = u.pm * BM; const bool lat = rowt < 32768;
        const int nsel = lat ? (rowt >> 14) : 2;
        const float* bs = lat ? base_lat + (size_t)rowt * 1024 : base_ctx + (size_t)(rowt - 32768) * 1024;
        float* os = lat ? out_lat + (size_t)rowt * 1024 : out_ctx + (size_t)(rowt - 32768) * 1024;
        const float* gv = gate + nsel * 6144 + goff;
        const int rl = wr * 64 + fr, col0 = u.pn * BM + wc * 32 + 4 * fq;
        f32x4 g[2][2];
#pragma unroll
        for (int bj = 0; bj < 2; ++bj)
#pragma unroll
            for (int n = 0; n < 2; ++n) g[bj][n] = *(const f32x4*)(gv + col0 + bj * HALF + n * 16);
#pragma unroll
        for (int ai = 0; ai < 2; ++ai)
#pragma unroll
            for (int m = 0; m < 4; ++m) { const size_t ro = (size_t)(rl + ai * HALF + m * 16) * 1024 + col0;
#pragma unroll
                for (int bj = 0; bj < 2; ++bj)
#pragma unroll
                    for (int n = 0; n < 2; ++n) { const f32x4 b = *(const f32x4*)(bs + ro + bj * HALF + n * 16); *(f32x4*)(os + ro + bj * HALF + n * 16) = b + g[bj][n] * acc[ai][bj][m][n]; } }
    }
};

template <class Epi, class Sched, bool ALIGN_EPI = false, bool SP2 = false>
__device__ __forceinline__ void gemm_phase(PG8_LAS unsigned char* lds, const Gemm g, const Sched& S, const Epi& E) {
    int tid_l = threadIdx.x; asm volatile("" : "+v"(tid_l));
    const int tid = tid_l, wid = __builtin_amdgcn_readfirstlane(tid >> 6), lane = tid & 63, wr = wid >> 2, wc = wid & 3, fr = lane & 15, fq = lane >> 4;
    const int K = g.K, nt = K / BK;
    unsigned voffA[2], voffB[2];
#pragma unroll
    for (int i = 0; i < 2; ++i) { int R, C; stage_rc(tid * 16 + i * 8192, R, C); const int Rb = Epi::PERM ? ((R & ~31) + perm32(R & 31)) : R;
        voffA[i] = (unsigned)(R * K + C) * 2u; voffB[i] = (unsigned)(Rb * K + C) * 2u; }
    const size_t kstep = (size_t)(BK * 2);
    const size_t hstep = (size_t)HALF * K * 2;
    const size_t tstep = 2 * hstep;
    const unsigned ldsw = (unsigned)wid * 1024u;
    const int aoff = lds_byte(wr * 64 + fr, fq * 8), boff = lds_byte(wc * 32 + fr, fq * 8);
#define PG8_SA(b, h) (((b) * 2 + (h)) * HTB)
#define PG8_SB(b, h) ((4 + (b) * 2 + (h)) * HTB)
#define PG8_STAGE(bufoff, gbase, voff) do { _Pragma("unroll") for (int _i = 0; _i < 2; ++_i) \
        __builtin_amdgcn_global_load_lds((const unsigned*)((const char*)(gbase) + (voff)[_i]), (PG8_LAS unsigned*)(lds + (bufoff) + ldsw + _i * 8192), 16, 0, 0); } while (0)
#define PG8_LDA(dst, b, h) do { _Pragma("unroll") for (int m = 0; m < 4; ++m) _Pragma("unroll") for (int k = 0; k < 2; ++k) dst[m][k] = *(const PG8_LAS bf16x8*)(lds + PG8_SA(b, h) + aoff + m * 2048 + k * 1024); } while (0)
#define PG8_LDB(dst, b, h) do { _Pragma("unroll") for (int n = 0; n < 2; ++n) _Pragma("unroll") for (int k = 0; k < 2; ++k) dst[n][k] = *(const PG8_LAS bf16x8*)(lds + PG8_SB(b, h) + boff + n * 2048 + k * 1024); } while (0)
#define PG8_MMA(ai, bj, At, Bt) do { __builtin_amdgcn_s_setprio(1); _Pragma("unroll") for (int m = 0; m < 4; ++m) _Pragma("unroll") for (int n = 0; n < 2; ++n) _Pragma("unroll") for (int k = 0; k < 2; ++k) \
        acc[ai][bj][m][n] = __builtin_amdgcn_mfma_f32_16x16x32_bf16(Bt[n][k], At[m][k], acc[ai][bj][m][n], 0, 0, 0); __builtin_amdgcn_s_setprio(0); } while (0)
#define PG8_WAIT_V(n) asm volatile("s_waitcnt vmcnt(" #n ")" ::: "memory")
#define PG8_WAIT_L(n) asm volatile("s_waitcnt lgkmcnt(" #n ")" ::: "memory")
#define PG8_BAR __builtin_amdgcn_s_barrier()
#define PG8_SCHED __builtin_amdgcn_sched_barrier(0)
    Unit cur, nxt; int ui = 0;
    if (!S.next(0, cur)) return;
    f32x4 acc[2][2][4][2];
#pragma unroll
    for (int a = 0; a < 2; ++a)
#pragma unroll
        for (int b = 0; b < 2; ++b)
#pragma unroll
            for (int m = 0; m < 4; ++m)
#pragma unroll
                for (int n = 0; n < 2; ++n) acc[a][b][m][n] = (f32x4){0.f, 0.f, 0.f, 0.f};
    bf16x8 At[4][2], B0[2][2], B1[2][2];
    const char* cA = (const char*)g.A + (size_t)cur.pm * tstep; const char* cB = (const char*)g.Bt + (size_t)cur.pn * tstep;
    S.a_ready(cur);
    if constexpr (SP2) {
        PG8_STAGE(PG8_SB(0, 0), cB, voffB); PG8_STAGE(PG8_SB(0, 1), cB + hstep, voffB); PG8_STAGE(PG8_SA(0, 0), cA, voffA); PG8_STAGE(PG8_SA(0, 1), cA + hstep, voffA);
        if (wr == 1) PG8_BAR;
        PG8_WAIT_V(2); PG8_BAR;
        PG8_STAGE(PG8_SB(1, 0), cB + kstep, voffB); PG8_STAGE(PG8_SA(1, 0), cA + kstep, voffA); PG8_STAGE(PG8_SB(1, 1), cB + hstep + kstep, voffB);
        PG8_WAIT_V(6); PG8_BAR;
    } else {
        PG8_STAGE(PG8_SB(0, 0), cB, voffB); PG8_STAGE(PG8_SA(0, 0), cA, voffA); PG8_STAGE(PG8_SB(0, 1), cB + hstep, voffB); PG8_STAGE(PG8_SA(0, 1), cA + hstep, voffA);
        if (wr == 1) PG8_BAR;
        PG8_WAIT_V(4); PG8_BAR;
        PG8_STAGE(PG8_SB(1, 0), cB + kstep, voffB); PG8_STAGE(PG8_SA(1, 0), cA + kstep, voffA); PG8_STAGE(PG8_SB(1, 1), cB + hstep + kstep, voffB);
        PG8_WAIT_V(6); PG8_BAR;
    }
    for (;;) {
        const bool has_next = S.next(ui + 1, nxt);
        const char* nA = has_next ? (const char*)g.A + (size_t)nxt.pm * tstep : cA; const char* nB = has_next ? (const char*)g.Bt + (size_t)nxt.pn * tstep : cB;
        for (int t = 0; t < nt; t += 2) {
            const bool last = (t == nt - 2);
            const char* a1 = cA + (size_t)(t + 1) * kstep;
            const char* a2 = last ? nA : cA + (size_t)(t + 2) * kstep; const char* b2 = last ? nB : cB + (size_t)(t + 2) * kstep;
            const char* a3 = a2 + kstep; const char* b3 = b2 + kstep;
            if (last && has_next) S.a_ready(nxt);
            if constexpr (SP2) {
            PG8_LDB(B0, 0, 0); PG8_LDB(B1, 0, 1); PG8_SCHED; PG8_LDA(At, 0, 0); PG8_STAGE(PG8_SA(1, 1), a1 + hstep, voffA);
            PG8_WAIT_V(8); PG8_WAIT_L(0); PG8_BAR; PG8_MMA(0, 0, At, B0); PG8_MMA(0, 1, At, B1); PG8_BAR; PG8_SCHED;
            PG8_LDA(At, 0, 1); PG8_STAGE(PG8_SB(0, 0), b2, voffB); PG8_STAGE(PG8_SB(0, 1), b2 + hstep, voffB); PG8_STAGE(PG8_SA(0, 0), a2, voffA);
            PG8_WAIT_V(8); PG8_WAIT_L(0); PG8_BAR; PG8_MMA(1, 0, At, B0); PG8_MMA(1, 1, At, B1); PG8_BAR; PG8_SCHED;
            PG8_LDB(B0, 1, 0); PG8_LDB(B1, 1, 1); PG8_SCHED; PG8_LDA(At, 1, 0); PG8_STAGE(PG8_SA(0, 1), a2 + hstep, voffA);
            PG8_WAIT_V(8); PG8_WAIT_L(0); PG8_BAR; PG8_MMA(0, 0, At, B0); PG8_MMA(0, 1, At, B1); PG8_BAR; PG8_SCHED;
            PG8_LDA(At, 1, 1); PG8_STAGE(PG8_SB(1, 0), b3, voffB); PG8_STAGE(PG8_SB(1, 1), b3 + hstep, voffB); PG8_STAGE(PG8_SA(1, 0), a3, voffA);
            PG8_WAIT_V(8); PG8_WAIT_L(0); PG8_BAR; PG8_MMA(1, 0, At, B0); PG8_MMA(1, 1, At, B1); PG8_BAR; PG8_SCHED;
            } else {
            PG8_LDB(B0, 0, 0); PG8_SCHED; PG8_LDA(At, 0, 0); PG8_STAGE(PG8_SA(1, 1), a1 + hstep, voffA);
            PG8_WAIT_L(8); PG8_BAR; PG8_WAIT_L(0); PG8_MMA(0, 0, At, B0); PG8_BAR; PG8_SCHED;
            PG8_LDB(B1, 0, 1); PG8_STAGE(PG8_SB(0, 0), b2, voffB);
            PG8_BAR; PG8_WAIT_L(0); PG8_MMA(0, 1, At, B1); PG8_BAR;
            PG8_LDA(At, 0, 1); PG8_STAGE(PG8_SA(0, 0), a2, voffA);
            PG8_BAR; PG8_WAIT_L(0); PG8_MMA(1, 0, At, B0); PG8_BAR; PG8_SCHED;
            PG8_STAGE(PG8_SB(0, 1), b2 + hstep, voffB);
            PG8_WAIT_V(6); PG8_BAR; PG8_MMA(1, 1, At, B1); PG8_BAR;
            PG8_LDB(B0, 1, 0); PG8_SCHED; PG8_LDA(At, 1, 0); PG8_STAGE(PG8_SA(0, 1), a2 + hstep, voffA);
            PG8_WAIT_L(8); PG8_BAR; PG8_WAIT_L(0); PG8_MMA(0, 0, At, B0); PG8_BAR; PG8_SCHED;
            PG8_LDB(B1, 1, 1); PG8_STAGE(PG8_SB(1, 0), b3, voffB);
            PG8_BAR; PG8_WAIT_L(0); PG8_MMA(0, 1, At, B1); PG8_BAR;
            PG8_LDA(At, 1, 1); PG8_STAGE(PG8_SA(1, 0), a3, voffA);
            PG8_BAR; PG8_WAIT_L(0); PG8_MMA(1, 0, At, B0); PG8_BAR; PG8_SCHED;
            PG8_STAGE(PG8_SB(1, 1), b3 + hstep, voffB);
            PG8_WAIT_V(6); PG8_BAR; PG8_MMA(1, 1, At, B1); PG8_BAR;
            }
        }
        if constexpr (ALIGN_EPI) { if (wr == 0) PG8_BAR; }
        if constexpr (!Epi::AFTER_DRAIN) { E(acc, cur, wr, wc, fr, fq); S.done(cur); }
        if (!has_next) break;
#pragma unroll
        for (int a = 0; a < 2; ++a)
#pragma unroll
            for (int b = 0; b < 2; ++b)
#pragma unroll
                for (int m = 0; m < 4; ++m)
#pragma unroll
                    for (int n = 0; n < 2; ++n) acc[a][b][m][n] = (f32x4){0.f, 0.f, 0.f, 0.f};
        cur = nxt; cA = nA; cB = nB; ++ui;
        if constexpr (ALIGN_EPI) { if (wr == 1) PG8_BAR; }
    }
    PG8_WAIT_V(0);
    if constexpr (!ALIGN_EPI) { if (wr == 0) PG8_BAR; }
    PG8_BAR;
    if constexpr (Epi::AFTER_DRAIN) { E.fused(acc, cur, wr, wc, fr, fq, lds, wid, lane); S.done(cur); }
#undef PG8_SA
#undef PG8_SB
#undef PG8_STAGE
#undef PG8_LDA
#undef PG8_LDB
#undef PG8_MMA
#undef PG8_WAIT_V
#undef PG8_WAIT_L
#undef PG8_BAR
#undef PG8_SCHED
}
}

constexpr int DM = 1024, NB = 2, SEQ = 16384, CTXL = 256, RL = NB * SEQ, RC = NB * CTXL, RT = RL + RC;
constexpr int NKT = (SEQ + CTXL) / 64;
constexpr int KT_BYTES = 64 * 128, VT_BYTES = 64 * 128;
constexpr int NCH = 260, CSTF = 4160;
constexpr float EPS = 1e-6f;
constexpr float QSCALE = 0.10206207261596577f * 1.4426950408889634f;
constexpr int NPH_L = 13, NPHASES = 1 + 2 * NPH_L;


constexpr size_t MiB = 1u << 20;
constexpr size_t WS_CTL = 0, CTL_ZERO_BYTES = 64 * 1024;
constexpr size_t WS_WIN = 1 * MiB, WS_WUQ = 9 * MiB, WS_WUKV = 11 * MiB, WS_WOUT = 12 * MiB, WS_WPQ = 16 * MiB, WS_SUBK = 24 * MiB;
constexpr size_t WS_MOD = 25 * MiB, WS_ROPE = 25 * MiB + 256 * 1024, WS_SC = 25 * MiB + 512 * 1024, WS_MS = WS_SC + 64 * 1024;
constexpr size_t WS_CTXS = 26 * MiB, WS_G = 28 * MiB, WS_KR = 31 * MiB, WS_TABU = 34 * MiB, WS_TABV = 66 * MiB;
constexpr size_t WS_ZA = 98 * MiB, WS_ZB = 163 * MiB, WS_Q = WS_ZA, WS_PQ = WS_ZA;
constexpr size_t WS_XN = 228 * MiB, WS_QA = WS_XN, WS_KVA = 253 * MiB, WS_VT = WS_XN;
constexpr size_t WS_MIX = 293 * MiB, WS_R66 = 358 * MiB, WS_KVRAW = WS_R66, WS_CST = WS_R66, WS_EID = WS_R66, WS_GATE = WS_R66 + 17 * MiB;
constexpr size_t WS_KN = 425 * MiB, WS_Q8 = 458 * MiB, WS_MODP = 491 * MiB, WS_END = 493 * MiB;
static_assert(WS_QA + (size_t)RT * 384 * 2 <= WS_KVA && WS_KVA + (size_t)RT * 256 * 2 <= WS_MIX, "QA/KVA inside the XN region");
static_assert(WS_VT + (size_t)NB * 8 * NKT * VT_BYTES <= WS_MIX, "Vt inside the XN region");
static_assert(WS_CST + (size_t)16 * NCH * CSTF * 4 <= WS_KN && WS_KVRAW + (size_t)RT * 1024 * 2 <= WS_KN, "R66 region");
static_assert(WS_KN + (size_t)NB * 8 * NKT * KT_BYTES <= WS_Q8 && WS_Q8 + (size_t)RT * 1024 <= WS_MODP, "Kn / Q8 regions");
static_assert(WS_G + (size_t)RT * 16 * 4 <= WS_KR && WS_KR + (size_t)RT * 32 * 2 <= WS_TABU, "G/KR");
constexpr int CW_BAR = 1024;

constexpr int LDS_BYTES = 147456, MISC_OFF = 143360;

#define LAS __attribute__((address_space(3)))
typedef unsigned short bf16;
typedef short bf16x8 __attribute__((ext_vector_type(8)));
typedef float f32x4 __attribute__((ext_vector_type(4)));
typedef float f32x16 __attribute__((ext_vector_type(16)));
typedef unsigned u32x4 __attribute__((ext_vector_type(4)));
typedef unsigned u32x2 __attribute__((ext_vector_type(2)));
#define LDS_WAIT() asm volatile("s_waitcnt lgkmcnt(0)" ::: "memory")

typedef float f32x2_t __attribute__((ext_vector_type(2))); typedef __bf16 bf16x2_t __attribute__((ext_vector_type(2)));
__device__ __forceinline__ unsigned pk2(float lo, float hi) { f32x2_t v = {lo, hi}; bf16x2_t b = __builtin_convertvector(v, bf16x2_t); return __builtin_bit_cast(unsigned, b); }
__device__ __forceinline__ unsigned f2bf(float f) { return pk2(f, 0.f) & 0xffffu; }
__device__ __forceinline__ float bflo(unsigned w) { return __builtin_bit_cast(float, w << 16); }
__device__ __forceinline__ float bfhi(unsigned w) { return __builtin_bit_cast(float, w & 0xffff0000u); }
__device__ __forceinline__ float bf2f(bf16 v) { return __builtin_bit_cast(float, (unsigned)v << 16); }
__device__ __forceinline__ float shfl_idx(float v, int srclane) { return __builtin_bit_cast(float, __builtin_amdgcn_ds_bpermute(srclane << 2, __builtin_bit_cast(int, v))); }
__device__ __forceinline__ int shfl_idx(int v, int srclane) { return __builtin_amdgcn_ds_bpermute(srclane << 2, v); }
#define DPP_ADD(v, ctrl) (v) += __builtin_bit_cast(float, __builtin_amdgcn_update_dpp(0, __builtin_bit_cast(int, (v)), (ctrl), 0xf, 0xf, true))
__device__ __forceinline__ float wave_sum(float v, int lane) {
    (void)lane;
    DPP_ADD(v, 0xB1);
    DPP_ADD(v, 0x4E);
    DPP_ADD(v, 0x141);
    DPP_ADD(v, 0x140);
    const int b = __builtin_bit_cast(int, v);
    return (__builtin_bit_cast(float, __builtin_amdgcn_readlane(b, 0)) + __builtin_bit_cast(float, __builtin_amdgcn_readlane(b, 16))) +
           (__builtin_bit_cast(float, __builtin_amdgcn_readlane(b, 32)) + __builtin_bit_cast(float, __builtin_amdgcn_readlane(b, 48)));
}
__device__ __forceinline__ float wave_max(float v, int lane) {
#pragma unroll
    for (int o = 1; o < 64; o <<= 1) v = fmaxf(v, shfl_idx(v, lane ^ o));
    return v;
}
__device__ __forceinline__ int crow(int g, int hh) { return (g & 3) + 8 * (g >> 2) + 4 * hh; }
__device__ __forceinline__ bf16x8 pack8(float a0, float a1, float a2, float a3, float a4, float a5, float a6, float a7) {
    u32x4 w; w.x = pk2(a0, a1); w.y = pk2(a2, a3); w.z = pk2(a4, a5); w.w = pk2(a6, a7); return __builtin_bit_cast(bf16x8, w);
}
__device__ __forceinline__ float gelu_f(float v) {
    const float av = fabsf(v), d = av * 0.2316418882f + 1.0f; const float t = __builtin_amdgcn_rcpf(d);
    float q = t * 0.5307027145f + (-0.7265760135f); q = q * t + 0.7107068705f; q = q * t + (-0.142248368f); q = q * t + 0.127414796f; q = q * t;
    const float e = __builtin_amdgcn_exp2f(v * v * (-0.72134752044f));
    const float mm = v * (q * e); return v < 0.f ? mm : v - mm;
}
#define MFMA32(a, b, c) __builtin_amdgcn_mfma_f32_32x32x16_bf16((a), (b), (c), 0, 0, 0)
#define ML_ZERO16 (f32x16){0.f, 0.f, 0.f, 0.f, 0.f, 0.f, 0.f, 0.f, 0.f, 0.f, 0.f, 0.f, 0.f, 0.f, 0.f, 0.f}

#define XB_TMO      128
#define XB_XCNT(j)  (256  + 64 * (j))
#define XB_XSUB(j)  (1280 + 64 * (j))
#define XB_XGEN(j)  (2304 + 64 * (j))
#define XB_TOP      3328
#define XB_TOPGEN   3392
#define XCD_BAR_WORDS 3456
#define XB_SPIN_CAP (1u << 18)
__device__ __forceinline__ unsigned xb_ld(unsigned* p)              { return __hip_atomic_load(p, __ATOMIC_RELAXED, __HIP_MEMORY_SCOPE_AGENT); }
__device__ __forceinline__ unsigned xb_add(unsigned* p, unsigned v) { return __hip_atomic_fetch_add(p, v, __ATOMIC_RELAXED, __HIP_MEMORY_SCOPE_AGENT); }
__device__ __forceinline__ unsigned xb_xcc_id() { return (unsigned)__builtin_amdgcn_s_getreg((3 << 11) | 20) & 0xFu; }
#define XB_SPIN(cond, bar) do { unsigned _sp = 0; while (cond) { __builtin_amdgcn_s_sleep(1); \
    if ((++_sp & 255u) == 0u) { if (xb_ld(&(bar)[XB_TMO])) break; if (_sp > XB_SPIN_CAP) { atomicAdd(&(bar)[XB_TMO], 1u); break; } } } } while (0)
struct XcdBarrier { unsigned* bar; unsigned x; volatile LAS unsigned* st; };
__device__ __forceinline__ XcdBarrier xcd_barrier_post(unsigned* bar, volatile LAS unsigned* st) {
    XcdBarrier b; b.bar = bar; b.x = xb_xcc_id(); b.st = st;
    if (threadIdx.x == 0) (void)xb_add(&bar[XB_XCNT(b.x)], 1u);
    return b;
}
__device__ __forceinline__ void xcd_barrier_complete(unsigned* bar, unsigned x, unsigned& nloc, unsigned& nx) {
    const unsigned G = gridDim.x * gridDim.y * gridDim.z;
    unsigned sum, cnt, mine, sp = 0u;
    for (;;) {
        sum = 0u; cnt = 0u; mine = 0u;
#pragma unroll
        for (unsigned j = 0; j < 16; ++j) { const unsigned c = xb_ld(&bar[XB_XCNT(j)]); sum += c; cnt += (c > 0u) ? 1u : 0u; mine = (j == x) ? c : mine; }
        if (sum == G) break;
        __builtin_amdgcn_s_sleep(1);
        if ((++sp & 255u) == 0u) { if (xb_ld(&bar[XB_TMO])) break; if (sp > XB_SPIN_CAP) { atomicAdd(&bar[XB_TMO], 1u); break; } }
    }
    nloc = mine > 0u ? mine : 1u; nx = cnt > 0u ? cnt : 1u;
}
__device__ __forceinline__ void xcd_barrier(const XcdBarrier& b) {
    asm volatile("s_waitcnt vmcnt(0)" ::: "memory");
    __syncthreads();
    if (threadIdx.x == 0) {
        unsigned* bar = b.bar;
        __builtin_amdgcn_s_waitcnt(0);
        unsigned nloc = b.st[0], nx = b.st[1];
        if (nloc == 0u) { xcd_barrier_complete(bar, b.x, nloc, nx); b.st[0] = nloc; b.st[1] = nx; }
        const unsigned old = xb_add(&bar[XB_XSUB(b.x)], 1u);
        const unsigned gen = old / nloc;
        if (old + 1u == (gen + 1u) * nloc) {
            __builtin_amdgcn_fence(__ATOMIC_RELEASE, "agent");
            asm volatile("s_waitcnt vmcnt(0)" ::: "memory");
            const unsigned og = xb_add(&bar[XB_TOP], 1u);
            const unsigned tg = og / nx;
            if (og + 1u == (tg + 1u) * nx) xb_add(&bar[XB_TOPGEN], 1u);
            else XB_SPIN(xb_ld(&bar[XB_TOPGEN]) == tg, bar);
            __builtin_amdgcn_fence(__ATOMIC_ACQUIRE, "agent");
            xb_add(&bar[XB_XGEN(b.x)], 1u);
            asm volatile("s_waitcnt vmcnt(0)" ::: "memory");
        } else {
            XB_SPIN(xb_ld(&bar[XB_XGEN(b.x)]) == gen, bar);
            __builtin_amdgcn_fence(__ATOMIC_ACQUIRE, "agent");
            asm volatile("s_waitcnt vmcnt(0)" ::: "memory");
        }
    }
    __syncthreads();
}

struct Args { const float* in[24]; float* out; unsigned char* ws; int ph_lo, ph_hi; };
#define CAS __attribute__((address_space(4)))
typedef const CAS unsigned char* karg_t;
struct KA { karg_t p;
    __device__ __forceinline__ const float* in(int k) const { return *(const float* const CAS*)(p + 8 * k); }
    __device__ __forceinline__ float* out() const { return *(float* const CAS*)(p + 192); }
    __device__ __forceinline__ unsigned char* ws() const { return *(unsigned char* const CAS*)(p + 200); }
    __device__ __forceinline__ int ph_lo() const { return *(const int CAS*)(p + 208); }
    __device__ __forceinline__ int ph_hi() const { return *(const int CAS*)(p + 212); }
};
static_assert(sizeof(Args) == 216, "Args layout");
__device__ __forceinline__ KA ka_fresh() { KA a; a.p = (karg_t)__builtin_amdgcn_kernarg_segment_ptr(); asm volatile("" : "+s"(a.p)); return a; }
struct Ctx {
    LAS unsigned char* lds;
    int tid, lane, wave, G, bid;
};
__device__ __forceinline__ Ctx ctx_fresh() {
    extern __shared__ __attribute__((aligned(16))) unsigned char lds_raw[];
    Ctx C; C.lds = (LAS unsigned char*)lds_raw; int t = threadIdx.x; asm volatile("" : "+v"(t));
    C.tid = t; C.lane = t & 63; C.wave = __builtin_amdgcn_readfirstlane(t >> 6); C.G = gridDim.x; C.bid = blockIdx.x; return C;
}
__device__ __forceinline__ const float* stream_in(const KA& A, const Ctx& C, int l, int row) {
    if (row < RL) return (l == 0 ? A.in(0) : (const float*)A.out()) + (size_t)row * DM;
    return (l == 0 ? A.in(2) : (const float*)(A.ws() + WS_CTXS)) + (size_t)(row - RL) * DM;
}
__device__ __forceinline__ float* stream_out(const KA& A, const Ctx& C, int row) {
    if (row < RL) return A.out() + (size_t)row * DM;
    return (float*)(A.ws() + WS_CTXS) + (size_t)(row - RL) * DM;
}

__device__ __forceinline__ void p0_transpose_item(const float* W, int K, int N, bf16* WT, int n0, int dst_row0, LAS float* scr, int kb, int lane) {
    const int k0 = 64 * kb;
#pragma unroll 8
    for (int i = 0; i < 32; ++i) { const int kk = 2 * i + (lane >> 5); const int n = n0 + (lane & 31); scr[kk * 33 + (lane & 31)] = (n < N) ? W[(size_t)(k0 + kk) * N + n] : 0.f; }
    LDS_WAIT(); asm volatile("" ::: "memory");
    const int c = lane & 7;
#pragma unroll
    for (int j = 0; j < 4; ++j) { const int n = (lane >> 3) + 8 * j; const LAS float* s = scr + (8 * c) * 33 + n;
        u32x4 o; o.x = pk2(s[0 * 33], s[1 * 33]); o.y = pk2(s[2 * 33], s[3 * 33]); o.z = pk2(s[4 * 33], s[5 * 33]); o.w = pk2(s[6 * 33], s[7 * 33]);
        *(u32x4*)(WT + (size_t)(dst_row0 + n) * K + k0 + 8 * c) = o; }
    LDS_WAIT(); asm volatile("" ::: "memory");
}
__device__ __forceinline__ void p0_poolw_item(const float* Win, const float* Wp, bf16* WT, LAS float* scr, int kb, int nb, int lane) {
    const int k0 = 64 * kb, g = nb >> 1, e = (nb & 1) * 32 + (lane & 31);
    float wc[64];
#pragma unroll
    for (int c = 0; c < 64; ++c) wc[c] = Wp[((size_t)g * 64 + c) * 64 + e];
#pragma unroll 2
    for (int i = 0; i < 32; ++i) { const int kk = 2 * i + (lane >> 5); const float* wr = Win + (size_t)(k0 + kk) * 1968 + g * 64; float a = 0.f;
#pragma unroll
        for (int c4 = 0; c4 < 16; ++c4) { const f32x4 x = *(const f32x4*)(wr + 4 * c4); a += x.x * wc[4 * c4] + x.y * wc[4 * c4 + 1] + x.z * wc[4 * c4 + 2] + x.w * wc[4 * c4 + 3]; }
        scr[kk * 33 + (lane & 31)] = a; }
    LDS_WAIT(); asm volatile("" ::: "memory");
    const int c = lane & 7;
#pragma unroll
    for (int j = 0; j < 4; ++j) { const int n = (lane >> 3) + 8 * j; const LAS float* sp = scr + (8 * c) * 33 + n;
        u32x4 o; o.x = pk2(sp[0 * 33], sp[1 * 33]); o.y = pk2(sp[2 * 33], sp[3 * 33]); o.z = pk2(sp[4 * 33], sp[5 * 33]); o.w = pk2(sp[6 * 33], sp[7 * 33]);
        *(u32x4*)(WT + (size_t)(32 * nb + n) * DM + k0 + 8 * c) = o; }
    LDS_WAIT(); asm volatile("" ::: "memory");
}
__device__ __forceinline__ void phase_prologue() {
    const KA A = ka_fresh(); const Ctx C = ctx_fresh();
    LAS float* scr = (LAS float*)(C.lds + C.wave * 16384);
    const int gw = C.bid * 8 + C.wave, NGW = C.G * 8, lane = C.lane;
    float* MODP = (float*)(A.ws() + WS_MODP);
    for (int it = gw; it < 2 * 96 * 8; it += NGW) {
        const int ks = it & 7, l = (it >> 3) / 96, j = ((it >> 3) % 96) * 64 + lane;
        const float* W = A.in(6) + ((size_t)l * DM + ks * 128) * 6144 + j;
        const float* c01 = A.in(1) + ks * 128; const float* c2p = A.in(3) + ks * 128;
        float a0 = 0.f, a1 = 0.f, a2 = 0.f;
#pragma unroll 16
        for (int k = 0; k < 128; ++k) {
            const float w = W[(size_t)k * 6144];
            const float c0 = c01[k], c1 = c01[DM + k], c2 = c2p[k];
            a0 += (c0 / (1.f + __expf(-c0))) * w; a1 += (c1 / (1.f + __expf(-c1))) * w; a2 += (c2 / (1.f + __expf(-c2))) * w;
        }
        float* mp = MODP + ((size_t)(l * 8 + ks) * 3) * 6144 + j;
        mp[0] = a0; mp[6144] = a1; mp[2 * 6144] = a2;
    }
    constexpr int I_IN = 16 * 64, I_UQ = 6 * 24, I_UKV = 4 * 32, I_OUT = 16 * 32, I_PQ = 16 * 64, I_L = I_IN + I_UQ + I_UKV + I_OUT + I_PQ;
    for (int it = gw; it < 2 * I_L; it += NGW) {
        const int l = it / I_L; int r = it % I_L;
        if (r < I_IN) {
            const int kb = r / 64, nb = r % 64;
            if (nb < 8) { p0_poolw_item(A.in(8) + (size_t)l * DM * 1968, A.in(9) + (size_t)l * 4 * 64 * 64, (bf16*)(A.ws() + WS_WIN) + (size_t)l * 2048 * DM, scr, kb, nb, lane); continue; }
            const int dst = nb < 29 ? 32 * nb : (nb < 61 ? 96 + 32 * nb : (nb == 61 ? 928 : (nb == 62 ? 960 : 992)));
            const int n0 = nb < 62 ? 32 * nb : 4096;
            p0_transpose_item(A.in(8) + (size_t)l * DM * 1968, DM, 1968, (bf16*)(A.ws() + WS_WIN) + (size_t)l * 2048 * DM, n0, dst, scr, kb, lane); continue; }
        r -= I_IN;
        if (r < I_UQ) { const int kb = r / 24, nb = r % 24; p0_transpose_item(A.in(13) + (size_t)l * 384 * 768, 384, 768, (bf16*)(A.ws() + WS_WUQ) + (size_t)l * 768 * 384, 32 * nb, 32 * nb, scr, kb, lane); continue; }
        r -= I_UQ;
        if (r < I_UKV) { const int kb = r / 32, nb = r % 32; p0_transpose_item(A.in(14) + (size_t)l * 256 * 1024, 256, 1024, (bf16*)(A.ws() + WS_WUKV) + (size_t)l * 1024 * 256, 32 * nb, 32 * nb, scr, kb, lane); continue; }
        r -= I_UKV;
        if (r < I_OUT) { const int kb = r / 32, nb = r % 32; p0_transpose_item(A.in(19) + (size_t)l * DM * DM, DM, DM, (bf16*)(A.ws() + WS_WOUT) + (size_t)l * DM * DM, 32 * nb, 32 * nb, scr, kb, lane); continue; }
        r -= I_OUT;
        { const int kb = r / 64, nb = r % 64; p0_transpose_item(A.in(20) + (size_t)l * DM * 2048, DM, 2048, (bf16*)(A.ws() + WS_WPQ) + (size_t)l * 2048 * DM, 32 * nb, 32 * nb, scr, kb, lane); }
    }
    const int gt = C.bid * 512 + C.tid, NT = C.G * 512;
    { const float* s = A.in(21); bf16* d = (bf16*)(A.ws() + WS_SUBK);
      for (int i = gt; i < 2 * 8 * 2 * 128 * 128 / 4; i += NT) { const f32x4 v = *(const f32x4*)(s + 4 * (size_t)i); u32x2 o; o.x = pk2(v.x, v.y); o.y = pk2(v.z, v.w); *(u32x2*)(d + 4 * (size_t)i) = o; } }
    { float* rp = (float*)(A.ws() + WS_ROPE);
      for (int i = gt; i < 256 * 8; i += NT) { const int p = i >> 3, f = i & 7;
          const float fr[8] = {1.0f, 0.31622776601683794f, 0.1f, 0.031622776601683794f, 0.01f, 0.0031622776601683794f, 0.001f, 0.00031622776601683794f};
          float fq = fr[0];
#pragma unroll
          for (int q = 1; q < 8; ++q) fq = (f == q) ? fr[q] : fq;
          const float ang = (float)p * fq;
          const double rev = (double)ang * 0.15915494309189535; const float fracr = (float)(rev - floor(rev));
          rp[2 * i] = __builtin_amdgcn_cosf(fracr); rp[2 * i + 1] = __builtin_amdgcn_sinf(fracr); } }
}

__device__ __forceinline__ void phase_modreduce() {
    const KA A = ka_fresh(); const Ctx C = ctx_fresh();
    const int gt = C.bid * 512 + C.tid, NT = C.G * 512;
    const float* MODP = (const float*)(A.ws() + WS_MODP); float* MOD = (float*)(A.ws() + WS_MOD);
    for (int i = gt; i < 2 * 3 * 6144; i += NT) { const int l = i / (3 * 6144), rem = i % (3 * 6144), j = rem % 6144;
        float a = A.in(7)[l * 6144 + j];
#pragma unroll
        for (int ks = 0; ks < 8; ++ks) a += MODP[((size_t)(l * 8 + ks) * 3) * 6144 + rem];
        MOD[i] = a; }
}
__device__ __forceinline__ void phase_norm(int l, int which) {
    const KA A = ka_fresh(); const Ctx C = ctx_fresh();
    const int gw = C.bid * 8 + C.wave, NGW = C.G * 8, lane = C.lane;
    const float* gain = A.in(which ? 5 : 4) + l * DM;
    const float* MOD = (const float*)(A.ws() + WS_MOD);
    bf16* XN = (bf16*)(A.ws() + WS_XN);
    const int nrows = (which == 1 && l == 1) ? RL : RT;
    for (int row = gw; row < nrows; row += NGW) {
        const float* xr = (which == 0) ? stream_in(A, C, l, row) : (const float*)stream_out(A, C, row);
        const int nsel = row < RL ? (row >> 14) : 2;
        const float* md = MOD + (l * 3 + nsel) * 6144 + which * 3072;
        f32x4 v[4]; float ss = 0.f;
#pragma unroll
        for (int i = 0; i < 4; ++i) { v[i] = *(const f32x4*)(xr + 4 * lane + 256 * i); ss += (v[i].x * v[i].x + v[i].y * v[i].y) + (v[i].z * v[i].z + v[i].w * v[i].w); }
        const float rs = 1.0f / sqrtf(wave_sum(ss, lane) * (1.f / DM) + EPS);
#pragma unroll
        for (int i = 0; i < 4; ++i) { const int j = 4 * lane + 256 * i;
            const f32x4 g = *(const f32x4*)(gain + j), sh = *(const f32x4*)(md + j), sc = *(const f32x4*)(md + 1024 + j);
            const f32x4 y = v[i] * rs * g * (sc + 1.0f) + sh;
            u32x2 o; o.x = pk2(y.x, y.y); o.y = pk2(y.z, y.w); *(u32x2*)(XN + (size_t)row * DM + j) = o; }
    }
}
constexpr float U_SCALE = 48.f, V_SCALE = 1.5f;
constexpr int TROW = 768;
struct __attribute__((packed, aligned(4))) U3 { unsigned a, b, c; };
__device__ __forceinline__ unsigned q_e2m3(float x) {
    const unsigned sg = (__builtin_bit_cast(unsigned, x) >> 31) << 5;
    const float a = fminf(fabsf(x), 7.5f);
    const float t = a * (a < 2.f ? 8.f : (a < 4.f ? 4.f : 2.f));
    return sg | ((unsigned)__builtin_rintf(t) + (a < 2.f ? 0u : (a < 4.f ? 8u : 16u)));
}
__device__ __forceinline__ void phase_tables(int l) {
    const KA A = ka_fresh(); const Ctx C = ctx_fresh();
    const size_t gt = (size_t)C.bid * 512 + C.tid, NT = (size_t)C.G * 512;
    const size_t n16 = (size_t)16384 * 1024 / 16;
#pragma unroll
    for (int w = 0; w < 2; ++w) {
        const float* s = A.in(22 + w) + (size_t)l * 16384 * 1024; unsigned char* d = A.ws() + (w ? WS_TABV : WS_TABU);
        const float sc = w ? V_SCALE : U_SCALE;
        for (size_t i = gt; i < n16; i += NT) {
            unsigned c[16];
#pragma unroll
            for (int q = 0; q < 4; ++q) { const f32x4 x = *(const f32x4*)(s + 16 * i + 4 * q);
                c[4 * q] = q_e2m3(x.x * sc); c[4 * q + 1] = q_e2m3(x.y * sc); c[4 * q + 2] = q_e2m3(x.z * sc); c[4 * q + 3] = q_e2m3(x.w * sc); }
            U3 o;
            o.a = c[0] | (c[1] << 6) | (c[2] << 12) | (c[3] << 18) | (c[4] << 24) | (c[5] << 30);
            o.b = (c[5] >> 2) | (c[6] << 4) | (c[7] << 10) | (c[8] << 16) | (c[9] << 22) | (c[10] << 28);
            o.c = (c[10] >> 4) | (c[11] << 2) | (c[12] << 8) | (c[13] << 14) | (c[14] << 20) | (c[15] << 26);
            *(U3*)(d + 12 * i) = o; }
    }
}

__device__ __forceinline__ void phase_post(int l) {
    const KA A = ka_fresh(); const Ctx C = ctx_fresh();
    const bf16* ZA = (const bf16*)(A.ws() + WS_ZA);
    bf16* MIX = (bf16*)(A.ws() + WS_MIX); bf16* QA = (bf16*)(A.ws() + WS_QA); bf16* KVA = (bf16*)(A.ws() + WS_KVA); bf16* KR = (bf16*)(A.ws() + WS_KR);
    float* GT = (float*)(A.ws() + WS_G);
    LAS float* U = (LAS float*)C.lds;
    const int tid = C.tid, lane = C.lane;
    for (int unit = C.bid; unit < RT / 32; unit += C.G) {
        const int r0 = unit * 32;
        int seq0, L;
        if (r0 < RL) { seq0 = (r0 >> 14) << 14; L = SEQ; } else { seq0 = RL + (((r0 - RL) >> 8) << 8); L = CTXL; }
        const int t0 = r0 - seq0;
        for (int idx = tid; idx < 48 * 32; idx += 512) { const int rr = idx >> 5, c8 = idx & 31; const int t = t0 - 8 + rr;
            u32x4 v = {0u, 0u, 0u, 0u};
            if (t >= 0 && t < L) v = *(const u32x4*)(ZA + (size_t)(seq0 + t) * 1024 + c8 * 8);
            LAS float* d = U + rr * 256 + c8 * 8;
            d[0] = bflo(v.x); d[1] = bfhi(v.x); d[2] = bflo(v.y); d[3] = bfhi(v.y); d[4] = bflo(v.z); d[5] = bfhi(v.z); d[6] = bflo(v.w); d[7] = bfhi(v.w); }
        __syncthreads();
        { const int ch = tid & 255, half = tid >> 8, hw = __builtin_amdgcn_readfirstlane(1 << (ch >> 6));
          const float sc = A.in(10)[l * 256 + ch];
          for (int i = half * 16; i < half * 16 + 16; ++i) { const int t = t0 + i; const int lo = max(t - hw, 0), hi = min(t + hw, L);
              float sm = 0.f; for (int tt = lo; tt < hi; ++tt) sm += U[(tt - t0 + 8) * 256 + ch];
              const float dv = sm / (float)(hi - lo) - U[(i + 8) * 256 + ch];
              MIX[(size_t)(r0 + i) * 1024 + ch] = (bf16)f2bf(dv * sc); } }
#pragma unroll
        for (int q = 0; q < 4; ++q) { const int row = r0 + C.wave * 4 + q; const bf16* za = ZA + (size_t)row * 1024;
            { float x[6]; float ss = 0.f;
#pragma unroll
              for (int i = 0; i < 3; ++i) { const unsigned w = *(const unsigned*)(za + 256 + 2 * lane + 128 * i); x[2 * i] = bflo(w); x[2 * i + 1] = bfhi(w); ss += x[2 * i] * x[2 * i] + x[2 * i + 1] * x[2 * i + 1]; }
              const float rs = 1.0f / sqrtf(wave_sum(ss, lane) * (1.f / 384.f) + EPS); const float* gq = A.in(11) + l * 384;
#pragma unroll
              for (int i = 0; i < 3; ++i) { const int j = 2 * lane + 128 * i; *(unsigned*)(QA + (size_t)row * 384 + j) = pk2(x[2 * i] * rs * gq[j], x[2 * i + 1] * rs * gq[j + 1]); } }
            { const u32x2 w = *(const u32x2*)(za + 640 + 4 * lane);
              const float x0 = bflo(w.x), x1 = bfhi(w.x), x2 = bflo(w.y), x3 = bfhi(w.y);
              const float rs = 1.0f / sqrtf(wave_sum(x0 * x0 + x1 * x1 + x2 * x2 + x3 * x3, lane) * (1.f / 256.f) + EPS); const float* gk = A.in(12) + l * 256 + 4 * lane;
              u32x2 o; o.x = pk2(x0 * rs * gk[0], x1 * rs * gk[1]); o.y = pk2(x2 * rs * gk[2], x3 * rs * gk[3]); *(u32x2*)(KVA + (size_t)row * 256 + 4 * lane) = o; }
            if (lane < 16) *(unsigned*)(KR + (size_t)row * 32 + 2 * lane) = *(const unsigned*)(za + 896 + 2 * lane);
            if (lane < 16) { float gv = bf2f(za[928 + lane]) + A.in(17)[l * 16 + lane];
                if ((lane >> 2) & 1) gv = fminf(gv, 0.f) - log1pf(__expf(-fabsf(gv)));
                GT[(size_t)row * 16 + lane] = gv; }
        }
        __syncthreads();
    }
}

__device__ __forceinline__ unsigned fp8x4(float a, float b, float c, float d) {
    a = __builtin_amdgcn_fmed3f(a, -448.f, 448.f); b = __builtin_amdgcn_fmed3f(b, -448.f, 448.f); c = __builtin_amdgcn_fmed3f(c, -448.f, 448.f); d = __builtin_amdgcn_fmed3f(d, -448.f, 448.f);
    int w = __builtin_amdgcn_cvt_pk_fp8_f32(a, b, 0, false); w = __builtin_amdgcn_cvt_pk_fp8_f32(c, d, w, true); return (unsigned)w;
}
__device__ __forceinline__ void qk_head(const bf16* src_lo, const bf16* src_hi, unsigned char* dst, int sw, const float* gn, bool rot, const float (&cs)[16], const float (&sn)[16], float oscale) {
    float ss = 0.f;
#pragma unroll 4
    for (int i = 0; i < 8; ++i) { const u32x4 w = *(const u32x4*)(src_lo + 8 * i);
        ss += (bflo(w.x) * bflo(w.x) + bfhi(w.x) * bfhi(w.x)) + (bflo(w.y) * bflo(w.y) + bfhi(w.y) * bfhi(w.y)) + (bflo(w.z) * bflo(w.z) + bfhi(w.z) * bfhi(w.z)) + (bflo(w.w) * bflo(w.w) + bfhi(w.w) * bfhi(w.w)); }
    u32x4 wr[4];
#pragma unroll
    for (int i = 0; i < 4; ++i) { wr[i] = *(const u32x4*)(src_hi + 8 * i); const u32x4 w = wr[i];
        ss += (bflo(w.x) * bflo(w.x) + bfhi(w.x) * bfhi(w.x)) + (bflo(w.y) * bflo(w.y) + bfhi(w.y) * bfhi(w.y)) + (bflo(w.z) * bflo(w.z) + bfhi(w.z) * bfhi(w.z)) + (bflo(w.w) * bflo(w.w) + bfhi(w.w) * bfhi(w.w)); }
    const float rs = oscale / sqrtf(ss * (1.f / 96.f) + EPS);
    __builtin_amdgcn_sched_barrier(0);
#pragma unroll 1
    for (int i = 0; i < 8; ++i) {
        const u32x4 w = *(const u32x4*)(src_lo + 8 * i); const f32x4 g0 = *(const f32x4*)(gn + 8 * i), g1 = *(const f32x4*)(gn + 8 * i + 4);
        u32x2 o; o.x = fp8x4(bflo(w.x) * rs * g0.x, bfhi(w.x) * rs * g0.y, bflo(w.y) * rs * g0.z, bfhi(w.y) * rs * g0.w);
        o.y = fp8x4(bflo(w.z) * rs * g1.x, bfhi(w.z) * rs * g1.y, bflo(w.w) * rs * g1.z, bfhi(w.w) * rs * g1.w);
        *(u32x2*)(dst + ((((i >> 1) ^ sw) << 4) + ((i & 1) << 3))) = o; }
    __builtin_amdgcn_sched_barrier(0);
#pragma unroll
    for (int i = 0; i < 2; ++i) {
        const u32x4 p = wr[i], q = wr[2 + i];
        const f32x4 ga = *(const f32x4*)(gn + 64 + 8 * i), gb = *(const f32x4*)(gn + 64 + 8 * i + 4), gc = *(const f32x4*)(gn + 80 + 8 * i), gd = *(const f32x4*)(gn + 80 + 8 * i + 4);
        float y1[8], y2[8];
        y1[0] = bflo(p.x) * rs * ga.x; y1[1] = bfhi(p.x) * rs * ga.y; y1[2] = bflo(p.y) * rs * ga.z; y1[3] = bfhi(p.y) * rs * ga.w; y1[4] = bflo(p.z) * rs * gb.x; y1[5] = bfhi(p.z) * rs * gb.y; y1[6] = bflo(p.w) * rs * gb.z; y1[7] = bfhi(p.w) * rs * gb.w;
        y2[0] = bflo(q.x) * rs * gc.x; y2[1] = bfhi(q.x) * rs * gc.y; y2[2] = bflo(q.y) * rs * gc.z; y2[3] = bfhi(q.y) * rs * gc.w; y2[4] = bflo(q.z) * rs * gd.x; y2[5] = bfhi(q.z) * rs * gd.y; y2[6] = bflo(q.w) * rs * gd.z; y2[7] = bfhi(q.w) * rs * gd.w;
        if (rot) {
#pragma unroll
            for (int j = 0; j < 8; ++j) { const float a = y1[j] * cs[8 * i + j] - y2[j] * sn[8 * i + j], bb = y2[j] * cs[8 * i + j] + y1[j] * sn[8 * i + j]; y1[j] = a; y2[j] = bb; }
        }
        u32x2 o; o.x = fp8x4(y1[0], y1[1], y1[2], y1[3]); o.y = fp8x4(y1[4], y1[5], y1[6], y1[7]); *(u32x2*)(dst + (((4 ^ sw) << 4) + (i << 3))) = o;
        u32x2 o2; o2.x = fp8x4(y2[0], y2[1], y2[2], y2[3]); o2.y = fp8x4(y2[4], y2[5], y2[6], y2[7]); *(u32x2*)(dst + (((5 ^ sw) << 4) + (i << 3))) = o2;
    }
    { u32x4 z; z.x = 0u; z.y = 0u; z.z = 0u; z.w = 0u; *(u32x4*)(dst + ((6 ^ sw) << 4)) = z; *(u32x4*)(dst + ((7 ^ sw) << 4)) = z; }
    __builtin_amdgcn_sched_barrier(0);
}
__device__ __forceinline__ void phase_qknorm(int l) {
    const KA A = ka_fresh(); const Ctx C = ctx_fresh();
    const int gw = C.bid * 8 + C.wave, NGW = C.G * 8, lane = C.lane;
    const bf16* Q = (const bf16*)(A.ws() + WS_Q); const bf16* KV = (const bf16*)(A.ws() + WS_KVRAW); const bf16* KR = (const bf16*)(A.ws() + WS_KR);
    unsigned char* KN = A.ws() + WS_KN; unsigned char* VT = A.ws() + WS_VT;
    const float* rope = (const float*)(A.ws() + WS_ROPE);
    const float* qg = A.in(15) + l * 96; const float* kg = A.in(16) + l * 96;
    for (int u = gw; u < (RT / 64) * 8; u += NGW) {
        const int h = u & 7, tl = u >> 3, row0 = tl * 64, row = row0 + lane;
        const bool lat = row0 < RL; int b, t0;
        if (lat) { b = row0 >> 14; t0 = row0 & (SEQ - 1); } else { b = (row0 - RL) >> 8; t0 = (row0 - RL) & 255; }
        const int ktile = lat ? (t0 >> 6) : (SEQ + t0) >> 6;
        float cs[16], sn[16];
#pragma unroll
        for (int i = 0; i < 16; ++i) { cs[i] = 1.f; sn[i] = 0.f; }
        if (lat) {
#pragma unroll
            for (int i = 0; i < 16; ++i) { const int p = (i < 8) ? (t0 >> 6) : lane; const float* rp = rope + (p * 8 + (i & 7)) * 2; cs[i] = rp[0]; sn[i] = rp[1]; }
        }
        { const bf16* qp = Q + (size_t)row * 768 + h * 96;
          qk_head(qp, qp + 64, A.ws() + WS_Q8 + (size_t)row * 1024 + h * 128, 0, qg, lat, cs, sn, QSCALE); }
        const bf16* kvp = KV + (size_t)row * 1024 + h * 128;
        qk_head(kvp, KR + (size_t)row * 32, KN + ((size_t)(b * 8 + h) * NKT + ktile) * KT_BYTES + lane * 128, (lane >> 1) & 7, kg, lat, cs, sn, 1.0f);
        { const int kap = lane & 15; const int pos = (lane & ~15) + 8 * ((kap >> 2) & 1) + 4 * (kap >> 3) + (kap & 3);
          bf16* vd = (bf16*)(VT + ((size_t)(b * 8 + h) * NKT + ktile) * VT_BYTES);
          const int pa = pos >> 3, pb = pos & 7;
#pragma unroll 1
          for (int i = 0; i < 8; ++i) { const u32x4 vv = *(const u32x4*)(kvp + 64 + 8 * i);
#pragma unroll
              for (int e = 0; e < 8; ++e) { const int d = 8 * i + e; const unsigned wd = (e >> 1) == 0 ? vv.x : ((e >> 1) == 1 ? vv.y : ((e >> 1) == 2 ? vv.z : vv.w)); const bf16 val = (bf16)((e & 1) ? (wd >> 16) : (wd & 0xffffu));
                  vd[(unsigned)(d * 64 + ((pa ^ ((d >> 1) & 7)) << 3) + pb)] = val; } } }
    }
}

__device__ __forceinline__ int ml_row(int b, int dir, int j, int s) {
    if (j < 4) { const int p = 64 * j + s; return RL + b * CTXL + (dir ? CTXL - 1 - p : p); }
    const int p = 64 * (j - 4) + s; return b * SEQ + (dir ? SEQ - 1 - p : p);
}
__device__ __forceinline__ void phase_ml_local() {
    const KA A = ka_fresh(); const Ctx C = ctx_fresh();
    const int gw = C.bid * 8 + C.wave, NGW = C.G * 8, lane = C.lane, r = lane & 31, hh = lane >> 5;
    const bf16* ZB = (const bf16*)(A.ws() + WS_ZB); const float* GT = (const float*)(A.ws() + WS_G);
    float* CST = (float*)(A.ws() + WS_CST); float* SC = (float*)(A.ws() + WS_SC);
    for (int u = gw; u < 16 * NCH; u += NGW) {
        const int sq = u / NCH, j = u % NCH, b = sq >> 3, h = (sq >> 1) & 3, dir = sq & 1;
        const int rowl = ml_row(b, dir, j, lane);
        const float gi = GT[(size_t)rowl * 16 + dir * 8 + h], lf = GT[(size_t)rowl * 16 + dir * 8 + 4 + h];
        float bs = lf;
#pragma unroll
        for (int o = 1; o < 64; o <<= 1) { const float tv = shfl_idx(bs, lane - o); if (lane >= o) bs += tv; }
        const float blast = shfl_idx(bs, 63);
        const float dec = blast + gi - bs;
        const float mloc = wave_max(dec, lane);
        const float w = __expf(dec - mloc);
        const int row0 = ml_row(b, dir, j, 0), rstep = dir ? -1 : 1;
        f32x16 acc[2][2];
#pragma unroll
        for (int vb = 0; vb < 2; ++vb)
#pragma unroll
            for (int db = 0; db < 2; ++db) acc[vb][db] = ML_ZERO16;
        float nacc0 = 0.f, nacc1 = 0.f;
#pragma unroll
        for (int st = 0; st < 4; ++st) {
            float ws[8]; unsigned rofs[8];
#pragma unroll
            for (int jj = 0; jj < 8; ++jj) { const int sidx = 16 * st + 8 * hh + jj; ws[jj] = shfl_idx(w, sidx); rofs[jj] = (unsigned)((row0 + rstep * sidx) * 1024 + h * 64 + r); }
            bf16x8 Af[2], Bf[2];
#pragma unroll
            for (int blk = 0; blk < 2; ++blk) {
                float kx[8];
#pragma unroll
                for (int jj = 0; jj < 8; ++jj) { kx[jj] = bf2f(ZB[rofs[jj] + 256 + 32 * blk]); Bf[blk][jj] = (short)ZB[rofs[jj] + 256 + 32 * blk]; }
                if (blk == 0) {
#pragma unroll
                    for (int jj = 0; jj < 8; ++jj) nacc0 += ws[jj] * kx[jj]; }
                else {
#pragma unroll
                    for (int jj = 0; jj < 8; ++jj) nacc1 += ws[jj] * kx[jj]; }
                float vx[8];
#pragma unroll
                for (int jj = 0; jj < 8; ++jj) vx[jj] = bf2f(ZB[rofs[jj] + 512 + 32 * blk]) * ws[jj];
                Af[blk] = pack8(vx[0], vx[1], vx[2], vx[3], vx[4], vx[5], vx[6], vx[7]);
            }
#pragma unroll
            for (int vb = 0; vb < 2; ++vb)
#pragma unroll
                for (int db = 0; db < 2; ++db) acc[vb][db] = MFMA32(Af[vb], Bf[db], acc[vb][db]);
            __builtin_amdgcn_sched_barrier(0);
        }
        float* cp = CST + (size_t)u * CSTF;
#pragma unroll
        for (int vb = 0; vb < 2; ++vb)
#pragma unroll
            for (int db = 0; db < 2; ++db)
#pragma unroll
                for (int g = 0; g < 16; ++g) cp[(32 * vb + crow(g, hh)) * 64 + 32 * db + r] = acc[vb][db][g];
        nacc0 += shfl_idx(nacc0, lane ^ 32); nacc1 += shfl_idx(nacc1, lane ^ 32);
        if (hh == 0) { cp[4096 + r] = nacc0; cp[4096 + 32 + r] = nacc1; }
        if (lane == 0) { SC[u * 2] = mloc; SC[u * 2 + 1] = blast; }
    }
}
__device__ __forceinline__ void phase_ml_scan() {
    const KA A = ka_fresh(); const Ctx C = ctx_fresh();
    const int gt = C.bid * 512 + C.tid, NT = C.G * 512;
    float* CST = (float*)(A.ws() + WS_CST); const float* SC = (const float*)(A.ws() + WS_SC); float* MS = (float*)(A.ws() + WS_MS);
    for (int e = gt; e < 16 * CSTF; e += NT) {
        const int sq = e / CSTF, el = e % CSTF;
        float* base = CST + (size_t)sq * NCH * CSTF + el;
        float cv = 0.f, m = -1e30f;
#pragma unroll 1
        for (int j0 = 0; j0 < NCH; j0 += 10) {
            float loc[10]; f32x2_t sc[10];
#pragma unroll
            for (int u = 0; u < 10; ++u) { loc[u] = base[(size_t)(j0 + u) * CSTF]; sc[u] = *(const f32x2_t*)(SC + (sq * NCH + j0 + u) * 2); }
#pragma unroll
            for (int u = 0; u < 10; ++u) {
                base[(size_t)(j0 + u) * CSTF] = cv;
                if (el == 0) MS[sq * NCH + j0 + u] = m;
                const float mn = fmaxf(sc[u].y + m, sc[u].x);
                cv = __expf(sc[u].y + m - mn) * cv + __expf(sc[u].x - mn) * loc[u]; m = mn;
            }
        }
    }
}
template <int DIR>
__device__ __forceinline__ void ml_sblock(f32x16& S, float& den, const bf16* ZB, const bf16x8 (&Qf)[4], int sb, int base_row, int h, int r, int hh, int jl, float a, float Mj) {
    S = ML_ZERO16;
    const int sr = 32 * sb + r; const int rows = base_row + (DIR ? 63 - sr : sr);
#pragma unroll
    for (int st = 0; st < 4; ++st) { const bf16x8 Kf = *(const bf16x8*)(ZB + (unsigned)(rows * 1024 + 256 + h * 64 + st * 16 + hh * 8)); S = MFMA32(Kf, Qf[st], S); }
#pragma unroll
    for (int g = 0; g < 16; ++g) { const int s = 32 * sb + crow(g, hh); const float as = shfl_idx(a, s);
        const float p = (s <= jl) ? S[g] * 0.125f * __expf(as - Mj) : 0.f; S[g] = p; den += p; }
}
template <int DIR>
__device__ __forceinline__ void ml_pv(f32x16& O, const f32x16& S, const bf16* ZB, int sb, int base_row, int h, int v, int hh) {
#pragma unroll
    for (int st2 = 0; st2 < 2; ++st2) {
        bf16x8 VA;
#pragma unroll
        for (int jj = 0; jj < 8; ++jj) { const int s = 32 * sb + 16 * st2 + 8 * (jj >> 2) + 4 * hh + (jj & 3); const int rows = base_row + (DIR ? 63 - s : s);
            VA[jj] = (short)ZB[(unsigned)(rows * 1024 + 512 + h * 64 + v)]; }
        const bf16x8 PB = pack8(S[8 * st2 + 0], S[8 * st2 + 1], S[8 * st2 + 2], S[8 * st2 + 3], S[8 * st2 + 4], S[8 * st2 + 5], S[8 * st2 + 6], S[8 * st2 + 7]);
        O = MFMA32(VA, PB, O);
        __builtin_amdgcn_sched_barrier(0);
    }
}
template <int DIR>
__device__ __forceinline__ void ml_out_dir(const KA& A, const Ctx& C, LAS float* H, int b, int h, int c, int base_row, int lane) {
    const bf16* ZB = (const bf16*)(A.ws() + WS_ZB); const float* GT = (const float*)(A.ws() + WS_G);
    const float* CST = (const float*)(A.ws() + WS_CST); const float* MS = (const float*)(A.ws() + WS_MS);
    const int r = lane & 31, hh = lane >> 5;
    const int j = DIR ? (c < 4 ? 3 - c : 263 - c) : c;
    const int sq = (b * 4 + h) * 2 + DIR;
    const float* Cp = CST + ((size_t)sq * NCH + j) * CSTF;
    const float m0 = MS[sq * NCH + j];
    const int rowl = base_row + (DIR ? 63 - lane : lane);
    const float gi = GT[(size_t)rowl * 16 + DIR * 8 + h], lf = GT[(size_t)rowl * 16 + DIR * 8 + 4 + h];
    float bs = lf;
#pragma unroll
    for (int o = 1; o < 64; o <<= 1) { const float tv = shfl_idx(bs, lane - o); if (lane >= o) bs += tv; }
    const float a = gi - bs;
    float pm = a;
#pragma unroll
    for (int o = 1; o < 64; o <<= 1) { const float tv = shfl_idx(pm, lane - o); if (lane >= o) pm = fmaxf(pm, tv); }
#pragma unroll 1
    for (int jb = 0; jb < 2; ++jb) {
        const int jl = 32 * jb + r;
        const float bj = shfl_idx(bs, jl), Mj = fmaxf(m0, shfl_idx(pm, jl));
        const int rowj = base_row + (DIR ? 63 - jl : jl);
        const int tok = DIR ? 63 - jl : jl;
        bf16x8 Qf[4];
#pragma unroll
        for (int st = 0; st < 4; ++st) Qf[st] = *(const bf16x8*)(ZB + (unsigned)(rowj * 1024 + h * 64 + st * 16 + hh * 8));
        f32x16 S0, S1 = ML_ZERO16; float den = 0.f;
        ml_sblock<DIR>(S0, den, ZB, Qf, 0, base_row, h, r, hh, jl, a, Mj);
        if (jb == 1) ml_sblock<DIR>(S1, den, ZB, Qf, 1, base_row, h, r, hh, jl, a, Mj);
        den += shfl_idx(den, lane ^ 32);
        const float wi = __expf(m0 - Mj) * 0.125f;
        float nq = 0.f;
#pragma unroll
        for (int st = 0; st < 4; ++st) { const f32x4 n0 = *(const f32x4*)(Cp + 4096 + st * 16 + hh * 8), n1 = *(const f32x4*)(Cp + 4096 + st * 16 + hh * 8 + 4);
            const u32x4 qw = __builtin_bit_cast(u32x4, Qf[st]);
            nq += n0.x * bflo(qw.x) + n0.y * bfhi(qw.x) + n0.z * bflo(qw.y) + n0.w * bfhi(qw.y) + n1.x * bflo(qw.z) + n1.y * bfhi(qw.z) + n1.z * bflo(qw.w) + n1.w * bfhi(qw.w); }
        nq += shfl_idx(nq, lane ^ 32);
        den += wi * nq;
        const float inv = 1.0f / fmaxf(fabsf(den), __expf(-(bj + Mj)));
#pragma unroll 1
        for (int vb = 0; vb < 2; ++vb) {
            const int v = 32 * vb + r;
            f32x16 O = ML_ZERO16;
            ml_pv<DIR>(O, S0, ZB, 0, base_row, h, v, hh);
            if (jb == 1) ml_pv<DIR>(O, S1, ZB, 1, base_row, h, v, hh);
            f32x16 I = ML_ZERO16;
#pragma unroll
            for (int st = 0; st < 4; ++st) { const float* cr = Cp + (size_t)v * 64 + st * 16 + hh * 8; const f32x4 c0 = *(const f32x4*)cr, c1 = *(const f32x4*)(cr + 4);
                const bf16x8 CA = pack8(c0.x, c0.y, c0.z, c0.w, c1.x, c1.y, c1.z, c1.w); I = MFMA32(CA, Qf[st], I); __builtin_amdgcn_sched_barrier(0); }
#pragma unroll
            for (int g = 0; g < 16; ++g) { const float hv = (O[g] + wi * I[g]) * inv; const int idx = (32 * vb + crow(g, hh)) * 65 + tok;
                if (DIR == 1) H[idx] = hv; else H[idx] += hv; }
        }
    }
}
__device__ __forceinline__ void phase_ml_out(int l) {
    const KA A = ka_fresh(); const Ctx C = ctx_fresh();
    const int gw = C.bid * 8 + C.wave, NGW = C.G * 8, lane = C.lane;
    const bf16* ZB = (const bf16*)(A.ws() + WS_ZB); bf16* MIX = (bf16*)(A.ws() + WS_MIX);
    LAS float* H = (LAS float*)(C.lds + C.wave * 16640);
    const int c_lo = (l == 1) ? 4 : 0, ncu = NCH - c_lo;
    for (int u = gw; u < 8 * ncu; u += NGW) {
        const int c = c_lo + u % ncu, bh = u / ncu, h = bh & 3, b = bh >> 2;
        const int base_row = c < 4 ? RL + b * CTXL + 64 * c : b * SEQ + 64 * (c - 4);
        ml_out_dir<1>(A, C, H, b, h, c, base_row, lane);
        LDS_WAIT(); asm volatile("" ::: "memory");
        ml_out_dir<0>(A, C, H, b, h, c, base_row, lane);
        LDS_WAIT(); asm volatile("" ::: "memory");
        float ss = 0.f;
#pragma unroll 8
        for (int v = 0; v < 64; ++v) { const float x = H[v * 65 + lane]; ss += x * x; }
        const float rs = 1.0f / sqrtf(ss * (1.f / 64.f) + EPS);
        const float gnv = A.in(18)[l * 256 + h * 64 + lane];
#pragma unroll 4
        for (int t = 0; t < 64; ++t) {
            const float rst = __builtin_bit_cast(float, __builtin_amdgcn_readlane(__builtin_bit_cast(int, rs), t));
            const size_t off = (size_t)(base_row + t) * 1024 + 768 + h * 64 + lane;
            const float o = bf2f(ZB[off]); const float sg = 1.0f / (1.0f + __expf(-o));
            MIX[off] = (bf16)f2bf(H[lane * 65 + t] * rst * gnv * sg);
        }
        LDS_WAIT(); asm volatile("" ::: "memory");
    }
}

__device__ __forceinline__ void glds16s(unsigned voff, const unsigned char* sbase, unsigned lds_dst) {
    unsigned keep;
    asm volatile("s_mov_b32 %0, m0\n\ts_mov_b32 m0, %3\n\ts_nop 0\n\tglobal_load_lds_dwordx4 %1, %2\n\ts_mov_b32 m0, %0" : "=&s"(keep) : "v"(voff), "s"(sbase), "s"(lds_dst) : "memory");
}
#define ATT_WAIT_BAR(N) asm volatile("s_waitcnt vmcnt(" #N ") lgkmcnt(0)\n\ts_barrier" ::: "memory")
constexpr int ATT_SLOT = 16384, ATT_NS = 6;
typedef int i32x8 __attribute__((ext_vector_type(8)));
#define MFMA8(a, b, c) __builtin_amdgcn_mfma_scale_f32_32x32x64_f8f6f4((a), (b), (c), 0, 0, 0, 127, 0, 127)
template <bool FIXEDREF>
__device__ __forceinline__ void attn_unit(const KA& A, const Ctx& C, int bh, int qrow0, int tile_lo, int ntiles) {
    int lane_ = C.lane; asm volatile("" : "+v"(lane_));
    const int lane = lane_, r = lane & 31, hh = lane >> 5, h = bh & 7;
    bf16* MIX = (bf16*)(A.ws() + WS_MIX);
    LAS unsigned char* lds = C.lds;
    const unsigned lds0 = (unsigned)(uintptr_t)lds;
    const int qrow = qrow0 + C.wave * 32 + r;
    const unsigned char* kg = A.ws() + WS_KN + ((size_t)bh * NKT + tile_lo) * KT_BYTES;
    const unsigned char* vg = A.ws() + WS_VT + ((size_t)bh * NKT + tile_lo) * VT_BYTES;
    const unsigned vo0 = (unsigned)(C.wave * 1024 + lane * 16);
    const unsigned d0 = lds0 + C.wave * 1024, d1 = d0 + 8192;
    int islot = 0;
#define ATT_ISSUE() do { const unsigned so_ = (unsigned)islot * ATT_SLOT; islot = (islot == ATT_NS - 1) ? 0 : islot + 1; \
        glds16s(vo0, kg, (unsigned)__builtin_amdgcn_readfirstlane(d0 + so_)); glds16s(vo0, vg, (unsigned)__builtin_amdgcn_readfirstlane(d1 + so_)); \
        kg += KT_BYTES; vg += VT_BYTES; } while (0)
    ATT_ISSUE(); ATT_ISSUE(); ATT_ISSUE();
    i32x8 qf[2];
    { const unsigned char* q8 = A.ws() + WS_Q8 + (size_t)qrow * 1024 + h * 128 + hh * 32;
#pragma unroll
      for (int st = 0; st < 2; ++st) { const u32x4 a = *(const u32x4*)(q8 + st * 64), b = *(const u32x4*)(q8 + st * 64 + 16);
          qf[st] = (i32x8){(int)a.x, (int)a.y, (int)a.z, (int)a.w, (int)b.x, (int)b.y, (int)b.z, (int)b.w}; } }
    f32x16 o0 = (f32x16){0.f, 0.f, 0.f, 0.f, 0.f, 0.f, 0.f, 0.f, 0.f, 0.f, 0.f, 0.f, 0.f, 0.f, 0.f, 0.f}, o1 = o0;
    float m = 0.f, lsum = 0.f;
    constexpr float THR = 8.f;
    const int ksw = (r >> 1) & 7;
    int cslot = 0, nslot = 1;
#define ATT_ADV() do { cslot = nslot; nslot = (nslot == ATT_NS - 1) ? 0 : nslot + 1; } while (0)
#define ATT_QKT(P0, P1, sl) do { const LAS unsigned char* Kb_ = lds + (sl) * ATT_SLOT + r * 128; P0 = ML_ZERO16; P1 = ML_ZERO16; \
        _Pragma("unroll") for (int st = 0; st < 2; ++st) { \
            const u32x4 a_ = *(const LAS u32x4*)(Kb_ + (((st * 4 + hh * 2) ^ ksw) << 4)), b_ = *(const LAS u32x4*)(Kb_ + (((st * 4 + hh * 2 + 1) ^ ksw) << 4)); \
            const u32x4 c_ = *(const LAS u32x4*)(Kb_ + 4096 + (((st * 4 + hh * 2) ^ ksw) << 4)), d_ = *(const LAS u32x4*)(Kb_ + 4096 + (((st * 4 + hh * 2 + 1) ^ ksw) << 4)); \
            P0 = MFMA8(((i32x8){(int)a_.x, (int)a_.y, (int)a_.z, (int)a_.w, (int)b_.x, (int)b_.y, (int)b_.z, (int)b_.w}), qf[st], P0); \
            P1 = MFMA8(((i32x8){(int)c_.x, (int)c_.y, (int)c_.z, (int)c_.w, (int)d_.x, (int)d_.y, (int)d_.z, (int)d_.w}), qf[st], P1); } } while (0)
#define ATT_H1(C0, C1, N0, N1, tt) do { \
        const bool more_ = (tt) + 1 < ntiles; \
        if ((tt) + 3 < ntiles) ATT_ISSUE(); \
        if (more_) ATT_QKT(N0, N1, nslot); \
        if (!FIXEDREF) { \
        float ta_ = __builtin_fmaxf(__builtin_fmaxf(C0[0], C0[1]), C0[2]), tb_ = __builtin_fmaxf(__builtin_fmaxf(C0[3], C0[4]), C0[5]), tc_ = __builtin_fmaxf(__builtin_fmaxf(C1[0], C1[1]), C1[2]), td_ = __builtin_fmaxf(__builtin_fmaxf(C1[3], C1[4]), C1[5]);     \
        _Pragma("unroll") for (int g = 6; g < 16; g += 2) { ta_ = __builtin_fmaxf(__builtin_fmaxf(ta_, C0[g]), C0[g + 1]); tc_ = __builtin_fmaxf(__builtin_fmaxf(tc_, C1[g]), C1[g + 1]); } \
        float tm_ = __builtin_fmaxf(__builtin_fmaxf(ta_, tb_), __builtin_fmaxf(tc_, td_)); \
        { const auto rr_ = __builtin_amdgcn_permlane32_swap(__builtin_bit_cast(unsigned, tm_), __builtin_bit_cast(unsigned, tm_), false, false);     \
          tm_ = __builtin_fmaxf(__builtin_bit_cast(float, rr_[0]), __builtin_bit_cast(float, rr_[1])); } \
        if ((tt) == 0) m = tm_;                             \
        else if (__any(tm_ - m > THR)) {                    \
            const float mn_ = __builtin_fmaxf(tm_, m), alpha_ = __builtin_amdgcn_exp2f(m - mn_); m = mn_; lsum *= alpha_; \
            _Pragma("unroll") for (int g = 0; g < 16; ++g) { o0[g] *= alpha_; o1[g] *= alpha_; } \
        } } } while (0)
#define ATT_H2(C0, C1, sl) do { \
        if (!FIXEDREF) { _Pragma("unroll") for (int g = 0; g < 16; ++g) { C0[g] -= m; C1[g] -= m; } } \
        float pa_ = 0.f, pb2_ = 0.f, pc_ = 0.f, pd_ = 0.f;                                      \
        _Pragma("unroll") for (int g = 0; g < 16; g += 2) { C0[g] = __builtin_amdgcn_exp2f(C0[g]); C0[g + 1] = __builtin_amdgcn_exp2f(C0[g + 1]); C1[g] = __builtin_amdgcn_exp2f(C1[g]); C1[g + 1] = __builtin_amdgcn_exp2f(C1[g + 1]); \
            pa_ += C0[g]; pb2_ += C0[g + 1]; pc_ += C1[g]; pd_ += C1[g + 1]; } \
        lsum += (pa_ + pb2_) + (pc_ + pd_); \
        bf16x8 pb_[2][2]; \
        pb_[0][0] = pack8(C0[0], C0[1], C0[2], C0[3], C0[4], C0[5], C0[6], C0[7]); pb_[0][1] = pack8(C0[8], C0[9], C0[10], C0[11], C0[12], C0[13], C0[14], C0[15]); \
        pb_[1][0] = pack8(C1[0], C1[1], C1[2], C1[3], C1[4], C1[5], C1[6], C1[7]); pb_[1][1] = pack8(C1[8], C1[9], C1[10], C1[11], C1[12], C1[13], C1[14], C1[15]); \
        const LAS unsigned char* Vb_ = lds + (sl) * ATT_SLOT + KT_BYTES; \
        { const int sw_ = (r >> 1) & 7; const LAS unsigned char* vrow_ = Vb_ + r * 128;        \
            _Pragma("unroll") for (int kb = 0; kb < 2; ++kb) _Pragma("unroll") for (int s2 = 0; s2 < 2; ++s2) { \
                const bf16x8 va_ = *(const LAS bf16x8*)(vrow_ + (((kb * 4 + s2 * 2 + hh) ^ sw_) << 4)), vb_ = *(const LAS bf16x8*)(vrow_ + 4096 + (((kb * 4 + s2 * 2 + hh) ^ sw_) << 4)); \
                o0 = MFMA32(va_, pb_[kb][s2], o0); o1 = MFMA32(vb_, pb_[kb][s2], o1); } } \
    } while (0)
#define ATT_SYNC(tt) do { if ((tt) + 2 < ntiles) ATT_WAIT_BAR(2); else ATT_WAIT_BAR(0); } while (0)
    f32x16 sA0, sA1, sB0, sB1;
    ATT_WAIT_BAR(4);
    ATT_QKT(sA0, sA1, 0);
    if (C.wave < 4) {
#pragma unroll 1
        for (int t = 0; t < ntiles; t += 2) {
            if (t + 1 < ntiles) ATT_SYNC(t);
            ATT_H1(sA0, sA1, sB0, sB1, t); ATT_H2(sA0, sA1, cslot); ATT_ADV();
            if (t + 2 < ntiles) ATT_SYNC(t + 1);
            ATT_H1(sB0, sB1, sA0, sA1, t + 1); ATT_H2(sB0, sB1, cslot); ATT_ADV();
        }
    } else {
        ATT_SYNC(0);
        ATT_H1(sA0, sA1, sB0, sB1, 0);
#pragma unroll 1
        for (int t = 1; t + 1 < ntiles; t += 2) {
            ATT_SYNC(t);
            ATT_H2(sA0, sA1, cslot); ATT_ADV(); ATT_H1(sB0, sB1, sA0, sA1, t);
            ATT_SYNC(t + 1);
            ATT_H2(sB0, sB1, cslot); ATT_ADV(); ATT_H1(sA0, sA1, sB0, sB1, t + 1);
        }
        ATT_H2(sA0, sA1, cslot); ATT_ADV(); ATT_H1(sB0, sB1, sA0, sA1, ntiles - 1);
        ATT_H2(sB0, sB1, cslot); ATT_ADV();
    }
#undef ATT_QKT
#undef ATT_H1
#undef ATT_H2
#undef ATT_SYNC
#undef ATT_ADV
    asm volatile("s_waitcnt lgkmcnt(0)\n\ts_barrier" ::: "memory");
#undef ATT_ISSUE
    lsum += shfl_idx(lsum, lane ^ 32);
    const float inv = 1.0f / lsum;
    { LAS bf16* stg = (LAS bf16*)(lds + ATT_NS * ATT_SLOT + C.wave * 4352);
#pragma unroll
      for (int g = 0; g < 16; ++g) { const int d = crow(g, hh); stg[r * 68 + d] = (bf16)f2bf(o0[g] * inv); stg[r * 68 + 32 + d] = (bf16)f2bf(o1[g] * inv); }
      LDS_WAIT(); asm volatile("" ::: "memory");
      bf16* ob = MIX + (size_t)(qrow0 + C.wave * 32) * 1024 + 256 + h * 64;
#pragma unroll
      for (int i = 0; i < 4; ++i) { const int row = i * 8 + (lane >> 3), ch = lane & 7;
          const u32x2 a = *(const LAS u32x2*)(stg + row * 68 + ch * 8), b = *(const LAS u32x2*)(stg + row * 68 + ch * 8 + 4);
          u32x4 v; v.x = a.x; v.y = a.y; v.z = b.x; v.w = b.y; *(u32x4*)(ob + (size_t)row * 1024 + ch * 8) = v; }
      LDS_WAIT(); asm volatile("" ::: "memory"); }
}
__device__ __forceinline__ void phase_attn(int l) {
    const KA A = ka_fresh(); const Ctx C = ctx_fresh();
    const int G = C.G;
    bool fixedref;
    { const int lane = C.lane; const float* qg = A.in(15) + l * 96; const float* kg = A.in(16) + l * 96;
      const float gq = wave_max(fmaxf(fabsf(qg[lane]), lane < 32 ? fabsf(qg[64 + lane]) : 0.f), lane), gk = wave_max(fmaxf(fabsf(kg[lane]), lane < 32 ? fabsf(kg[64 + lane]) : 0.f), lane);
      fixedref = (96.f * QSCALE * gq * gk) < 100.f; }
    for (int u = C.bid; u < 1024 + (l == 1 ? 0 : 16); u += G) {
        if (u < 1024) {
            int pair, qb;
            if (G == 256) { const int vcu = u & 255, rnd = u >> 8; pair = 2 * (vcu & 7) + (rnd >> 1); qb = (vcu >> 3) + 32 * (rnd & 1); }
            else { pair = u >> 6; qb = u & 63; }
            if (fixedref) attn_unit<true>(A, C, pair, (pair >> 3) * SEQ + qb * 256, 0, NKT); else attn_unit<false>(A, C, pair, (pair >> 3) * SEQ + qb * 256, 0, NKT);
        } else { const int pair = u - 1024;
            if (fixedref) attn_unit<true>(A, C, pair, RL + (pair >> 3) * CTXL, NKT - 4, 4); else attn_unit<false>(A, C, pair, RL + (pair >> 3) * CTXL, NKT - 4, 4); }
    }
}

__device__ __forceinline__ int f2key(float f) { const int b = __builtin_bit_cast(int, f); return b ^ ((b >> 31) & 0x7fffffff); }
__device__ __forceinline__ float key2f(int k) { return __builtin_bit_cast(float, k ^ ((k >> 31) & 0x7fffffff)); }
__device__ __forceinline__ void topk_ins(int (&lst)[16], int v) {
#pragma unroll
    for (int i = 0; i < 16; ++i) { const int hi = max(lst[i], v); v = min(lst[i], v); lst[i] = hi; }
}
__device__ __forceinline__ void bitonic_sort16_desc(int (&a)[16]) {
#pragma unroll
    for (int k = 2; k <= 16; k <<= 1)
#pragma unroll
        for (int j = k >> 1; j > 0; j >>= 1)
#pragma unroll
            for (int i = 0; i < 16; ++i) { const int p = i ^ j;
                if (p > i) { const int hi = max(a[i], a[p]), lo = min(a[i], a[p]); const bool desc = ((i & k) == 0) || (k == 16); a[i] = desc ? hi : lo; a[p] = desc ? lo : hi; } }
}
__device__ __forceinline__ void merge16_desc(int (&lst)[16], const int (&nw)[16]) {
#pragma unroll
    for (int i = 0; i < 16; ++i) lst[i] = max(lst[i], nw[15 - i]);
#pragma unroll
    for (int j = 8; j > 0; j >>= 1)
#pragma unroll
        for (int i = 0; i < 16; ++i) { const int p = i ^ j; if (p > i) { const int hi = max(lst[i], lst[p]), lo = min(lst[i], lst[p]); lst[i] = hi; lst[p] = lo; } }
}
__device__ __forceinline__ void topk_half(int (&lst)[16], const bf16* qp, const bf16* skp, int hh, int lane) {
    bf16x8 bq[8];
#pragma unroll
    for (int st = 0; st < 8; ++st) bq[st] = *(const bf16x8*)(qp + st * 16);
#pragma unroll
    for (int i = 0; i < 16; ++i) lst[i] = f2key(-3.0e38f);
    bf16x8 an[8];
#pragma unroll
    for (int st = 0; st < 8; ++st) an[st] = *(const bf16x8*)(skp + st * 16);
#pragma unroll 1
    for (int blk = 0; blk < 4; ++blk) {
        f32x16 acc = (f32x16){0.f, 0.f, 0.f, 0.f, 0.f, 0.f, 0.f, 0.f, 0.f, 0.f, 0.f, 0.f, 0.f, 0.f, 0.f, 0.f};
#pragma unroll
        for (int st = 0; st < 8; ++st) acc = MFMA32(an[st], bq[st], acc);
        if (blk < 3) {
#pragma unroll
            for (int st = 0; st < 8; ++st) an[st] = *(const bf16x8*)(skp + (blk + 1) * 32 * 128 + st * 16); }
        int nk[16];
#pragma unroll
        for (int g = 0; g < 16; ++g) { const unsigned n = (unsigned)(blk * 32 + crow(g, hh));
            const float sv = acc[g];
            nk[g] = f2key(__builtin_bit_cast(float, (__builtin_bit_cast(unsigned, sv) & ~127u) | n)); }
        bitonic_sort16_desc(nk);
        merge16_desc(lst, nk);
    }
    int oth[16];
#pragma unroll
    for (int i = 0; i < 16; ++i) oth[i] = shfl_idx(lst[i], lane ^ 32);
    merge16_desc(lst, oth);
}
__device__ __forceinline__ void phase_topk(int l) {
    const KA A = ka_fresh(); const Ctx C = ctx_fresh();
    const int gw = C.bid * 8 + C.wave, NGW = C.G * 8, lane = C.lane, r = lane & 31, hh = lane >> 5;
    const bf16* PQ = (const bf16*)(A.ws() + WS_PQ); const bf16* SK = (const bf16*)(A.ws() + WS_SUBK);
    int* EID = (int*)(A.ws() + WS_EID); float* GATE = (float*)(A.ws() + WS_GATE);
    const int nrows = (l == 1) ? RL : RT;
    for (int unit = gw; unit < (nrows / 32) * 8; unit += NGW) {
        const int h = unit & 7, r0 = (unit >> 3) * 32; const size_t row = (size_t)(r0 + r);
        int L[2][16];
        topk_half(L[0], PQ + row * 2048 + h * 256 + hh * 8, SK + ((size_t)((l * 8 + h) * 2 + 0) * 128 + r) * 128 + hh * 8, hh, lane);
        __builtin_amdgcn_sched_barrier(0);
        topk_half(L[1], PQ + row * 2048 + h * 256 + 128 + hh * 8, SK + ((size_t)((l * 8 + h) * 2 + 1) * 128 + r) * 128 + hh * 8, hh, lane);
        __builtin_amdgcn_sched_barrier(0);
        int best[16];
#pragma unroll
        for (int j = 0; j < 16; ++j) best[j] = f2key(__builtin_bit_cast(float, (__builtin_bit_cast(unsigned, key2f(L[0][0]) + key2f(L[1][j])) & ~255u) | (unsigned)j));
#pragma unroll
        for (int i = 1; i < 16; ++i)
#pragma unroll
            for (int j = 0; j < 16; ++j)
                if ((i + 1) * (j + 1) <= 16) topk_ins(best, f2key(__builtin_bit_cast(float, (__builtin_bit_cast(unsigned, key2f(L[0][i]) + key2f(L[1][j])) & ~255u) | (unsigned)(i * 16 + j))));
        float ev[16]; float esum = 0.f;
        const float mx = __builtin_bit_cast(float, __builtin_bit_cast(unsigned, key2f(best[0])) & ~255u);
#pragma unroll
        for (int k = 0; k < 16; ++k) { ev[k] = __expf(__builtin_bit_cast(float, __builtin_bit_cast(unsigned, key2f(best[k])) & ~255u) - mx); esum += ev[k]; }
        const float einv = 1.0f / esum;
#pragma unroll
        for (int k = 0; k < 8; ++k) {
            const int b_lo = best[k], b_hi = best[k + 8]; const float e_lo = ev[k], e_hi = ev[k + 8];
            const int bk = hh ? b_hi : b_lo; const float gk = (hh ? e_hi : e_lo) * einv;
            const unsigned code = __builtin_bit_cast(unsigned, key2f(bk)) & 255u;
            const unsigned ci = code >> 4, cj = code & 15u; unsigned n0 = 0u, n1 = 0u;
#pragma unroll
            for (int i = 0; i < 16; ++i) { n0 = (ci == (unsigned)i) ? (__builtin_bit_cast(unsigned, key2f(L[0][i])) & 127u) : n0; n1 = (cj == (unsigned)i) ? (__builtin_bit_cast(unsigned, key2f(L[1][i])) & 127u) : n1; }
            EID[row * 128 + h * 16 + hh * 8 + k] = (int)(n0 * 128u + n1); GATE[row * 128 + h * 16 + hh * 8 + k] = gk;
        }
    }
}
typedef float f32x2v __attribute__((ext_vector_type(2)));
typedef unsigned u32x6 __attribute__((ext_vector_type(6)));
typedef float f32x32 __attribute__((ext_vector_type(32)));
#define FFN_NB 4
__device__ __forceinline__ void phase_ffn(int l) {
    const KA A = ka_fresh(); const Ctx C = ctx_fresh();
    const int gw = C.bid * 8 + C.wave, NGW = C.G * 8, lane = C.lane;
    const bf16* XN = (const bf16*)(A.ws() + WS_XN); const unsigned char* TU = A.ws() + WS_TABU; const unsigned char* TV = A.ws() + WS_TABV;
    const int* EID = (const int*)(A.ws() + WS_EID); const float* GATE = (const float*)(A.ws() + WS_GATE);
    const float* MOD = (const float*)(A.ws() + WS_MOD);
    const int nrows = (l == 1) ? RL : RT;
    for (int row = gw; row < nrows; row += NGW) {
        float hv[16];
        { const u32x4 a = *(const u32x4*)(XN + (size_t)row * DM + lane * 16), b = *(const u32x4*)(XN + (size_t)row * DM + lane * 16 + 8);
          hv[0] = bflo(a.x); hv[1] = bfhi(a.x); hv[2] = bflo(a.y); hv[3] = bfhi(a.y); hv[4] = bflo(a.z); hv[5] = bfhi(a.z); hv[6] = bflo(a.w); hv[7] = bfhi(a.w);
          hv[8] = bflo(b.x); hv[9] = bfhi(b.x); hv[10] = bflo(b.y); hv[11] = bfhi(b.y); hv[12] = bflo(b.z); hv[13] = bfhi(b.z); hv[14] = bflo(b.w); hv[15] = bfhi(b.w); }
        float out[16];
#pragma unroll
        for (int i = 0; i < 16; ++i) out[i] = 0.f;
        const int idA = EID[(size_t)row * 128 + lane], idB = EID[(size_t)row * 128 + 64 + lane]; const float gtA = GATE[(size_t)row * 128 + lane], gtB = GATE[(size_t)row * 128 + 64 + lane];
#define FFN_LOAD(UU, VV, GK, e0) do { _Pragma("unroll") for (int k = 0; k < FFN_NB; ++k) { const int ee_ = (e0) + k; \
            const int id_ = __builtin_amdgcn_readlane(ee_ < 64 ? idA : idB, ee_ & 63); GK[k] = __builtin_bit_cast(float, __builtin_amdgcn_readlane(__builtin_bit_cast(int, ee_ < 64 ? gtA : gtB), ee_ & 63)); \
            UU[k] = *(const U3*)(TU + (size_t)id_ * TROW + lane * 12); VV[k] = *(const U3*)(TV + (size_t)id_ * TROW + lane * 12); } } while (0)
          \
#define FFN_COMP(UU, VV, GK) do { _Pragma("unroll") for (int k = 0; k < FFN_NB; k += 2) { \
            const u32x6 us_ = {UU[k].a, UU[k].b, UU[k].c, UU[k + 1].a, UU[k + 1].b, UU[k + 1].c}; \
            const f32x32 uf_ = __builtin_amdgcn_cvt_scalef32_pk32_f32_fp6(us_, 1.0f); \
            float d0_ = 0.f, d1_ = 0.f; \
            _Pragma("unroll") for (int i = 0; i < 16; ++i) { d0_ += hv[i] * uf_[i]; d1_ += hv[i] * uf_[16 + i]; } \
            d0_ = wave_sum(d0_, lane) * (1.0f / U_SCALE); d1_ = wave_sum(d1_, lane) * (1.0f / U_SCALE); \
            const float w0_ = GK[k] * gelu_f(d0_) * (1.0f / V_SCALE), w1_ = GK[k + 1] * gelu_f(d1_) * (1.0f / V_SCALE); \
            const u32x6 vs_ = {VV[k].a, VV[k].b, VV[k].c, VV[k + 1].a, VV[k + 1].b, VV[k + 1].c}; \
            const f32x32 vf_ = __builtin_amdgcn_cvt_scalef32_pk32_f32_fp6(vs_, 1.0f); \
            _Pragma("unroll") for (int i = 0; i < 16; ++i) out[i] += w0_ * vf_[i] + w1_ * vf_[16 + i]; } } while (0)
        U3 uA[FFN_NB], vA[FFN_NB], uB[FFN_NB], vB[FFN_NB]; float gA[FFN_NB], gB[FFN_NB];
        FFN_LOAD(uA, vA, gA, 0);
#pragma unroll 1
        for (int e = 0; e < 128; e += 2 * FFN_NB) {
            FFN_LOAD(uB, vB, gB, e + FFN_NB);
            FFN_COMP(uA, vA, gA);
            if (e + 2 * FFN_NB < 128) FFN_LOAD(uA, vA, gA, e + 2 * FFN_NB);
            FFN_COMP(uB, vB, gB);
        }
#undef FFN_LOAD
#undef FFN_COMP
        const int nsel = row < RL ? (row >> 14) : 2;
        const float* gf = MOD + (l * 3 + nsel) * 6144 + 5 * 1024;
        float* xr = stream_out(A, C, row);
#pragma unroll
        for (int q = 0; q < 4; ++q) { const int j = lane * 16 + q * 4;
            const f32x4 x = *(const f32x4*)(xr + j); f32x4 g = *(const f32x4*)(gf + j);
            f32x4 o; o.x = x.x + g.x * out[q * 4 + 0]; o.y = x.y + g.y * out[q * 4 + 1]; o.z = x.z + g.z * out[q * 4 + 2]; o.w = x.w + g.w * out[q * 4 + 3];
            *(f32x4*)(xr + j) = o; }
    }
}

template <class Epi>
__device__ __forceinline__ void run_gemm(const pg8::bf16_t* Amat, const pg8::bf16_t* Bt, int N, int K, const Epi& E, int M = RT) {
    const Ctx C = ctx_fresh();
    pg8::Gemm g{Amat, Bt, M, N, K}; pg8::StaticOrder S; S.init(M, N, C.G, C.bid);
    pg8::gemm_phase<Epi, pg8::StaticOrder, true, true>(C.lds, g, S, E);
}
__device__ __forceinline__ void seam() {
    const KA A = ka_fresh(); const Ctx C = ctx_fresh();
    XcdBarrier b; b.bar = (unsigned*)(A.ws() + WS_CTL) + CW_BAR; b.x = xb_xcc_id(); b.st = (volatile LAS unsigned*)(C.lds + MISC_OFF) + 8;
    xcd_barrier(b);
}
#define IN(k) (lo <= (k) && (k) < hi)
#define SEAM(k) do { if (IN(k) && IN((k) + 1)) seam(); } while (0)
template <int l>
__device__ __forceinline__ void layer_body(const int lo, const int hi) {
        const int p0 = 1 + NPH_L * l;
        if (IN(p0 + 0)) { phase_norm(l, 0); phase_tables(l); }
        SEAM(p0 + 0);
        if (IN(p0 + 1)) {
            const KA A = ka_fresh(); unsigned char* ws = A.ws();
            pg8::EpiBf16<0> E{(pg8::bf16_t*)(ws + WS_ZA), 1024, nullptr, 1024, (size_t)(WS_ZB - WS_ZA) / 2, 1.f};
            run_gemm(( const pg8::bf16_t*)(ws + WS_XN), (const pg8::bf16_t*)(ws + WS_WIN) + (size_t)l * 2048 * DM, 2048, DM, E);
        }
        SEAM(p0 + 1);
        if (IN(p0 + 2)) phase_post(l);
        SEAM(p0 + 2);
        if (IN(p0 + 3)) {
#pragma unroll 1
            for (int gi = 0; gi < 2; ++gi) {
                const KA A = ka_fresh(); unsigned char* ws = A.ws();
                const int N = gi ? 1024 : 768, K = gi ? 256 : 384;
                pg8::EpiBf16<0> E{(pg8::bf16_t*)(ws + (gi ? WS_KVRAW : WS_Q)), N, nullptr, 0, 0, 1.f};
                run_gemm((const pg8::bf16_t*)(ws + (gi ? WS_KVA : WS_QA)), (const pg8::bf16_t*)(ws + (gi ? WS_WUKV : WS_WUQ)) + (size_t)l * N * K, N, K, E);
            }
        }
        SEAM(p0 + 3);
        if (IN(p0 + 4)) phase_qknorm(l);
        SEAM(p0 + 4);
        if (IN(p0 + 5)) phase_ml_local();
        SEAM(p0 + 5);
        if (IN(p0 + 6)) phase_ml_scan();
        SEAM(p0 + 6);
        if (IN(p0 + 7)) {
            phase_ml_out(l);
            __syncthreads();
            phase_attn(l);
        }
        SEAM(p0 + 7);
        if (IN(p0 + 8)) {
            const KA A = ka_fresh(); unsigned char* ws = A.ws();
            pg8::EpiResGate E{l == 0 ? A.in(0) : (const float*)A.out(), l == 0 ? A.in(2) : (const float*)(ws + WS_CTXS), A.out(), (float*)(ws + WS_CTXS), (const float*)(ws + WS_MOD) + (size_t)l * 3 * 6144, 2 * 1024};
            run_gemm((const pg8::bf16_t*)(ws + WS_MIX), (const pg8::bf16_t*)(ws + WS_WOUT) + (size_t)l * DM * DM, DM, DM, E, l == 1 ? RL : RT);
        }
        SEAM(p0 + 8);
        if (IN(p0 + 9)) phase_norm(l, 1);
        SEAM(p0 + 9);

        if (IN(p0 + 10)) {
            const KA A = ka_fresh(); unsigned char* ws = A.ws();
            pg8::EpiBf16<0> E{(pg8::bf16_t*)(ws + WS_PQ), 2048, nullptr, 0, 0, 1.f};
            run_gemm((const pg8::bf16_t*)(ws + WS_XN), (const pg8::bf16_t*)(ws + WS_WPQ) + (size_t)l * 2048 * DM, 2048, DM, E, l == 1 ? RL : RT);
        }
        SEAM(p0 + 10);
                if (IN(p0 + 11)) phase_topk(l);
        SEAM(p0 + 11);
        if (IN(p0 + 12)) phase_ffn(l);
        if (l == 0) SEAM(p0 + 12);
    }
__global__ void __launch_bounds__(512, 2) mk_fwd(Args unused_args) {
    { const KA A = ka_fresh(); const Ctx C = ctx_fresh();
      volatile LAS unsigned* MISC = (volatile LAS unsigned*)(C.lds + MISC_OFF);
      if (C.tid < 64) MISC[C.tid] = 0u;
      __syncthreads();
      (void)xcd_barrier_post((unsigned*)(A.ws() + WS_CTL) + CW_BAR, MISC + 8); }
    int lo, hi;
    { const KA A = ka_fresh(); lo = A.ph_lo(); hi = A.ph_hi(); }
    if (IN(0)) phase_prologue();
    if (IN(0)) { if (lo == 0 && hi == NPHASES) seam(); }
    if (IN(0) && lo == 0 && hi == NPHASES) phase_modreduce();
    SEAM(0);
    layer_body<0>(lo, hi);
    layer_body<1>(lo, hi);
#undef IN
#undef SEAM
}

extern "C" void kernel_launch(void* const* d_in, const int* in_sizes, int n_in, void* d_out, int out_size, void* d_ws, size_t ws_size, hipStream_t stream) {
    static int grid = 0;
    if (grid == 0) {
        if (n_in != 24 || out_size != RL * DM || ws_size < WS_END) { fprintf(stderr, "kernel_launch: unexpected shapes (n_in %d, out %d, ws %zu)\n", n_in, out_size, ws_size); grid = -1; return; }
        int dev = 0, cus = 0, per_cu = 0;
        if (hipGetDevice(&dev) != hipSuccess || hipDeviceGetAttribute(&cus, hipDeviceAttributeMultiprocessorCount, dev) != hipSuccess) { grid = -1; return; }
        if (hipFuncSetAttribute((const void*)mk_fwd, hipFuncAttributeMaxDynamicSharedMemorySize, LDS_BYTES) != hipSuccess) { fprintf(stderr, "kernel_launch: hipFuncSetAttribute failed\n"); grid = -1; return; }
        if (hipOccupancyMaxActiveBlocksPerMultiprocessor(&per_cu, (const void*)mk_fwd, 512, LDS_BYTES) != hipSuccess || per_cu < 1) { fprintf(stderr, "kernel_launch: occupancy query says %d\n", per_cu); per_cu = 1; }
        (void)hipGetLastError();
        grid = cus;
    }
    if (grid < 0) return;
    (void)hipMemsetAsync((char*)d_ws + WS_CTL, 0, CTL_ZERO_BYTES, stream);
    Args a{};
    for (int i = 0; i < 24; ++i) a.in[i] = (const float*)d_in[i];
    a.out = (float*)d_out; a.ws = (unsigned char*)d_ws;
    a.ph_lo = 0; a.ph_hi = NPHASES;
    hipLaunchKernelGGL(mk_fwd, dim3(grid), dim3(512), LDS_BYTES, stream, a);
}
```

```cpp
#include <hip/hip_runtime.h>
#include <cstdio>
#include <cstdint>

namespace pg8 {
#define PG8_LAS __attribute__((address_space(3)))
typedef unsigned short bf16_t;
typedef short bf16x8 __attribute__((ext_vector_type(8)));
typedef float f32x4 __attribute__((ext_vector_type(4)));
typedef unsigned u32x4 __attribute__((ext_vector_type(4)));
constexpr int BM = 256, BK = 64, HALF = 128, HTB = HALF * BK * 2  , STAGE_BYTES = 8 * HTB, NXCD = 8, WGM = 8;

__host__ __device__ __forceinline__ int lds_byte(int r, int c) { const int st = (r >> 4) * 2 + (c >> 5), rr = r & 15, cc = c & 31, ob = rr * 64 + cc * 2; return st * 1024 + (ob ^ (((ob >> 9) & 1) << 5)); }
__host__ __device__ __forceinline__ void stage_rc(int b, int& R, int& C) { const int st = b / 1024, sb = b % 1024, swz = sb ^ (((sb >> 9) & 1) << 5); R = (st >> 1) * 16 + swz / 64; C = (st & 1) * 32 + (swz % 64) / 2; }
__host__ __device__ __forceinline__ int perm32(int rho) { const int n = rho >> 4, i = rho & 15; return 8 * (i >> 2) + 4 * n + (i & 3); }

struct Unit { int pm, pn; };
struct Gemm { const bf16_t* A; const bf16_t* Bt; int M, N, K; };

struct StaticOrder {
    int nM, nN, nwg, G, c;
    __host__ __device__ void init(int M, int N, int G_, int c_) { nM = M / BM; nN = N / BM; nwg = nM * nN; G = G_; c = c_; }
    __host__ __device__ bool next(int i, Unit& u) const {
        const long L = (long)i * G + c; if (L >= nwg) return false;
        int wgid = (int)L; { const int q = nwg / NXCD, r = nwg % NXCD, xcd = wgid % NXCD, off = wgid / NXCD; wgid = (xcd < r ? xcd * (q + 1) : r * (q + 1) + (xcd - r) * q) + off; }
        const int nig = WGM * nN, gid = wgid / nig, fm = gid * WGM, gsz = (nM - fm) < WGM ? (nM - fm) : WGM;
        u.pm = fm + ((wgid % nig) % gsz); u.pn = (wgid % nig) / gsz; return true;
    }
    __device__ __forceinline__ void a_ready(const Unit&) const {}
    __device__ __forceinline__ void done(const Unit&) const {}
};

__device__ __forceinline__ unsigned cvt_pk_bf16(float lo, float hi) { unsigned r; asm volatile("v_cvt_pk_bf16_f32 %0, %1, %2" : "=v"(r) : "v"(lo), "v"(hi)); return r; }
typedef float f32x2 __attribute__((ext_vector_type(2)));
__device__ __forceinline__ f32x2 gelu_pk(f32x2 v) {
    const f32x2 av = __builtin_elementwise_abs(v), d = av * 0.2316418882f + 1.0f;
    f32x2 t; t.x = __builtin_amdgcn_rcpf(d.x); t.y = __builtin_amdgcn_rcpf(d.y);
    f32x2 q = t * 0.5307027145f + (-0.7265760135f); q = q * t + 0.7107068705f; q = q * t + (-0.142248368f); q = q * t + 0.127414796f; q = q * t;
    const f32x2 s = (v * v) * (-0.72134752044f);
    f32x2 e; e.x = __builtin_amdgcn_exp2f(s.x); e.y = __builtin_amdgcn_exp2f(s.y);
    const f32x2 m = v * (q * e), r = v - m;
    f32x2 o; o.x = v.x < 0.f ? m.x : r.x; o.y = v.y < 0.f ? m.y : r.y; return o;
}

template <int ACT  > struct EpiBf16 {
    static constexpr bool PERM = true, AFTER_DRAIN = false; static_assert(ACT == 0 || ACT == 1, "EpiBf16: ACT is 0 (none) or 1 (gelu_pk)");
    bf16_t* O; int ldc; const float* bias; int split_cols; size_t split_stride; float scale0;
    __device__ __forceinline__ void operator()(const f32x4 (&acc)[2][2][4][2], const Unit& u, int wr, int wc, int fr, int fq) const {
        const int row0 = u.pm * BM + wr * 64 + fr; int colt = u.pn * BM; bf16_t* base = O;
        float sc = 1.f; if (split_cols) { const int t = colt / split_cols; base += (size_t)t * split_stride; colt -= t * split_cols; if (t == 0) sc = scale0; }
        const int col0 = colt + wc * 32 + 8 * fq, bcol0 = u.pn * BM + wc * 32 + 8 * fq;
        f32x4 bv[2][2];
#pragma unroll
        for (int bj = 0; bj < 2; ++bj)
#pragma unroll
            for (int n = 0; n < 2; ++n) bv[bj][n] = bias ? *(const f32x4*)(bias + bcol0 + bj * HALF + 4 * n) : (f32x4){0.f, 0.f, 0.f, 0.f};
#pragma unroll
        for (int ai = 0; ai < 2; ++ai)
#pragma unroll
            for (int m = 0; m < 4; ++m) { bf16_t* rowp = base + (size_t)(row0 + ai * HALF + m * 16) * ldc + col0;
#pragma unroll
                for (int bj = 0; bj < 2; ++bj) { f32x4 v0 = acc[ai][bj][m][0] + bv[bj][0], v1 = acc[ai][bj][m][1] + bv[bj][1];
                    if (ACT == 1) { f32x2 a = gelu_pk((f32x2){v0[0], v0[1]}), b = gelu_pk((f32x2){v0[2], v0[3]}), c = gelu_pk((f32x2){v1[0], v1[1]}), d = gelu_pk((f32x2){v1[2], v1[3]});
                        v0 = (f32x4){a.x, a.y, b.x, b.y}; v1 = (f32x4){c.x, c.y, d.x, d.y}; }
                    v0 = v0 * sc; v1 = v1 * sc; u32x4 w; w.x = cvt_pk_bf16(v0[0], v0[1]); w.y = cvt_pk_bf16(v0[2], v0[3]); w.z = cvt_pk_bf16(v1[0], v1[1]); w.w = cvt_pk_bf16(v1[2], v1[3]);
                    *(u32x4*)(rowp + bj * HALF) = w; } }
    }
};


struct EpiResGate {
    static constexpr bool PERM = false, AFTER_DRAIN = false;
    const float* base_lat; const float* base_ctx; float* out_lat; float* out_ctx; const float* gate;
    int goff;
    __device__ __forceinline__ void operator()(const f32x4 (&acc)[2][2][4][2], const Unit& u, int wr, int wc, int fr, int fq) const {
        const int rowt = u.pm * BM; const bool lat = rowt < 32768;
        const int nsel = lat ? (rowt >> 14) : 2;
        const float* bs = lat ? base_lat + (size_t)rowt * 1024 : base_ctx + (size_t)(rowt - 32768) * 1024;
        float* os = lat ? out_lat + (size_t)rowt * 1024 : out_ctx + (size_t)(rowt - 32768) * 1024;
        const float* gv = gate + nsel * 6144 + goff;
        const int rl = wr * 64 + fr, col0 = u.pn * BM + wc * 32 + 4 * fq;
        f32x4 g[2][2];
#pragma unroll
        for (int bj = 0; bj < 2; ++bj)
#pragma unroll
            for (int n = 0; n < 2; ++n) g[bj][n] = *(const f32x4*)(gv + col0 + bj * HALF + n * 16);
#pragma unroll
        for (int ai = 0; ai < 2; ++ai)
#pragma unroll
            for (int m = 0; m < 4; ++m) { const size_t ro = (size_t)(rl + ai * HALF + m * 16) * 1024 + col0;
#pragma unroll
                for (int bj = 0; bj < 2; ++bj)
#pragma unroll
                    for (int n = 0; n < 2; ++n) { const f32x4 b = *(const f32x4*)(bs + ro + bj * HALF + n * 16); *(f32x4*)(os + ro + bj * HALF + n * 16) = b + g[bj][n] * acc[ai][bj][m][n]; } }
    }
};

template <class Epi, class Sched, bool ALIGN_EPI = false, bool SP2 = false>
__device__ __forceinline__ void gemm_phase(PG8_LAS unsigned char* lds, const Gemm g, const Sched& S, const Epi& E) {
    int tid_l = threadIdx.x; asm volatile("" : "+v"(tid_l));
    const int tid = tid_l, wid = __builtin_amdgcn_readfirstlane(tid >> 6), lane = tid & 63, wr = wid >> 2, wc = wid & 3, fr = lane & 15, fq = lane >> 4;
    const int K = g.K, nt = K / BK;
    unsigned voffA[2], voffB[2];
#pragma unroll
    for (int i = 0; i < 2; ++i) { int R, C; stage_rc(tid * 16 + i * 8192, R, C); const int Rb = Epi::PERM ? ((R & ~31) + perm32(R & 31)) : R;
        voffA[i] = (unsigned)(R * K + C) * 2u; voffB[i] = (unsigned)(Rb * K + C) * 2u; }
    const size_t kstep = (size_t)(BK * 2);
    const size_t hstep = (size_t)HALF * K * 2;
    const size_t tstep = 2 * hstep;
    const unsigned ldsw = (unsigned)wid * 1024u;
    const int aoff = lds_byte(wr * 64 + fr, fq * 8), boff = lds_byte(wc * 32 + fr, fq * 8);
#define PG8_SA(b, h) (((b) * 2 + (h)) * HTB)
#define PG8_SB(b, h) ((4 + (b) * 2 + (h)) * HTB)
#define PG8_STAGE(bufoff, gbase, voff) do { _Pragma("unroll") for (int _i = 0; _i < 2; ++_i) \
        __builtin_amdgcn_global_load_lds((const unsigned*)((const char*)(gbase) + (voff)[_i]), (PG8_LAS unsigned*)(lds + (bufoff) + ldsw + _i * 8192), 16, 0, 0); } while (0)
#define PG8_LDA(dst, b, h) do { _Pragma("unroll") for (int m = 0; m < 4; ++m) _Pragma("unroll") for (int k = 0; k < 2; ++k) dst[m][k] = *(const PG8_LAS bf16x8*)(lds + PG8_SA(b, h) + aoff + m * 2048 + k * 1024); } while (0)
#define PG8_LDB(dst, b, h) do { _Pragma("unroll") for (int n = 0; n < 2; ++n) _Pragma("unroll") for (int k = 0; k < 2; ++k) dst[n][k] = *(const PG8_LAS bf16x8*)(lds + PG8_SB(b, h) + boff + n * 2048 + k * 1024); } while (0)
#define PG8_MMA(ai, bj, At, Bt) do { __builtin_amdgcn_s_setprio(1); _Pragma("unroll") for (int m = 0; m < 4; ++m) _Pragma("unroll") for (int n = 0; n < 2; ++n) _Pragma("unroll") for (int k = 0; k < 2; ++k) \
        acc[ai][bj][m][n] = __builtin_amdgcn_mfma_f32_16x16x32_bf16(Bt[n][k], At[m][k], acc[ai][bj][m][n], 0, 0, 0); __builtin_amdgcn_s_setprio(0); } while (0)
#define PG8_WAIT_V(n) asm volatile("s_waitcnt vmcnt(" #n ")" ::: "memory")
#define PG8_WAIT_L(n) asm volatile("s_waitcnt lgkmcnt(" #n ")" ::: "memory")
#define PG8_BAR __builtin_amdgcn_s_barrier()
#define PG8_SCHED __builtin_amdgcn_sched_barrier(0)
    Unit cur, nxt; int ui = 0;
    if (!S.next(0, cur)) return;
    f32x4 acc[2][2][4][2];
#pragma unroll
    for (int a = 0; a < 2; ++a)
#pragma unroll
        for (int b = 0; b < 2; ++b)
#pragma unroll
            for (int m = 0; m < 4; ++m)
#pragma unroll
                for (int n = 0; n < 2; ++n) acc[a][b][m][n] = (f32x4){0.f, 0.f, 0.f, 0.f};
    bf16x8 At[4][2], B0[2][2], B1[2][2];
    const char* cA = (const char*)g.A + (size_t)cur.pm * tstep; const char* cB = (const char*)g.Bt + (size_t)cur.pn * tstep;
    S.a_ready(cur);
    if constexpr (SP2) {
        PG8_STAGE(PG8_SB(0, 0), cB, voffB); PG8_STAGE(PG8_SB(0, 1), cB + hstep, voffB); PG8_STAGE(PG8_SA(0, 0), cA, voffA); PG8_STAGE(PG8_SA(0, 1), cA + hstep, voffA);
        if (wr == 1) PG8_BAR;
        PG8_WAIT_V(2); PG8_BAR;
        PG8_STAGE(PG8_SB(1, 0), cB + kstep, voffB); PG8_STAGE(PG8_SA(1, 0), cA + kstep, voffA); PG8_STAGE(PG8_SB(1, 1), cB + hstep + kstep, voffB);
        PG8_WAIT_V(6); PG8_BAR;
    } else {
        PG8_STAGE(PG8_SB(0, 0), cB, voffB); PG8_STAGE(PG8_SA(0, 0), cA, voffA); PG8_STAGE(PG8_SB(0, 1), cB + hstep, voffB); PG8_STAGE(PG8_SA(0, 1), cA + hstep, voffA);
        if (wr == 1) PG8_BAR;
        PG8_WAIT_V(4); PG8_BAR;
        PG8_STAGE(PG8_SB(1, 0), cB + kstep, voffB); PG8_STAGE(PG8_SA(1, 0), cA + kstep, voffA); PG8_STAGE(PG8_SB(1, 1), cB + hstep + kstep, voffB);
        PG8_WAIT_V(6); PG8_BAR;
    }
    for (;;) {
        const bool has_next = S.next(ui + 1, nxt);
        const char* nA = has_next ? (const char*)g.A + (size_t)nxt.pm * tstep : cA; const char* nB = has_next ? (const char*)g.Bt + (size_t)nxt.pn * tstep : cB;
        for (int t = 0; t < nt; t += 2) {
            const bool last = (t == nt - 2);
            const char* a1 = cA + (size_t)(t + 1) * kstep;
            const char* a2 = last ? nA : cA + (size_t)(t + 2) * kstep; const char* b2 = last ? nB : cB + (size_t)(t + 2) * kstep;
            const char* a3 = a2 + kstep; const char* b3 = b2 + kstep;
            if (last && has_next) S.a_ready(nxt);
            if constexpr (SP2) {
            PG8_LDB(B0, 0, 0); PG8_LDB(B1, 0, 1); PG8_SCHED; PG8_LDA(At, 0, 0); PG8_STAGE(PG8_SA(1, 1), a1 + hstep, voffA);
            PG8_WAIT_V(8); PG8_WAIT_L(0); PG8_BAR; PG8_MMA(0, 0, At, B0); PG8_MMA(0, 1, At, B1); PG8_BAR; PG8_SCHED;
            PG8_LDA(At, 0, 1); PG8_STAGE(PG8_SB(0, 0), b2, voffB); PG8_STAGE(PG8_SB(0, 1), b2 + hstep, voffB); PG8_STAGE(PG8_SA(0, 0), a2, voffA);
            PG8_WAIT_V(8); PG8_WAIT_L(0); PG8_BAR; PG8_MMA(1, 0, At, B0); PG8_MMA(1, 1, At, B1); PG8_BAR; PG8_SCHED;
            PG8_LDB(B0, 1, 0); PG8_LDB(B1, 1, 1); PG8_SCHED; PG8_LDA(At, 1, 0); PG8_STAGE(PG8_SA(0, 1), a2 + hstep, voffA);
            PG8_WAIT_V(8); PG8_WAIT_L(0); PG8_BAR; PG8_MMA(0, 0, At, B0); PG8_MMA(0, 1, At, B1); PG8_BAR; PG8_SCHED;
            PG8_LDA(At, 1, 1); PG8_STAGE(PG8_SB(1, 0), b3, voffB); PG8_STAGE(PG8_SB(1, 1), b3 + hstep, voffB); PG8_STAGE(PG8_SA(1, 0), a3, voffA);
            PG8_WAIT_V(8); PG8_WAIT_L(0); PG8_BAR; PG8_MMA(1, 0, At, B0); PG8_MMA(1, 1, At, B1); PG8_BAR; PG8_SCHED;
            } else {
            PG8_LDB(B0, 0, 0); PG8_SCHED; PG8_LDA(At, 0, 0); PG8_STAGE(PG8_SA(1, 1), a1 + hstep, voffA);
            PG8_WAIT_L(8); PG8_BAR; PG8_WAIT_L(0); PG8_MMA(0, 0, At, B0); PG8_BAR; PG8_SCHED;
            PG8_LDB(B1, 0, 1); PG8_STAGE(PG8_SB(0, 0), b2, voffB);
            PG8_BAR; PG8_WAIT_L(0); PG8_MMA(0, 1, At, B1); PG8_BAR;
            PG8_LDA(At, 0, 1); PG8_STAGE(PG8_SA(0, 0), a2, voffA);
            PG8_BAR; PG8_WAIT_L(0); PG8_MMA(1, 0, At, B0); PG8_BAR; PG8_SCHED;
            PG8_STAGE(PG8_SB(0, 1), b2 + hstep, voffB);
            PG8_WAIT_V(6); PG8_BAR; PG8_MMA(1, 1, At, B1); PG8_BAR;
            PG8_LDB(B0, 1, 0); PG8_SCHED; PG8_LDA(At, 1, 0); PG8_STAGE(PG8_SA(0, 1), a2 + hstep, voffA);
            PG8_WAIT_L(8); PG8_BAR; PG8_WAIT_L(0); PG8_MMA(0, 0, At, B0); PG8_BAR; PG8_SCHED;
            PG8_LDB(B1, 1, 1); PG8_STAGE(PG8_SB(1, 0), b3, voffB);
            PG8_BAR; PG8_WAIT_L(0); PG8_MMA(0, 1, At, B1); PG8_BAR;
            PG8_LDA(At, 1, 1); PG8_STAGE(PG8_SA(1, 0), a3, voffA);
            PG8_BAR; PG8_WAIT_L(0); PG8_MMA(1, 0, At, B0); PG8_BAR; PG8_SCHED;
            PG8_STAGE(PG8_SB(1, 1), b3 + hstep, voffB);
            PG8_WAIT_V(6); PG8_BAR; PG8_MMA(1, 1, At, B1); PG8_BAR;
            }
        }
        if constexpr (ALIGN_EPI) { if (wr == 0) PG8_BAR; }
        if constexpr (!Epi::AFTER_DRAIN) { E(acc, cur, wr, wc, fr, fq); S.done(cur); }
        if (!has_next) break;
#pragma unroll
        for (int a = 0; a < 2; ++a)
#pragma unroll
            for (int b = 0; b < 2; ++b)
#pragma unroll
                for (int m = 0; m < 4; ++m)
#pragma unroll
                    for (int n = 0; n < 2; ++n) acc[a][b][m][n] = (f32x4){0.f, 0.f, 0.f, 0.f};
        cur = nxt; cA = nA; cB = nB; ++ui;
        if constexpr (ALIGN_EPI) { if (wr == 1) PG8_BAR; }
    }
    PG8_WAIT_V(0);
    if constexpr (!ALIGN_EPI) { if (wr == 0) PG8_BAR; }
    PG8_BAR;
    if constexpr (Epi::AFTER_DRAIN) { E.fused(acc, cur, wr, wc, fr, fq, lds, wid, lane); S.done(cur); }
#undef PG8_SA
#undef PG8_SB
#undef PG8_STAGE
#undef PG8_LDA
#undef PG8_LDB
#undef PG8_MMA
#undef PG8_WAIT_V
#undef PG8_WAIT_L
#undef PG8_BAR
#undef PG8_SCHED
}
}

constexpr int DM = 1024, NB = 2, SEQ = 16384, CTXL = 256, RL = NB * SEQ, RC = NB * CTXL, RT = RL + RC;
constexpr int NKT = (SEQ + CTXL) / 64;
constexpr int KT_BYTES = 64 * 128, VT_BYTES = 64 * 128;
constexpr int NCH = 260, CSTF = 4160;
constexpr float EPS = 1e-6f;
constexpr float QSCALE = 0.10206207261596577f * 1.4426950408889634f;
constexpr int NPH_L = 13, NPHASES = 1 + 2 * NPH_L;


constexpr size_t MiB = 1u << 20;
constexpr size_t WS_CTL = 0, CTL_ZERO_BYTES = 64 * 1024;
constexpr size_t WS_WIN = 1 * MiB, WS_WUQ = 9 * MiB, WS_WUKV = 11 * MiB, WS_WOUT = 12 * MiB, WS_WPQ = 16 * MiB, WS_SUBK = 24 * MiB;
constexpr size_t WS_MOD = 25 * MiB, WS_ROPE = 25 * MiB + 256 * 1024, WS_SC = 25 * MiB + 512 * 1024, WS_MS = WS_SC + 64 * 1024;
constexpr size_t WS_CTXS = 26 * MiB, WS_G = 28 * MiB, WS_KR = 31 * MiB, WS_TABU = 34 * MiB, WS_TABV = 66 * MiB;
constexpr size_t WS_ZA = 98 * MiB, WS_ZB = 163 * MiB, WS_Q = WS_ZA, WS_PQ = WS_ZA;
constexpr size_t WS_XN = 228 * MiB, WS_QA = WS_XN, WS_KVA = 253 * MiB, WS_VT = WS_XN;
constexpr size_t WS_MIX = 293 * MiB, WS_R66 = 358 * MiB, WS_KVRAW = WS_R66, WS_CST = WS_R66, WS_EID = WS_R66, WS_GATE = WS_R66 + 17 * MiB;
constexpr size_t WS_KN = 425 * MiB, WS_Q8 = 458 * MiB, WS_MODP = 491 * MiB, WS_END = 493 * MiB;
static_assert(WS_QA + (size_t)RT * 384 * 2 <= WS_KVA && WS_KVA + (size_t)RT * 256 * 2 <= WS_MIX, "QA/KVA inside the XN region");
static_assert(WS_VT + (size_t)NB * 8 * NKT * VT_BYTES <= WS_MIX, "Vt inside the XN region");
static_assert(WS_CST + (size_t)16 * NCH * CSTF * 4 <= WS_KN && WS_KVRAW + (size_t)RT * 1024 * 2 <= WS_KN, "R66 region");
static_assert(WS_KN + (size_t)NB * 8 * NKT * KT_BYTES <= WS_Q8 && WS_Q8 + (size_t)RT * 1024 <= WS_MODP, "Kn / Q8 regions");
static_assert(WS_G + (size_t)RT * 16 * 4 <= WS_KR && WS_KR + (size_t)RT * 32 * 2 <= WS_TABU, "G/KR");
constexpr int CW_BAR = 1024;

constexpr int LDS_BYTES = 147456, MISC_OFF = 143360;

#define LAS __attribute__((address_space(3)))
typedef unsigned short bf16;
typedef short bf16x8 __attribute__((ext_vector_type(8)));
typedef float f32x4 __attribute__((ext_vector_type(4)));
typedef float f32x16 __attribute__((ext_vector_type(16)));
typedef unsigned u32x4 __attribute__((ext_vector_type(4)));
typedef unsigned u32x2 __attribute__((ext_vector_type(2)));
#define LDS_WAIT() asm volatile("s_waitcnt lgkmcnt(0)" ::: "memory")

typedef float f32x2_t __attribute__((ext_vector_type(2))); typedef __bf16 bf16x2_t __attribute__((ext_vector_type(2)));
__device__ __forceinline__ unsigned pk2(float lo, float hi) { f32x2_t v = {lo, hi}; bf16x2_t b = __builtin_convertvector(v, bf16x2_t); return __builtin_bit_cast(unsigned, b); }
__device__ __forceinline__ unsigned f2bf(float f) { return pk2(f, 0.f) & 0xffffu; }
__device__ __forceinline__ float bflo(unsigned w) { return __builtin_bit_cast(float, w << 16); }
__device__ __forceinline__ float bfhi(unsigned w) { return __builtin_bit_cast(float, w & 0xffff0000u); }
__device__ __forceinline__ float bf2f(bf16 v) { return __builtin_bit_cast(float, (unsigned)v << 16); }
__device__ __forceinline__ float shfl_idx(float v, int srclane) { return __builtin_bit_cast(float, __builtin_amdgcn_ds_bpermute(srclane << 2, __builtin_bit_cast(int, v))); }
__device__ __forceinline__ int shfl_idx(int v, int srclane) { return __builtin_amdgcn_ds_bpermute(srclane << 2, v); }
#define DPP_ADD(v, ctrl) (v) += __builtin_bit_cast(float, __builtin_amdgcn_update_dpp(0, __builtin_bit_cast(int, (v)), (ctrl), 0xf, 0xf, true))
__device__ __forceinline__ float wave_sum(float v, int lane) {
    (void)lane;
    DPP_ADD(v, 0xB1);
    DPP_ADD(v, 0x4E);
    DPP_ADD(v, 0x141);
    DPP_ADD(v, 0x140);
    const int b = __builtin_bit_cast(int, v);
    return (__builtin_bit_cast(float, __builtin_amdgcn_readlane(b, 0)) + __builtin_bit_cast(float, __builtin_amdgcn_readlane(b, 16))) +
           (__builtin_bit_cast(float, __builtin_amdgcn_readlane(b, 32)) + __builtin_bit_cast(float, __builtin_amdgcn_readlane(b, 48)));
}
__device__ __forceinline__ float wave_max(float v, int lane) {
#pragma unroll
    for (int o = 1; o < 64; o <<= 1) v = fmaxf(v, shfl_idx(v, lane ^ o));
    return v;
}
__device__ __forceinline__ int crow(int g, int hh) { return (g & 3) + 8 * (g >> 2) + 4 * hh; }
__device__ __forceinline__ bf16x8 pack8(float a0, float a1, float a2, float a3, float a4, float a5, float a6, float a7) {
    u32x4 w; w.x = pk2(a0, a1); w.y = pk2(a2, a3); w.z = pk2(a4, a5); w.w = pk2(a6, a7); return __builtin_bit_cast(bf16x8, w);
}
__device__ __forceinline__ float gelu_f(float v) {
    const float av = fabsf(v), d = av * 0.2316418882f + 1.0f; const float t = __builtin_amdgcn_rcpf(d);
    float q = t * 0.5307027145f + (-0.7265760135f); q = q * t + 0.7107068705f; q = q * t + (-0.142248368f); q = q * t + 0.127414796f; q = q * t;
    const float e = __builtin_amdgcn_exp2f(v * v * (-0.72134752044f));
    const float mm = v * (q * e); return v < 0.f ? mm : v - mm;
}
#define MFMA32(a, b, c) __builtin_amdgcn_mfma_f32_32x32x16_bf16((a), (b), (c), 0, 0, 0)
#define ML_ZERO16 (f32x16){0.f, 0.f, 0.f, 0.f, 0.f, 0.f, 0.f, 0.f, 0.f, 0.f, 0.f, 0.f, 0.f, 0.f, 0.f, 0.f}

#define XB_TMO      128
#define XB_XCNT(j)  (256  + 64 * (j))
#define XB_XSUB(j)  (1280 + 64 * (j))
#define XB_XGEN(j)  (2304 + 64 * (j))
#define XB_TOP      3328
#define XB_TOPGEN   3392
#define XCD_BAR_WORDS 3456
#define XB_SPIN_CAP (1u << 18)
__device__ __forceinline__ unsigned xb_ld(unsigned* p)              { return __hip_atomic_load(p, __ATOMIC_RELAXED, __HIP_MEMORY_SCOPE_AGENT); }
__device__ __forceinline__ unsigned xb_add(unsigned* p, unsigned v) { return __hip_atomic_fetch_add(p, v, __ATOMIC_RELAXED, __HIP_MEMORY_SCOPE_AGENT); }
__device__ __forceinline__ unsigned xb_xcc_id() { return (unsigned)__builtin_amdgcn_s_getreg((3 << 11) | 20) & 0xFu; }
#define XB_SPIN(cond, bar) do { unsigned _sp = 0; while (cond) { __builtin_amdgcn_s_sleep(1); \
    if ((++_sp & 255u) == 0u) { if (xb_ld(&(bar)[XB_TMO])) break; if (_sp > XB_SPIN_CAP) { atomicAdd(&(bar)[XB_TMO], 1u); break; } } } } while (0)
struct XcdBarrier { unsigned* bar; unsigned x; volatile LAS unsigned* st; };
__device__ __forceinline__ XcdBarrier xcd_barrier_post(unsigned* bar, volatile LAS unsigned* st) {
    XcdBarrier b; b.bar = bar; b.x = xb_xcc_id(); b.st = st;
    if (threadIdx.x == 0) (void)xb_add(&bar[XB_XCNT(b.x)], 1u);
    return b;
}
__device__ __forceinline__ void xcd_barrier_complete(unsigned* bar, unsigned x, unsigned& nloc, unsigned& nx) {
    const unsigned G = gridDim.x * gridDim.y * gridDim.z;
    unsigned sum, cnt, mine, sp = 0u;
    for (;;) {
        sum = 0u; cnt = 0u; mine = 0u;
#pragma unroll
        for (unsigned j = 0; j < 16; ++j) { const unsigned c = xb_ld(&bar[XB_XCNT(j)]); sum += c; cnt += (c > 0u) ? 1u : 0u; mine = (j == x) ? c : mine; }
        if (sum == G) break;
        __builtin_amdgcn_s_sleep(1);
        if ((++sp & 255u) == 0u) { if (xb_ld(&bar[XB_TMO])) break; if (sp > XB_SPIN_CAP) { atomicAdd(&bar[XB_TMO], 1u); break; } }
    }
    nloc = mine > 0u ? mine : 1u; nx = cnt > 0u ? cnt : 1u;
}
__device__ __forceinline__ void xcd_barrier(const XcdBarrier& b) {
    asm volatile("s_waitcnt vmcnt(0)" ::: "memory");
    __syncthreads();
    if (threadIdx.x == 0) {
        unsigned* bar = b.bar;
        __builtin_amdgcn_s_waitcnt(0);
        unsigned nloc = b.st[0], nx = b.st[1];
        if (nloc == 0u) { xcd_barrier_complete(bar, b.x, nloc, nx); b.st[0] = nloc; b.st[1] = nx; }
        const unsigned old = xb_add(&bar[XB_XSUB(b.x)], 1u);
        const unsigned gen = old / nloc;
        if (old + 1u == (gen + 1u) * nloc) {
            __builtin_amdgcn_fence(__ATOMIC_RELEASE, "agent");
            asm volatile("s_waitcnt vmcnt(0)" ::: "memory");
            const unsigned og = xb_add(&bar[XB_TOP], 1u);
            const unsigned tg = og / nx;
            if (og + 1u == (tg + 1u) * nx) xb_add(&bar[XB_TOPGEN], 1u);
            else XB_SPIN(xb_ld(&bar[XB_TOPGEN]) == tg, bar);
            __builtin_amdgcn_fence(__ATOMIC_ACQUIRE, "agent");
            xb_add(&bar[XB_XGEN(b.x)], 1u);
            asm volatile("s_waitcnt vmcnt(0)" ::: "memory");
        } else {
            XB_SPIN(xb_ld(&bar[XB_XGEN(b.x)]) == gen, bar);
            __builtin_amdgcn_fence(__ATOMIC_ACQUIRE, "agent");
            asm volatile("s_waitcnt vmcnt(0)" ::: "memory");
        }
    }
    __syncthreads();
}

struct Args { const float* in[24]; float* out; unsigned char* ws; int ph_lo, ph_hi; };
#define CAS __attribute__((address_space(4)))
typedef const CAS unsigned char* karg_t;
struct KA { karg_t p;
    __device__ __forceinline__ const float* in(int k) const { return *(const float* const CAS*)(p + 8 * k); }
    __device__ __forceinline__ float* out() const { return *(float* const CAS*)(p + 192); }
    __device__ __forceinline__ unsigned char* ws() const { return *(unsigned char* const CAS*)(p + 200); }
    __device__ __forceinline__ int ph_lo() const { return *(const int CAS*)(p + 208); }
    __device__ __forceinline__ int ph_hi() const { return *(const int CAS*)(p + 212); }
};
static_assert(sizeof(Args) == 216, "Args layout");
__device__ __forceinline__ KA ka_fresh() { KA a; a.p = (karg_t)__builtin_amdgcn_kernarg_segment_ptr(); asm volatile("" : "+s"(a.p)); return a; }
struct Ctx {
    LAS unsigned char* lds;
    int tid, lane, wave, G, bid;
};
__device__ __forceinline__ Ctx ctx_fresh() {
    extern __shared__ __attribute__((aligned(16))) unsigned char lds_raw[];
    Ctx C; C.lds = (LAS unsigned char*)lds_raw; int t = threadIdx.x; asm volatile("" : "+v"(t));
    C.tid = t; C.lane = t & 63; C.wave = __builtin_amdgcn_readfirstlane(t >> 6); C.G = gridDim.x; C.bid = blockIdx.x; return C;
}
__device__ __forceinline__ const float* stream_in(const KA& A, const Ctx& C, int l, int row) {
    if (row < RL) return (l == 0 ? A.in(0) : (const float*)A.out()) + (size_t)row * DM;
    return (l == 0 ? A.in(2) : (const float*)(A.ws() + WS_CTXS)) + (size_t)(row - RL) * DM;
}
__device__ __forceinline__ float* stream_out(const KA& A, const Ctx& C, int row) {
    if (row < RL) return A.out() + (size_t)row * DM;
    return (float*)(A.ws() + WS_CTXS) + (size_t)(row - RL) * DM;
}

__device__ __forceinline__ void p0_transpose_item(const float* W, int K, int N, bf16* WT, int n0, int dst_row0, LAS float* scr, int kb, int lane) {
    const int k0 = 64 * kb;
#pragma unroll 8
    for (int i = 0; i < 32; ++i) { const int kk = 2 * i + (lane >> 5); const int n = n0 + (lane & 31); scr[kk * 33 + (lane & 31)] = (n < N) ? W[(size_t)(k0 + kk) * N + n] : 0.f; }
    LDS_WAIT(); asm volatile("" ::: "memory");
    const int c = lane & 7;
#pragma unroll
    for (int j = 0; j < 4; ++j) { const int n = (lane >> 3) + 8 * j; const LAS float* s = scr + (8 * c) * 33 + n;
        u32x4 o; o.x = pk2(s[0 * 33], s[1 * 33]); o.y = pk2(s[2 * 33], s[3 * 33]); o.z = pk2(s[4 * 33], s[5 * 33]); o.w = pk2(s[6 * 33], s[7 * 33]);
        *(u32x4*)(WT + (size_t)(dst_row0 + n) * K + k0 + 8 * c) = o; }
    LDS_WAIT(); asm volatile("" ::: "memory");
}
__device__ __forceinline__ void p0_poolw_item(const float* Win, const float* Wp, bf16* WT, LAS float* scr, int kb, int nb, int lane) {
    const int k0 = 64 * kb, g = nb >> 1, e = (nb & 1) * 32 + (lane & 31);
    float wc[64];
#pragma unroll
    for (int c = 0; c < 64; ++c) wc[c] = Wp[((size_t)g * 64 + c) * 64 + e];
#pragma unroll 2
    for (int i = 0; i < 32; ++i) { const int kk = 2 * i + (lane >> 5); const float* wr = Win + (size_t)(k0 + kk) * 1968 + g * 64; float a = 0.f;
#pragma unroll
        for (int c4 = 0; c4 < 16; ++c4) { const f32x4 x = *(const f32x4*)(wr + 4 * c4); a += x.x * wc[4 * c4] + x.y * wc[4 * c4 + 1] + x.z * wc[4 * c4 + 2] + x.w * wc[4 * c4 + 3]; }
        scr[kk * 33 + (lane & 31)] = a; }
    LDS_WAIT(); asm volatile("" ::: "memory");
    const int c = lane & 7;
#pragma unroll
    for (int j = 0; j < 4; ++j) { const int n = (lane >> 3) + 8 * j; const LAS float* sp = scr + (8 * c) * 33 + n;
        u32x4 o; o.x = pk2(sp[0 * 33], sp[1 * 33]); o.y = pk2(sp[2 * 33], sp[3 * 33]); o.z = pk2(sp[4 * 33], sp[5 * 33]); o.w = pk2(sp[6 * 33], sp[7 * 33]);
        *(u32x4*)(WT + (size_t)(32 * nb + n) * DM + k0 + 8 * c) = o; }
    LDS_WAIT(); asm volatile("" ::: "memory");
}
__device__ __forceinline__ void phase_prologue() {
    const KA A = ka_fresh(); const Ctx C = ctx_fresh();
    LAS float* scr = (LAS float*)(C.lds + C.wave * 16384);
    const int gw = C.bid * 8 + C.wave, NGW = C.G * 8, lane = C.lane;
    float* MODP = (float*)(A.ws() + WS_MODP);
    for (int it = gw; it < 2 * 96 * 8; it += NGW) {
        const int ks = it & 7, l = (it >> 3) / 96, j = ((it >> 3) % 96) * 64 + lane;
        const float* W = A.in(6) + ((size_t)l * DM + ks * 128) * 6144 + j;
        const float* c01 = A.in(1) + ks * 128; const float* c2p = A.in(3) + ks * 128;
        float a0 = 0.f, a1 = 0.f, a2 = 0.f;
#pragma unroll 16
        for (int k = 0; k < 128; ++k) {
            const float w = W[(size_t)k * 6144];
            const float c0 = c01[k], c1 = c01[DM + k], c2 = c2p[k];
            a0 += (c0 / (1.f + __expf(-c0))) * w; a1 += (c1 / (1.f + __expf(-c1))) * w; a2 += (c2 / (1.f + __expf(-c2))) * w;
        }
        float* mp = MODP + ((size_t)(l * 8 + ks) * 3) * 6144 + j;
        mp[0] = a0; mp[6144] = a1; mp[2 * 6144] = a2;
    }
    constexpr int I_IN = 16 * 64, I_UQ = 6 * 24, I_UKV = 4 * 32, I_OUT = 16 * 32, I_PQ = 16 * 64, I_L = I_IN + I_UQ + I_UKV + I_OUT + I_PQ;
    for (int it = gw; it < 2 * I_L; it += NGW) {
        const int l = it / I_L; int r = it % I_L;
        if (r < I_IN) {
            const int kb = r / 64, nb = r % 64;
            if (nb < 8) { p0_poolw_item(A.in(8) + (size_t)l * DM * 1968, A.in(9) + (size_t)l * 4 * 64 * 64, (bf16*)(A.ws() + WS_WIN) + (size_t)l * 2048 * DM, scr, kb, nb, lane); continue; }
            const int dst = nb < 29 ? 32 * nb : (nb < 61 ? 96 + 32 * nb : (nb == 61 ? 928 : (nb == 62 ? 960 : 992)));
            const int n0 = nb < 62 ? 32 * nb : 4096;
            p0_transpose_item(A.in(8) + (size_t)l * DM * 1968, DM, 1968, (bf16*)(A.ws() + WS_WIN) + (size_t)l * 2048 * DM, n0, dst, scr, kb, lane); continue; }
        r -= I_IN;
        if (r < I_UQ) { const int kb = r / 24, nb = r % 24; p0_transpose_item(A.in(13) + (size_t)l * 384 * 768, 384, 768, (bf16*)(A.ws() + WS_WUQ) + (size_t)l * 768 * 384, 32 * nb, 32 * nb, scr, kb, lane); continue; }
        r -= I_UQ;
        if (r < I_UKV) { const int kb = r / 32, nb = r % 32; p0_transpose_item(A.in(14) + (size_t)l * 256 * 1024, 256, 1024, (bf16*)(A.ws() + WS_WUKV) + (size_t)l * 1024 * 256, 32 * nb, 32 * nb, scr, kb, lane); continue; }
        r -= I_UKV;
        if (r < I_OUT) { const int kb = r / 32, nb = r % 32; p0_transpose_item(A.in(19) + (size_t)l * DM * DM, DM, DM, (bf16*)(A.ws() + WS_WOUT) + (size_t)l * DM * DM, 32 * nb, 32 * nb, scr, kb, lane); continue; }
        r -= I_OUT;
        { const int kb = r / 64, nb = r % 64; p0_transpose_item(A.in(20) + (size_t)l * DM * 2048, DM, 2048, (bf16*)(A.ws() + WS_WPQ) + (size_t)l * 2048 * DM, 32 * nb, 32 * nb, scr, kb, lane); }
    }
    const int gt = C.bid * 512 + C.tid, NT = C.G * 512;
    { const float* s = A.in(21); bf16* d = (bf16*)(A.ws() + WS_SUBK);
      for (int i = gt; i < 2 * 8 * 2 * 128 * 128 / 4; i += NT) { const f32x4 v = *(const f32x4*)(s + 4 * (size_t)i); u32x2 o; o.x = pk2(v.x, v.y); o.y = pk2(v.z, v.w); *(u32x2*)(d + 4 * (size_t)i) = o; } }
    { float* rp = (float*)(A.ws() + WS_ROPE);
      for (int i = gt; i < 256 * 8; i += NT) { const int p = i >> 3, f = i & 7;
          const float fr[8] = {1.0f, 0.31622776601683794f, 0.1f, 0.031622776601683794f, 0.01f, 0.0031622776601683794f, 0.001f, 0.00031622776601683794f};
          float fq = fr[0];
#pragma unroll
          for (int q = 1; q < 8; ++q) fq = (f == q) ? fr[q] : fq;
          const float ang = (float)p * fq;
          const double rev = (double)ang * 0.15915494309189535; const float fracr = (float)(rev - floor(rev));
          rp[2 * i] = __builtin_amdgcn_cosf(fracr); rp[2 * i + 1] = __builtin_amdgcn_sinf(fracr); } }
}

__device__ __forceinline__ void phase_modreduce() {
    const KA A = ka_fresh(); const Ctx C = ctx_fresh();
    const int gt = C.bid * 512 + C.tid, NT = C.G * 512;
    const float* MODP = (const float*)(A.ws() + WS_MODP); float* MOD = (float*)(A.ws() + WS_MOD);
    for (int i = gt; i < 2 * 3 * 6144; i += NT) { const int l = i / (3 * 6144), rem = i % (3 * 6144), j = rem % 6144;
        float a = A.in(7)[l * 6144 + j];
#pragma unroll
        for (int ks = 0; ks < 8; ++ks) a += MODP[((size_t)(l * 8 + ks) * 3) * 6144 + rem];
        MOD[i] = a; }
}
__device__ __forceinline__ void phase_norm(int l, int which) {
    const KA A = ka_fresh(); const Ctx C = ctx_fresh();
    const int gw = C.bid * 8 + C.wave, NGW = C.G * 8, lane = C.lane;
    const float* gain = A.in(which ? 5 : 4) + l * DM;
    const float* MOD = (const float*)(A.ws() + WS_MOD);
    bf16* XN = (bf16*)(A.ws() + WS_XN);
    const int nrows = (which == 1 && l == 1) ? RL : RT;
    for (int row = gw; row < nrows; row += NGW) {
        const float* xr = (which == 0) ? stream_in(A, C, l, row) : (const float*)stream_out(A, C, row);
        const int nsel = row < RL ? (row >> 14) : 2;
        const float* md = MOD + (l * 3 + nsel) * 6144 + which * 3072;
        f32x4 v[4]; float ss = 0.f;
#pragma unroll
        for (int i = 0; i < 4; ++i) { v[i] = *(const f32x4*)(xr + 4 * lane + 256 * i); ss += (v[i].x * v[i].x + v[i].y * v[i].y) + (v[i].z * v[i].z + v[i].w * v[i].w); }
        const float rs = 1.0f / sqrtf(wave_sum(ss, lane) * (1.f / DM) + EPS);
#pragma unroll
        for (int i = 0; i < 4; ++i) { const int j = 4 * lane + 256 * i;
            const f32x4 g = *(const f32x4*)(gain + j), sh = *(const f32x4*)(md + j), sc = *(const f32x4*)(md + 1024 + j);
            const f32x4 y = v[i] * rs * g * (sc + 1.0f) + sh;
            u32x2 o; o.x = pk2(y.x, y.y); o.y = pk2(y.z, y.w); *(u32x2*)(XN + (size_t)row * DM + j) = o; }
    }
}
constexpr float U_SCALE = 48.f, V_SCALE = 1.5f;
constexpr int TROW = 768;
struct __attribute__((packed, aligned(4))) U3 { unsigned a, b, c; };
__device__ __forceinline__ unsigned q_e2m3(float x) {
    const unsigned sg = (__builtin_bit_cast(unsigned, x) >> 31) << 5;
    const float a = fminf(fabsf(x), 7.5f);
    const float t = a * (a < 2.f ? 8.f : (a < 4.f ? 4.f : 2.f));
    return sg | ((unsigned)__builtin_rintf(t) + (a < 2.f ? 0u : (a < 4.f ? 8u : 16u)));
}
__device__ __forceinline__ void phase_tables(int l) {
    const KA A = ka_fresh(); const Ctx C = ctx_fresh();
    const size_t gt = (size_t)C.bid * 512 + C.tid, NT = (size_t)C.G * 512;
    const size_t n16 = (size_t)16384 * 1024 / 16;
#pragma unroll
    for (int w = 0; w < 2; ++w) {
        const float* s = A.in(22 + w) + (size_t)l * 16384 * 1024; unsigned char* d = A.ws() + (w ? WS_TABV : WS_TABU);
        const float sc = w ? V_SCALE : U_SCALE;
        for (size_t i = gt; i < n16; i += NT) {
            unsigned c[16];
#pragma unroll
            for (int q = 0; q < 4; ++q) { const f32x4 x = *(const f32x4*)(s + 16 * i + 4 * q);
                c[4 * q] = q_e2m3(x.x * sc); c[4 * q + 1] = q_e2m3(x.y * sc); c[4 * q + 2] = q_e2m3(x.z * sc); c[4 * q + 3] = q_e2m3(x.w * sc); }
            U3 o;
            o.a = c[0] | (c[1] << 6) | (c[2] << 12) | (c[3] << 18) | (c[4] << 24) | (c[5] << 30);
            o.b = (c[5] >> 2) | (c[6] << 4) | (c[7] << 10) | (c[8] << 16) | (c[9] << 22) | (c[10] << 28);
            o.c = (c[10] >> 4) | (c[11] << 2) | (c[12] << 8) | (c[13] << 14) | (c[14] << 20) | (c[15] << 26);
            *(U3*)(d + 12 * i) = o; }
    }
}

__device__ __forceinline__ void phase_post(int l) {
    const KA A = ka_fresh(); const Ctx C = ctx_fresh();
    const bf16* ZA = (const bf16*)(A.ws() + WS_ZA);
    bf16* MIX = (bf16*)(A.ws() + WS_MIX); bf16* QA = (bf16*)(A.ws() + WS_QA); bf16* KVA = (bf16*)(A.ws() + WS_KVA); bf16* KR = (bf16*)(A.ws() + WS_KR);
    float* GT = (float*)(A.ws() + WS_G);
    LAS float* U = (LAS float*)C.lds;
    const int tid = C.tid, lane = C.lane;
    for (int unit = C.bid; unit < RT / 32; unit += C.G) {
        const int r0 = unit * 32;
        int seq0, L;
        if (r0 < RL) { seq0 = (r0 >> 14) << 14; L = SEQ; } else { seq0 = RL + (((r0 - RL) >> 8) << 8); L = CTXL; }
        const int t0 = r0 - seq0;
        for (int idx = tid; idx < 48 * 32; idx += 512) { const int rr = idx >> 5, c8 = idx & 31; const int t = t0 - 8 + rr;
            u32x4 v = {0u, 0u, 0u, 0u};
            if (t >= 0 && t < L) v = *(const u32x4*)(ZA + (size_t)(seq0 + t) * 1024 + c8 * 8);
            LAS float* d = U + rr * 256 + c8 * 8;
            d[0] = bflo(v.x); d[1] = bfhi(v.x); d[2] = bflo(v.y); d[3] = bfhi(v.y); d[4] = bflo(v.z); d[5] = bfhi(v.z); d[6] = bflo(v.w); d[7] = bfhi(v.w); }
        __syncthreads();
        { const int ch = tid & 255, half = tid >> 8, hw = __builtin_amdgcn_readfirstlane(1 << (ch >> 6));
          const float sc = A.in(10)[l * 256 + ch];
          for (int i = half * 16; i < half * 16 + 16; ++i) { const int t = t0 + i; const int lo = max(t - hw, 0), hi = min(t + hw, L);
              float sm = 0.f; for (int tt = lo; tt < hi; ++tt) sm += U[(tt - t0 + 8) * 256 + ch];
              const float dv = sm / (float)(hi - lo) - U[(i + 8) * 256 + ch];
              MIX[(size_t)(r0 + i) * 1024 + ch] = (bf16)f2bf(dv * sc); } }
#pragma unroll
        for (int q = 0; q < 4; ++q) { const int row = r0 + C.wave * 4 + q; const bf16* za = ZA + (size_t)row * 1024;
            { float x[6]; float ss = 0.f;
#pragma unroll
              for (int i = 0; i < 3; ++i) { const unsigned w = *(const unsigned*)(za + 256 + 2 * lane + 128 * i); x[2 * i] = bflo(w); x[2 * i + 1] = bfhi(w); ss += x[2 * i] * x[2 * i] + x[2 * i + 1] * x[2 * i + 1]; }
              const float rs = 1.0f / sqrtf(wave_sum(ss, lane) * (1.f / 384.f) + EPS); const float* gq = A.in(11) + l * 384;
#pragma unroll
              for (int i = 0; i < 3; ++i) { const int j = 2 * lane + 128 * i; *(unsigned*)(QA + (size_t)row * 384 + j) = pk2(x[2 * i] * rs * gq[j], x[2 * i + 1] * rs * gq[j + 1]); } }
            { const u32x2 w = *(const u32x2*)(za + 640 + 4 * lane);
              const float x0 = bflo(w.x), x1 = bfhi(w.x), x2 = bflo(w.y), x3 = bfhi(w.y);
              const float rs = 1.0f / sqrtf(wave_sum(x0 * x0 + x1 * x1 + x2 * x2 + x3 * x3, lane) * (1.f / 256.f) + EPS); const float* gk = A.in(12) + l * 256 + 4 * lane;
              u32x2 o; o.x = pk2(x0 * rs * gk[0], x1 * rs * gk[1]); o.y = pk2(x2 * rs * gk[2], x3 * rs * gk[3]); *(u32x2*)(KVA + (size_t)row * 256 + 4 * lane) = o; }
            if (lane < 16) *(unsigned*)(KR + (size_t)row * 32 + 2 * lane) = *(const unsigned*)(za + 896 + 2 * lane);
            if (lane < 16) { float gv = bf2f(za[928 + lane]) + A.in(17)[l * 16 + lane];
                if ((lane >> 2) & 1) gv = fminf(gv, 0.f) - log1pf(__expf(-fabsf(gv)));
                GT[(size_t)row * 16 + lane] = gv; }
        }
        __syncthreads();
    }
}

__device__ __forceinline__ unsigned fp8x4(float a, float b, float c, float d) {
    a = __builtin_amdgcn_fmed3f(a, -448.f, 448.f); b = __builtin_amdgcn_fmed3f(b, -448.f, 448.f); c = __builtin_amdgcn_fmed3f(c, -448.f, 448.f); d = __builtin_amdgcn_fmed3f(d, -448.f, 448.f);
    int w = __builtin_amdgcn_cvt_pk_fp8_f32(a, b, 0, false); w = __builtin_amdgcn_cvt_pk_fp8_f32(c, d, w, true); return (unsigned)w;
}
__device__ __forceinline__ void qk_head(const bf16* src_lo, const bf16* src_hi, unsigned char* dst, int sw, const float* gn, bool rot, const float (&cs)[16], const float (&sn)[16], float oscale) {
    float ss = 0.f;
#pragma unroll 4
    for (int i = 0; i < 8; ++i) { const u32x4 w = *(const u32x4*)(src_lo + 8 * i);
        ss += (bflo(w.x) * bflo(w.x) + bfhi(w.x) * bfhi(w.x)) + (bflo(w.y) * bflo(w.y) + bfhi(w.y) * bfhi(w.y)) + (bflo(w.z) * bflo(w.z) + bfhi(w.z) * bfhi(w.z)) + (bflo(w.w) * bflo(w.w) + bfhi(w.w) * bfhi(w.w)); }
    u32x4 wr[4];
#pragma unroll
    for (int i = 0; i < 4; ++i) { wr[i] = *(const u32x4*)(src_hi + 8 * i); const u32x4 w = wr[i];
        ss += (bflo(w.x) * bflo(w.x) + bfhi(w.x) * bfhi(w.x)) + (bflo(w.y) * bflo(w.y) + bfhi(w.y) * bfhi(w.y)) + (bflo(w.z) * bflo(w.z) + bfhi(w.z) * bfhi(w.z)) + (bflo(w.w) * bflo(w.w) + bfhi(w.w) * bfhi(w.w)); }
    const float rs = oscale / sqrtf(ss * (1.f / 96.f) + EPS);
    __builtin_amdgcn_sched_barrier(0);
#pragma unroll 1
    for (int i = 0; i < 8; ++i) {
        const u32x4 w = *(const u32x4*)(src_lo + 8 * i); const f32x4 g0 = *(const f32x4*)(gn + 8 * i), g1 = *(const f32x4*)(gn + 8 * i + 4);
        u32x2 o; o.x = fp8x4(bflo(w.x) * rs * g0.x, bfhi(w.x) * rs * g0.y, bflo(w.y) * rs * g0.z, bfhi(w.y) * rs * g0.w);
        o.y = fp8x4(bflo(w.z) * rs * g1.x, bfhi(w.z) * rs * g1.y, bflo(w.w) * rs * g1.z, bfhi(w.w) * rs * g1.w);
        *(u32x2*)(dst + ((((i >> 1) ^ sw) << 4) + ((i & 1) << 3))) = o; }
    __builtin_amdgcn_sched_barrier(0);
#pragma unroll
    for (int i = 0; i < 2; ++i) {
        const u32x4 p = wr[i], q = wr[2 + i];
        const f32x4 ga = *(const f32x4*)(gn + 64 + 8 * i), gb = *(const f32x4*)(gn + 64 + 8 * i + 4), gc = *(const f32x4*)(gn + 80 + 8 * i), gd = *(const f32x4*)(gn + 80 + 8 * i + 4);
        float y1[8], y2[8];
        y1[0] = bflo(p.x) * rs * ga.x; y1[1] = bfhi(p.x) * rs * ga.y; y1[2] = bflo(p.y) * rs * ga.z; y1[3] = bfhi(p.y) * rs * ga.w; y1[4] = bflo(p.z) * rs * gb.x; y1[5] = bfhi(p.z) * rs * gb.y; y1[6] = bflo(p.w) * rs * gb.z; y1[7] = bfhi(p.w) * rs * gb.w;
        y2[0] = bflo(q.x) * rs * gc.x; y2[1] = bfhi(q.x) * rs * gc.y; y2[2] = bflo(q.y) * rs * gc.z; y2[3] = bfhi(q.y) * rs * gc.w; y2[4] = bflo(q.z) * rs * gd.x; y2[5] = bfhi(q.z) * rs * gd.y; y2[6] = bflo(q.w) * rs * gd.z; y2[7] = bfhi(q.w) * rs * gd.w;
        if (rot) {
#pragma unroll
            for (int j = 0; j < 8; ++j) { const float a = y1[j] * cs[8 * i + j] - y2[j] * sn[8 * i + j], bb = y2[j] * cs[8 * i + j] + y1[j] * sn[8 * i + j]; y1[j] = a; y2[j] = bb; }
        }
        u32x2 o; o.x = fp8x4(y1[0], y1[1], y1[2], y1[3]); o.y = fp8x4(y1[4], y1[5], y1[6], y1[7]); *(u32x2*)(dst + (((4 ^ sw) << 4) + (i << 3))) = o;
        u32x2 o2; o2.x = fp8x4(y2[0], y2[1], y2[2], y2[3]); o2.y = fp8x4(y2[4], y2[5], y2[6], y2[7]); *(u32x2*)(dst + (((5 ^ sw) << 4) + (i << 3))) = o2;
    }
    { u32x4 z; z.x = 0u; z.y = 0u; z.z = 0u; z.w = 0u; *(u32x4*)(dst + ((6 ^ sw) << 4)) = z; *(u32x4*)(dst + ((7 ^ sw) << 4)) = z; }
    __builtin_amdgcn_sched_barrier(0);
}
__device__ __forceinline__ void phase_qknorm(int l) {
    const KA A = ka_fresh(); const Ctx C = ctx_fresh();
    const int gw = C.bid * 8 + C.wave, NGW = C.G * 8, lane = C.lane;
    const bf16* Q = (const bf16*)(A.ws() + WS_Q); const bf16* KV = (const bf16*)(A.ws() + WS_KVRAW); const bf16* KR = (const bf16*)(A.ws() + WS_KR);
    unsigned char* KN = A.ws() + WS_KN; unsigned char* VT = A.ws() + WS_VT;
    const float* rope = (const float*)(A.ws() + WS_ROPE);
    const float* qg = A.in(15) + l * 96; const float* kg = A.in(16) + l * 96;
    for (int u = gw; u < (RT / 64) * 8; u += NGW) {
        const int h = u & 7, tl = u >> 3, row0 = tl * 64, row = row0 + lane;
        const bool lat = row0 < RL; int b, t0;
        if (lat) { b = row0 >> 14; t0 = row0 & (SEQ - 1); } else { b = (row0 - RL) >> 8; t0 = (row0 - RL) & 255; }
        const int ktile = lat ? (t0 >> 6) : (SEQ + t0) >> 6;
        float cs[16], sn[16];
#pragma unroll
        for (int i = 0; i < 16; ++i) { cs[i] = 1.f; sn[i] = 0.f; }
        if (lat) {
#pragma unroll
            for (int i = 0; i < 16; ++i) { const int p = (i < 8) ? (t0 >> 6) : lane; const float* rp = rope + (p * 8 + (i & 7)) * 2; cs[i] = rp[0]; sn[i] = rp[1]; }
        }
        { const bf16* qp = Q + (size_t)row * 768 + h * 96;
          qk_head(qp, qp + 64, A.ws() + WS_Q8 + (size_t)row * 1024 + h * 128, 0, qg, lat, cs, sn, QSCALE); }
        const bf16* kvp = KV + (size_t)row * 1024 + h * 128;
        qk_head(kvp, KR + (size_t)row * 32, KN + ((size_t)(b * 8 + h) * NKT + ktile) * KT_BYTES + lane * 128, (lane >> 1) & 7, kg, lat, cs, sn, 1.0f);
        { const int kap = lane & 15; const int pos = (lane & ~15) + 8 * ((kap >> 2) & 1) + 4 * (kap >> 3) + (kap & 3);
          bf16* vd = (bf16*)(VT + ((size_t)(b * 8 + h) * NKT + ktile) * VT_BYTES);
          const int pa = pos >> 3, pb = pos & 7;
#pragma unroll 1
          for (int i = 0; i < 8; ++i) { const u32x4 vv = *(const u32x4*)(kvp + 64 + 8 * i);
#pragma unroll
              for (int e = 0; e < 8; ++e) { const int d = 8 * i + e; const unsigned wd = (e >> 1) == 0 ? vv.x : ((e >> 1) == 1 ? vv.y : ((e >> 1) == 2 ? vv.z : vv.w)); const bf16 val = (bf16)((e & 1) ? (wd >> 16) : (wd & 0xffffu));
                  vd[(unsigned)(d * 64 + ((pa ^ ((d >> 1) & 7)) << 3) + pb)] = val; } } }
    }
}

__device__ __forceinline__ int ml_row(int b, int dir, int j, int s) {
    if (j < 4) { const int p = 64 * j + s; return RL + b * CTXL + (dir ? CTXL - 1 - p : p); }
    const int p = 64 * (j - 4) + s; return b * SEQ + (dir ? SEQ - 1 - p : p);
}
__device__ __forceinline__ void phase_ml_local() {
    const KA A = ka_fresh(); const Ctx C = ctx_fresh();
    const int gw = C.bid * 8 + C.wave, NGW = C.G * 8, lane = C.lane, r = lane & 31, hh = lane >> 5;
    const bf16* ZB = (const bf16*)(A.ws() + WS_ZB); const float* GT = (const float*)(A.ws() + WS_G);
    float* CST = (float*)(A.ws() + WS_CST); float* SC = (float*)(A.ws() + WS_SC);
    for (int u = gw; u < 16 * NCH; u += NGW) {
        const int sq = u / NCH, j = u % NCH, b = sq >> 3, h = (sq >> 1) & 3, dir = sq & 1;
        const int rowl = ml_row(b, dir, j, lane);
        const float gi = GT[(size_t)rowl * 16 + dir * 8 + h], lf = GT[(size_t)rowl * 16 + dir * 8 + 4 + h];
        float bs = lf;
#pragma unroll
        for (int o = 1; o < 64; o <<= 1) { const float tv = shfl_idx(bs, lane - o); if (lane >= o) bs += tv; }
        const float blast = shfl_idx(bs, 63);
        const float dec = blast + gi - bs;
        const float mloc = wave_max(dec, lane);
        const float w = __expf(dec - mloc);
        const int row0 = ml_row(b, dir, j, 0), rstep = dir ? -1 : 1;
        f32x16 acc[2][2];
#pragma unroll
        for (int vb = 0; vb < 2; ++vb)
#pragma unroll
            for (int db = 0; db < 2; ++db) acc[vb][db] = ML_ZERO16;
        float nacc0 = 0.f, nacc1 = 0.f;
#pragma unroll
        for (int st = 0; st < 4; ++st) {
            float ws[8]; unsigned rofs[8];
#pragma unroll
            for (int jj = 0; jj < 8; ++jj) { const int sidx = 16 * st + 8 * hh + jj; ws[jj] = shfl_idx(w, sidx); rofs[jj] = (unsigned)((row0 + rstep * sidx) * 1024 + h * 64 + r); }
            bf16x8 Af[2], Bf[2];
#pragma unroll
            for (int blk = 0; blk < 2; ++blk) {
                float kx[8];
#pragma unroll
                for (int jj = 0; jj < 8; ++jj) { kx[jj] = bf2f(ZB[rofs[jj] + 256 + 32 * blk]); Bf[blk][jj] = (short)ZB[rofs[jj] + 256 + 32 * blk]; }
                if (blk == 0) {
#pragma unroll
                    for (int jj = 0; jj < 8; ++jj) nacc0 += ws[jj] * kx[jj]; }
                else {
#pragma unroll
                    for (int jj = 0; jj < 8; ++jj) nacc1 += ws[jj] * kx[jj]; }
                float vx[8];
#pragma unroll
                for (int jj = 0; jj < 8; ++jj) vx[jj] = bf2f(ZB[rofs[jj] + 512 + 32 * blk]) * ws[jj];
                Af[blk] = pack8(vx[0], vx[1], vx[2], vx[3], vx[4], vx[5], vx[6], vx[7]);
            }
#pragma unroll
            for (int vb = 0; vb < 2; ++vb)
#pragma unroll
                for (int db = 0; db < 2; ++db) acc[vb][db] = MFMA32(Af[vb], Bf[db], acc[vb][db]);
            __builtin_amdgcn_sched_barrier(0);
        }
        float* cp = CST + (size_t)u * CSTF;
#pragma unroll
        for (int vb = 0; vb < 2; ++vb)
#pragma unroll
            for (int db = 0; db < 2; ++db)
#pragma unroll
                for (int g = 0; g < 16; ++g) cp[(32 * vb + crow(g, hh)) * 64 + 32 * db + r] = acc[vb][db][g];
        nacc0 += shfl_idx(nacc0, lane ^ 32); nacc1 += shfl_idx(nacc1, lane ^ 32);
        if (hh == 0) { cp[4096 + r] = nacc0; cp[4096 + 32 + r] = nacc1; }
        if (lane == 0) { SC[u * 2] = mloc; SC[u * 2 + 1] = blast; }
    }
}
__device__ __forceinline__ void phase_ml_scan() {
    const KA A = ka_fresh(); const Ctx C = ctx_fresh();
    const int gt = C.bid * 512 + C.tid, NT = C.G * 512;
    float* CST = (float*)(A.ws() + WS_CST); const float* SC = (const float*)(A.ws() + WS_SC); float* MS = (float*)(A.ws() + WS_MS);
    for (int e = gt; e < 16 * CSTF; e += NT) {
        const int sq = e / CSTF, el = e % CSTF;
        float* base = CST + (size_t)sq * NCH * CSTF + el;
        float cv = 0.f, m = -1e30f;
#pragma unroll 1
        for (int j0 = 0; j0 < NCH; j0 += 10) {
            float loc[10]; f32x2_t sc[10];
#pragma unroll
            for (int u = 0; u < 10; ++u) { loc[u] = base[(size_t)(j0 + u) * CSTF]; sc[u] = *(const f32x2_t*)(SC + (sq * NCH + j0 + u) * 2); }
#pragma unroll
            for (int u = 0; u < 10; ++u) {
                base[(size_t)(j0 + u) * CSTF] = cv;
                if (el == 0) MS[sq * NCH + j0 + u] = m;
                const float mn = fmaxf(sc[u].y + m, sc[u].x);
                cv = __expf(sc[u].y + m - mn) * cv + __expf(sc[u].x - mn) * loc[u]; m = mn;
            }
        }
    }
}
template <int DIR>
__device__ __forceinline__ void ml_sblock(f32x16& S, float& den, const bf16* ZB, const bf16x8 (&Qf)[4], int sb, int base_row, int h, int r, int hh, int jl, float a, float Mj) {
    S = ML_ZERO16;
    const int sr = 32 * sb + r; const int rows = base_row + (DIR ? 63 - sr : sr);
#pragma unroll
    for (int st = 0; st < 4; ++st) { const bf16x8 Kf = *(const bf16x8*)(ZB + (unsigned)(rows * 1024 + 256 + h * 64 + st * 16 + hh * 8)); S = MFMA32(Kf, Qf[st], S); }
#pragma unroll
    for (int g = 0; g < 16; ++g) { const int s = 32 * sb + crow(g, hh); const float as = shfl_idx(a, s);
        const float p = (s <= jl) ? S[g] * 0.125f * __expf(as - Mj) : 0.f; S[g] = p; den += p; }
}
template <int DIR>
__device__ __forceinline__ void ml_pv(f32x16& O, const f32x16& S, const bf16* ZB, int sb, int base_row, int h, int v, int hh) {
#pragma unroll
    for (int st2 = 0; st2 < 2; ++st2) {
        bf16x8 VA;
#pragma unroll
        for (int jj = 0; jj < 8; ++jj) { const int s = 32 * sb + 16 * st2 + 8 * (jj >> 2) + 4 * hh + (jj & 3); const int rows = base_row + (DIR ? 63 - s : s);
            VA[jj] = (short)ZB[(unsigned)(rows * 1024 + 512 + h * 64 + v)]; }
        const bf16x8 PB = pack8(S[8 * st2 + 0], S[8 * st2 + 1], S[8 * st2 + 2], S[8 * st2 + 3], S[8 * st2 + 4], S[8 * st2 + 5], S[8 * st2 + 6], S[8 * st2 + 7]);
        O = MFMA32(VA, PB, O);
        __builtin_amdgcn_sched_barrier(0);
    }
}
template <int DIR>
__device__ __forceinline__ void ml_out_dir(const KA& A, const Ctx& C, LAS float* H, int b, int h, int c, int base_row, int lane) {
    const bf16* ZB = (const bf16*)(A.ws() + WS_ZB); const float* GT = (const float*)(A.ws() + WS_G);
    const float* CST = (const float*)(A.ws() + WS_CST); const float* MS = (const float*)(A.ws() + WS_MS);
    const int r = lane & 31, hh = lane >> 5;
    const int j = DIR ? (c < 4 ? 3 - c : 263 - c) : c;
    const int sq = (b * 4 + h) * 2 + DIR;
    const float* Cp = CST + ((size_t)sq * NCH + j) * CSTF;
    const float m0 = MS[sq * NCH + j];
    const int rowl = base_row + (DIR ? 63 - lane : lane);
    const float gi = GT[(size_t)rowl * 16 + DIR * 8 + h], lf = GT[(size_t)rowl * 16 + DIR * 8 + 4 + h];
    float bs = lf;
#pragma unroll
    for (int o = 1; o < 64; o <<= 1) { const float tv = shfl_idx(bs, lane - o); if (lane >= o) bs += tv; }
    const float a = gi - bs;
    float pm = a;
#pragma unroll
    for (int o = 1; o < 64; o <<= 1) { const float tv = shfl_idx(pm, lane - o); if (lane >= o) pm = fmaxf(pm, tv); }
#pragma unroll 1
    for (int jb = 0; jb < 2; ++jb) {
        const int jl = 32 * jb + r;
        const float bj = shfl_idx(bs, jl), Mj = fmaxf(m0, shfl_idx(pm, jl));
        const int rowj = base_row + (DIR ? 63 - jl : jl);
        const int tok = DIR ? 63 - jl : jl;
        bf16x8 Qf[4];
#pragma unroll
        for (int st = 0; st < 4; ++st) Qf[st] = *(const bf16x8*)(ZB + (unsigned)(rowj * 1024 + h * 64 + st * 16 + hh * 8));
        f32x16 S0, S1 = ML_ZERO16; float den = 0.f;
        ml_sblock<DIR>(S0, den, ZB, Qf, 0, base_row, h, r, hh, jl, a, Mj);
        if (jb == 1) ml_sblock<DIR>(S1, den, ZB, Qf, 1, base_row, h, r, hh, jl, a, Mj);
        den += shfl_idx(den, lane ^ 32);
        const float wi = __expf(m0 - Mj) * 0.125f;
        float nq = 0.f;
#pragma unroll
        for (int st = 0; st < 4; ++st) { const f32x4 n0 = *(const f32x4*)(Cp + 4096 + st * 16 + hh * 8), n1 = *(const f32x4*)(Cp + 4096 + st * 16 + hh * 8 + 4);
            const u32x4 qw = __builtin_bit_cast(u32x4, Qf[st]);
            nq += n0.x * bflo(qw.x) + n0.y * bfhi(qw.x) + n0.z * bflo(qw.y) + n0.w * bfhi(qw.y) + n1.x * bflo(qw.z) + n1.y * bfhi(qw.z) + n1.z * bflo(qw.w) + n1.w * bfhi(qw.w); }
        nq += shfl_idx(nq, lane ^ 32);
        den += wi * nq;
        const float inv = 1.0f / fmaxf(fabsf(den), __expf(-(bj + Mj)));
#pragma unroll 1
        for (int vb = 0; vb < 2; ++vb) {
            const int v = 32 * vb + r;
            f32x16 O = ML_ZERO16;
            ml_pv<DIR>(O, S0, ZB, 0, base_row, h, v, hh);
            if (jb == 1) ml_pv<DIR>(O, S1, ZB, 1, base_row, h, v, hh);
            f32x16 I = ML_ZERO16;
#pragma unroll
            for (int st = 0; st < 4; ++st) { const float* cr = Cp + (size_t)v * 64 + st * 16 + hh * 8; const f32x4 c0 = *(const f32x4*)cr, c1 = *(const f32x4*)(cr + 4);
                const bf16x8 CA = pack8(c0.x, c0.y, c0.z, c0.w, c1.x, c1.y, c1.z, c1.w); I = MFMA32(CA, Qf[st], I); __builtin_amdgcn_sched_barrier(0); }
#pragma unroll
            for (int g = 0; g < 16; ++g) { const float hv = (O[g] + wi * I[g]) * inv; const int idx = (32 * vb + crow(g, hh)) * 65 + tok;
                if (DIR == 1) H[idx] = hv; else H[idx] += hv; }
        }
    }
}
__device__ __forceinline__ void phase_ml_out(int l) {
    const KA A = ka_fresh(); const Ctx C = ctx_fresh();
    const int gw = C.bid * 8 + C.wave, NGW = C.G * 8, lane = C.lane;
    const bf16* ZB = (const bf16*)(A.ws() + WS_ZB); bf16* MIX = (bf16*)(A.ws() + WS_MIX);
    LAS float* H = (LAS float*)(C.lds + C.wave * 16640);
    const int c_lo = (l == 1) ? 4 : 0, ncu = NCH - c_lo;
    for (int u = gw; u < 8 * ncu; u += NGW) {
        const int c = c_lo + u % ncu, bh = u / ncu, h = bh & 3, b = bh >> 2;
        const int base_row = c < 4 ? RL + b * CTXL + 64 * c : b * SEQ + 64 * (c - 4);
        ml_out_dir<1>(A, C, H, b, h, c, base_row, lane);
        LDS_WAIT(); asm volatile("" ::: "memory");
        ml_out_dir<0>(A, C, H, b, h, c, base_row, lane);
        LDS_WAIT(); asm volatile("" ::: "memory");
        float ss = 0.f;
#pragma unroll 8
        for (int v = 0; v < 64; ++v) { const float x = H[v * 65 + lane]; ss += x * x; }
        const float rs = 1.0f / sqrtf(ss * (1.f / 64.f) + EPS);
        const float gnv = A.in(18)[l * 256 + h * 64 + lane];
#pragma unroll 4
        for (int t = 0; t < 64; ++t) {
            const float rst = __builtin_bit_cast(float, __builtin_amdgcn_readlane(__builtin_bit_cast(int, rs), t));
            const size_t off = (size_t)(base_row + t) * 1024 + 768 + h * 64 + lane;
            const float o = bf2f(ZB[off]); const float sg = 1.0f / (1.0f + __expf(-o));
            MIX[off] = (bf16)f2bf(H[lane * 65 + t] * rst * gnv * sg);
        }
        LDS_WAIT(); asm volatile("" ::: "memory");
    }
}

__device__ __forceinline__ void glds16s(unsigned voff, const unsigned char* sbase, unsigned lds_dst) {
    unsigned keep;
    asm volatile("s_mov_b32 %0, m0\n\ts_mov_b32 m0, %3\n\ts_nop 0\n\tglobal_load_lds_dwordx4 %1, %2\n\ts_mov_b32 m0, %0" : "=&s"(keep) : "v"(voff), "s"(sbase), "s"(lds_dst) : "memory");
}
#define ATT_WAIT_BAR(N) asm volatile("s_waitcnt vmcnt(" #N ") lgkmcnt(0)\n\ts_barrier" ::: "memory")
constexpr int ATT_SLOT = 16384, ATT_NS = 6;
typedef int i32x8 __attribute__((ext_vector_type(8)));
#define MFMA8(a, b, c) __builtin_amdgcn_mfma_scale_f32_32x32x64_f8f6f4((a), (b), (c), 0, 0, 0, 127, 0, 127)
template <bool FIXEDREF>
__device__ __forceinline__ void attn_unit(const KA& A, const Ctx& C, int bh, int qrow0, int tile_lo, int ntiles) {
    int lane_ = C.lane; asm volatile("" : "+v"(lane_));
    const int lane = lane_, r = lane & 31, hh = lane >> 5, h = bh & 7;
    bf16* MIX = (bf16*)(A.ws() + WS_MIX);
    LAS unsigned char* lds = C.lds;
    const unsigned lds0 = (unsigned)(uintptr_t)lds;
    const int qrow = qrow0 + C.wave * 32 + r;
    const unsigned char* kg = A.ws() + WS_KN + ((size_t)bh * NKT + tile_lo) * KT_BYTES;
    const unsigned char* vg = A.ws() + WS_VT + ((size_t)bh * NKT + tile_lo) * VT_BYTES;
    const unsigned vo0 = (unsigned)(C.wave * 1024 + lane * 16);
    const unsigned d0 = lds0 + C.wave * 1024, d1 = d0 + 8192;
    int islot = 0;
#define ATT_ISSUE() do { const unsigned so_ = (unsigned)islot * ATT_SLOT; islot = (islot == ATT_NS - 1) ? 0 : islot + 1; \
        glds16s(vo0, kg, (unsigned)__builtin_amdgcn_readfirstlane(d0 + so_)); glds16s(vo0, vg, (unsigned)__builtin_amdgcn_readfirstlane(d1 + so_)); \
        kg += KT_BYTES; vg += VT_BYTES; } while (0)
    ATT_ISSUE(); ATT_ISSUE(); ATT_ISSUE();
    i32x8 qf[2];
    { const unsigned char* q8 = A.ws() + WS_Q8 + (size_t)qrow * 1024 + h * 128 + hh * 32;
#pragma unroll
      for (int st = 0; st < 2; ++st) { const u32x4 a = *(const u32x4*)(q8 + st * 64), b = *(const u32x4*)(q8 + st * 64 + 16);
          qf[st] = (i32x8){(int)a.x, (int)a.y, (int)a.z, (int)a.w, (int)b.x, (int)b.y, (int)b.z, (int)b.w}; } }
    f32x16 o0 = (f32x16){0.f, 0.f, 0.f, 0.f, 0.f, 0.f, 0.f, 0.f, 0.f, 0.f, 0.f, 0.f, 0.f, 0.f, 0.f, 0.f}, o1 = o0;
    float m = 0.f, lsum = 0.f;
    constexpr float THR = 8.f;
    const int ksw = (r >> 1) & 7;
    int cslot = 0, nslot = 1;
#define ATT_ADV() do { cslot = nslot; nslot = (nslot == ATT_NS - 1) ? 0 : nslot + 1; } while (0)
#define ATT_QKT(P0, P1, sl) do { const LAS unsigned char* Kb_ = lds + (sl) * ATT_SLOT + r * 128; P0 = ML_ZERO16; P1 = ML_ZERO16; \
        _Pragma("unroll") for (int st = 0; st < 2; ++st) { \
            const u32x4 a_ = *(const LAS u32x4*)(Kb_ + (((st * 4 + hh * 2) ^ ksw) << 4)), b_ = *(const LAS u32x4*)(Kb_ + (((st * 4 + hh * 2 + 1) ^ ksw) << 4)); \
            const u32x4 c_ = *(const LAS u32x4*)(Kb_ + 4096 + (((st * 4 + hh * 2) ^ ksw) << 4)), d_ = *(const LAS u32x4*)(Kb_ + 4096 + (((st * 4 + hh * 2 + 1) ^ ksw) << 4)); \
            P0 = MFMA8(((i32x8){(int)a_.x, (int)a_.y, (int)a_.z, (int)a_.w, (int)b_.x, (int)b_.y, (int)b_.z, (int)b_.w}), qf[st], P0); \
            P1 = MFMA8(((i32x8){(int)c_.x, (int)c_.y, (int)c_.z, (int)c_.w, (int)d_.x, (int)d_.y, (int)d_.z, (int)d_.w}), qf[st], P1); } } while (0)
#define ATT_H1(C0, C1, N0, N1, tt) do { \
        const bool more_ = (tt) + 1 < ntiles; \
        if ((tt) + 3 < ntiles) ATT_ISSUE(); \
        if (more_) ATT_QKT(N0, N1, nslot); \
        if (!FIXEDREF) { \
        float ta_ = __builtin_fmaxf(__builtin_fmaxf(C0[0], C0[1]), C0[2]), tb_ = __builtin_fmaxf(__builtin_fmaxf(C0[3], C0[4]), C0[5]), tc_ = __builtin_fmaxf(__builtin_fmaxf(C1[0], C1[1]), C1[2]), td_ = __builtin_fmaxf(__builtin_fmaxf(C1[3], C1[4]), C1[5]);     \
        _Pragma("unroll") for (int g = 6; g < 16; g += 2) { ta_ = __builtin_fmaxf(__builtin_fmaxf(ta_, C0[g]), C0[g + 1]); tc_ = __builtin_fmaxf(__builtin_fmaxf(tc_, C1[g]), C1[g + 1]); } \
        float tm_ = __builtin_fmaxf(__builtin_fmaxf(ta_, tb_), __builtin_fmaxf(tc_, td_)); \
        { const auto rr_ = __builtin_amdgcn_permlane32_swap(__builtin_bit_cast(unsigned, tm_), __builtin_bit_cast(unsigned, tm_), false, false);     \
          tm_ = __builtin_fmaxf(__builtin_bit_cast(float, rr_[0]), __builtin_bit_cast(float, rr_[1])); } \
        if ((tt) == 0) m = tm_;                             \
        else if (__any(tm_ - m > THR)) {                    \
            const float mn_ = __builtin_fmaxf(tm_, m), alpha_ = __builtin_amdgcn_exp2f(m - mn_); m = mn_; lsum *= alpha_; \
            _Pragma("unroll") for (int g = 0; g < 16; ++g) { o0[g] *= alpha_; o1[g] *= alpha_; } \
        } } } while (0)
#define ATT_H2(C0, C1, sl) do { \
        if (!FIXEDREF) { _Pragma("unroll") for (int g = 0; g < 16; ++g) { C0[g] -= m; C1[g] -= m; } } \
        float pa_ = 0.f, pb2_ = 0.f, pc_ = 0.f, pd_ = 0.f;                                      \
        _Pragma("unroll") for (int g = 0; g < 16; g += 2) { C0[g] = __builtin_amdgcn_exp2f(C0[g]); C0[g + 1] = __builtin_amdgcn_exp2f(C0[g + 1]); C1[g] = __builtin_amdgcn_exp2f(C1[g]); C1[g + 1] = __builtin_amdgcn_exp2f(C1[g + 1]); \
            pa_ += C0[g]; pb2_ += C0[g + 1]; pc_ += C1[g]; pd_ += C1[g + 1]; } \
        lsum += (pa_ + pb2_) + (pc_ + pd_); \
        bf16x8 pb_[2][2]; \
        pb_[0][0] = pack8(C0[0], C0[1], C0[2], C0[3], C0[4], C0[5], C0[6], C0[7]); pb_[0][1] = pack8(C0[8], C0[9], C0[10], C0[11], C0[12], C0[13], C0[14], C0[15]); \
        pb_[1][0] = pack8(C1[0], C1[1], C1[2], C1[3], C1[4], C1[5], C1[6], C1[7]); pb_[1][1] = pack8(C1[8], C1[9], C1[10], C1[11], C1[12], C1[13], C1[14], C1[15]); \
        const LAS unsigned char* Vb_ = lds + (sl) * ATT_SLOT + KT_BYTES; \
        { const int sw_ = (r >> 1) & 7; const LAS unsigned char* vrow_ = Vb_ + r * 128;        \
            _Pragma("unroll") for (int kb = 0; kb < 2; ++kb) _Pragma("unroll") for (int s2 = 0; s2 < 2; ++s2) { \
                const bf16x8 va_ = *(const LAS bf16x8*)(vrow_ + (((kb * 4 + s2 * 2 + hh) ^ sw_) << 4)), vb_ = *(const LAS bf16x8*)(vrow_ + 4096 + (((kb * 4 + s2 * 2 + hh) ^ sw_) << 4)); \
                o0 = MFMA32(va_, pb_[kb][s2], o0); o1 = MFMA32(vb_, pb_[kb][s2], o1); } } \
    } while (0)
#define ATT_SYNC(tt) do { if ((tt) + 2 < ntiles) ATT_WAIT_BAR(2); else ATT_WAIT_BAR(0); } while (0)
    f32x16 sA0, sA1, sB0, sB1;
    ATT_WAIT_BAR(4);
    ATT_QKT(sA0, sA1, 0);
    if (C.wave < 4) {
#pragma unroll 1
        for (int t = 0; t < ntiles; t += 2) {
            if (t + 1 < ntiles) ATT_SYNC(t);
            ATT_H1(sA0, sA1, sB0, sB1, t); ATT_H2(sA0, sA1, cslot); ATT_ADV();
            if (t + 2 < ntiles) ATT_SYNC(t + 1);
            ATT_H1(sB0, sB1, sA0, sA1, t + 1); ATT_H2(sB0, sB1, cslot); ATT_ADV();
        }
    } else {
        ATT_SYNC(0);
        ATT_H1(sA0, sA1, sB0, sB1, 0);
#pragma unroll 1
        for (int t = 1; t + 1 < ntiles; t += 2) {
            ATT_SYNC(t);
            ATT_H2(sA0, sA1, cslot); ATT_ADV(); ATT_H1(sB0, sB1, sA0, sA1, t);
            ATT_SYNC(t + 1);
            ATT_H2(sB0, sB1, cslot); ATT_ADV(); ATT_H1(sA0, sA1, sB0, sB1, t + 1);
        }
        ATT_H2(sA0, sA1, cslot); ATT_ADV(); ATT_H1(sB0, sB1, sA0, sA1, ntiles - 1);
        ATT_H2(sB0, sB1, cslot); ATT_ADV();
    }
#undef ATT_QKT
#undef ATT_H1
#undef ATT_H2
#undef ATT_SYNC
#undef ATT_ADV
    asm volatile("s_waitcnt lgkmcnt(0)\n\ts_barrier" ::: "memory");
#undef ATT_ISSUE
    lsum += shfl_idx(lsum, lane ^ 32);
    const float inv = 1.0f / lsum;
    { LAS bf16* stg = (LAS bf16*)(lds + ATT_NS * ATT_SLOT + C.wave * 4352);
#pragma unroll
      for (int g = 0; g < 16; ++g) { const int d = crow(g, hh); stg[r * 68 + d] = (bf16)f2bf(o0[g] * inv); stg[r * 68 + 32 + d] = (bf16)f2bf(o1[g] * inv); }
      LDS_WAIT(); asm volatile("" ::: "memory");
      bf16* ob = MIX + (size_t)(qrow0 + C.wave * 32) * 1024 + 256 + h * 64;
#pragma unroll
      for (int i = 0; i < 4; ++i) { const int row = i * 8 + (lane >> 3), ch = lane & 7;
          const u32x2 a = *(const LAS u32x2*)(stg + row * 68 + ch * 8), b = *(const LAS u32x2*)(stg + row * 68 + ch * 8 + 4);
          u32x4 v; v.x = a.x; v.y = a.y; v.z = b.x; v.w = b.y; *(u32x4*)(ob + (size_t)row * 1024 + ch * 8) = v; }
      LDS_WAIT(); asm volatile("" ::: "memory"); }
}
__device__ __forceinline__ void phase_attn(int l) {
    const KA A = ka_fresh(); const Ctx C = ctx_fresh();
    const int G = C.G;
    bool fixedref;
    { const int lane = C.lane; const float* qg = A.in(15) + l * 96; const float* kg = A.in(16) + l * 96;
      const float gq = wave_max(fmaxf(fabsf(qg[lane]), lane < 32 ? fabsf(qg[64 + lane]) : 0.f), lane), gk = wave_max(fmaxf(fabsf(kg[lane]), lane < 32 ? fabsf(kg[64 + lane]) : 0.f), lane);
      fixedref = (96.f * QSCALE * gq * gk) < 100.f; }
    for (int u = C.bid; u < 1024 + (l == 1 ? 0 : 16); u += G) {
        if (u < 1024) {
            int pair, qb;
            if (G == 256) { const int vcu = u & 255, rnd = u >> 8; pair = 2 * (vcu & 7) + (rnd >> 1); qb = (vcu >> 3) + 32 * (rnd & 1); }
            else { pair = u >> 6; qb = u & 63; }
            if (fixedref) attn_unit<true>(A, C, pair, (pair >> 3) * SEQ + qb * 256, 0, NKT); else attn_unit<false>(A, C, pair, (pair >> 3) * SEQ + qb * 256, 0, NKT);
        } else { const int pair = u - 1024;
            if (fixedref) attn_unit<true>(A, C, pair, RL + (pair >> 3) * CTXL, NKT - 4, 4); else attn_unit<false>(A, C, pair, RL + (pair >> 3) * CTXL, NKT - 4, 4); }
    }
}

__device__ __forceinline__ int f2key(float f) { const int b = __builtin_bit_cast(int, f); return b ^ ((b >> 31) & 0x7fffffff); }
__device__ __forceinline__ float key2f(int k) { return __builtin_bit_cast(float, k ^ ((k >> 31) & 0x7fffffff)); }
__device__ __forceinline__ void topk_ins(int (&lst)[16], int v) {
#pragma unroll
    for (int i = 0; i < 16; ++i) { const int hi = max(lst[i], v); v = min(lst[i], v); lst[i] = hi; }
}
__device__ __forceinline__ void bitonic_sort16_desc(int (&a)[16]) {
#pragma unroll
    for (int k = 2; k <= 16; k <<= 1)
#pragma unroll
        for (int j = k >> 1; j > 0; j >>= 1)
#pragma unroll
            for (int i = 0; i < 16; ++i) { const int p = i ^ j;
                if (p > i) { const int hi = max(a[i], a[p]), lo = min(a[i], a[p]); const bool desc = ((i & k) == 0) || (k == 16); a[i] = desc ? hi : lo; a[p] = desc ? lo : hi; } }
}
__device__ __forceinline__ void merge16_desc(int (&lst)[16], const int (&nw)[16]) {
#pragma unroll
    for (int i = 0; i < 16; ++i) lst[i] = max(lst[i], nw[15 - i]);
#pragma unroll
    for (int j = 8; j > 0; j >>= 1)
#pragma unroll
        for (int i = 0; i < 16; ++i) { const int p = i ^ j; if (p > i) { const int hi = max(lst[i], lst[p]), lo = min(lst[i], lst[p]); lst[i] = hi; lst[p] = lo; } }
}
__device__ __forceinline__ void topk_half(int (&lst)[16], const bf16* qp, const bf16* skp, int hh, int lane) {
    bf16x8 bq[8];
#pragma unroll
    for (int st = 0; st < 8; ++st) bq[st] = *(const bf16x8*)(qp + st * 16);
#pragma unroll
    for (int i = 0; i < 16; ++i) lst[i] = f2key(-3.0e38f);
    bf16x8 an[8];
#pragma unroll
    for (int st = 0; st < 8; ++st) an[st] = *(const bf16x8*)(skp + st * 16);
#pragma unroll 1
    for (int blk = 0; blk < 4; ++blk) {
        f32x16 acc = (f32x16){0.f, 0.f, 0.f, 0.f, 0.f, 0.f, 0.f, 0.f, 0.f, 0.f, 0.f, 0.f, 0.f, 0.f, 0.f, 0.f};
#pragma unroll
        for (int st = 0; st < 8; ++st) acc = MFMA32(an[st], bq[st], acc);
        if (blk < 3) {
#pragma unroll
            for (int st = 0; st < 8; ++st) an[st] = *(const bf16x8*)(skp + (blk + 1) * 32 * 128 + st * 16); }
        int nk[16];
#pragma unroll
        for (int g = 0; g < 16; ++g) { const unsigned n = (unsigned)(blk * 32 + crow(g, hh));
            const float sv = acc[g];
            nk[g] = f2key(__builtin_bit_cast(float, (__builtin_bit_cast(unsigned, sv) & ~127u) | n)); }
        bitonic_sort16_desc(nk);
        merge16_desc(lst, nk);
    }
    int oth[16];
#pragma unroll
    for (int i = 0; i < 16; ++i) oth[i] = shfl_idx(lst[i], lane ^ 32);
    merge16_desc(lst, oth);
}
__device__ __forceinline__ void phase_topk(int l) {
    const KA A = ka_fresh(); const Ctx C = ctx_fresh();
    const int gw = C.bid * 8 + C.wave, NGW = C.G * 8, lane = C.lane, r = lane & 31, hh = lane >> 5;
    const bf16* PQ = (const bf16*)(A.ws() + WS_PQ); const bf16* SK = (const bf16*)(A.ws() + WS_SUBK);
    int* EID = (int*)(A.ws() + WS_EID); float* GATE = (float*)(A.ws() + WS_GATE);
    const int nrows = (l == 1) ? RL : RT;
    for (int unit = gw; unit < (nrows / 32) * 8; unit += NGW) {
        const int h = unit & 7, r0 = (unit >> 3) * 32; const size_t row = (size_t)(r0 + r);
        int L[2][16];
        topk_half(L[0], PQ + row * 2048 + h * 256 + hh * 8, SK + ((size_t)((l * 8 + h) * 2 + 0) * 128 + r) * 128 + hh * 8, hh, lane);
        __builtin_amdgcn_sched_barrier(0);
        topk_half(L[1], PQ + row * 2048 + h * 256 + 128 + hh * 8, SK + ((size_t)((l * 8 + h) * 2 + 1) * 128 + r) * 128 + hh * 8, hh, lane);
        __builtin_amdgcn_sched_barrier(0);
        int best[16];
#pragma unroll
        for (int j = 0; j < 16; ++j) best[j] = f2key(__builtin_bit_cast(float, (__builtin_bit_cast(unsigned, key2f(L[0][0]) + key2f(L[1][j])) & ~255u) | (unsigned)j));
#pragma unroll
        for (int i = 1; i < 16; ++i)
#pragma unroll
            for (int j = 0; j < 16; ++j)
                if ((i + 1) * (j + 1) <= 16) topk_ins(best, f2key(__builtin_bit_cast(float, (__builtin_bit_cast(unsigned, key2f(L[0][i]) + key2f(L[1][j])) & ~255u) | (unsigned)(i * 16 + j))));
        float ev[16]; float esum = 0.f;
        const float mx = __builtin_bit_cast(float, __builtin_bit_cast(unsigned, key2f(best[0])) & ~255u);
#pragma unroll
        for (int k = 0; k < 16; ++k) { ev[k] = __expf(__builtin_bit_cast(float, __builtin_bit_cast(unsigned, key2f(best[k])) & ~255u) - mx); esum += ev[k]; }
        const float einv = 1.0f / esum;
#pragma unroll
        for (int k = 0; k < 8; ++k) {
            const int b_lo = best[k], b_hi = best[k + 8]; const float e_lo = ev[k], e_hi = ev[k + 8];
            const int bk = hh ? b_hi : b_lo; const float gk = (hh ? e_hi : e_lo) * einv;
            const unsigned code = __builtin_bit_cast(unsigned, key2f(bk)) & 255u;
            const unsigned ci = code >> 4, cj = code & 15u; unsigned n0 = 0u, n1 = 0u;
#pragma unroll
            for (int i = 0; i < 16; ++i) { n0 = (ci == (unsigned)i) ? (__builtin_bit_cast(unsigned, key2f(L[0][i])) & 127u) : n0; n1 = (cj == (unsigned)i) ? (__builtin_bit_cast(unsigned, key2f(L[1][i])) & 127u) : n1; }
            EID[row * 128 + h * 16 + hh * 8 + k] = (int)(n0 * 128u + n1); GATE[row * 128 + h * 16 + hh * 8 + k] = gk;
        }
    }
}
typedef float f32x2v __attribute__((ext_vector_type(2)));
typedef unsigned u32x6 __attribute__((ext_vector_type(6)));
typedef float f32x32 __attribute__((ext_vector_type(32)));
#define FFN_NB 4
__device__ __forceinline__ void phase_ffn(int l) {
    const KA A = ka_fresh(); const Ctx C = ctx_fresh();
    const int gw = C.bid * 8 + C.wave, NGW = C.G * 8, lane = C.lane;
    const bf16* XN = (const bf16*)(A.ws() + WS_XN); const unsigned char* TU = A.ws() + WS_TABU; const unsigned char* TV = A.ws() + WS_TABV;
    const int* EID = (const int*)(A.ws() + WS_EID); const float* GATE = (const float*)(A.ws() + WS_GATE);
    const float* MOD = (const float*)(A.ws() + WS_MOD);
    const int nrows = (l == 1) ? RL : RT;
    for (int row = gw; row < nrows; row += NGW) {
        float hv[16];
        { const u32x4 a = *(const u32x4*)(XN + (size_t)row * DM + lane * 16), b = *(const u32x4*)(XN + (size_t)row * DM + lane * 16 + 8);
          hv[0] = bflo(a.x); hv[1] = bfhi(a.x); hv[2] = bflo(a.y); hv[3] = bfhi(a.y); hv[4] = bflo(a.z); hv[5] = bfhi(a.z); hv[6] = bflo(a.w); hv[7] = bfhi(a.w);
          hv[8] = bflo(b.x); hv[9] = bfhi(b.x); hv[10] = bflo(b.y); hv[11] = bfhi(b.y); hv[12] = bflo(b.z); hv[13] = bfhi(b.z); hv[14] = bflo(b.w); hv[15] = bfhi(b.w); }
        float out[16];
#pragma unroll
        for (int i = 0; i < 16; ++i) out[i] = 0.f;
        const int idA = EID[(size_t)row * 128 + lane], idB = EID[(size_t)row * 128 + 64 + lane]; const float gtA = GATE[(size_t)row * 128 + lane], gtB = GATE[(size_t)row * 128 + 64 + lane];
        int ln = lane; asm volatile("" : "+v"(ln));
        const bool b0 = ln & 1, b1 = ln & 2; const int q4 = ln >> 2, x16 = ln ^ 16, x32 = ln ^ 32;
        float dA = 0.f, dB = 0.f;
#define FFN_LOADU(UU, ID, e0) do { _Pragma("unroll") for (int k = 0; k < 4; ++k) { const int id_ = __builtin_amdgcn_readlane(ID, (e0) + k); UU[k] = *(const U3*)(TU + (size_t)id_ * TROW + lane * 12); } } while (0)
#define FFN_DOT4(UU, DV, e0) do { float p_[4]; \
            _Pragma("unroll") for (int k = 0; k < 4; k += 2) { \
                const u32x6 us_ = {UU[k].a, UU[k].b, UU[k].c, UU[k + 1].a, UU[k + 1].b, UU[k + 1].c}; \
                const f32x32 uf_ = __builtin_amdgcn_cvt_scalef32_pk32_f32_fp6(us_, 1.0f);        \
                float d0_ = 0.f, d1_ = 0.f; \
                _Pragma("unroll") for (int i = 0; i < 16; ++i) { d0_ += hv[i] * uf_[i]; d1_ += hv[i] * uf_[16 + i]; } \
                p_[k] = d0_; p_[k + 1] = d1_; } \
            float x01_ = b0 ? p_[1] : p_[0], y01_ = b0 ? p_[0] : p_[1], x23_ = b0 ? p_[3] : p_[2], y23_ = b0 ? p_[2] : p_[3]; \
            x01_ += __builtin_bit_cast(float, __builtin_amdgcn_update_dpp(0, __builtin_bit_cast(int, y01_), 0xB1, 0xf, 0xf, true)); \
            x23_ += __builtin_bit_cast(float, __builtin_amdgcn_update_dpp(0, __builtin_bit_cast(int, y23_), 0xB1, 0xf, 0xf, true)); \
            float x_ = b1 ? x23_ : x01_; const float y_ = b1 ? x01_ : x23_; \
            x_ += __builtin_bit_cast(float, __builtin_amdgcn_update_dpp(0, __builtin_bit_cast(int, y_), 0x4E, 0xf, 0xf, true)); \
            DPP_ADD(x_, 0x124); DPP_ADD(x_, 0x128);                  \
            x_ += shfl_idx(x_, x16); x_ += shfl_idx(x_, x32);       \
            DV = (q4 == ((e0) >> 2)) ? x_ : DV; } while (0)
        { U3 ua[4], ub[4];
          FFN_LOADU(ua, idA, 0);
#pragma unroll 1
          for (int e = 0; e < 64; e += 8) { FFN_LOADU(ub, idA, e + 4); FFN_DOT4(ua, dA, e); if (e + 8 < 64) FFN_LOADU(ua, idA, e + 8); else FFN_LOADU(ua, idB, 0); FFN_DOT4(ub, dA, e + 4); }
#pragma unroll 1
          for (int e = 0; e < 64; e += 8) { FFN_LOADU(ub, idB, e + 4); FFN_DOT4(ua, dB, e); if (e + 8 < 64) FFN_LOADU(ua, idB, e + 8); FFN_DOT4(ub, dB, e + 4); } }
#undef FFN_LOADU
#undef FFN_DOT4
        const float wA = gtA * gelu_f(dA * (1.0f / U_SCALE)) * (1.0f / V_SCALE), wB = gtB * gelu_f(dB * (1.0f / U_SCALE)) * (1.0f / V_SCALE);
#define FFN_LOADV(VV, ID, e0) do { _Pragma("unroll") for (int k = 0; k < 4; ++k) { const int id_ = __builtin_amdgcn_readlane(ID, (e0) + k); VV[k] = *(const U3*)(TV + (size_t)id_ * TROW + lane * 12); } } while (0)
#define FFN_ACC4(VV, WV, e0) do { _Pragma("unroll") for (int k = 0; k < 4; k += 2) { \
            const float w0_ = __builtin_bit_cast(float, __builtin_amdgcn_readlane(__builtin_bit_cast(int, WV), (e0) + k)), w1_ = __builtin_bit_cast(float, __builtin_amdgcn_readlane(__builtin_bit_cast(int, WV), (e0) + k + 1)); \
            const u32x6 vs_ = {VV[k].a, VV[k].b, VV[k].c, VV[k + 1].a, VV[k + 1].b, VV[k + 1].c}; \
            const f32x32 vf_ = __builtin_amdgcn_cvt_scalef32_pk32_f32_fp6(vs_, 1.0f); \
            _Pragma("unroll") for (int i = 0; i < 16; ++i) out[i] += w0_ * vf_[i] + w1_ * vf_[16 + i]; } } while (0)
        { U3 va[4], vb[4];
          FFN_LOADV(va, idA, 0);
#pragma unroll 1
          for (int e = 0; e < 64; e += 8) { FFN_LOADV(vb, idA, e + 4); FFN_ACC4(va, wA, e); if (e + 8 < 64) FFN_LOADV(va, idA, e + 8); else FFN_LOADV(va, idB, 0); FFN_ACC4(vb, wA, e + 4); }
#pragma unroll 1
          for (int e = 0; e < 64; e += 8) { FFN_LOADV(vb, idB, e + 4); FFN_ACC4(va, wB, e); if (e + 8 < 64) FFN_LOADV(va, idB, e + 8); FFN_ACC4(vb, wB, e + 4); } }
#undef FFN_LOADV
#undef FFN_ACC4
        const int nsel = row < RL ? (row >> 14) : 2;
        const float* gf = MOD + (l * 3 + nsel) * 6144 + 5 * 1024;
        float* xr = stream_out(A, C, row);
#pragma unroll
        for (int q = 0; q < 4; ++q) { const int j = lane * 16 + q * 4;
            const f32x4 x = *(const f32x4*)(xr + j); f32x4 g = *(const f32x4*)(gf + j);
            f32x4 o; o.x = x.x + g.x * out[q * 4 + 0]; o.y = x.y + g.y * out[q * 4 + 1]; o.z = x.z + g.z * out[q * 4 + 2]; o.w = x.w + g.w * out[q * 4 + 3];
            *(f32x4*)(xr + j) = o; }
    }
}

template <class Epi>
__device__ __forceinline__ void run_gemm(const pg8::bf16_t* Amat, const pg8::bf16_t* Bt, int N, int K, const Epi& E, int M = RT) {
    const Ctx C = ctx_fresh();
    pg8::Gemm g{Amat, Bt, M, N, K}; pg8::StaticOrder S; S.init(M, N, C.G, C.bid);
    pg8::gemm_phase<Epi, pg8::StaticOrder, true, true>(C.lds, g, S, E);
}
__device__ __forceinline__ void seam() {
    const KA A = ka_fresh(); const Ctx C = ctx_fresh();
    XcdBarrier b; b.bar = (unsigned*)(A.ws() + WS_CTL) + CW_BAR; b.x = xb_xcc_id(); b.st = (volatile LAS unsigned*)(C.lds + MISC_OFF) + 8;
    xcd_barrier(b);
}
#define IN(k) (lo <= (k) && (k) < hi)
#define SEAM(k) do { if (IN(k) && IN((k) + 1)) seam(); } while (0)
template <int l>
__device__ __forceinline__ void layer_body(const int lo, const int hi) {
        const int p0 = 1 + NPH_L * l;
        if (IN(p0 + 0)) { phase_norm(l, 0); phase_tables(l); }
        SEAM(p0 + 0);
        if (IN(p0 + 1)) {
            const KA A = ka_fresh(); unsigned char* ws = A.ws();
            pg8::EpiBf16<0> E{(pg8::bf16_t*)(ws + WS_ZA), 1024, nullptr, 1024, (size_t)(WS_ZB - WS_ZA) / 2, 1.f};
            run_gemm(( const pg8::bf16_t*)(ws + WS_XN), (const pg8::bf16_t*)(ws + WS_WIN) + (size_t)l * 2048 * DM, 2048, DM, E);
        }
        SEAM(p0 + 1);
        if (IN(p0 + 2)) phase_post(l);
        SEAM(p0 + 2);
        if (IN(p0 + 3)) {
#pragma unroll 1
            for (int gi = 0; gi < 2; ++gi) {
                const KA A = ka_fresh(); unsigned char* ws = A.ws();
                const int N = gi ? 1024 : 768, K = gi ? 256 : 384;
                pg8::EpiBf16<0> E{(pg8::bf16_t*)(ws + (gi ? WS_KVRAW : WS_Q)), N, nullptr, 0, 0, 1.f};
                run_gemm((const pg8::bf16_t*)(ws + (gi ? WS_KVA : WS_QA)), (const pg8::bf16_t*)(ws + (gi ? WS_WUKV : WS_WUQ)) + (size_t)l * N * K, N, K, E);
            }
        }
        SEAM(p0 + 3);
        if (IN(p0 + 4)) phase_qknorm(l);
        SEAM(p0 + 4);
        if (IN(p0 + 5)) phase_ml_local();
        SEAM(p0 + 5);
        if (IN(p0 + 6)) phase_ml_scan();
        SEAM(p0 + 6);
        if (IN(p0 + 7)) {
            phase_ml_out(l);
            __syncthreads();
            phase_attn(l);
        }
        SEAM(p0 + 7);
        if (IN(p0 + 8)) {
            const KA A = ka_fresh(); unsigned char* ws = A.ws();
            pg8::EpiResGate E{l == 0 ? A.in(0) : (const float*)A.out(), l == 0 ? A.in(2) : (const float*)(ws + WS_CTXS), A.out(), (float*)(ws + WS_CTXS), (const float*)(ws + WS_MOD) + (size_t)l * 3 * 6144, 2 * 1024};
            run_gemm((const pg8::bf16_t*)(ws + WS_MIX), (const pg8::bf16_t*)(ws + WS_WOUT) + (size_t)l * DM * DM, DM, DM, E, l == 1 ? RL : RT);
        }
        SEAM(p0 + 8);
        if (IN(p0 + 9)) phase_norm(l, 1);
        SEAM(p0 + 9);

        if (IN(p0 + 10)) {
            const KA A = ka_fresh(); unsigned char* ws = A.ws();
            pg8::EpiBf16<0> E{(pg8::bf16_t*)(ws + WS_PQ), 2048, nullptr, 0, 0, 1.f};
            run_gemm((const pg8::bf16_t*)(ws + WS_XN), (const pg8::bf16_t*)(ws + WS_WPQ) + (size_t)l * 2048 * DM, 2048, DM, E, l == 1 ? RL : RT);
        }
        SEAM(p0 + 10);
                if (IN(p0 + 11)) phase_topk(l);
        SEAM(p0 + 11);
        if (IN(p0 + 12)) phase_ffn(l);
        if (l == 0) SEAM(p0 + 12);
    }
__global__ void __launch_bounds__(512, 2) mk_fwd(Args unused_args) {
    { const KA A = ka_fresh(); const Ctx C = ctx_fresh();
      volatile LAS unsigned* MISC = (volatile LAS unsigned*)(C.lds + MISC_OFF);
      if (C.tid < 64) MISC[C.tid] = 0u;
      __syncthreads();
      (void)xcd_barrier_post((unsigned*)(A.ws() + WS_CTL) + CW_BAR, MISC + 8); }
    int lo, hi;
    { const KA A = ka_fresh(); lo = A.ph_lo(); hi = A.ph_hi(); }
    if (IN(0)) phase_prologue();
    if (IN(0)) { if (lo == 0 && hi == NPHASES) seam(); }
    if (IN(0) && lo == 0 && hi == NPHASES) phase_modreduce();
    SEAM(0);
    layer_body<0>(lo, hi);
    layer_body<1>(lo, hi);
#undef IN
#undef SEAM
}

extern "C" void kernel_launch(void* const* d_in, const int* in_sizes, int n_in, void* d_out, int out_size, void* d_ws, size_t ws_size, hipStream_t stream) {
    static int grid = 0;
    if (grid == 0) {
        if (n_in != 24 || out_size != RL * DM || ws_size < WS_END) { fprintf(stderr, "kernel_launch: unexpected shapes (n_in %d, out %d, ws %zu)\n", n_in, out_size, ws_size); grid = -1; return; }
        int dev = 0, cus = 0, per_cu = 0;
        if (hipGetDevice(&dev) != hipSuccess || hipDeviceGetAttribute(&cus, hipDeviceAttributeMultiprocessorCount, dev) != hipSuccess) { grid = -1; return; }
        if (hipFuncSetAttribute((const void*)mk_fwd, hipFuncAttributeMaxDynamicSharedMemorySize, LDS_BYTES) != hipSuccess) { fprintf(stderr, "kernel_launch: hipFuncSetAttribute failed\n"); grid = -1; return; }
        if (hipOccupancyMaxActiveBlocksPerMultiprocessor(&per_cu, (const void*)mk_fwd, 512, LDS_BYTES) != hipSuccess || per_cu < 1) { fprintf(stderr, "kernel_launch: occupancy query says %d\n", per_cu); per_cu = 1; }
        (void)hipGetLastError();
        grid = cus;
    }
    if (grid < 0) return;
    (void)hipMemsetAsync((char*)d_ws + WS_CTL, 0, CTL_ZERO_BYTES, stream);
    Args a{};
    for (int i = 0; i < 24; ++i) a.in[i] = (const float*)d_in[i];
    a.out = (float*)d_out; a.ws = (unsigned char*)d_ws;
    a.ph_lo = 0; a.ph_hi = NPHASES;
    hipLaunchKernelGGL(mk_fwd, dim3(grid), dim3(512), LDS_BYTES, stream, a);
}
```

```cpp
#include <hip/hip_runtime.h>
#include <cstdio>
#include <cstdint>

namespace pg8 {
#define PG8_LAS __attribute__((address_space(3)))
typedef unsigned short bf16_t;
typedef short bf16x8 __attribute__((ext_vector_type(8)));
typedef float f32x4 __attribute__((ext_vector_type(4)));
typedef unsigned u32x4 __attribute__((ext_vector_type(4)));
constexpr int BM = 256, BK = 64, HALF = 128, HTB = HALF * BK * 2  , STAGE_BYTES = 8 * HTB, NXCD = 8, WGM = 8;

__host__ __device__ __forceinline__ int lds_byte(int r, int c) { const int st = (r >> 4) * 2 + (c >> 5), rr = r & 15, cc = c & 31, ob = rr * 64 + cc * 2; return st * 1024 + (ob ^ (((ob >> 9) & 1) << 5)); }
__host__ __device__ __forceinline__ void stage_rc(int b, int& R, int& C) { const int st = b / 1024, sb = b % 1024, swz = sb ^ (((sb >> 9) & 1) << 5); R = (st >> 1) * 16 + swz / 64; C = (st & 1) * 32 + (swz % 64) / 2; }
__host__ __device__ __forceinline__ int perm32(int rho) { const int n = rho >> 4, i = rho & 15; return 8 * (i >> 2) + 4 * n + (i & 3); }

struct Unit { int pm, pn; };
struct Gemm { const bf16_t* A; const bf16_t* Bt; int M, N, K; };

struct StaticOrder {
    int nM, nN, nwg, G, c;
    __host__ __device__ void init(int M, int N, int G_, int c_) { nM = M / BM; nN = N / BM; nwg = nM * nN; G = G_; c = c_; }
    __host__ __device__ bool next(int i, Unit& u) const {
        const long L = (long)i * G + c; if (L >= nwg) return false;
        int wgid = (int)L; { const int q = nwg / NXCD, r = nwg % NXCD, xcd = wgid % NXCD, off = wgid / NXCD; wgid = (xcd < r ? xcd * (q + 1) : r * (q + 1) + (xcd - r) * q) + off; }
        const int nig = WGM * nN, gid = wgid / nig, fm = gid * WGM, gsz = (nM - fm) < WGM ? (nM - fm) : WGM;
        u.pm = fm + ((wgid % nig) % gsz); u.pn = (wgid % nig) / gsz; return true;
    }
    __device__ __forceinline__ void a_ready(const Unit&) const {}
    __device__ __forceinline__ void done(const Unit&) const {}
};

__device__ __forceinline__ unsigned cvt_pk_bf16(float lo, float hi) { unsigned r; asm volatile("v_cvt_pk_bf16_f32 %0, %1, %2" : "=v"(r) : "v"(lo), "v"(hi)); return r; }
typedef float f32x2 __attribute__((ext_vector_type(2)));
__device__ __forceinline__ f32x2 gelu_pk(f32x2 v) {
    const f32x2 av = __builtin_elementwise_abs(v), d = av * 0.2316418882f + 1.0f;
    f32x2 t; t.x = __builtin_amdgcn_rcpf(d.x); t.y = __builtin_amdgcn_rcpf(d.y);
    f32x2 q = t * 0.5307027145f + (-0.7265760135f); q = q * t + 0.7107068705f; q = q * t + (-0.142248368f); q = q * t + 0.127414796f; q = q * t;
    const f32x2 s = (v * v) * (-0.72134752044f);
    f32x2 e; e.x = __builtin_amdgcn_exp2f(s.x); e.y = __builtin_amdgcn_exp2f(s.y);
    const f32x2 m = v * (q * e), r = v - m;
    f32x2 o; o.x = v.x < 0.f ? m.x : r.x; o.y = v.y < 0.f ? m.y : r.y; return o;
}

template <int ACT  > struct EpiBf16 {
    static constexpr bool PERM = true, AFTER_DRAIN = false; static_assert(ACT == 0 || ACT == 1, "EpiBf16: ACT is 0 (none) or 1 (gelu_pk)");
    bf16_t* O; int ldc; const float* bias; int split_cols; size_t split_stride; float scale0;
    __device__ __forceinline__ void operator()(const f32x4 (&acc)[2][2][4][2], const Unit& u, int wr, int wc, int fr, int fq) const {
        const int row0 = u.pm * BM + wr * 64 + fr; int colt = u.pn * BM; bf16_t* base = O;
        float sc = 1.f; if (split_cols) { const int t = colt / split_cols; base += (size_t)t * split_stride; colt -= t * split_cols; if (t == 0) sc = scale0; }
        const int col0 = colt + wc * 32 + 8 * fq, bcol0 = u.pn * BM + wc * 32 + 8 * fq;
        f32x4 bv[2][2];
#pragma unroll
        for (int bj = 0; bj < 2; ++bj)
#pragma unroll
            for (int n = 0; n < 2; ++n) bv[bj][n] = bias ? *(const f32x4*)(bias + bcol0 + bj * HALF + 4 * n) : (f32x4){0.f, 0.f, 0.f, 0.f};
#pragma unroll
        for (int ai = 0; ai < 2; ++ai)
#pragma unroll
            for (int m = 0; m < 4; ++m) { bf16_t* rowp = base + (size_t)(row0 + ai * HALF + m * 16) * ldc + col0;
#pragma unroll
                for (int bj = 0; bj < 2; ++bj) { f32x4 v0 = acc[ai][bj][m][0] + bv[bj][0], v1 = acc[ai][bj][m][1] + bv[bj][1];
                    if (ACT == 1) { f32x2 a = gelu_pk((f32x2){v0[0], v0[1]}), b = gelu_pk((f32x2){v0[2], v0[3]}), c = gelu_pk((f32x2){v1[0], v1[1]}), d = gelu_pk((f32x2){v1[2], v1[3]});
                        v0 = (f32x4){a.x, a.y, b.x, b.y}; v1 = (f32x4){c.x, c.y, d.x, d.y}; }
                    v0 = v0 * sc; v1 = v1 * sc; u32x4 w; w.x = cvt_pk_bf16(v0[0], v0[1]); w.y = cvt_pk_bf16(v0[2], v0[3]); w.z = cvt_pk_bf16(v1[0], v1[1]); w.w = cvt_pk_bf16(v1[2], v1[3]);
                    *(u32x4*)(rowp + bj * HALF) = w; } }
    }
};


struct EpiResGate {
    static constexpr bool PERM = false, AFTER_DRAIN = false;
    const float* base_lat; const float* base_ctx; float* out_lat; float* out_ctx; const float* gate;
    int goff;
    __device__ __forceinline__ void operator()(const f32x4 (&acc)[2][2][4][2], const Unit& u, int wr, int wc, int fr, int fq) const {
        const int rowt = u.pm * BM; const bool lat = rowt < 32768;
        const int nsel = lat ? (rowt >> 14) : 2;
        const float* bs = lat ? base_lat + (size_t)rowt * 1024 : base_ctx + (size_t)(rowt - 32768) * 1024;
        float* os = lat ? out_lat + (size_t)rowt * 1024 : out_ctx + (size_t)(rowt - 32768) * 1024;
        const float* gv = gate + nsel * 6144 + goff;
        const int rl = wr * 64 + fr, col0 = u.pn * BM + wc * 32 + 4 * fq;
        f32x4 g[2][2];
#pragma unroll
        for (int bj = 0; bj < 2; ++bj)
#pragma unroll
            for (int n = 0; n < 2; ++n) g[bj][n] = *(const f32x4*)(gv + col0 + bj * HALF + n * 16);
#pragma unroll
        for (int ai = 0; ai < 2; ++ai)
#pragma unroll
            for (int m = 0; m < 4; ++m) { const size_t ro = (size_t)(rl + ai * HALF + m * 16) * 1024 + col0;
#pragma unroll
                for (int bj = 0; bj < 2; ++bj)
#pragma unroll
                    for (int n = 0; n < 2; ++n) { const f32x4 b = *(const f32x4*)(bs + ro + bj * HALF + n * 16); *(f32x4*)(os + ro + bj * HALF + n * 16) = b + g[bj][n] * acc[ai][bj][m][n]; } }
    }
};

template <class Epi, class Sched, bool ALIGN_EPI = false, bool SP2 = false>
__device__ __forceinline__ void gemm_phase(PG8_LAS unsigned char* lds, const Gemm g, const Sched& S, const Epi& E) {
    int tid_l = threadIdx.x; asm volatile("" : "+v"(tid_l));
    const int tid = tid_l, wid = __builtin_amdgcn_readfirstlane(tid >> 6), lane = tid & 63, wr = wid >> 2, wc = wid & 3, fr = lane & 15, fq = lane >> 4;
    const int K = g.K, nt = K / BK;
    unsigned voffA[2], voffB[2];
#pragma unroll
    for (int i = 0; i < 2; ++i) { int R, C; stage_rc(tid * 16 + i * 8192, R, C); const int Rb = Epi::PERM ? ((R & ~31) + perm32(R & 31)) : R;
        voffA[i] = (unsigned)(R * K + C) * 2u; voffB[i] = (unsigned)(Rb * K + C) * 2u; }
    const size_t kstep = (size_t)(BK * 2);
    const size_t hstep = (size_t)HALF * K * 2;
    const size_t tstep = 2 * hstep;
    const unsigned ldsw = (unsigned)wid * 1024u;
    const int aoff = lds_byte(wr * 64 + fr, fq * 8), boff = lds_byte(wc * 32 + fr, fq * 8);
#define PG8_SA(b, h) (((b) * 2 + (h)) * HTB)
#define PG8_SB(b, h) ((4 + (b) * 2 + (h)) * HTB)
#define PG8_STAGE(bufoff, gbase, voff) do { _Pragma("unroll") for (int _i = 0; _i < 2; ++_i) \
        __builtin_amdgcn_global_load_lds((const unsigned*)((const char*)(gbase) + (voff)[_i]), (PG8_LAS unsigned*)(lds + (bufoff) + ldsw + _i * 8192), 16, 0, 0); } while (0)
#define PG8_LDA(dst, b, h) do { _Pragma("unroll") for (int m = 0; m < 4; ++m) _Pragma("unroll") for (int k = 0; k < 2; ++k) dst[m][k] = *(const PG8_LAS bf16x8*)(lds + PG8_SA(b, h) + aoff + m * 2048 + k * 1024); } while (0)
#define PG8_LDB(dst, b, h) do { _Pragma("unroll") for (int n = 0; n < 2; ++n) _Pragma("unroll") for (int k = 0; k < 2; ++k) dst[n][k] = *(const PG8_LAS bf16x8*)(lds + PG8_SB(b, h) + boff + n * 2048 + k * 1024); } while (0)
#define PG8_MMA(ai, bj, At, Bt) do { __builtin_amdgcn_s_setprio(1); _Pragma("unroll") for (int m = 0; m < 4; ++m) _Pragma("unroll") for (int n = 0; n < 2; ++n) _Pragma("unroll") for (int k = 0; k < 2; ++k) \
        acc[ai][bj][m][n] = __builtin_amdgcn_mfma_f32_16x16x32_bf16(Bt[n][k], At[m][k], acc[ai][bj][m][n], 0, 0, 0); __builtin_amdgcn_s_setprio(0); } while (0)
#define PG8_WAIT_V(n) asm volatile("s_waitcnt vmcnt(" #n ")" ::: "memory")
#define PG8_WAIT_L(n) asm volatile("s_waitcnt lgkmcnt(" #n ")" ::: "memory")
#define PG8_BAR __builtin_amdgcn_s_barrier()
#define PG8_SCHED __builtin_amdgcn_sched_barrier(0)
    Unit cur, nxt; int ui = 0;
    if (!S.next(0, cur)) return;
    f32x4 acc[2][2][4][2];
#pragma unroll
    for (int a = 0; a < 2; ++a)
#pragma unroll
        for (int b = 0; b < 2; ++b)
#pragma unroll
            for (int m = 0; m < 4; ++m)
#pragma unroll
                for (int n = 0; n < 2; ++n) acc[a][b][m][n] = (f32x4){0.f, 0.f, 0.f, 0.f};
    bf16x8 At[4][2], B0[2][2], B1[2][2];
    const char* cA = (const char*)g.A + (size_t)cur.pm * tstep; const char* cB = (const char*)g.Bt + (size_t)cur.pn * tstep;
    S.a_ready(cur);
    if constexpr (SP2) {
        PG8_STAGE(PG8_SB(0, 0), cB, voffB); PG8_STAGE(PG8_SB(0, 1), cB + hstep, voffB); PG8_STAGE(PG8_SA(0, 0), cA, voffA); PG8_STAGE(PG8_SA(0, 1), cA + hstep, voffA);
        if (wr == 1) PG8_BAR;
        PG8_WAIT_V(2); PG8_BAR;
        PG8_STAGE(PG8_SB(1, 0), cB + kstep, voffB); PG8_STAGE(PG8_SA(1, 0), cA + kstep, voffA); PG8_STAGE(PG8_SB(1, 1), cB + hstep + kstep, voffB);
        PG8_WAIT_V(6); PG8_BAR;
    } else {
        PG8_STAGE(PG8_SB(0, 0), cB, voffB); PG8_STAGE(PG8_SA(0, 0), cA, voffA); PG8_STAGE(PG8_SB(0, 1), cB + hstep, voffB); PG8_STAGE(PG8_SA(0, 1), cA + hstep, voffA);
        if (wr == 1) PG8_BAR;
        PG8_WAIT_V(4); PG8_BAR;
        PG8_STAGE(PG8_SB(1, 0), cB + kstep, voffB); PG8_STAGE(PG8_SA(1, 0), cA + kstep, voffA); PG8_STAGE(PG8_SB(1, 1), cB + hstep + kstep, voffB);
        PG8_WAIT_V(6); PG8_BAR;
    }
    for (;;) {
        const bool has_next = S.next(ui + 1, nxt);
        const char* nA = has_next ? (const char*)g.A + (size_t)nxt.pm * tstep : cA; const char* nB = has_next ? (const char*)g.Bt + (size_t)nxt.pn * tstep : cB;
        for (int t = 0; t < nt; t += 2) {
            const bool last = (t == nt - 2);
            const char* a1 = cA + (size_t)(t + 1) * kstep;
            const char* a2 = last ? nA : cA + (size_t)(t + 2) * kstep; const char* b2 = last ? nB : cB + (size_t)(t + 2) * kstep;
            const char* a3 = a2 + kstep; const char* b3 = b2 + kstep;
            if (last && has_next) S.a_ready(nxt);
            if constexpr (SP2) {
            PG8_LDB(B0, 0, 0); PG8_LDB(B1, 0, 1); PG8_SCHED; PG8_LDA(At, 0, 0); PG8_STAGE(PG8_SA(1, 1), a1 + hstep, voffA);
            PG8_WAIT_V(8); PG8_WAIT_L(0); PG8_BAR; PG8_MMA(0, 0, At, B0); PG8_MMA(0, 1, At, B1); PG8_BAR; PG8_SCHED;
            PG8_LDA(At, 0, 1); PG8_STAGE(PG8_SB(0, 0), b2, voffB); PG8_STAGE(PG8_SB(0, 1), b2 + hstep, voffB); PG8_STAGE(PG8_SA(0, 0), a2, voffA);
            PG8_WAIT_V(8); PG8_WAIT_L(0); PG8_BAR; PG8_MMA(1, 0, At, B0); PG8_MMA(1, 1, At, B1); PG8_BAR; PG8_SCHED;
            PG8_LDB(B0, 1, 0); PG8_LDB(B1, 1, 1); PG8_SCHED; PG8_LDA(At, 1, 0); PG8_STAGE(PG8_SA(0, 1), a2 + hstep, voffA);
            PG8_WAIT_V(8); PG8_WAIT_L(0); PG8_BAR; PG8_MMA(0, 0, At, B0); PG8_MMA(0, 1, At, B1); PG8_BAR; PG8_SCHED;
            PG8_LDA(At, 1, 1); PG8_STAGE(PG8_SB(1, 0), b3, voffB); PG8_STAGE(PG8_SB(1, 1), b3 + hstep, voffB); PG8_STAGE(PG8_SA(1, 0), a3, voffA);
            PG8_WAIT_V(8); PG8_WAIT_L(0); PG8_BAR; PG8_MMA(1, 0, At, B0); PG8_MMA(1, 1, At, B1); PG8_BAR; PG8_SCHED;
            } else {
            PG8_LDB(B0, 0, 0); PG8_SCHED; PG8_LDA(At, 0, 0); PG8_STAGE(PG8_SA(1, 1), a1 + hstep, voffA);
            PG8_WAIT_L(8); PG8_BAR; PG8_WAIT_L(0); PG8_MMA(0, 0, At, B0); PG8_BAR; PG8_SCHED;
            PG8_LDB(B1, 0, 1); PG8_STAGE(PG8_SB(0, 0), b2, voffB);
            PG8_BAR; PG8_WAIT_L(0); PG8_MMA(0, 1, At, B1); PG8_BAR;
            PG8_LDA(At, 0, 1); PG8_STAGE(PG8_SA(0, 0), a2, voffA);
            PG8_BAR; PG8_WAIT_L(0); PG8_MMA(1, 0, At, B0); PG8_BAR; PG8_SCHED;
            PG8_STAGE(PG8_SB(0, 1), b2 + hstep, voffB);
            PG8_WAIT_V(6); PG8_BAR; PG8_MMA(1, 1, At, B1); PG8_BAR;
            PG8_LDB(B0, 1, 0); PG8_SCHED; PG8_LDA(At, 1, 0); PG8_STAGE(PG8_SA(0, 1), a2 + hstep, voffA);
            PG8_WAIT_L(8); PG8_BAR; PG8_WAIT_L(0); PG8_MMA(0, 0, At, B0); PG8_BAR; PG8_SCHED;
            PG8_LDB(B1, 1, 1); PG8_STAGE(PG8_SB(1, 0), b3, voffB);
            PG8_BAR; PG8_WAIT_L(0); PG8_MMA(0, 1, At, B1); PG8_BAR;
            PG8_LDA(At, 1, 1); PG8_STAGE(PG8_SA(1, 0), a3, voffA);
            PG8_BAR; PG8_WAIT_L(0); PG8_MMA(1, 0, At, B0); PG8_BAR; PG8_SCHED;
            PG8_STAGE(PG8_SB(1, 1), b3 + hstep, voffB);
            PG8_WAIT_V(6); PG8_BAR; PG8_MMA(1, 1, At, B1); PG8_BAR;
            }
        }
        if constexpr (ALIGN_EPI) { if (wr == 0) PG8_BAR; }
        if constexpr (!Epi::AFTER_DRAIN) { E(acc, cur, wr, wc, fr, fq); S.done(cur); }
        if (!has_next) break;
#pragma unroll
        for (int a = 0; a < 2; ++a)
#pragma unroll
            for (int b = 0; b < 2; ++b)
#pragma unroll
                for (int m = 0; m < 4; ++m)
#pragma unroll
                    for (int n = 0; n < 2; ++n) acc[a][b][m][n] = (f32x4){0.f, 0.f, 0.f, 0.f};
        cur = nxt; cA = nA; cB = nB; ++ui;
        if constexpr (ALIGN_EPI) { if (wr == 1) PG8_BAR; }
    }
    PG8_WAIT_V(0);
    if constexpr (!ALIGN_EPI) { if (wr == 0) PG8_BAR; }
    PG8_BAR;
    if constexpr (Epi::AFTER_DRAIN) { E.fused(acc, cur, wr, wc, fr, fq, lds, wid, lane); S.done(cur); }
#undef PG8_SA
#undef PG8_SB
#undef PG8_STAGE
#undef PG8_LDA
#undef PG8_LDB
#undef PG8_MMA
#undef PG8_WAIT_V
#undef PG8_WAIT_L
#undef PG8_BAR
#undef PG8_SCHED
}
}

constexpr int DM = 1024, NB = 2, SEQ = 16384, CTXL = 256, RL = NB * SEQ, RC = NB * CTXL, RT = RL + RC;
constexpr int NKT = (SEQ + CTXL) / 64;
constexpr int KT_BYTES = 64 * 128, VT_BYTES = 64 * 128;
constexpr int NCH = 260, CSTF = 4160;
constexpr float EPS = 1e-6f;
constexpr float QSCALE = 0.10206207261596577f * 1.4426950408889634f;
constexpr int NPH_L = 13, NPHASES = 1 + 2 * NPH_L;


constexpr size_t MiB = 1u << 20;
constexpr size_t WS_CTL = 0, CTL_ZERO_BYTES = 64 * 1024;
constexpr size_t WS_WIN = 1 * MiB, WS_WUQ = 9 * MiB, WS_WUKV = 11 * MiB, WS_WOUT = 12 * MiB, WS_WPQ = 16 * MiB, WS_SUBK = 24 * MiB;
constexpr size_t WS_MOD = 25 * MiB, WS_ROPE = 25 * MiB + 256 * 1024, WS_SC = 25 * MiB + 512 * 1024, WS_MS = WS_SC + 64 * 1024;
constexpr size_t WS_CTXS = 26 * MiB, WS_G = 28 * MiB, WS_KR = 31 * MiB, WS_TABU = 34 * MiB, WS_TABV = 66 * MiB;
constexpr size_t WS_ZA = 98 * MiB, WS_ZB = 163 * MiB, WS_Q = WS_ZA, WS_PQ = WS_ZA;
constexpr size_t WS_XN = 228 * MiB, WS_QA = WS_XN, WS_KVA = 253 * MiB, WS_VT = WS_XN;
constexpr size_t WS_MIX = 293 * MiB, WS_R66 = 358 * MiB, WS_KVRAW = WS_R66, WS_CST = WS_R66, WS_EID = WS_R66, WS_GATE = WS_R66 + 17 * MiB;
constexpr size_t WS_KN = 425 * MiB, WS_Q8 = 458 * MiB, WS_MODP = 491 * MiB, WS_END = 493 * MiB;
static_assert(WS_QA + (size_t)RT * 384 * 2 <= WS_KVA && WS_KVA + (size_t)RT * 256 * 2 <= WS_MIX, "QA/KVA inside the XN region");
static_assert(WS_VT + (size_t)NB * 8 * NKT * VT_BYTES <= WS_MIX, "Vt inside the XN region");
static_assert(WS_CST + (size_t)16 * NCH * CSTF * 4 <= WS_KN && WS_KVRAW + (size_t)RT * 1024 * 2 <= WS_KN, "R66 region");
static_assert(WS_KN + (size_t)NB * 8 * NKT * KT_BYTES <= WS_Q8 && WS_Q8 + (size_t)RT * 1024 <= WS_MODP, "Kn / Q8 regions");
static_assert(WS_G + (size_t)RT * 16 * 4 <= WS_KR && WS_KR + (size_t)RT * 32 * 2 <= WS_TABU, "G/KR");
constexpr int CW_BAR = 1024;

constexpr int LDS_BYTES = 147456, MISC_OFF = 143360;

#define LAS __attribute__((address_space(3)))
typedef unsigned short bf16;
typedef short bf16x8 __attribute__((ext_vector_type(8)));
typedef float f32x4 __attribute__((ext_vector_type(4)));
typedef float f32x16 __attribute__((ext_vector_type(16)));
typedef unsigned u32x4 __attribute__((ext_vector_type(4)));
typedef unsigned u32x2 __attribute__((ext_vector_type(2)));
#define LDS_WAIT() asm volatile("s_waitcnt lgkmcnt(0)" ::: "memory")

typedef float f32x2_t __attribute__((ext_vector_type(2))); typedef __bf16 bf16x2_t __attribute__((ext_vector_type(2)));
__device__ __forceinline__ unsigned pk2(float lo, float hi) { f32x2_t v = {lo, hi}; bf16x2_t b = __builtin_convertvector(v, bf16x2_t); return __builtin_bit_cast(unsigned, b); }
__device__ __forceinline__ unsigned f2bf(float f) { return pk2(f, 0.f) & 0xffffu; }
__device__ __forceinline__ float bflo(unsigned w) { return __builtin_bit_cast(float, w << 16); }
__device__ __forceinline__ float bfhi(unsigned w) { return __builtin_bit_cast(float, w & 0xffff0000u); }
__device__ __forceinline__ float bf2f(bf16 v) { return __builtin_bit_cast(float, (unsigned)v << 16); }
__device__ __forceinline__ float shfl_idx(float v, int srclane) { return __builtin_bit_cast(float, __builtin_amdgcn_ds_bpermute(srclane << 2, __builtin_bit_cast(int, v))); }
__device__ __forceinline__ int shfl_idx(int v, int srclane) { return __builtin_amdgcn_ds_bpermute(srclane << 2, v); }
#define DPP_ADD(v, ctrl) (v) += __builtin_bit_cast(float, __builtin_amdgcn_update_dpp(0, __builtin_bit_cast(int, (v)), (ctrl), 0xf, 0xf, true))
__device__ __forceinline__ float wave_sum(float v, int lane) {
    (void)lane;
    DPP_ADD(v, 0xB1);
    DPP_ADD(v, 0x4E);
    DPP_ADD(v, 0x141);
    DPP_ADD(v, 0x140);
    const int b = __builtin_bit_cast(int, v);
    return (__builtin_bit_cast(float, __builtin_amdgcn_readlane(b, 0)) + __builtin_bit_cast(float, __builtin_amdgcn_readlane(b, 16))) +
           (__builtin_bit_cast(float, __builtin_amdgcn_readlane(b, 32)) + __builtin_bit_cast(float, __builtin_amdgcn_readlane(b, 48)));
}
__device__ __forceinline__ float wave_max(float v, int lane) {
#pragma unroll
    for (int o = 1; o < 64; o <<= 1) v = fmaxf(v, shfl_idx(v, lane ^ o));
    return v;
}
__device__ __forceinline__ int crow(int g, int hh) { return (g & 3) + 8 * (g >> 2) + 4 * hh; }
__device__ __forceinline__ bf16x8 pack8(float a0, float a1, float a2, float a3, float a4, float a5, float a6, float a7) {
    u32x4 w; w.x = pk2(a0, a1); w.y = pk2(a2, a3); w.z = pk2(a4, a5); w.w = pk2(a6, a7); return __builtin_bit_cast(bf16x8, w);
}
__device__ __forceinline__ float gelu_f(float v) {
    const float av = fabsf(v), d = av * 0.2316418882f + 1.0f; const float t = __builtin_amdgcn_rcpf(d);
    float q = t * 0.5307027145f + (-0.7265760135f); q = q * t + 0.7107068705f; q = q * t + (-0.142248368f); q = q * t + 0.127414796f; q = q * t;
    const float e = __builtin_amdgcn_exp2f(v * v * (-0.72134752044f));
    const float mm = v * (q * e); return v < 0.f ? mm : v - mm;
}
#define MFMA32(a, b, c) __builtin_amdgcn_mfma_f32_32x32x16_bf16((a), (b), (c), 0, 0, 0)
#define ML_ZERO16 (f32x16){0.f, 0.f, 0.f, 0.f, 0.f, 0.f, 0.f, 0.f, 0.f, 0.f, 0.f, 0.f, 0.f, 0.f, 0.f, 0.f}

#define XB_TMO      128
#define XB_XCNT(j)  (256  + 64 * (j))
#define XB_XSUB(j)  (1280 + 64 * (j))
#define XB_XGEN(j)  (2304 + 64 * (j))
#define XB_TOP      3328
#define XB_TOPGEN   3392
#define XCD_BAR_WORDS 3456
#define XB_SPIN_CAP (1u << 18)
__device__ __forceinline__ unsigned xb_ld(unsigned* p)              { return __hip_atomic_load(p, __ATOMIC_RELAXED, __HIP_MEMORY_SCOPE_AGENT); }
__device__ __forceinline__ unsigned xb_add(unsigned* p, unsigned v) { return __hip_atomic_fetch_add(p, v, __ATOMIC_RELAXED, __HIP_MEMORY_SCOPE_AGENT); }
__device__ __forceinline__ unsigned xb_xcc_id() { return (unsigned)__builtin_amdgcn_s_getreg((3 << 11) | 20) & 0xFu; }
#define XB_SPIN(cond, bar) do { unsigned _sp = 0; while (cond) { __builtin_amdgcn_s_sleep(1); \
    if ((++_sp & 255u) == 0u) { if (xb_ld(&(bar)[XB_TMO])) break; if (_sp > XB_SPIN_CAP) { atomicAdd(&(bar)[XB_TMO], 1u); break; } } } } while (0)
struct XcdBarrier { unsigned* bar; unsigned x; volatile LAS unsigned* st; };
__device__ __forceinline__ XcdBarrier xcd_barrier_post(unsigned* bar, volatile LAS unsigned* st) {
    XcdBarrier b; b.bar = bar; b.x = xb_xcc_id(); b.st = st;
    if (threadIdx.x == 0) (void)xb_add(&bar[XB_XCNT(b.x)], 1u);
    return b;
}
__device__ __forceinline__ void xcd_barrier_complete(unsigned* bar, unsigned x, unsigned& nloc, unsigned& nx) {
    const unsigned G = gridDim.x * gridDim.y * gridDim.z;
    unsigned sum, cnt, mine, sp = 0u;
    for (;;) {
        sum = 0u; cnt = 0u; mine = 0u;
#pragma unroll
        for (unsigned j = 0; j < 16; ++j) { const unsigned c = xb_ld(&bar[XB_XCNT(j)]); sum += c; cnt += (c > 0u) ? 1u : 0u; mine = (j == x) ? c : mine; }
        if (sum == G) break;
        __builtin_amdgcn_s_sleep(1);
        if ((++sp & 255u) == 0u) { if (xb_ld(&bar[XB_TMO])) break; if (sp > XB_SPIN_CAP) { atomicAdd(&bar[XB_TMO], 1u); break; } }
    }
    nloc = mine > 0u ? mine : 1u; nx = cnt > 0u ? cnt : 1u;
}
__device__ __forceinline__ void xcd_barrier(const XcdBarrier& b) {
    asm volatile("s_waitcnt vmcnt(0)" ::: "memory");
    __syncthreads();
    if (threadIdx.x == 0) {
        unsigned* bar = b.bar;
        __builtin_amdgcn_s_waitcnt(0);
        unsigned nloc = b.st[0], nx = b.st[1];
        if (nloc == 0u) { xcd_barrier_complete(bar, b.x, nloc, nx); b.st[0] = nloc; b.st[1] = nx; }
        const unsigned old = xb_add(&bar[XB_XSUB(b.x)], 1u);
        const unsigned gen = old / nloc;
        if (old + 1u == (gen + 1u) * nloc) {
            __builtin_amdgcn_fence(__ATOMIC_RELEASE, "agent");
            asm volatile("s_waitcnt vmcnt(0)" ::: "memory");
            const unsigned og = xb_add(&bar[XB_TOP], 1u);
            const unsigned tg = og / nx;
            if (og + 1u == (tg + 1u) * nx) xb_add(&bar[XB_TOPGEN], 1u);
            else XB_SPIN(xb_ld(&bar[XB_TOPGEN]) == tg, bar);
            __builtin_amdgcn_fence(__ATOMIC_ACQUIRE, "agent");
            xb_add(&bar[XB_XGEN(b.x)], 1u);
            asm volatile("s_waitcnt vmcnt(0)" ::: "memory");
        } else {
            XB_SPIN(xb_ld(&bar[XB_XGEN(b.x)]) == gen, bar);
            __builtin_amdgcn_fence(__ATOMIC_ACQUIRE, "agent");
            asm volatile("s_waitcnt vmcnt(0)" ::: "memory");
        }
    }
    __syncthreads();
}

struct Args { const float* in[24]; float* out; unsigned char* ws; int ph_lo, ph_hi; };
#define CAS __attribute__((address_space(4)))
typedef const CAS unsigned char* karg_t;
struct KA { karg_t p;
    __device__ __forceinline__ const float* in(int k) const { return *(const float* const CAS*)(p + 8 * k); }
    __device__ __forceinline__ float* out() const { return *(float* const CAS*)(p + 192); }
    __device__ __forceinline__ unsigned char* ws() const { return *(unsigned char* const CAS*)(p + 200); }
    __device__ __forceinline__ int ph_lo() const { return *(const int CAS*)(p + 208); }
    __device__ __forceinline__ int ph_hi() const { return *(const int CAS*)(p + 212); }
};
static_assert(sizeof(Args) == 216, "Args layout");
__device__ __forceinline__ KA ka_fresh() { KA a; a.p = (karg_t)__builtin_amdgcn_kernarg_segment_ptr(); asm volatile("" : "+s"(a.p)); return a; }
struct Ctx {
    LAS unsigned char* lds;
    int tid, lane, wave, G, bid;
};
__device__ __forceinline__ Ctx ctx_fresh() {
    extern __shared__ __attribute__((aligned(16))) unsigned char lds_raw[];
    Ctx C; C.lds = (LAS unsigned char*)lds_raw; int t = threadIdx.x; asm volatile("" : "+v"(t));
    C.tid = t; C.lane = t & 63; C.wave = __builtin_amdgcn_readfirstlane(t >> 6); C.G = gridDim.x; C.bid = blockIdx.x; return C;
}
__device__ __forceinline__ const float* stream_in(const KA& A, const Ctx& C, int l, int row) {
    if (row < RL) return (l == 0 ? A.in(0) : (const float*)A.out()) + (size_t)row * DM;
    return (l == 0 ? A.in(2) : (const float*)(A.ws() + WS_CTXS)) + (size_t)(row - RL) * DM;
}
__device__ __forceinline__ float* stream_out(const KA& A, const Ctx& C, int row) {
    if (row < RL) return A.out() + (size_t)row * DM;
    return (float*)(A.ws() + WS_CTXS) + (size_t)(row - RL) * DM;
}

__device__ __forceinline__ void p0_transpose_item(const float* W, int K, int N, bf16* WT, int n0, int dst_row0, LAS float* scr, int kb, int lane) {
    const int k0 = 64 * kb;
#pragma unroll 8
    for (int i = 0; i < 32; ++i) { const int kk = 2 * i + (lane >> 5); const int n = n0 + (lane & 31); scr[kk * 33 + (lane & 31)] = (n < N) ? W[(size_t)(k0 + kk) * N + n] : 0.f; }
    LDS_WAIT(); asm volatile("" ::: "memory");
    const int c = lane & 7;
#pragma unroll
    for (int j = 0; j < 4; ++j) { const int n = (lane >> 3) + 8 * j; const LAS float* s = scr + (8 * c) * 33 + n;
        u32x4 o; o.x = pk2(s[0 * 33], s[1 * 33]); o.y = pk2(s[2 * 33], s[3 * 33]); o.z = pk2(s[4 * 33], s[5 * 33]); o.w = pk2(s[6 * 33], s[7 * 33]);
        *(u32x4*)(WT + (size_t)(dst_row0 + n) * K + k0 + 8 * c) = o; }
    LDS_WAIT(); asm volatile("" ::: "memory");
}
__device__ __forceinline__ void p0_poolw_item(const float* Win, const float* Wp, bf16* WT, LAS float* scr, int kb, int nb, int lane) {
    const int k0 = 64 * kb, g = nb >> 1, e = (nb & 1) * 32 + (lane & 31);
    float wc[64];
#pragma unroll
    for (int c = 0; c < 64; ++c) wc[c] = Wp[((size_t)g * 64 + c) * 64 + e];
#pragma unroll 2
    for (int i = 0; i < 32; ++i) { const int kk = 2 * i + (lane >> 5); const float* wr = Win + (size_t)(k0 + kk) * 1968 + g * 64; float a = 0.f;
#pragma unroll
        for (int c4 = 0; c4 < 16; ++c4) { const f32x4 x = *(const f32x4*)(wr + 4 * c4); a += x.x * wc[4 * c4] + x.y * wc[4 * c4 + 1] + x.z * wc[4 * c4 + 2] + x.w * wc[4 * c4 + 3]; }
        scr[kk * 33 + (lane & 31)] = a; }
    LDS_WAIT(); asm volatile("" ::: "memory");
    const int c = lane & 7;
#pragma unroll
    for (int j = 0; j < 4; ++j) { const int n = (lane >> 3) + 8 * j; const LAS float* sp = scr + (8 * c) * 33 + n;
        u32x4 o; o.x = pk2(sp[0 * 33], sp[1 * 33]); o.y = pk2(sp[2 * 33], sp[3 * 33]); o.z = pk2(sp[4 * 33], sp[5 * 33]); o.w = pk2(sp[6 * 33], sp[7 * 33]);
        *(u32x4*)(WT + (size_t)(32 * nb + n) * DM + k0 + 8 * c) = o; }
    LDS_WAIT(); asm volatile("" ::: "memory");
}
__device__ __forceinline__ void phase_prologue() {
    const KA A = ka_fresh(); const Ctx C = ctx_fresh();
    LAS float* scr = (LAS float*)(C.lds + C.wave * 16384);
    const int gw = C.bid * 8 + C.wave, NGW = C.G * 8, lane = C.lane;
    float* MODP = (float*)(A.ws() + WS_MODP);
    for (int it = gw; it < 2 * 96 * 8; it += NGW) {
        const int ks = it & 7, l = (it >> 3) / 96, j = ((it >> 3) % 96) * 64 + lane;
        const float* W = A.in(6) + ((size_t)l * DM + ks * 128) * 6144 + j;
        const float* c01 = A.in(1) + ks * 128; const float* c2p = A.in(3) + ks * 128;
        float a0 = 0.f, a1 = 0.f, a2 = 0.f;
#pragma unroll 16
        for (int k = 0; k < 128; ++k) {
            const float w = W[(size_t)k * 6144];
            const float c0 = c01[k], c1 = c01[DM + k], c2 = c2p[k];
            a0 += (c0 / (1.f + __expf(-c0))) * w; a1 += (c1 / (1.f + __expf(-c1))) * w; a2 += (c2 / (1.f + __expf(-c2))) * w;
        }
        float* mp = MODP + ((size_t)(l * 8 + ks) * 3) * 6144 + j;
        mp[0] = a0; mp[6144] = a1; mp[2 * 6144] = a2;
    }
    constexpr int I_IN = 16 * 64, I_UQ = 6 * 24, I_UKV = 4 * 32, I_OUT = 16 * 32, I_PQ = 16 * 64, I_L = I_IN + I_UQ + I_UKV + I_OUT + I_PQ;
    for (int it = gw; it < 2 * I_L; it += NGW) {
        const int l = it / I_L; int r = it % I_L;
        if (r < I_IN) {
            const int kb = r / 64, nb = r % 64;
            if (nb < 8) { p0_poolw_item(A.in(8) + (size_t)l * DM * 1968, A.in(9) + (size_t)l * 4 * 64 * 64, (bf16*)(A.ws() + WS_WIN) + (size_t)l * 2048 * DM, scr, kb, nb, lane); continue; }
            const int dst = nb < 29 ? 32 * nb : (nb < 61 ? 96 + 32 * nb : (nb == 61 ? 928 : (nb == 62 ? 960 : 992)));
            const int n0 = nb < 62 ? 32 * nb : 4096;
            p0_transpose_item(A.in(8) + (size_t)l * DM * 1968, DM, 1968, (bf16*)(A.ws() + WS_WIN) + (size_t)l * 2048 * DM, n0, dst, scr, kb, lane); continue; }
        r -= I_IN;
        if (r < I_UQ) { const int kb = r / 24, nb = r % 24; p0_transpose_item(A.in(13) + (size_t)l * 384 * 768, 384, 768, (bf16*)(A.ws() + WS_WUQ) + (size_t)l * 768 * 384, 32 * nb, 32 * nb, scr, kb, lane); continue; }
        r -= I_UQ;
        if (r < I_UKV) { const int kb = r / 32, nb = r % 32; p0_transpose_item(A.in(14) + (size_t)l * 256 * 1024, 256, 1024, (bf16*)(A.ws() + WS_WUKV) + (size_t)l * 1024 * 256, 32 * nb, 32 * nb, scr, kb, lane); continue; }
        r -= I_UKV;
        if (r < I_OUT) { const int kb = r / 32, nb = r % 32; p0_transpose_item(A.in(19) + (size_t)l * DM * DM, DM, DM, (bf16*)(A.ws() + WS_WOUT) + (size_t)l * DM * DM, 32 * nb, 32 * nb, scr, kb, lane); continue; }
        r -= I_OUT;
        { const int kb = r / 64, nb = r % 64; p0_transpose_item(A.in(20) + (size_t)l * DM * 2048, DM, 2048, (bf16*)(A.ws() + WS_WPQ) + (size_t)l * 2048 * DM, 32 * nb, 32 * nb, scr, kb, lane); }
    }
    const int gt = C.bid * 512 + C.tid, NT = C.G * 512;
    { const float* s = A.in(21); bf16* d = (bf16*)(A.ws() + WS_SUBK);
      for (int i = gt; i < 2 * 8 * 2 * 128 * 128 / 4; i += NT) { const f32x4 v = *(const f32x4*)(s + 4 * (size_t)i); u32x2 o; o.x = pk2(v.x, v.y); o.y = pk2(v.z, v.w); *(u32x2*)(d + 4 * (size_t)i) = o; } }
    { float* rp = (float*)(A.ws() + WS_ROPE);
      for (int i = gt; i < 256 * 8; i += NT) { const int p = i >> 3, f = i & 7;
          const float fr[8] = {1.0f, 0.31622776601683794f, 0.1f, 0.031622776601683794f, 0.01f, 0.0031622776601683794f, 0.001f, 0.00031622776601683794f};
          float fq = fr[0];
#pragma unroll
          for (int q = 1; q < 8; ++q) fq = (f == q) ? fr[q] : fq;
          const float ang = (float)p * fq;
          const double rev = (double)ang * 0.15915494309189535; const float fracr = (float)(rev - floor(rev));
          rp[2 * i] = __builtin_amdgcn_cosf(fracr); rp[2 * i + 1] = __builtin_amdgcn_sinf(fracr); } }
}

__device__ __forceinline__ void phase_modreduce() {
    const KA A = ka_fresh(); const Ctx C = ctx_fresh();
    const int gt = C.bid * 512 + C.tid, NT = C.G * 512;
    const float* MODP = (const float*)(A.ws() + WS_MODP); float* MOD = (float*)(A.ws() + WS_MOD);
    for (int i = gt; i < 2 * 3 * 6144; i += NT) { const int l = i / (3 * 6144), rem = i % (3 * 6144), j = rem % 6144;
        float a = A.in(7)[l * 6144 + j];
#pragma unroll
        for (int ks = 0; ks < 8; ++ks) a += MODP[((size_t)(l * 8 + ks) * 3) * 6144 + rem];
        MOD[i] = a; }
}
__device__ __forceinline__ void phase_norm(int l, int which) {
    const KA A = ka_fresh(); const Ctx C = ctx_fresh();
    const int gw = C.bid * 8 + C.wave, NGW = C.G * 8, lane = C.lane;
    const float* gain = A.in(which ? 5 : 4) + l * DM;
    const float* MOD = (const float*)(A.ws() + WS_MOD);
    bf16* XN = (bf16*)(A.ws() + WS_XN);
    const int nrows = (which == 1 && l == 1) ? RL : RT;
    for (int row = gw; row < nrows; row += NGW) {
        const float* xr = (which == 0) ? stream_in(A, C, l, row) : (const float*)stream_out(A, C, row);
        const int nsel = row < RL ? (row >> 14) : 2;
        const float* md = MOD + (l * 3 + nsel) * 6144 + which * 3072;
        f32x4 v[4]; float ss = 0.f;
#pragma unroll
        for (int i = 0; i < 4; ++i) { v[i] = *(const f32x4*)(xr + 4 * lane + 256 * i); ss += (v[i].x * v[i].x + v[i].y * v[i].y) + (v[i].z * v[i].z + v[i].w * v[i].w); }
        const float rs = 1.0f / sqrtf(wave_sum(ss, lane) * (1.f / DM) + EPS);
#pragma unroll
        for (int i = 0; i < 4; ++i) { const int j = 4 * lane + 256 * i;
            const f32x4 g = *(const f32x4*)(gain + j), sh = *(const f32x4*)(md + j), sc = *(const f32x4*)(md + 1024 + j);
            const f32x4 y = v[i] * rs * g * (sc + 1.0f) + sh;
            u32x2 o; o.x = pk2(y.x, y.y); o.y = pk2(y.z, y.w); *(u32x2*)(XN + (size_t)row * DM + j) = o; }
    }
}
constexpr float U_SCALE = 48.f, V_SCALE = 1.5f;
constexpr int TROW = 768;
struct __attribute__((packed, aligned(4))) U3 { unsigned a, b, c; };
__device__ __forceinline__ unsigned q_e2m3(float x) {
    const unsigned sg = (__builtin_bit_cast(unsigned, x) >> 31) << 5;
    const float a = fminf(fabsf(x), 7.5f);
    const float t = a * (a < 2.f ? 8.f : (a < 4.f ? 4.f : 2.f));
    return sg | ((unsigned)__builtin_rintf(t) + (a < 2.f ? 0u : (a < 4.f ? 8u : 16u)));
}
__device__ __forceinline__ void phase_tables(int l) {
    const KA A = ka_fresh(); const Ctx C = ctx_fresh();
    const size_t gt = (size_t)C.bid * 512 + C.tid, NT = (size_t)C.G * 512;
    const size_t n16 = (size_t)16384 * 1024 / 16;
#pragma unroll
    for (int w = 0; w < 2; ++w) {
        const float* s = A.in(22 + w) + (size_t)l * 16384 * 1024; unsigned char* d = A.ws() + (w ? WS_TABV : WS_TABU);
        const float sc = w ? V_SCALE : U_SCALE;
        for (size_t i = gt; i < n16; i += NT) {
            unsigned c[16];
#pragma unroll
            for (int q = 0; q < 4; ++q) { const f32x4 x = *(const f32x4*)(s + 16 * i + 4 * q);
                c[4 * q] = q_e2m3(x.x * sc); c[4 * q + 1] = q_e2m3(x.y * sc); c[4 * q + 2] = q_e2m3(x.z * sc); c[4 * q + 3] = q_e2m3(x.w * sc); }
            U3 o;
            o.a = c[0] | (c[1] << 6) | (c[2] << 12) | (c[3] << 18) | (c[4] << 24) | (c[5] << 30);
            o.b = (c[5] >> 2) | (c[6] << 4) | (c[7] << 10) | (c[8] << 16) | (c[9] << 22) | (c[10] << 28);
            o.c = (c[10] >> 4) | (c[11] << 2) | (c[12] << 8) | (c[13] << 14) | (c[14] << 20) | (c[15] << 26);
            *(U3*)(d + 12 * i) = o; }
    }
}

__device__ __forceinline__ void phase_post(int l) {
    const KA A = ka_fresh(); const Ctx C = ctx_fresh();
    const bf16* ZA = (const bf16*)(A.ws() + WS_ZA);
    bf16* MIX = (bf16*)(A.ws() + WS_MIX); bf16* QA = (bf16*)(A.ws() + WS_QA); bf16* KVA = (bf16*)(A.ws() + WS_KVA); bf16* KR = (bf16*)(A.ws() + WS_KR);
    float* GT = (float*)(A.ws() + WS_G);
    LAS float* U = (LAS float*)C.lds;
    const int tid = C.tid, lane = C.lane;
    for (int unit = C.bid; unit < RT / 32; unit += C.G) {
        const int r0 = unit * 32;
        int seq0, L;
        if (r0 < RL) { seq0 = (r0 >> 14) << 14; L = SEQ; } else { seq0 = RL + (((r0 - RL) >> 8) << 8); L = CTXL; }
        const int t0 = r0 - seq0;
        for (int idx = tid; idx < 48 * 32; idx += 512) { const int rr = idx >> 5, c8 = idx & 31; const int t = t0 - 8 + rr;
            u32x4 v = {0u, 0u, 0u, 0u};
            if (t >= 0 && t < L) v = *(const u32x4*)(ZA + (size_t)(seq0 + t) * 1024 + c8 * 8);
            LAS float* d = U + rr * 256 + c8 * 8;
            d[0] = bflo(v.x); d[1] = bfhi(v.x); d[2] = bflo(v.y); d[3] = bfhi(v.y); d[4] = bflo(v.z); d[5] = bfhi(v.z); d[6] = bflo(v.w); d[7] = bfhi(v.w); }
        __syncthreads();
        { const int ch = tid & 255, half = tid >> 8, hw = __builtin_amdgcn_readfirstlane(1 << (ch >> 6));
          const float sc = A.in(10)[l * 256 + ch];
          for (int i = half * 16; i < half * 16 + 16; ++i) { const int t = t0 + i; const int lo = max(t - hw, 0), hi = min(t + hw, L);
              float sm = 0.f; for (int tt = lo; tt < hi; ++tt) sm += U[(tt - t0 + 8) * 256 + ch];
              const float dv = sm / (float)(hi - lo) - U[(i + 8) * 256 + ch];
              MIX[(size_t)(r0 + i) * 1024 + ch] = (bf16)f2bf(dv * sc); } }
#pragma unroll
        for (int q = 0; q < 4; ++q) { const int row = r0 + C.wave * 4 + q; const bf16* za = ZA + (size_t)row * 1024;
            { float x[6]; float ss = 0.f;
#pragma unroll
              for (int i = 0; i < 3; ++i) { const unsigned w = *(const unsigned*)(za + 256 + 2 * lane + 128 * i); x[2 * i] = bflo(w); x[2 * i + 1] = bfhi(w); ss += x[2 * i] * x[2 * i] + x[2 * i + 1] * x[2 * i + 1]; }
              const float rs = 1.0f / sqrtf(wave_sum(ss, lane) * (1.f / 384.f) + EPS); const float* gq = A.in(11) + l * 384;
#pragma unroll
              for (int i = 0; i < 3; ++i) { const int j = 2 * lane + 128 * i; *(unsigned*)(QA + (size_t)row * 384 + j) = pk2(x[2 * i] * rs * gq[j], x[2 * i + 1] * rs * gq[j + 1]); } }
            { const u32x2 w = *(const u32x2*)(za + 640 + 4 * lane);
              const float x0 = bflo(w.x), x1 = bfhi(w.x), x2 = bflo(w.y), x3 = bfhi(w.y);
              const float rs = 1.0f / sqrtf(wave_sum(x0 * x0 + x1 * x1 + x2 * x2 + x3 * x3, lane) * (1.f / 256.f) + EPS); const float* gk = A.in(12) + l * 256 + 4 * lane;
              u32x2 o; o.x = pk2(x0 * rs * gk[0], x1 * rs * gk[1]); o.y = pk2(x2 * rs * gk[2], x3 * rs * gk[3]); *(u32x2*)(KVA + (size_t)row * 256 + 4 * lane) = o; }
            if (lane < 16) *(unsigned*)(KR + (size_t)row * 32 + 2 * lane) = *(const unsigned*)(za + 896 + 2 * lane);
            if (lane < 16) { float gv = bf2f(za[928 + lane]) + A.in(17)[l * 16 + lane];
                if ((lane >> 2) & 1) gv = fminf(gv, 0.f) - log1pf(__expf(-fabsf(gv)));
                GT[(size_t)row * 16 + lane] = gv; }
        }
        __syncthreads();
    }
}

__device__ __forceinline__ unsigned fp8x4(float a, float b, float c, float d) {
    a = __builtin_amdgcn_fmed3f(a, -448.f, 448.f); b = __builtin_amdgcn_fmed3f(b, -448.f, 448.f); c = __builtin_amdgcn_fmed3f(c, -448.f, 448.f); d = __builtin_amdgcn_fmed3f(d, -448.f, 448.f);
    int w = __builtin_amdgcn_cvt_pk_fp8_f32(a, b, 0, false); w = __builtin_amdgcn_cvt_pk_fp8_f32(c, d, w, true); return (unsigned)w;
}
__device__ __forceinline__ void qk_head(const bf16* src_lo, const bf16* src_hi, unsigned char* dst, int sw, const float* gn, bool rot, const float (&cs)[16], const float (&sn)[16], float oscale) {
    float ss = 0.f;
#pragma unroll 4
    for (int i = 0; i < 8; ++i) { const u32x4 w = *(const u32x4*)(src_lo + 8 * i);
        ss += (bflo(w.x) * bflo(w.x) + bfhi(w.x) * bfhi(w.x)) + (bflo(w.y) * bflo(w.y) + bfhi(w.y) * bfhi(w.y)) + (bflo(w.z) * bflo(w.z) + bfhi(w.z) * bfhi(w.z)) + (bflo(w.w) * bflo(w.w) + bfhi(w.w) * bfhi(w.w)); }
    u32x4 wr[4];
#pragma unroll
    for (int i = 0; i < 4; ++i) { wr[i] = *(const u32x4*)(src_hi + 8 * i); const u32x4 w = wr[i];
        ss += (bflo(w.x) * bflo(w.x) + bfhi(w.x) * bfhi(w.x)) + (bflo(w.y) * bflo(w.y) + bfhi(w.y) * bfhi(w.y)) + (bflo(w.z) * bflo(w.z) + bfhi(w.z) * bfhi(w.z)) + (bflo(w.w) * bflo(w.w) + bfhi(w.w) * bfhi(w.w)); }
    const float rs = oscale / sqrtf(ss * (1.f / 96.f) + EPS);
    __builtin_amdgcn_sched_barrier(0);
#pragma unroll 1
    for (int i = 0; i < 8; ++i) {
        const u32x4 w = *(const u32x4*)(src_lo + 8 * i); const f32x4 g0 = *(const f32x4*)(gn + 8 * i), g1 = *(const f32x4*)(gn + 8 * i + 4);
        u32x2 o; o.x = fp8x4(bflo(w.x) * rs * g0.x, bfhi(w.x) * rs * g0.y, bflo(w.y) * rs * g0.z, bfhi(w.y) * rs * g0.w);
        o.y = fp8x4(bflo(w.z) * rs * g1.x, bfhi(w.z) * rs * g1.y, bflo(w.w) * rs * g1.z, bfhi(w.w) * rs * g1.w);
        *(u32x2*)(dst + ((((i >> 1) ^ sw) << 4) + ((i & 1) << 3))) = o; }
    __builtin_amdgcn_sched_barrier(0);
#pragma unroll
    for (int i = 0; i < 2; ++i) {
        const u32x4 p = wr[i], q = wr[2 + i];
        const f32x4 ga = *(const f32x4*)(gn + 64 + 8 * i), gb = *(const f32x4*)(gn + 64 + 8 * i + 4), gc = *(const f32x4*)(gn + 80 + 8 * i), gd = *(const f32x4*)(gn + 80 + 8 * i + 4);
        float y1[8], y2[8];
        y1[0] = bflo(p.x) * rs * ga.x; y1[1] = bfhi(p.x) * rs * ga.y; y1[2] = bflo(p.y) * rs * ga.z; y1[3] = bfhi(p.y) * rs * ga.w; y1[4] = bflo(p.z) * rs * gb.x; y1[5] = bfhi(p.z) * rs * gb.y; y1[6] = bflo(p.w) * rs * gb.z; y1[7] = bfhi(p.w) * rs * gb.w;
        y2[0] = bflo(q.x) * rs * gc.x; y2[1] = bfhi(q.x) * rs * gc.y; y2[2] = bflo(q.y) * rs * gc.z; y2[3] = bfhi(q.y) * rs * gc.w; y2[4] = bflo(q.z) * rs * gd.x; y2[5] = bfhi(q.z) * rs * gd.y; y2[6] = bflo(q.w) * rs * gd.z; y2[7] = bfhi(q.w) * rs * gd.w;
        if (rot) {
#pragma unroll
            for (int j = 0; j < 8; ++j) { const float a = y1[j] * cs[8 * i + j] - y2[j] * sn[8 * i + j], bb = y2[j] * cs[8 * i + j] + y1[j] * sn[8 * i + j]; y1[j] = a; y2[j] = bb; }
        }
        u32x2 o; o.x = fp8x4(y1[0], y1[1], y1[2], y1[3]); o.y = fp8x4(y1[4], y1[5], y1[6], y1[7]); *(u32x2*)(dst + (((4 ^ sw) << 4) + (i << 3))) = o;
        u32x2 o2; o2.x = fp8x4(y2[0], y2[1], y2[2], y2[3]); o2.y = fp8x4(y2[4], y2[5], y2[6], y2[7]); *(u32x2*)(dst + (((5 ^ sw) << 4) + (i << 3))) = o2;
    }
    { u32x4 z; z.x = 0u; z.y = 0u; z.z = 0u; z.w = 0u; *(u32x4*)(dst + ((6 ^ sw) << 4)) = z; *(u32x4*)(dst + ((7 ^ sw) << 4)) = z; }
    __builtin_amdgcn_sched_barrier(0);
}
__device__ __forceinline__ void phase_qknorm(int l) {
    const KA A = ka_fresh(); const Ctx C = ctx_fresh();
    const int gw = C.bid * 8 + C.wave, NGW = C.G * 8, lane = C.lane;
    const bf16* Q = (const bf16*)(A.ws() + WS_Q); const bf16* KV = (const bf16*)(A.ws() + WS_KVRAW); const bf16* KR = (const bf16*)(A.ws() + WS_KR);
    unsigned char* KN = A.ws() + WS_KN; unsigned char* VT = A.ws() + WS_VT;
    const float* rope = (const float*)(A.ws() + WS_ROPE);
    const float* qg = A.in(15) + l * 96; const float* kg = A.in(16) + l * 96;
    for (int u = gw; u < (RT / 64) * 8; u += NGW) {
        const int h = u & 7, tl = u >> 3, row0 = tl * 64, row = row0 + lane;
        const bool lat = row0 < RL; int b, t0;
        if (lat) { b = row0 >> 14; t0 = row0 & (SEQ - 1); } else { b = (row0 - RL) >> 8; t0 = (row0 - RL) & 255; }
        const int ktile = lat ? (t0 >> 6) : (SEQ + t0) >> 6;
        float cs[16], sn[16];
#pragma unroll
        for (int i = 0; i < 16; ++i) { cs[i] = 1.f; sn[i] = 0.f; }
        if (lat) {
#pragma unroll
            for (int i = 0; i < 16; ++i) { const int p = (i < 8) ? (t0 >> 6) : lane; const float* rp = rope + (p * 8 + (i & 7)) * 2; cs[i] = rp[0]; sn[i] = rp[1]; }
        }
        { const bf16* qp = Q + (size_t)row * 768 + h * 96;
          qk_head(qp, qp + 64, A.ws() + WS_Q8 + (size_t)row * 1024 + h * 128, 0, qg, lat, cs, sn, QSCALE); }
        const bf16* kvp = KV + (size_t)row * 1024 + h * 128;
        qk_head(kvp, KR + (size_t)row * 32, KN + ((size_t)(b * 8 + h) * NKT + ktile) * KT_BYTES + lane * 128, (lane >> 1) & 7, kg, lat, cs, sn, 1.0f);
        { const int kap = lane & 15; const int pos = (lane & ~15) + 8 * ((kap >> 2) & 1) + 4 * (kap >> 3) + (kap & 3);
          bf16* vd = (bf16*)(VT + ((size_t)(b * 8 + h) * NKT + ktile) * VT_BYTES);
          const int pa = pos >> 3, pb = pos & 7;
#pragma unroll 1
          for (int i = 0; i < 8; ++i) { const u32x4 vv = *(const u32x4*)(kvp + 64 + 8 * i);
#pragma unroll
              for (int e = 0; e < 8; ++e) { const int d = 8 * i + e; const unsigned wd = (e >> 1) == 0 ? vv.x : ((e >> 1) == 1 ? vv.y : ((e >> 1) == 2 ? vv.z : vv.w)); const bf16 val = (bf16)((e & 1) ? (wd >> 16) : (wd & 0xffffu));
                  vd[(unsigned)(d * 64 + ((pa ^ ((d >> 1) & 7)) << 3) + pb)] = val; } } }
    }
}

__device__ __forceinline__ int ml_row(int b, int dir, int j, int s) {
    if (j < 4) { const int p = 64 * j + s; return RL + b * CTXL + (dir ? CTXL - 1 - p : p); }
    const int p = 64 * (j - 4) + s; return b * SEQ + (dir ? SEQ - 1 - p : p);
}
__device__ __forceinline__ void phase_ml_local() {
    const KA A = ka_fresh(); const Ctx C = ctx_fresh();
    const int gw = C.bid * 8 + C.wave, NGW = C.G * 8, lane = C.lane, r = lane & 31, hh = lane >> 5;
    const bf16* ZB = (const bf16*)(A.ws() + WS_ZB); const float* GT = (const float*)(A.ws() + WS_G);
    float* CST = (float*)(A.ws() + WS_CST); float* SC = (float*)(A.ws() + WS_SC);
    for (int u = gw; u < 16 * NCH; u += NGW) {
        const int sq = u / NCH, j = u % NCH, b = sq >> 3, h = (sq >> 1) & 3, dir = sq & 1;
        const int rowl = ml_row(b, dir, j, lane);
        const float gi = GT[(size_t)rowl * 16 + dir * 8 + h], lf = GT[(size_t)rowl * 16 + dir * 8 + 4 + h];
        float bs = lf;
#pragma unroll
        for (int o = 1; o < 64; o <<= 1) { const float tv = shfl_idx(bs, lane - o); if (lane >= o) bs += tv; }
        const float blast = shfl_idx(bs, 63);
        const float dec = blast + gi - bs;
        const float mloc = wave_max(dec, lane);
        const float w = __expf(dec - mloc);
        const int row0 = ml_row(b, dir, j, 0), rstep = dir ? -1 : 1;
        f32x16 acc[2][2];
#pragma unroll
        for (int vb = 0; vb < 2; ++vb)
#pragma unroll
            for (int db = 0; db < 2; ++db) acc[vb][db] = ML_ZERO16;
        float nacc0 = 0.f, nacc1 = 0.f;
#pragma unroll
        for (int st = 0; st < 4; ++st) {
            float ws[8]; unsigned rofs[8];
#pragma unroll
            for (int jj = 0; jj < 8; ++jj) { const int sidx = 16 * st + 8 * hh + jj; ws[jj] = shfl_idx(w, sidx); rofs[jj] = (unsigned)((row0 + rstep * sidx) * 1024 + h * 64 + r); }
            bf16x8 Af[2], Bf[2];
#pragma unroll
            for (int blk = 0; blk < 2; ++blk) {
                float kx[8];
#pragma unroll
                for (int jj = 0; jj < 8; ++jj) { kx[jj] = bf2f(ZB[rofs[jj] + 256 + 32 * blk]); Bf[blk][jj] = (short)ZB[rofs[jj] + 256 + 32 * blk]; }
                if (blk == 0) {
#pragma unroll
                    for (int jj = 0; jj < 8; ++jj) nacc0 += ws[jj] * kx[jj]; }
                else {
#pragma unroll
                    for (int jj = 0; jj < 8; ++jj) nacc1 += ws[jj] * kx[jj]; }
                float vx[8];
#pragma unroll
                for (int jj = 0; jj < 8; ++jj) vx[jj] = bf2f(ZB[rofs[jj] + 512 + 32 * blk]) * ws[jj];
                Af[blk] = pack8(vx[0], vx[1], vx[2], vx[3], vx[4], vx[5], vx[6], vx[7]);
            }
#pragma unroll
            for (int vb = 0; vb < 2; ++vb)
#pragma unroll
                for (int db = 0; db < 2; ++db) acc[vb][db] = MFMA32(Af[vb], Bf[db], acc[vb][db]);
            __builtin_amdgcn_sched_barrier(0);
        }
        float* cp = CST + (size_t)u * CSTF;
#pragma unroll
        for (int vb = 0; vb < 2; ++vb)
#pragma unroll
            for (int db = 0; db < 2; ++db)
#pragma unroll
                for (int g = 0; g < 16; ++g) cp[(32 * vb + crow(g, hh)) * 64 + 32 * db + r] = acc[vb][db][g];
        nacc0 += shfl_idx(nacc0, lane ^ 32); nacc1 += shfl_idx(nacc1, lane ^ 32);
        if (hh == 0) { cp[4096 + r] = nacc0; cp[4096 + 32 + r] = nacc1; }
        if (lane == 0) { SC[u * 2] = mloc; SC[u * 2 + 1] = blast; }
    }
}
__device__ __forceinline__ void phase_ml_scan() {
    const KA A = ka_fresh(); const Ctx C = ctx_fresh();
    const int gt = C.bid * 512 + C.tid, NT = C.G * 512;
    float* CST = (float*)(A.ws() + WS_CST); const float* SC = (const float*)(A.ws() + WS_SC); float* MS = (float*)(A.ws() + WS_MS);
    for (int e = gt; e < 16 * CSTF; e += NT) {
        const int sq = e / CSTF, el = e % CSTF;
        float* base = CST + (size_t)sq * NCH * CSTF + el;
        float cv = 0.f, m = -1e30f;
#pragma unroll 1
        for (int j0 = 0; j0 < NCH; j0 += 10) {
            float loc[10]; f32x2_t sc[10];
#pragma unroll
            for (int u = 0; u < 10; ++u) { loc[u] = base[(size_t)(j0 + u) * CSTF]; sc[u] = *(const f32x2_t*)(SC + (sq * NCH + j0 + u) * 2); }
#pragma unroll
            for (int u = 0; u < 10; ++u) {
                base[(size_t)(j0 + u) * CSTF] = cv;
                if (el == 0) MS[sq * NCH + j0 + u] = m;
                const float mn = fmaxf(sc[u].y + m, sc[u].x);
                cv = __expf(sc[u].y + m - mn) * cv + __expf(sc[u].x - mn) * loc[u]; m = mn;
            }
        }
    }
}
template <int DIR>
__device__ __forceinline__ void ml_sblock(f32x16& S, float& den, const bf16* ZB, const bf16x8 (&Qf)[4], int sb, int base_row, int h, int r, int hh, int jl, float a, float Mj) {
    S = ML_ZERO16;
    const int sr = 32 * sb + r; const int rows = base_row + (DIR ? 63 - sr : sr);
#pragma unroll
    for (int st = 0; st < 4; ++st) { const bf16x8 Kf = *(const bf16x8*)(ZB + (unsigned)(rows * 1024 + 256 + h * 64 + st * 16 + hh * 8)); S = MFMA32(Kf, Qf[st], S); }
#pragma unroll
    for (int g = 0; g < 16; ++g) { const int s = 32 * sb + crow(g, hh); const float as = shfl_idx(a, s);
        const float p = (s <= jl) ? S[g] * 0.125f * __expf(as - Mj) : 0.f; S[g] = p; den += p; }
}
template <int DIR>
__device__ __forceinline__ void ml_pv(f32x16& O, const f32x16& S, const bf16* ZB, int sb, int base_row, int h, int v, int hh) {
#pragma unroll
    for (int st2 = 0; st2 < 2; ++st2) {
        bf16x8 VA;
#pragma unroll
        for (int jj = 0; jj < 8; ++jj) { const int s = 32 * sb + 16 * st2 + 8 * (jj >> 2) + 4 * hh + (jj & 3); const int rows = base_row + (DIR ? 63 - s : s);
            VA[jj] = (short)ZB[(unsigned)(rows * 1024 + 512 + h * 64 + v)]; }
        const bf16x8 PB = pack8(S[8 * st2 + 0], S[8 * st2 + 1], S[8 * st2 + 2], S[8 * st2 + 3], S[8 * st2 + 4], S[8 * st2 + 5], S[8 * st2 + 6], S[8 * st2 + 7]);
        O = MFMA32(VA, PB, O);
        __builtin_amdgcn_sched_barrier(0);
    }
}
template <int DIR>
__device__ __forceinline__ void ml_out_dir(const KA& A, const Ctx& C, LAS float* H, int b, int h, int c, int base_row, int lane) {
    const bf16* ZB = (const bf16*)(A.ws() + WS_ZB); const float* GT = (const float*)(A.ws() + WS_G);
    const float* CST = (const float*)(A.ws() + WS_CST); const float* MS = (const float*)(A.ws() + WS_MS);
    const int r = lane & 31, hh = lane >> 5;
    const int j = DIR ? (c < 4 ? 3 - c : 263 - c) : c;
    const int sq = (b * 4 + h) * 2 + DIR;
    const float* Cp = CST + ((size_t)sq * NCH + j) * CSTF;
    const float m0 = MS[sq * NCH + j];
    const int rowl = base_row + (DIR ? 63 - lane : lane);
    const float gi = GT[(size_t)rowl * 16 + DIR * 8 + h], lf = GT[(size_t)rowl * 16 + DIR * 8 + 4 + h];
    float bs = lf;
#pragma unroll
    for (int o = 1; o < 64; o <<= 1) { const float tv = shfl_idx(bs, lane - o); if (lane >= o) bs += tv; }
    const float a = gi - bs;
    float pm = a;
#pragma unroll
    for (int o = 1; o < 64; o <<= 1) { const float tv = shfl_idx(pm, lane - o); if (lane >= o) pm = fmaxf(pm, tv); }
#pragma unroll 1
    for (int jb = 0; jb < 2; ++jb) {
        const int jl = 32 * jb + r;
        const float bj = shfl_idx(bs, jl), Mj = fmaxf(m0, shfl_idx(pm, jl));
        const int rowj = base_row + (DIR ? 63 - jl : jl);
        const int tok = DIR ? 63 - jl : jl;
        bf16x8 Qf[4];
#pragma unroll
        for (int st = 0; st < 4; ++st) Qf[st] = *(const bf16x8*)(ZB + (unsigned)(rowj * 1024 + h * 64 + st * 16 + hh * 8));
        f32x16 S0, S1 = ML_ZERO16; float den = 0.f;
        ml_sblock<DIR>(S0, den, ZB, Qf, 0, base_row, h, r, hh, jl, a, Mj);
        if (jb == 1) ml_sblock<DIR>(S1, den, ZB, Qf, 1, base_row, h, r, hh, jl, a, Mj);
        den += shfl_idx(den, lane ^ 32);
        const float wi = __expf(m0 - Mj) * 0.125f;
        float nq = 0.f;
#pragma unroll
        for (int st = 0; st < 4; ++st) { const f32x4 n0 = *(const f32x4*)(Cp + 4096 + st * 16 + hh * 8), n1 = *(const f32x4*)(Cp + 4096 + st * 16 + hh * 8 + 4);
            const u32x4 qw = __builtin_bit_cast(u32x4, Qf[st]);
            nq += n0.x * bflo(qw.x) + n0.y * bfhi(qw.x) + n0.z * bflo(qw.y) + n0.w * bfhi(qw.y) + n1.x * bflo(qw.z) + n1.y * bfhi(qw.z) + n1.z * bflo(qw.w) + n1.w * bfhi(qw.w); }
        nq += shfl_idx(nq, lane ^ 32);
        den += wi * nq;
        const float inv = 1.0f / fmaxf(fabsf(den), __expf(-(bj + Mj)));
#pragma unroll 1
        for (int vb = 0; vb < 2; ++vb) {
            const int v = 32 * vb + r;
            f32x16 O = ML_ZERO16;
            ml_pv<DIR>(O, S0, ZB, 0, base_row, h, v, hh);
            if (jb == 1) ml_pv<DIR>(O, S1, ZB, 1, base_row, h, v, hh);
            f32x16 I = ML_ZERO16;
#pragma unroll
            for (int st = 0; st < 4; ++st) { const float* cr = Cp + (size_t)v * 64 + st * 16 + hh * 8; const f32x4 c0 = *(const f32x4*)cr, c1 = *(const f32x4*)(cr + 4);
                const bf16x8 CA = pack8(c0.x, c0.y, c0.z, c0.w, c1.x, c1.y, c1.z, c1.w); I = MFMA32(CA, Qf[st], I); __builtin_amdgcn_sched_barrier(0); }
#pragma unroll
            for (int g = 0; g < 16; ++g) { const float hv = (O[g] + wi * I[g]) * inv; const int idx = (32 * vb + crow(g, hh)) * 65 + tok;
                if (DIR == 1) H[idx] = hv; else H[idx] += hv; }
        }
    }
}
__device__ __forceinline__ void phase_ml_out(int l) {
    const KA A = ka_fresh(); const Ctx C = ctx_fresh();
    const int gw = C.bid * 8 + C.wave, NGW = C.G * 8, lane = C.lane;
    const bf16* ZB = (const bf16*)(A.ws() + WS_ZB); bf16* MIX = (bf16*)(A.ws() + WS_MIX);
    LAS float* H = (LAS float*)(C.lds + C.wave * 16640);
    const int c_lo = (l == 1) ? 4 : 0, ncu = NCH - c_lo;
    for (int u = gw; u < 8 * ncu; u += NGW) {
        const int c = c_lo + u % ncu, bh = u / ncu, h = bh & 3, b = bh >> 2;
        const int base_row = c < 4 ? RL + b * CTXL + 64 * c : b * SEQ + 64 * (c - 4);
        ml_out_dir<1>(A, C, H, b, h, c, base_row, lane);
        LDS_WAIT(); asm volatile("" ::: "memory");
        ml_out_dir<0>(A, C, H, b, h, c, base_row, lane);
        LDS_WAIT(); asm volatile("" ::: "memory");
        float ss = 0.f;
#pragma unroll 8
        for (int v = 0; v < 64; ++v) { const float x = H[v * 65 + lane]; ss += x * x; }
        const float rs = 1.0f / sqrtf(ss * (1.f / 64.f) + EPS);
        const float gnv = A.in(18)[l * 256 + h * 64 + lane];
#pragma unroll 4
        for (int t = 0; t < 64; ++t) {
            const float rst = __builtin_bit_cast(float, __builtin_amdgcn_readlane(__builtin_bit_cast(int, rs), t));
            const size_t off = (size_t)(base_row + t) * 1024 + 768 + h * 64 + lane;
            const float o = bf2f(ZB[off]); const float sg = 1.0f / (1.0f + __expf(-o));
            MIX[off] = (bf16)f2bf(H[lane * 65 + t] * rst * gnv * sg);
        }
        LDS_WAIT(); asm volatile("" ::: "memory");
    }
}

__device__ __forceinline__ void glds16s(unsigned voff, const unsigned char* sbase, unsigned lds_dst) {
    unsigned keep;
    asm volatile("s_mov_b32 %0, m0\n\ts_mov_b32 m0, %3\n\ts_nop 0\n\tglobal_load_lds_dwordx4 %1, %2\n\ts_mov_b32 m0, %0" : "=&s"(keep) : "v"(voff), "s"(sbase), "s"(lds_dst) : "memory");
}
#define ATT_WAIT_BAR(N) asm volatile("s_waitcnt vmcnt(" #N ") lgkmcnt(0)\n\ts_barrier" ::: "memory")
constexpr int ATT_SLOT = 16384, ATT_NS = 6;
typedef int i32x8 __attribute__((ext_vector_type(8)));
#define MFMA8(a, b, c) __builtin_amdgcn_mfma_scale_f32_32x32x64_f8f6f4((a), (b), (c), 0, 0, 0, 127, 0, 127)
template <bool FIXEDREF>
__device__ __forceinline__ void attn_unit(const KA& A, const Ctx& C, int bh, int qrow0, int tile_lo, int ntiles) {
    int lane_ = C.lane; asm volatile("" : "+v"(lane_));
    const int lane = lane_, r = lane & 31, hh = lane >> 5, h = bh & 7;
    bf16* MIX = (bf16*)(A.ws() + WS_MIX);
    LAS unsigned char* lds = C.lds;
    const unsigned lds0 = (unsigned)(uintptr_t)lds;
    const int qrow = qrow0 + C.wave * 32 + r;
    const unsigned char* kg = A.ws() + WS_KN + ((size_t)bh * NKT + tile_lo) * KT_BYTES;
    const unsigned char* vg = A.ws() + WS_VT + ((size_t)bh * NKT + tile_lo) * VT_BYTES;
    const unsigned vo0 = (unsigned)(C.wave * 1024 + lane * 16);
    const unsigned d0 = lds0 + C.wave * 1024, d1 = d0 + 8192;
    int islot = 0;
#define ATT_ISSUE() do { const unsigned so_ = (unsigned)islot * ATT_SLOT; islot = (islot == ATT_NS - 1) ? 0 : islot + 1; \
        glds16s(vo0, kg, (unsigned)__builtin_amdgcn_readfirstlane(d0 + so_)); glds16s(vo0, vg, (unsigned)__builtin_amdgcn_readfirstlane(d1 + so_)); \
        kg += KT_BYTES; vg += VT_BYTES; } while (0)
    ATT_ISSUE(); ATT_ISSUE(); ATT_ISSUE();
    i32x8 qf[2];
    { const unsigned char* q8 = A.ws() + WS_Q8 + (size_t)qrow * 1024 + h * 128 + hh * 32;
#pragma unroll
      for (int st = 0; st < 2; ++st) { const u32x4 a = *(const u32x4*)(q8 + st * 64), b = *(const u32x4*)(q8 + st * 64 + 16);
          qf[st] = (i32x8){(int)a.x, (int)a.y, (int)a.z, (int)a.w, (int)b.x, (int)b.y, (int)b.z, (int)b.w}; } }
    f32x16 o0 = (f32x16){0.f, 0.f, 0.f, 0.f, 0.f, 0.f, 0.f, 0.f, 0.f, 0.f, 0.f, 0.f, 0.f, 0.f, 0.f, 0.f}, o1 = o0;
    float m = 0.f, lsum = 0.f;
    constexpr float THR = 8.f;
    const int ksw = (r >> 1) & 7;
    int cslot = 0, nslot = 1;
#define ATT_ADV() do { cslot = nslot; nslot = (nslot == ATT_NS - 1) ? 0 : nslot + 1; } while (0)
#define ATT_QKT(P0, P1, sl) do { const LAS unsigned char* Kb_ = lds + (sl) * ATT_SLOT + r * 128; P0 = ML_ZERO16; P1 = ML_ZERO16; \
        _Pragma("unroll") for (int st = 0; st < 2; ++st) { \
            const u32x4 a_ = *(const LAS u32x4*)(Kb_ + (((st * 4 + hh * 2) ^ ksw) << 4)), b_ = *(const LAS u32x4*)(Kb_ + (((st * 4 + hh * 2 + 1) ^ ksw) << 4)); \
            const u32x4 c_ = *(const LAS u32x4*)(Kb_ + 4096 + (((st * 4 + hh * 2) ^ ksw) << 4)), d_ = *(const LAS u32x4*)(Kb_ + 4096 + (((st * 4 + hh * 2 + 1) ^ ksw) << 4)); \
            P0 = MFMA8(((i32x8){(int)a_.x, (int)a_.y, (int)a_.z, (int)a_.w, (int)b_.x, (int)b_.y, (int)b_.z, (int)b_.w}), qf[st], P0); \
            P1 = MFMA8(((i32x8){(int)c_.x, (int)c_.y, (int)c_.z, (int)c_.w, (int)d_.x, (int)d_.y, (int)d_.z, (int)d_.w}), qf[st], P1); } } while (0)
#define ATT_H1(C0, C1, N0, N1, tt) do { \
        const bool more_ = (tt) + 1 < ntiles; \
        if ((tt) + 3 < ntiles) ATT_ISSUE(); \
        if (more_) ATT_QKT(N0, N1, nslot); \
        if (!FIXEDREF) { \
        float ta_ = __builtin_fmaxf(__builtin_fmaxf(C0[0], C0[1]), C0[2]), tb_ = __builtin_fmaxf(__builtin_fmaxf(C0[3], C0[4]), C0[5]), tc_ = __builtin_fmaxf(__builtin_fmaxf(C1[0], C1[1]), C1[2]), td_ = __builtin_fmaxf(__builtin_fmaxf(C1[3], C1[4]), C1[5]);     \
        _Pragma("unroll") for (int g = 6; g < 16; g += 2) { ta_ = __builtin_fmaxf(__builtin_fmaxf(ta_, C0[g]), C0[g + 1]); tc_ = __builtin_fmaxf(__builtin_fmaxf(tc_, C1[g]), C1[g + 1]); } \
        float tm_ = __builtin_fmaxf(__builtin_fmaxf(ta_, tb_), __builtin_fmaxf(tc_, td_)); \
        { const auto rr_ = __builtin_amdgcn_permlane32_swap(__builtin_bit_cast(unsigned, tm_), __builtin_bit_cast(unsigned, tm_), false, false);     \
          tm_ = __builtin_fmaxf(__builtin_bit_cast(float, rr_[0]), __builtin_bit_cast(float, rr_[1])); } \
        if ((tt) == 0) m = tm_;                             \
        else if (__any(tm_ - m > THR)) {                    \
            const float mn_ = __builtin_fmaxf(tm_, m), alpha_ = __builtin_amdgcn_exp2f(m - mn_); m = mn_; lsum *= alpha_; \
            _Pragma("unroll") for (int g = 0; g < 16; ++g) { o0[g] *= alpha_; o1[g] *= alpha_; } \
        } } } while (0)
#define ATT_H2(C0, C1, sl) do { \
        if (!FIXEDREF) { _Pragma("unroll") for (int g = 0; g < 16; ++g) { C0[g] -= m; C1[g] -= m; } } \
        float pa_ = 0.f, pb2_ = 0.f, pc_ = 0.f, pd_ = 0.f;                                      \
        _Pragma("unroll") for (int g = 0; g < 16; g += 2) { C0[g] = __builtin_amdgcn_exp2f(C0[g]); C0[g + 1] = __builtin_amdgcn_exp2f(C0[g + 1]); C1[g] = __builtin_amdgcn_exp2f(C1[g]); C1[g + 1] = __builtin_amdgcn_exp2f(C1[g + 1]); \
            pa_ += C0[g]; pb2_ += C0[g + 1]; pc_ += C1[g]; pd_ += C1[g + 1]; } \
        lsum += (pa_ + pb2_) + (pc_ + pd_); \
        bf16x8 pb_[2][2]; \
        pb_[0][0] = pack8(C0[0], C0[1], C0[2], C0[3], C0[4], C0[5], C0[6], C0[7]); pb_[0][1] = pack8(C0[8], C0[9], C0[10], C0[11], C0[12], C0[13], C0[14], C0[15]); \
        pb_[1][0] = pack8(C1[0], C1[1], C1[2], C1[3], C1[4], C1[5], C1[6], C1[7]); pb_[1][1] = pack8(C1[8], C1[9], C1[10], C1[11], C1[12], C1[13], C1[14], C1[15]); \
        const LAS unsigned char* Vb_ = lds + (sl) * ATT_SLOT + KT_BYTES; \
        { const int sw_ = (r >> 1) & 7; const LAS unsigned char* vrow_ = Vb_ + r * 128;        \
            _Pragma("unroll") for (int kb = 0; kb < 2; ++kb) _Pragma("unroll") for (int s2 = 0; s2 < 2; ++s2) { \
                const bf16x8 va_ = *(const LAS bf16x8*)(vrow_ + (((kb * 4 + s2 * 2 + hh) ^ sw_) << 4)), vb_ = *(const LAS bf16x8*)(vrow_ + 4096 + (((kb * 4 + s2 * 2 + hh) ^ sw_) << 4)); \
                o0 = MFMA32(va_, pb_[kb][s2], o0); o1 = MFMA32(vb_, pb_[kb][s2], o1); } } \
    } while (0)
#define ATT_SYNC(tt) do { if ((tt) + 2 < ntiles) ATT_WAIT_BAR(2); else ATT_WAIT_BAR(0); } while (0)
    f32x16 sA0, sA1, sB0, sB1;
    ATT_WAIT_BAR(4);
    ATT_QKT(sA0, sA1, 0);
    if (C.wave < 4) {
#pragma unroll 1
        for (int t = 0; t < ntiles; t += 2) {
            if (t + 1 < ntiles) ATT_SYNC(t);
            ATT_H1(sA0, sA1, sB0, sB1, t); ATT_H2(sA0, sA1, cslot); ATT_ADV();
            if (t + 2 < ntiles) ATT_SYNC(t + 1);
            ATT_H1(sB0, sB1, sA0, sA1, t + 1); ATT_H2(sB0, sB1, cslot); ATT_ADV();
        }
    } else {
        ATT_SYNC(0);
        ATT_H1(sA0, sA1, sB0, sB1, 0);
#pragma unroll 1
        for (int t = 1; t + 1 < ntiles; t += 2) {
            ATT_SYNC(t);
            ATT_H2(sA0, sA1, cslot); ATT_ADV(); ATT_H1(sB0, sB1, sA0, sA1, t);
            ATT_SYNC(t + 1);
            ATT_H2(sB0, sB1, cslot); ATT_ADV(); ATT_H1(sA0, sA1, sB0, sB1, t + 1);
        }
        ATT_H2(sA0, sA1, cslot); ATT_ADV(); ATT_H1(sB0, sB1, sA0, sA1, ntiles - 1);
        ATT_H2(sB0, sB1, cslot); ATT_ADV();
    }
#undef ATT_QKT
#undef ATT_H1
#undef ATT_H2
#undef ATT_SYNC
#undef ATT_ADV
    asm volatile("s_waitcnt lgkmcnt(0)\n\ts_barrier" ::: "memory");
#undef ATT_ISSUE
    lsum += shfl_idx(lsum, lane ^ 32);
    const float inv = 1.0f / lsum;
    { LAS bf16* stg = (LAS bf16*)(lds + ATT_NS * ATT_SLOT + C.wave * 4352);
#pragma unroll
      for (int g = 0; g < 16; ++g) { const int d = crow(g, hh); stg[r * 68 + d] = (bf16)f2bf(o0[g] * inv); stg[r * 68 + 32 + d] = (bf16)f2bf(o1[g] * inv); }
      LDS_WAIT(); asm volatile("" ::: "memory");
      bf16* ob = MIX + (size_t)(qrow0 + C.wave * 32) * 1024 + 256 + h * 64;
#pragma unroll
      for (int i = 0; i < 4; ++i) { const int row = i * 8 + (lane >> 3), ch = lane & 7;
          const u32x2 a = *(const LAS u32x2*)(stg + row * 68 + ch * 8), b = *(const LAS u32x2*)(stg + row * 68 + ch * 8 + 4);
          u32x4 v; v.x = a.x; v.y = a.y; v.z = b.x; v.w = b.y; *(u32x4*)(ob + (size_t)row * 1024 + ch * 8) = v; }
      LDS_WAIT(); asm volatile("" ::: "memory"); }
}
__device__ __forceinline__ void phase_attn(int l) {
    const KA A = ka_fresh(); const Ctx C = ctx_fresh();
    const int G = C.G;
    bool fixedref;
    { const int lane = C.lane; const float* qg = A.in(15) + l * 96; const float* kg = A.in(16) + l * 96;
      const float gq = wave_max(fmaxf(fabsf(qg[lane]), lane < 32 ? fabsf(qg[64 + lane]) : 0.f), lane), gk = wave_max(fmaxf(fabsf(kg[lane]), lane < 32 ? fabsf(kg[64 + lane]) : 0.f), lane);
      fixedref = (96.f * QSCALE * gq * gk) < 100.f; }
    for (int u = C.bid; u < 1024 + (l == 1 ? 0 : 16); u += G) {
        if (u < 1024) {
            int pair, qb;
            if (G == 256) { const int vcu = u & 255, rnd = u >> 8; pair = 2 * (vcu & 7) + (rnd >> 1); qb = (vcu >> 3) + 32 * (rnd & 1); }
            else { pair = u >> 6; qb = u & 63; }
            if (fixedref) attn_unit<true>(A, C, pair, (pair >> 3) * SEQ + qb * 256, 0, NKT); else attn_unit<false>(A, C, pair, (pair >> 3) * SEQ + qb * 256, 0, NKT);
        } else { const int pair = u - 1024;
            if (fixedref) attn_unit<true>(A, C, pair, RL + (pair >> 3) * CTXL, NKT - 4, 4); else attn_unit<false>(A, C, pair, RL + (pair >> 3) * CTXL, NKT - 4, 4); }
    }
}

__device__ __forceinline__ int f2key(float f) { const int b = __builtin_bit_cast(int, f); return b ^ ((b >> 31) & 0x7fffffff); }
__device__ __forceinline__ float key2f(int k) { return __builtin_bit_cast(float, k ^ ((k >> 31) & 0x7fffffff)); }
__device__ __forceinline__ void topk_ins(int (&lst)[16], int v) {
#pragma unroll
    for (int i = 0; i < 16; ++i) { const int hi = max(lst[i], v); v = min(lst[i], v); lst[i] = hi; }
}
__device__ __forceinline__ void bitonic_sort16_desc(int (&a)[16]) {
#pragma unroll
    for (int k = 2; k <= 16; k <<= 1)
#pragma unroll
        for (int j = k >> 1; j > 0; j >>= 1)
#pragma unroll
            for (int i = 0; i < 16; ++i) { const int p = i ^ j;
                if (p > i) { const int hi = max(a[i], a[p]), lo = min(a[i], a[p]); const bool desc = ((i & k) == 0) || (k == 16); a[i] = desc ? hi : lo; a[p] = desc ? lo : hi; } }
}
__device__ __forceinline__ void merge16_desc(int (&lst)[16], const int (&nw)[16]) {
#pragma unroll
    for (int i = 0; i < 16; ++i) lst[i] = max(lst[i], nw[15 - i]);
#pragma unroll
    for (int j = 8; j > 0; j >>= 1)
#pragma unroll
        for (int i = 0; i < 16; ++i) { const int p = i ^ j; if (p > i) { const int hi = max(lst[i], lst[p]), lo = min(lst[i], lst[p]); lst[i] = hi; lst[p] = lo; } }
}
__device__ __forceinline__ void topk_half(int (&lst)[16], const bf16* qp, const bf16* skp, int hh, int lane) {
    bf16x8 bq[8];
#pragma unroll
    for (int st = 0; st < 8; ++st) bq[st] = *(const bf16x8*)(qp + st * 16);
#pragma unroll
    for (int i = 0; i < 16; ++i) lst[i] = f2key(-3.0e38f);
    bf16x8 an[8];
#pragma unroll
    for (int st = 0; st < 8; ++st) an[st] = *(const bf16x8*)(skp + st * 16);
#pragma unroll 1
    for (int blk = 0; blk < 4; ++blk) {
        f32x16 acc = (f32x16){0.f, 0.f, 0.f, 0.f, 0.f, 0.f, 0.f, 0.f, 0.f, 0.f, 0.f, 0.f, 0.f, 0.f, 0.f, 0.f};
#pragma unroll
        for (int st = 0; st < 8; ++st) acc = MFMA32(an[st], bq[st], acc);
        if (blk < 3) {
#pragma unroll
            for (int st = 0; st < 8; ++st) an[st] = *(const bf16x8*)(skp + (blk + 1) * 32 * 128 + st * 16); }
        int nk[16];
#pragma unroll
        for (int g = 0; g < 16; ++g) { const unsigned n = (unsigned)(blk * 32 + crow(g, hh));
            const float sv = acc[g];
            nk[g] = f2key(__builtin_bit_cast(float, (__builtin_bit_cast(unsigned, sv) & ~127u) | n)); }
        bitonic_sort16_desc(nk);
        merge16_desc(lst, nk);
    }
    int oth[16];
#pragma unroll
    for (int i = 0; i < 16; ++i) oth[i] = shfl_idx(lst[i], lane ^ 32);
    merge16_desc(lst, oth);
}
__device__ __forceinline__ void phase_topk(int l) {
    const KA A = ka_fresh(); const Ctx C = ctx_fresh();
    const int gw = C.bid * 8 + C.wave, NGW = C.G * 8, lane = C.lane, r = lane & 31, hh = lane >> 5;
    const bf16* PQ = (const bf16*)(A.ws() + WS_PQ); const bf16* SK = (const bf16*)(A.ws() + WS_SUBK);
    int* EID = (int*)(A.ws() + WS_EID); float* GATE = (float*)(A.ws() + WS_GATE);
    const int nrows = (l == 1) ? RL : RT;
    for (int unit = gw; unit < (nrows / 32) * 8; unit += NGW) {
        const int h = unit & 7, r0 = (unit >> 3) * 32; const size_t row = (size_t)(r0 + r);
        int L[2][16];
        topk_half(L[0], PQ + row * 2048 + h * 256 + hh * 8, SK + ((size_t)((l * 8 + h) * 2 + 0) * 128 + r) * 128 + hh * 8, hh, lane);
        __builtin_amdgcn_sched_barrier(0);
        topk_half(L[1], PQ + row * 2048 + h * 256 + 128 + hh * 8, SK + ((size_t)((l * 8 + h) * 2 + 1) * 128 + r) * 128 + hh * 8, hh, lane);
        __builtin_amdgcn_sched_barrier(0);
        int best[16];
#pragma unroll
        for (int j = 0; j < 16; ++j) best[j] = f2key(__builtin_bit_cast(float, (__builtin_bit_cast(unsigned, key2f(L[0][0]) + key2f(L[1][j])) & ~255u) | (unsigned)j));
#pragma unroll
        for (int i = 1; i < 16; ++i)
#pragma unroll
            for (int j = 0; j < 16; ++j)
                if ((i + 1) * (j + 1) <= 16) topk_ins(best, f2key(__builtin_bit_cast(float, (__builtin_bit_cast(unsigned, key2f(L[0][i]) + key2f(L[1][j])) & ~255u) | (unsigned)(i * 16 + j))));
        float ev[16]; float esum = 0.f;
        const float mx = __builtin_bit_cast(float, __builtin_bit_cast(unsigned, key2f(best[0])) & ~255u);
#pragma unroll
        for (int k = 0; k < 16; ++k) { ev[k] = __expf(__builtin_bit_cast(float, __builtin_bit_cast(unsigned, key2f(best[k])) & ~255u) - mx); esum += ev[k]; }
        const float einv = 1.0f / esum;
#pragma unroll
        for (int k = 0; k < 8; ++k) {
            const int b_lo = best[k], b_hi = best[k + 8]; const float e_lo = ev[k], e_hi = ev[k + 8];
            const int bk = hh ? b_hi : b_lo; const float gk = (hh ? e_hi : e_lo) * einv;
            const unsigned code = __builtin_bit_cast(unsigned, key2f(bk)) & 255u;
            const unsigned ci = code >> 4, cj = code & 15u; unsigned n0 = 0u, n1 = 0u;
#pragma unroll
            for (int i = 0; i < 16; ++i) { n0 = (ci == (unsigned)i) ? (__builtin_bit_cast(unsigned, key2f(L[0][i])) & 127u) : n0; n1 = (cj == (unsigned)i) ? (__builtin_bit_cast(unsigned, key2f(L[1][i])) & 127u) : n1; }
            EID[row * 128 + h * 16 + hh * 8 + k] = (int)(n0 * 128u + n1); GATE[row * 128 + h * 16 + hh * 8 + k] = gk;
        }
    }
}
typedef float f32x2v __attribute__((ext_vector_type(2)));
typedef unsigned u32x6 __attribute__((ext_vector_type(6)));
typedef float f32x32 __attribute__((ext_vector_type(32)));
#define FFN_NB 4
__device__ __forceinline__ void phase_ffn(int l) {
    const KA A = ka_fresh(); const Ctx C = ctx_fresh();
    const int gw = C.bid * 8 + C.wave, NGW = C.G * 8, lane = C.lane;
    const bf16* XN = (const bf16*)(A.ws() + WS_XN); const unsigned char* TU = A.ws() + WS_TABU; const unsigned char* TV = A.ws() + WS_TABV;
    const int* EID = (const int*)(A.ws() + WS_EID); const float* GATE = (const float*)(A.ws() + WS_GATE);
    const float* MOD = (const float*)(A.ws() + WS_MOD);
    const int nrows = (l == 1) ? RL : RT;
    for (int row = gw; row < nrows; row += NGW) {
        f32x2_t hv[8];
        { const u32x4 a = *(const u32x4*)(XN + (size_t)row * DM + lane * 16), b = *(const u32x4*)(XN + (size_t)row * DM + lane * 16 + 8);
          hv[0] = (f32x2_t){bflo(a.x), bfhi(a.x)}; hv[1] = (f32x2_t){bflo(a.y), bfhi(a.y)}; hv[2] = (f32x2_t){bflo(a.z), bfhi(a.z)}; hv[3] = (f32x2_t){bflo(a.w), bfhi(a.w)};
          hv[4] = (f32x2_t){bflo(b.x), bfhi(b.x)}; hv[5] = (f32x2_t){bflo(b.y), bfhi(b.y)}; hv[6] = (f32x2_t){bflo(b.z), bfhi(b.z)}; hv[7] = (f32x2_t){bflo(b.w), bfhi(b.w)}; }
        f32x2_t out[8];
#pragma unroll
        for (int i = 0; i < 8; ++i) out[i] = (f32x2_t){0.f, 0.f};
        const int idA = EID[(size_t)row * 128 + lane], idB = EID[(size_t)row * 128 + 64 + lane]; const float gtA = GATE[(size_t)row * 128 + lane], gtB = GATE[(size_t)row * 128 + 64 + lane];
        int ln = lane; asm volatile("" : "+v"(ln));
        const bool b0 = ln & 1, b1 = ln & 2; const int q4 = ln >> 2, x16 = ln ^ 16, x32 = ln ^ 32;
        float dA = 0.f, dB = 0.f;
#define FFN_LOADU(UU, ID, e0) do { _Pragma("unroll") for (int k = 0; k < 4; ++k) { const int id_ = __builtin_amdgcn_readlane(ID, (e0) + k); UU[k] = *(const U3*)(TU + (size_t)id_ * TROW + lane * 12); } } while (0)
#define FFN_DOT4(UU, DV, e0) do { float p_[4]; \
            _Pragma("unroll") for (int k = 0; k < 4; k += 2) { \
                const u32x6 us_ = {UU[k].a, UU[k].b, UU[k].c, UU[k + 1].a, UU[k + 1].b, UU[k + 1].c}; \
                const f32x32 uf_ = __builtin_amdgcn_cvt_scalef32_pk32_f32_fp6(us_, 1.0f);        \
                f32x2_t d0_ = {0.f, 0.f}, d1_ = {0.f, 0.f}; \
                _Pragma("unroll") for (int i = 0; i < 8; ++i) { d0_ = hv[i] * (f32x2_t){uf_[2 * i], uf_[2 * i + 1]} + d0_; d1_ = hv[i] * (f32x2_t){uf_[16 + 2 * i], uf_[17 + 2 * i]} + d1_; } \
                p_[k] = d0_.x + d0_.y; p_[k + 1] = d1_.x + d1_.y; } \
            float x01_ = b0 ? p_[1] : p_[0], y01_ = b0 ? p_[0] : p_[1], x23_ = b0 ? p_[3] : p_[2], y23_ = b0 ? p_[2] : p_[3]; \
            x01_ += __builtin_bit_cast(float, __builtin_amdgcn_update_dpp(0, __builtin_bit_cast(int, y01_), 0xB1, 0xf, 0xf, true)); \
            x23_ += __builtin_bit_cast(float, __builtin_amdgcn_update_dpp(0, __builtin_bit_cast(int, y23_), 0xB1, 0xf, 0xf, true)); \
            float x_ = b1 ? x23_ : x01_; const float y_ = b1 ? x01_ : x23_; \
            x_ += __builtin_bit_cast(float, __builtin_amdgcn_update_dpp(0, __builtin_bit_cast(int, y_), 0x4E, 0xf, 0xf, true)); \
            DPP_ADD(x_, 0x124); DPP_ADD(x_, 0x128);                  \
            x_ += shfl_idx(x_, x16); x_ += shfl_idx(x_, x32);       \
            DV = (q4 == ((e0) >> 2)) ? x_ : DV; } while (0)
        { U3 ua[4], ub[4];
          FFN_LOADU(ua, idA, 0);
#pragma unroll 1
          for (int e = 0; e < 64; e += 8) { FFN_LOADU(ub, idA, e + 4); FFN_DOT4(ua, dA, e); if (e + 8 < 64) FFN_LOADU(ua, idA, e + 8); else FFN_LOADU(ua, idB, 0); FFN_DOT4(ub, dA, e + 4); }
#pragma unroll 1
          for (int e = 0; e < 64; e += 8) { FFN_LOADU(ub, idB, e + 4); FFN_DOT4(ua, dB, e); if (e + 8 < 64) FFN_LOADU(ua, idB, e + 8); FFN_DOT4(ub, dB, e + 4); } }
#undef FFN_LOADU
#undef FFN_DOT4
        const float wA = gtA * gelu_f(dA * (1.0f / U_SCALE)) * (1.0f / V_SCALE), wB = gtB * gelu_f(dB * (1.0f / U_SCALE)) * (1.0f / V_SCALE);
#define FFN_LOADV(VV, ID, e0) do { _Pragma("unroll") for (int k = 0; k < 4; ++k) { const int id_ = __builtin_amdgcn_readlane(ID, (e0) + k); VV[k] = *(const U3*)(TV + (size_t)id_ * TROW + lane * 12); } } while (0)
#define FFN_ACC4(VV, WV, e0) do { _Pragma("unroll") for (int k = 0; k < 4; k += 2) { \
            const float w0_ = __builtin_bit_cast(float, __builtin_amdgcn_readlane(__builtin_bit_cast(int, WV), (e0) + k)), w1_ = __builtin_bit_cast(float, __builtin_amdgcn_readlane(__builtin_bit_cast(int, WV), (e0) + k + 1)); \
            const u32x6 vs_ = {VV[k].a, VV[k].b, VV[k].c, VV[k + 1].a, VV[k + 1].b, VV[k + 1].c}; \
            const f32x32 vf_ = __builtin_amdgcn_cvt_scalef32_pk32_f32_fp6(vs_, 1.0f); \
            const f32x2_t w0p_ = {w0_, w0_}, w1p_ = {w1_, w1_}; \
            _Pragma("unroll") for (int i = 0; i < 8; ++i) { out[i] = w0p_ * (f32x2_t){vf_[2 * i], vf_[2 * i + 1]} + out[i]; out[i] = w1p_ * (f32x2_t){vf_[16 + 2 * i], vf_[17 + 2 * i]} + out[i]; } } } while (0)
        { U3 va[4], vb[4];
          FFN_LOADV(va, idA, 0);
#pragma unroll 1
          for (int e = 0; e < 64; e += 8) { FFN_LOADV(vb, idA, e + 4); FFN_ACC4(va, wA, e); if (e + 8 < 64) FFN_LOADV(va, idA, e + 8); else FFN_LOADV(va, idB, 0); FFN_ACC4(vb, wA, e + 4); }
#pragma unroll 1
          for (int e = 0; e < 64; e += 8) { FFN_LOADV(vb, idB, e + 4); FFN_ACC4(va, wB, e); if (e + 8 < 64) FFN_LOADV(va, idB, e + 8); FFN_ACC4(vb, wB, e + 4); } }
#undef FFN_LOADV
#undef FFN_ACC4
        const int nsel = row < RL ? (row >> 14) : 2;
        const float* gf = MOD + (l * 3 + nsel) * 6144 + 5 * 1024;
        float* xr = stream_out(A, C, row);
#pragma unroll
        for (int q = 0; q < 4; ++q) { const int j = lane * 16 + q * 4;
            const f32x4 x = *(const f32x4*)(xr + j); f32x4 g = *(const f32x4*)(gf + j);
            f32x4 o; o.x = x.x + g.x * out[q * 2].x; o.y = x.y + g.y * out[q * 2].y; o.z = x.z + g.z * out[q * 2 + 1].x; o.w = x.w + g.w * out[q * 2 + 1].y;
            *(f32x4*)(xr + j) = o; }
    }
}

template <class Epi>
__device__ __forceinline__ void run_gemm(const pg8::bf16_t* Amat, const pg8::bf16_t* Bt, int N, int K, const Epi& E, int M = RT) {
    const Ctx C = ctx_fresh();
    pg8::Gemm g{Amat, Bt, M, N, K}; pg8::StaticOrder S; S.init(M, N, C.G, C.bid);
    pg8::gemm_phase<Epi, pg8::StaticOrder, true, true>(C.lds, g, S, E);
}
__device__ __forceinline__ void seam() {
    const KA A = ka_fresh(); const Ctx C = ctx_fresh();
    XcdBarrier b; b.bar = (unsigned*)(A.ws() + WS_CTL) + CW_BAR; b.x = xb_xcc_id(); b.st = (volatile LAS unsigned*)(C.lds + MISC_OFF) + 8;
    xcd_barrier(b);
}
#define IN(k) (lo <= (k) && (k) < hi)
#define SEAM(k) do { if (IN(k) && IN((k) + 1)) seam(); } while (0)
template <int l>
__device__ __forceinline__ void layer_body(const int lo, const int hi) {
        const int p0 = 1 + NPH_L * l;
        if (IN(p0 + 0)) { phase_norm(l, 0); phase_tables(l); }
        SEAM(p0 + 0);
        if (IN(p0 + 1)) {
            const KA A = ka_fresh(); unsigned char* ws = A.ws();
            pg8::EpiBf16<0> E{(pg8::bf16_t*)(ws + WS_ZA), 1024, nullptr, 1024, (size_t)(WS_ZB - WS_ZA) / 2, 1.f};
            run_gemm(( const pg8::bf16_t*)(ws + WS_XN), (const pg8::bf16_t*)(ws + WS_WIN) + (size_t)l * 2048 * DM, 2048, DM, E);
        }
        SEAM(p0 + 1);
        if (IN(p0 + 2)) phase_post(l);
        SEAM(p0 + 2);
        if (IN(p0 + 3)) {
#pragma unroll 1
            for (int gi = 0; gi < 2; ++gi) {
                const KA A = ka_fresh(); unsigned char* ws = A.ws();
                const int N = gi ? 1024 : 768, K = gi ? 256 : 384;
                pg8::EpiBf16<0> E{(pg8::bf16_t*)(ws + (gi ? WS_KVRAW : WS_Q)), N, nullptr, 0, 0, 1.f};
                run_gemm((const pg8::bf16_t*)(ws + (gi ? WS_KVA : WS_QA)), (const pg8::bf16_t*)(ws + (gi ? WS_WUKV : WS_WUQ)) + (size_t)l * N * K, N, K, E);
            }
        }
        SEAM(p0 + 3);
        if (IN(p0 + 4)) phase_qknorm(l);
        SEAM(p0 + 4);
        if (IN(p0 + 5)) phase_ml_local();
        SEAM(p0 + 5);
        if (IN(p0 + 6)) phase_ml_scan();
        SEAM(p0 + 6);
        if (IN(p0 + 7)) {
            phase_ml_out(l);
            __syncthreads();
            phase_attn(l);
        }
        SEAM(p0 + 7);
        if (IN(p0 + 8)) {
            const KA A = ka_fresh(); unsigned char* ws = A.ws();
            pg8::EpiResGate E{l == 0 ? A.in(0) : (const float*)A.out(), l == 0 ? A.in(2) : (const float*)(ws + WS_CTXS), A.out(), (float*)(ws + WS_CTXS), (const float*)(ws + WS_MOD) + (size_t)l * 3 * 6144, 2 * 1024};
            run_gemm((const pg8::bf16_t*)(ws + WS_MIX), (const pg8::bf16_t*)(ws + WS_WOUT) + (size_t)l * DM * DM, DM, DM, E, l == 1 ? RL : RT);
        }
        SEAM(p0 + 8);
        if (IN(p0 + 9)) phase_norm(l, 1);
        SEAM(p0 + 9);

        if (IN(p0 + 10)) {
            const KA A = ka_fresh(); unsigned char* ws = A.ws();
            pg8::EpiBf16<0> E{(pg8::bf16_t*)(ws + WS_PQ), 2048, nullptr, 0, 0, 1.f};
            run_gemm((const pg8::bf16_t*)(ws + WS_XN), (const pg8::bf16_t*)(ws + WS_WPQ) + (size_t)l * 2048 * DM, 2048, DM, E, l == 1 ? RL : RT);
        }
        SEAM(p0 + 10);
                if (IN(p0 + 11)) phase_topk(l);
        SEAM(p0 + 11);
        if (IN(p0 + 12)) phase_ffn(l);
        if (l == 0) SEAM(p0 + 12);
    }
__global__ void __launch_bounds__(512, 2) mk_fwd(Args unused_args) {
    { const KA A = ka_fresh(); const Ctx C = ctx_fresh();
      volatile LAS unsigned* MISC = (volatile LAS unsigned*)(C.lds + MISC_OFF);
      if (C.tid < 64) MISC[C.tid] = 0u;
      __syncthreads();
      (void)xcd_barrier_post((unsigned*)(A.ws() + WS_CTL) + CW_BAR, MISC + 8); }
    int lo, hi;
    { const KA A = ka_fresh(); lo = A.ph_lo(); hi = A.ph_hi(); }
    if (IN(0)) phase_prologue();
    if (IN(0)) { if (lo == 0 && hi == NPHASES) seam(); }
    if (IN(0) && lo == 0 && hi == NPHASES) phase_modreduce();
    SEAM(0);
    layer_body<0>(lo, hi);
    layer_body<1>(lo, hi);
#undef IN
#undef SEAM
}

extern "C" void kernel_launch(void* const* d_in, const int* in_sizes, int n_in, void* d_out, int out_size, void* d_ws, size_t ws_size, hipStream_t stream) {
    static int grid = 0;
    if (grid == 0) {
        if (n_in != 24 || out_size != RL * DM || ws_size < WS_END) { fprintf(stderr, "kernel_launch: unexpected shapes (n_in %d, out %d, ws %zu)\n", n_in, out_size, ws_size); grid = -1; return; }
        int dev = 0, cus = 0, per_cu = 0;
        if (hipGetDevice(&dev) != hipSuccess || hipDeviceGetAttribute(&cus, hipDeviceAttributeMultiprocessorCount, dev) != hipSuccess) { grid = -1; return; }
        if (hipFuncSetAttribute((const void*)mk_fwd, hipFuncAttributeMaxDynamicSharedMemorySize, LDS_BYTES) != hipSuccess) { fprintf(stderr, "kernel_launch: hipFuncSetAttribute failed\n"); grid = -1; return; }
        if (hipOccupancyMaxActiveBlocksPerMultiprocessor(&per_cu, (const void*)mk_fwd, 512, LDS_BYTES) != hipSuccess || per_cu < 1) { fprintf(stderr, "kernel_launch: occupancy query says %d\n", per_cu); per_cu = 1; }
        (void)hipGetLastError();
        grid = cus;
    }
    if (grid < 0) return;
    (void)hipMemsetAsync((char*)d_ws + WS_CTL, 0, CTL_ZERO_BYTES, stream);
    Args a{};
    for (int i = 0; i < 24; ++i) a.in[i] = (const float*)d_in[i];
    a.out = (float*)d_out; a.ws = (unsigned char*)d_ws;
    a.ph_lo = 0; a.ph_hi = NPHASES;
    hipLaunchKernelGGL(mk_fwd, dim3(grid), dim3(512), LDS_BYTES, stream, a);
}
```

```cpp
#include <hip/hip_runtime.h>
#include <cstdio>
#include <cstdint>

namespace pg8 {
#define PG8_LAS __attribute__((address_space(3)))
typedef unsigned short bf16_t;
typedef short bf16x8 __attribute__((ext_vector_type(8)));
typedef float f32x4 __attribute__((ext_vector_type(4)));
typedef unsigned u32x4 __attribute__((ext_vector_type(4)));
constexpr int BM = 256, BK = 64, HALF = 128, HTB = HALF * BK * 2  , STAGE_BYTES = 8 * HTB, NXCD = 8, WGM = 8;

__host__ __device__ __forceinline__ int lds_byte(int r, int c) { const int st = (r >> 4) * 2 + (c >> 5), rr = r & 15, cc = c & 31, ob = rr * 64 + cc * 2; return st * 1024 + (ob ^ (((ob >> 9) & 1) << 5)); }
__host__ __device__ __forceinline__ void stage_rc(int b, int& R, int& C) { const int st = b / 1024, sb = b % 1024, swz = sb ^ (((sb >> 9) & 1) << 5); R = (st >> 1) * 16 + swz / 64; C = (st & 1) * 32 + (swz % 64) / 2; }
__host__ __device__ __forceinline__ int perm32(int rho) { const int n = rho >> 4, i = rho & 15; return 8 * (i >> 2) + 4 * n + (i & 3); }

struct Unit { int pm, pn; };
struct Gemm { const bf16_t* A; const bf16_t* Bt; int M, N, K; };

struct StaticOrder {
    int nM, nN, nwg, G, c;
    __host__ __device__ void init(int M, int N, int G_, int c_) { nM = M / BM; nN = N / BM; nwg = nM * nN; G = G_; c = c_; }
    __host__ __device__ bool next(int i, Unit& u) const {
        const long L = (long)i * G + c; if (L >= nwg) return false;
        int wgid = (int)L; { const int q = nwg / NXCD, r = nwg % NXCD, xcd = wgid % NXCD, off = wgid / NXCD; wgid = (xcd < r ? xcd * (q + 1) : r * (q + 1) + (xcd - r) * q) + off; }
        const int nig = WGM * nN, gid = wgid / nig, fm = gid * WGM, gsz = (nM - fm) < WGM ? (nM - fm) : WGM;
        u.pm = fm + ((wgid % nig) % gsz); u.pn = (wgid % nig) / gsz; return true;
    }
    __device__ __forceinline__ void a_ready(const Unit&) const {}
    __device__ __forceinline__ void done(const Unit&) const {}
};

__device__ __forceinline__ unsigned cvt_pk_bf16(float lo, float hi) { unsigned r; asm volatile("v_cvt_pk_bf16_f32 %0, %1, %2" : "=v"(r) : "v"(lo), "v"(hi)); return r; }
typedef float f32x2 __attribute__((ext_vector_type(2)));
__device__ __forceinline__ f32x2 gelu_pk(f32x2 v) {
    const f32x2 av = __builtin_elementwise_abs(v), d = av * 0.2316418882f + 1.0f;
    f32x2 t; t.x = __builtin_amdgcn_rcpf(d.x); t.y = __builtin_amdgcn_rcpf(d.y);
    f32x2 q = t * 0.5307027145f + (-0.7265760135f); q = q * t + 0.7107068705f; q = q * t + (-0.142248368f); q = q * t + 0.127414796f; q = q * t;
    const f32x2 s = (v * v) * (-0.72134752044f);
    f32x2 e; e.x = __builtin_amdgcn_exp2f(s.x); e.y = __builtin_amdgcn_exp2f(s.y);
    const f32x2 m = v * (q * e), r = v - m;
    f32x2 o; o.x = v.x < 0.f ? m.x : r.x; o.y = v.y < 0.f ? m.y : r.y; return o;
}

template <int ACT  > struct EpiBf16 {
    static constexpr bool PERM = true, AFTER_DRAIN = false; static_assert(ACT == 0 || ACT == 1, "EpiBf16: ACT is 0 (none) or 1 (gelu_pk)");
    bf16_t* O; int ldc; const float* bias; int split_cols; size_t split_stride; float scale0;
    __device__ __forceinline__ void operator()(const f32x4 (&acc)[2][2][4][2], const Unit& u, int wr, int wc, int fr, int fq) const {
        const int row0 = u.pm * BM + wr * 64 + fr; int colt = u.pn * BM; bf16_t* base = O;
        float sc = 1.f; if (split_cols) { const int t = colt / split_cols; base += (size_t)t * split_stride; colt -= t * split_cols; if (t == 0) sc = scale0; }
        const int col0 = colt + wc * 32 + 8 * fq, bcol0 = u.pn * BM + wc * 32 + 8 * fq;
        f32x4 bv[2][2];
#pragma unroll
        for (int bj = 0; bj < 2; ++bj)
#pragma unroll
            for (int n = 0; n < 2; ++n) bv[bj][n] = bias ? *(const f32x4*)(bias + bcol0 + bj * HALF + 4 * n) : (f32x4){0.f, 0.f, 0.f, 0.f};
#pragma unroll
        for (int ai = 0; ai < 2; ++ai)
#pragma unroll
            for (int m = 0; m < 4; ++m) { bf16_t* rowp = base + (size_t)(row0 + ai * HALF + m * 16) * ldc + col0;
#pragma unroll
                for (int bj = 0; bj < 2; ++bj) { f32x4 v0 = acc[ai][bj][m][0] + bv[bj][0], v1 = acc[ai][bj][m][1] + bv[bj][1];
                    if (ACT == 1) { f32x2 a = gelu_pk((f32x2){v0[0], v0[1]}), b = gelu_pk((f32x2){v0[2], v0[3]}), c = gelu_pk((f32x2){v1[0], v1[1]}), d = gelu_pk((f32x2){v1[2], v1[3]});
                        v0 = (f32x4){a.x, a.y, b.x, b.y}; v1 = (f32x4){c.x, c.y, d.x, d.y}; }
                    v0 = v0 * sc; v1 = v1 * sc; u32x4 w; w.x = cvt_pk_bf16(v0[0], v0[1]); w.y = cvt_pk_bf16(v0[2], v0[3]); w.z = cvt_pk_bf16(v1[0], v1[1]); w.w = cvt_pk_bf16(v1[2], v1[3]);
                    *(u32x4*)(rowp + bj * HALF) = w; } }
    }
};


struct EpiResGate {
    static constexpr bool PERM = false, AFTER_DRAIN = false;
    const float* base_lat; const float* base_ctx; float* out_lat; float* out_ctx; const float* gate;
    int goff;
    __device__ __forceinline__ void operator()(const f32x4 (&acc)[2][2][4][2], const Unit& u, int wr, int wc, int fr, int fq) const {
        const int rowt = u.pm * BM; const bool lat = rowt < 32768;
        const int nsel = lat ? (rowt >> 14) : 2;
        const float* bs = lat ? base_lat + (size_t)rowt * 1024 : base_ctx + (size_t)(rowt - 32768) * 1024;
        float* os = lat ? out_lat + (size_t)rowt * 1024 : out_ctx + (size_t)(rowt - 32768) * 1024;
        const float* gv = gate + nsel * 6144 + goff;
        const int rl = wr * 64 + fr, col0 = u.pn * BM + wc * 32 + 4 * fq;
        f32x4 g[2][2];
#pragma unroll
        for (int bj = 0; bj < 2; ++bj)
#pragma unroll
            for (int n = 0; n < 2; ++n) g[bj][n] = *(const f32x4*)(gv + col0 + bj * HALF + n * 16);
#pragma unroll
        for (int ai = 0; ai < 2; ++ai)
#pragma unroll
            for (int m = 0; m < 4; ++m) { const size_t ro = (size_t)(rl + ai * HALF + m * 16) * 1024 + col0;
#pragma unroll
                for (int bj = 0; bj < 2; ++bj)
#pragma unroll
                    for (int n = 0; n < 2; ++n) { const f32x4 b = *(const f32x4*)(bs + ro + bj * HALF + n * 16); *(f32x4*)(os + ro + bj * HALF + n * 16) = b + g[bj][n] * acc[ai][bj][m][n]; } }
    }
};

template <class Epi, class Sched, bool ALIGN_EPI = false, bool SP2 = false>
__device__ __forceinline__ void gemm_phase(PG8_LAS unsigned char* lds, const Gemm g, const Sched& S, const Epi& E) {
    int tid_l = threadIdx.x; asm volatile("" : "+v"(tid_l));
    const int tid = tid_l, wid = __builtin_amdgcn_readfirstlane(tid >> 6), lane = tid & 63, wr = wid >> 2, wc = wid & 3, fr = lane & 15, fq = lane >> 4;
    const int K = g.K, nt = K / BK;
    unsigned voffA[2], voffB[2];
#pragma unroll
    for (int i = 0; i < 2; ++i) { int R, C; stage_rc(tid * 16 + i * 8192, R, C); const int Rb = Epi::PERM ? ((R & ~31) + perm32(R & 31)) : R;
        voffA[i] = (unsigned)(R * K + C) * 2u; voffB[i] = (unsigned)(Rb * K + C) * 2u; }
    const size_t kstep = (size_t)(BK * 2);
    const size_t hstep = (size_t)HALF * K * 2;
    const size_t tstep = 2 * hstep;
    const unsigned ldsw = (unsigned)wid * 1024u;
    const int aoff = lds_byte(wr * 64 + fr, fq * 8), boff = lds_byte(wc * 32 + fr, fq * 8);
#define PG8_SA(b, h) (((b) * 2 + (h)) * HTB)
#define PG8_SB(b, h) ((4 + (b) * 2 + (h)) * HTB)
#define PG8_STAGE(bufoff, gbase, voff) do { _Pragma("unroll") for (int _i = 0; _i < 2; ++_i) \
        __builtin_amdgcn_global_load_lds((const unsigned*)((const char*)(gbase) + (voff)[_i]), (PG8_LAS unsigned*)(lds + (bufoff) + ldsw + _i * 8192), 16, 0, 0); } while (0)
#define PG8_LDA(dst, b, h) do { _Pragma("unroll") for (int m = 0; m < 4; ++m) _Pragma("unroll") for (int k = 0; k < 2; ++k) dst[m][k] = *(const PG8_LAS bf16x8*)(lds + PG8_SA(b, h) + aoff + m * 2048 + k * 1024); } while (0)
#define PG8_LDB(dst, b, h) do { _Pragma("unroll") for (int n = 0; n < 2; ++n) _Pragma("unroll") for (int k = 0; k < 2; ++k) dst[n][k] = *(const PG8_LAS bf16x8*)(lds + PG8_SB(b, h) + boff + n * 2048 + k * 1024); } while (0)
#define PG8_MMA(ai, bj, At, Bt) do { __builtin_amdgcn_s_setprio(1); _Pragma("unroll") for (int m = 0; m < 4; ++m) _Pragma("unroll") for (int n = 0; n < 2; ++n) _Pragma("unroll") for (int k = 0; k < 2; ++k) \
        acc[ai][bj][m][n] = __builtin_amdgcn_mfma_f32_16x16x32_bf16(Bt[n][k], At[m][k], acc[ai][bj][m][n], 0, 0, 0); __builtin_amdgcn_s_setprio(0); } while (0)
#define PG8_WAIT_V(n) asm volatile("s_waitcnt vmcnt(" #n ")" ::: "memory")
#define PG8_WAIT_L(n) asm volatile("s_waitcnt lgkmcnt(" #n ")" ::: "memory")
#define PG8_BAR __builtin_amdgcn_s_barrier()
#define PG8_SCHED __builtin_amdgcn_sched_barrier(0)
    Unit cur, nxt; int ui = 0;
    if (!S.next(0, cur)) return;
    f32x4 acc[2][2][4][2];
#pragma unroll
    for (int a = 0; a < 2; ++a)
#pragma unroll
        for (int b = 0; b < 2; ++b)
#pragma unroll
            for (int m = 0; m < 4; ++m)
#pragma unroll
                for (int n = 0; n < 2; ++n) acc[a][b][m][n] = (f32x4){0.f, 0.f, 0.f, 0.f};
    bf16x8 At[4][2], B0[2][2], B1[2][2];
    const char* cA = (const char*)g.A + (size_t)cur.pm * tstep; const char* cB = (const char*)g.Bt + (size_t)cur.pn * tstep;
    S.a_ready(cur);
    if constexpr (SP2) {
        PG8_STAGE(PG8_SB(0, 0), cB, voffB); PG8_STAGE(PG8_SB(0, 1), cB + hstep, voffB); PG8_STAGE(PG8_SA(0, 0), cA, voffA); PG8_STAGE(PG8_SA(0, 1), cA + hstep, voffA);
        if (wr == 1) PG8_BAR;
        PG8_WAIT_V(2); PG8_BAR;
        PG8_STAGE(PG8_SB(1, 0), cB + kstep, voffB); PG8_STAGE(PG8_SA(1, 0), cA + kstep, voffA); PG8_STAGE(PG8_SB(1, 1), cB + hstep + kstep, voffB);
        PG8_WAIT_V(6); PG8_BAR;
    } else {
        PG8_STAGE(PG8_SB(0, 0), cB, voffB); PG8_STAGE(PG8_SA(0, 0), cA, voffA); PG8_STAGE(PG8_SB(0, 1), cB + hstep, voffB); PG8_STAGE(PG8_SA(0, 1), cA + hstep, voffA);
        if (wr == 1) PG8_BAR;
        PG8_WAIT_V(4); PG8_BAR;
        PG8_STAGE(PG8_SB(1, 0), cB + kstep, voffB); PG8_STAGE(PG8_SA(1, 0), cA + kstep, voffA); PG8_STAGE(PG8_SB(1, 1), cB + hstep + kstep, voffB);
        PG8_WAIT_V(6); PG8_BAR;
    }
    for (;;) {
        const bool has_next = S.next(ui + 1, nxt);
        const char* nA = has_next ? (const char*)g.A + (size_t)nxt.pm * tstep : cA; const char* nB = has_next ? (const char*)g.Bt + (size_t)nxt.pn * tstep : cB;
        for (int t = 0; t < nt; t += 2) {
            const bool last = (t == nt - 2);
            const char* a1 = cA + (size_t)(t + 1) * kstep;
            const char* a2 = last ? nA : cA + (size_t)(t + 2) * kstep; const char* b2 = last ? nB : cB + (size_t)(t + 2) * kstep;
            const char* a3 = a2 + kstep; const char* b3 = b2 + kstep;
            if (last && has_next) S.a_ready(nxt);
            if constexpr (SP2) {
            PG8_LDB(B0, 0, 0); PG8_LDB(B1, 0, 1); PG8_SCHED; PG8_LDA(At, 0, 0); PG8_STAGE(PG8_SA(1, 1), a1 + hstep, voffA);
            PG8_WAIT_V(8); PG8_WAIT_L(0); PG8_BAR; PG8_MMA(0, 0, At, B0); PG8_MMA(0, 1, At, B1); PG8_BAR; PG8_SCHED;
            PG8_LDA(At, 0, 1); PG8_STAGE(PG8_SB(0, 0), b2, voffB); PG8_STAGE(PG8_SB(0, 1), b2 + hstep, voffB); PG8_STAGE(PG8_SA(0, 0), a2, voffA);
            PG8_WAIT_V(8); PG8_WAIT_L(0); PG8_BAR; PG8_MMA(1, 0, At, B0); PG8_MMA(1, 1, At, B1); PG8_BAR; PG8_SCHED;
            PG8_LDB(B0, 1, 0); PG8_LDB(B1, 1, 1); PG8_SCHED; PG8_LDA(At, 1, 0); PG8_STAGE(PG8_SA(0, 1), a2 + hstep, voffA);
            PG8_WAIT_V(8); PG8_WAIT_L(0); PG8_BAR; PG8_MMA(0, 0, At, B0); PG8_MMA(0, 1, At, B1); PG8_BAR; PG8_SCHED;
            PG8_LDA(At, 1, 1); PG8_STAGE(PG8_SB(1, 0), b3, voffB); PG8_STAGE(PG8_SB(1, 1), b3 + hstep, voffB); PG8_STAGE(PG8_SA(1, 0), a3, voffA);
            PG8_WAIT_V(8); PG8_WAIT_L(0); PG8_BAR; PG8_MMA(1, 0, At, B0); PG8_MMA(1, 1, At, B1); PG8_BAR; PG8_SCHED;
            } else {
            PG8_LDB(B0, 0, 0); PG8_SCHED; PG8_LDA(At, 0, 0); PG8_STAGE(PG8_SA(1, 1), a1 + hstep, voffA);
            PG8_WAIT_L(8); PG8_BAR; PG8_WAIT_L(0); PG8_MMA(0, 0, At, B0); PG8_BAR; PG8_SCHED;
            PG8_LDB(B1, 0, 1); PG8_STAGE(PG8_SB(0, 0), b2, voffB);
            PG8_BAR; PG8_WAIT_L(0); PG8_MMA(0, 1, At, B1); PG8_BAR;
            PG8_LDA(At, 0, 1); PG8_STAGE(PG8_SA(0, 0), a2, voffA);
            PG8_BAR; PG8_WAIT_L(0); PG8_MMA(1, 0, At, B0); PG8_BAR; PG8_SCHED;
            PG8_STAGE(PG8_SB(0, 1), b2 + hstep, voffB);
            PG8_WAIT_V(6); PG8_BAR; PG8_MMA(1, 1, At, B1); PG8_BAR;
            PG8_LDB(B0, 1, 0); PG8_SCHED; PG8_LDA(At, 1, 0); PG8_STAGE(PG8_SA(0, 1), a2 + hstep, voffA);
            PG8_WAIT_L(8); PG8_BAR; PG8_WAIT_L(0); PG8_MMA(0, 0, At, B0); PG8_BAR; PG8_SCHED;
            PG8_LDB(B1, 1, 1); PG8_STAGE(PG8_SB(1, 0), b3, voffB);
            PG8_BAR; PG8_WAIT_L(0); PG8_MMA(0, 1, At, B1); PG8_BAR;
            PG8_LDA(At, 1, 1); PG8_STAGE(PG8_SA(1, 0), a3, voffA);
            PG8_BAR; PG8_WAIT_L(0); PG8_MMA(1, 0, At, B0); PG8_BAR; PG8_SCHED;
            PG8_STAGE(PG8_SB(1, 1), b3 + hstep, voffB);
            PG8_WAIT_V(6); PG8_BAR; PG8_MMA(1, 1, At, B1); PG8_BAR;
            }
        }
        if constexpr (ALIGN_EPI) { if (wr == 0) PG8_BAR; }
        if constexpr (!Epi::AFTER_DRAIN) { E(acc, cur, wr, wc, fr, fq); S.done(cur); }
        if (!has_next) break;
#pragma unroll
        for (int a = 0; a < 2; ++a)
#pragma unroll
            for (int b = 0; b < 2; ++b)
#pragma unroll
                for (int m = 0; m < 4; ++m)
#pragma unroll
                    for (int n = 0; n < 2; ++n) acc[a][b][m][n] = (f32x4){0.f, 0.f, 0.f, 0.f};
        cur = nxt; cA = nA; cB = nB; ++ui;
        if constexpr (ALIGN_EPI) { if (wr == 1) PG8_BAR; }
    }
    PG8_WAIT_V(0);
    if constexpr (!ALIGN_EPI) { if (wr == 0) PG8_BAR; }
    PG8_BAR;
    if constexpr (Epi::AFTER_DRAIN) { E.fused(acc, cur, wr, wc, fr, fq, lds, wid, lane); S.done(cur); }
#undef PG8_SA
#undef PG8_SB
#undef PG8_STAGE
#undef PG8_LDA
#undef PG8_LDB
#undef PG8_MMA
#undef PG8_WAIT_V
#undef PG8_WAIT_L
#undef PG8_BAR
#undef PG8_SCHED
}
}

constexpr int DM = 1024, NB = 2, SEQ = 16384, CTXL = 256, RL = NB * SEQ, RC = NB * CTXL, RT = RL + RC;
constexpr int NKT = (SEQ + CTXL) / 64;
constexpr int KT_BYTES = 64 * 128, VT_BYTES = 64 * 128;
constexpr int NCH = 260, CSTF = 4160;
constexpr float EPS = 1e-6f;
constexpr float QSCALE = 0.10206207261596577f * 1.4426950408889634f;
constexpr int NPH_L = 13, NPHASES = 1 + 2 * NPH_L;


constexpr size_t MiB = 1u << 20;
constexpr size_t WS_CTL = 0, CTL_ZERO_BYTES = 64 * 1024;
constexpr size_t WS_WIN = 1 * MiB, WS_WUQ = 9 * MiB, WS_WUKV = 11 * MiB, WS_WOUT = 12 * MiB, WS_WPQ = 16 * MiB, WS_SUBK = 24 * MiB;
constexpr size_t WS_MOD = 25 * MiB, WS_ROPE = 25 * MiB + 256 * 1024, WS_SC = 25 * MiB + 512 * 1024, WS_MS = WS_SC + 64 * 1024;
constexpr size_t WS_CTXS = 26 * MiB, WS_G = 28 * MiB, WS_KR = 31 * MiB, WS_TABU = 34 * MiB, WS_TABV = 66 * MiB;
constexpr size_t WS_ZA = 98 * MiB, WS_ZB = 163 * MiB, WS_Q = WS_ZA, WS_PQ = WS_ZA;
constexpr size_t WS_XN = 228 * MiB, WS_QA = WS_XN, WS_KVA = 253 * MiB, WS_VT = WS_XN;
constexpr size_t WS_MIX = 293 * MiB, WS_R66 = 358 * MiB, WS_KVRAW = WS_R66, WS_CST = WS_R66, WS_EID = WS_R66, WS_GATE = WS_R66 + 17 * MiB;
constexpr size_t WS_KN = 425 * MiB, WS_Q8 = 458 * MiB, WS_MODP = 491 * MiB, WS_END = 493 * MiB;
static_assert(WS_QA + (size_t)RT * 384 * 2 <= WS_KVA && WS_KVA + (size_t)RT * 256 * 2 <= WS_MIX, "QA/KVA inside the XN region");
static_assert(WS_VT + (size_t)NB * 8 * NKT * VT_BYTES <= WS_MIX, "Vt inside the XN region");
static_assert(WS_CST + (size_t)16 * NCH * CSTF * 4 <= WS_KN && WS_KVRAW + (size_t)RT * 1024 * 2 <= WS_KN, "R66 region");
static_assert(WS_KN + (size_t)NB * 8 * NKT * KT_BYTES <= WS_Q8 && WS_Q8 + (size_t)RT * 1024 <= WS_MODP, "Kn / Q8 regions");
static_assert(WS_G + (size_t)RT * 16 * 4 <= WS_KR && WS_KR + (size_t)RT * 32 * 2 <= WS_TABU, "G/KR");
constexpr int CW_BAR = 1024;

constexpr int LDS_BYTES = 147456, MISC_OFF = 143360;

#define LAS __attribute__((address_space(3)))
typedef unsigned short bf16;
typedef short bf16x8 __attribute__((ext_vector_type(8)));
typedef float f32x4 __attribute__((ext_vector_type(4)));
typedef float f32x16 __attribute__((ext_vector_type(16)));
typedef unsigned u32x4 __attribute__((ext_vector_type(4)));
typedef unsigned u32x2 __attribute__((ext_vector_type(2)));
#define LDS_WAIT() asm volatile("s_waitcnt lgkmcnt(0)" ::: "memory")

typedef float f32x2_t __attribute__((ext_vector_type(2))); typedef __bf16 bf16x2_t __attribute__((ext_vector_type(2)));
__device__ __forceinline__ unsigned pk2(float lo, float hi) { f32x2_t v = {lo, hi}; bf16x2_t b = __builtin_convertvector(v, bf16x2_t); return __builtin_bit_cast(unsigned, b); }
__device__ __forceinline__ unsigned f2bf(float f) { return pk2(f, 0.f) & 0xffffu; }
__device__ __forceinline__ float bflo(unsigned w) { return __builtin_bit_cast(float, w << 16); }
__device__ __forceinline__ float bfhi(unsigned w) { return __builtin_bit_cast(float, w & 0xffff0000u); }
__device__ __forceinline__ float bf2f(bf16 v) { return __builtin_bit_cast(float, (unsigned)v << 16); }
__device__ __forceinline__ float shfl_idx(float v, int srclane) { return __builtin_bit_cast(float, __builtin_amdgcn_ds_bpermute(srclane << 2, __builtin_bit_cast(int, v))); }
__device__ __forceinline__ int shfl_idx(int v, int srclane) { return __builtin_amdgcn_ds_bpermute(srclane << 2, v); }
#define DPP_ADD(v, ctrl) (v) += __builtin_bit_cast(float, __builtin_amdgcn_update_dpp(0, __builtin_bit_cast(int, (v)), (ctrl), 0xf, 0xf, true))
__device__ __forceinline__ float wave_sum(float v, int lane) {
    (void)lane;
    DPP_ADD(v, 0xB1);
    DPP_ADD(v, 0x4E);
    DPP_ADD(v, 0x141);
    DPP_ADD(v, 0x140);
    const int b = __builtin_bit_cast(int, v);
    return (__builtin_bit_cast(float, __builtin_amdgcn_readlane(b, 0)) + __builtin_bit_cast(float, __builtin_amdgcn_readlane(b, 16))) +
           (__builtin_bit_cast(float, __builtin_amdgcn_readlane(b, 32)) + __builtin_bit_cast(float, __builtin_amdgcn_readlane(b, 48)));
}
__device__ __forceinline__ float wave_max(float v, int lane) {
#pragma unroll
    for (int o = 1; o < 64; o <<= 1) v = fmaxf(v, shfl_idx(v, lane ^ o));
    return v;
}
__device__ __forceinline__ int crow(int g, int hh) { return (g & 3) + 8 * (g >> 2) + 4 * hh; }
__device__ __forceinline__ bf16x8 pack8(float a0, float a1, float a2, float a3, float a4, float a5, float a6, float a7) {
    u32x4 w; w.x = pk2(a0, a1); w.y = pk2(a2, a3); w.z = pk2(a4, a5); w.w = pk2(a6, a7); return __builtin_bit_cast(bf16x8, w);
}
__device__ __forceinline__ float gelu_f(float v) {
    const float av = fabsf(v), d = av * 0.2316418882f + 1.0f; const float t = __builtin_amdgcn_rcpf(d);
    float q = t * 0.5307027145f + (-0.7265760135f); q = q * t + 0.7107068705f; q = q * t + (-0.142248368f); q = q * t + 0.127414796f; q = q * t;
    const float e = __builtin_amdgcn_exp2f(v * v * (-0.72134752044f));
    const float mm = v * (q * e); return v < 0.f ? mm : v - mm;
}
#define MFMA32(a, b, c) __builtin_amdgcn_mfma_f32_32x32x16_bf16((a), (b), (c), 0, 0, 0)
#define ML_ZERO16 (f32x16){0.f, 0.f, 0.f, 0.f, 0.f, 0.f, 0.f, 0.f, 0.f, 0.f, 0.f, 0.f, 0.f, 0.f, 0.f, 0.f}

#define XB_TMO      128
#define XB_XCNT(j)  (256  + 64 * (j))
#define XB_XSUB(j)  (1280 + 64 * (j))
#define XB_XGEN(j)  (2304 + 64 * (j))
#define XB_TOP      3328
#define XB_TOPGEN   3392
#define XCD_BAR_WORDS 3456
#define XB_SPIN_CAP (1u << 18)
__device__ __forceinline__ unsigned xb_ld(unsigned* p)              { return __hip_atomic_load(p, __ATOMIC_RELAXED, __HIP_MEMORY_SCOPE_AGENT); }
__device__ __forceinline__ unsigned xb_add(unsigned* p, unsigned v) { return __hip_atomic_fetch_add(p, v, __ATOMIC_RELAXED, __HIP_MEMORY_SCOPE_AGENT); }
__device__ __forceinline__ unsigned xb_xcc_id() { return (unsigned)__builtin_amdgcn_s_getreg((3 << 11) | 20) & 0xFu; }
#define XB_SPIN(cond, bar) do { unsigned _sp = 0; while (cond) { __builtin_amdgcn_s_sleep(1); \
    if ((++_sp & 255u) == 0u) { if (xb_ld(&(bar)[XB_TMO])) break; if (_sp > XB_SPIN_CAP) { atomicAdd(&(bar)[XB_TMO], 1u); break; } } } } while (0)
struct XcdBarrier { unsigned* bar; unsigned x; volatile LAS unsigned* st; };
__device__ __forceinline__ XcdBarrier xcd_barrier_post(unsigned* bar, volatile LAS unsigned* st) {
    XcdBarrier b; b.bar = bar; b.x = xb_xcc_id(); b.st = st;
    if (threadIdx.x == 0) (void)xb_add(&bar[XB_XCNT(b.x)], 1u);
    return b;
}
__device__ __forceinline__ void xcd_barrier_complete(unsigned* bar, unsigned x, unsigned& nloc, unsigned& nx) {
    const unsigned G = gridDim.x * gridDim.y * gridDim.z;
    unsigned sum, cnt, mine, sp = 0u;
    for (;;) {
        sum = 0u; cnt = 0u; mine = 0u;
#pragma unroll
        for (unsigned j = 0; j < 16; ++j) { const unsigned c = xb_ld(&bar[XB_XCNT(j)]); sum += c; cnt += (c > 0u) ? 1u : 0u; mine = (j == x) ? c : mine; }
        if (sum == G) break;
        __builtin_amdgcn_s_sleep(1);
        if ((++sp & 255u) == 0u) { if (xb_ld(&bar[XB_TMO])) break; if (sp > XB_SPIN_CAP) { atomicAdd(&bar[XB_TMO], 1u); break; } }
    }
    nloc = mine > 0u ? mine : 1u; nx = cnt > 0u ? cnt : 1u;
}
__device__ __forceinline__ void xcd_barrier(const XcdBarrier& b) {
    asm volatile("s_waitcnt vmcnt(0)" ::: "memory");
    __syncthreads();
    if (threadIdx.x == 0) {
        unsigned* bar = b.bar;
        __builtin_amdgcn_s_waitcnt(0);
        unsigned nloc = b.st[0], nx = b.st[1];
        if (nloc == 0u) { xcd_barrier_complete(bar, b.x, nloc, nx); b.st[0] = nloc; b.st[1] = nx; }
        const unsigned old = xb_add(&bar[XB_XSUB(b.x)], 1u);
        const unsigned gen = old / nloc;
        if (old + 1u == (gen + 1u) * nloc) {
            __builtin_amdgcn_fence(__ATOMIC_RELEASE, "agent");
            asm volatile("s_waitcnt vmcnt(0)" ::: "memory");
            const unsigned og = xb_add(&bar[XB_TOP], 1u);
            const unsigned tg = og / nx;
            if (og + 1u == (tg + 1u) * nx) xb_add(&bar[XB_TOPGEN], 1u);
            else XB_SPIN(xb_ld(&bar[XB_TOPGEN]) == tg, bar);
            __builtin_amdgcn_fence(__ATOMIC_ACQUIRE, "agent");
            xb_add(&bar[XB_XGEN(b.x)], 1u);
            asm volatile("s_waitcnt vmcnt(0)" ::: "memory");
        } else {
            XB_SPIN(xb_ld(&bar[XB_XGEN(b.x)]) == gen, bar);
            __builtin_amdgcn_fence(__ATOMIC_ACQUIRE, "agent");
            asm volatile("s_waitcnt vmcnt(0)" ::: "memory");
        }
    }
    __syncthreads();
}

struct Args { const float* in[24]; float* out; unsigned char* ws; int ph_lo, ph_hi; };
#define CAS __attribute__((address_space(4)))
typedef const CAS unsigned char* karg_t;
struct KA { karg_t p;
    __device__ __forceinline__ const float* in(int k) const { return *(const float* const CAS*)(p + 8 * k); }
    __device__ __forceinline__ float* out() const { return *(float* const CAS*)(p + 192); }
    __device__ __forceinline__ unsigned char* ws() const { return *(unsigned char* const CAS*)(p + 200); }
    __device__ __forceinline__ int ph_lo() const { return *(const int CAS*)(p + 208); }
    __device__ __forceinline__ int ph_hi() const { return *(const int CAS*)(p + 212); }
};
static_assert(sizeof(Args) == 216, "Args layout");
__device__ __forceinline__ KA ka_fresh() { KA a; a.p = (karg_t)__builtin_amdgcn_kernarg_segment_ptr(); asm volatile("" : "+s"(a.p)); return a; }
struct Ctx {
    LAS unsigned char* lds;
    int tid, lane, wave, G, bid;
};
__device__ __forceinline__ Ctx ctx_fresh() {
    extern __shared__ __attribute__((aligned(16))) unsigned char lds_raw[];
    Ctx C; C.lds = (LAS unsigned char*)lds_raw; int t = threadIdx.x; asm volatile("" : "+v"(t));
    C.tid = t; C.lane = t & 63; C.wave = __builtin_amdgcn_readfirstlane(t >> 6); C.G = gridDim.x; C.bid = blockIdx.x; return C;
}
__device__ __forceinline__ const float* stream_in(const KA& A, const Ctx& C, int l, int row) {
    if (row < RL) return (l == 0 ? A.in(0) : (const float*)A.out()) + (size_t)row * DM;
    return (l == 0 ? A.in(2) : (const float*)(A.ws() + WS_CTXS)) + (size_t)(row - RL) * DM;
}
__device__ __forceinline__ float* stream_out(const KA& A, const Ctx& C, int row) {
    if (row < RL) return A.out() + (size_t)row * DM;
    return (float*)(A.ws() + WS_CTXS) + (size_t)(row - RL) * DM;
}

__device__ __forceinline__ void p0_transpose_item(const float* W, int K, int N, bf16* WT, int n0, int dst_row0, LAS float* scr, int kb, int lane) {
    const int k0 = 64 * kb;
#pragma unroll 8
    for (int i = 0; i < 32; ++i) { const int kk = 2 * i + (lane >> 5); const int n = n0 + (lane & 31); scr[kk * 33 + (lane & 31)] = (n < N) ? W[(size_t)(k0 + kk) * N + n] : 0.f; }
    LDS_WAIT(); asm volatile("" ::: "memory");
    const int c = lane & 7;
#pragma unroll
    for (int j = 0; j < 4; ++j) { const int n = (lane >> 3) + 8 * j; const LAS float* s = scr + (8 * c) * 33 + n;
        u32x4 o; o.x = pk2(s[0 * 33], s[1 * 33]); o.y = pk2(s[2 * 33], s[3 * 33]); o.z = pk2(s[4 * 33], s[5 * 33]); o.w = pk2(s[6 * 33], s[7 * 33]);
        *(u32x4*)(WT + (size_t)(dst_row0 + n) * K + k0 + 8 * c) = o; }
    LDS_WAIT(); asm volatile("" ::: "memory");
}
__device__ __forceinline__ void p0_poolw_item(const float* Win, const float* Wp, bf16* WT, LAS float* scr, int kb, int nb, int lane) {
    const int k0 = 64 * kb, g = nb >> 1, e = (nb & 1) * 32 + (lane & 31);
    float wc[64];
#pragma unroll
    for (int c = 0; c < 64; ++c) wc[c] = Wp[((size_t)g * 64 + c) * 64 + e];
#pragma unroll 2
    for (int i = 0; i < 32; ++i) { const int kk = 2 * i + (lane >> 5); const float* wr = Win + (size_t)(k0 + kk) * 1968 + g * 64; float a = 0.f;
#pragma unroll
        for (int c4 = 0; c4 < 16; ++c4) { const f32x4 x = *(const f32x4*)(wr + 4 * c4); a += x.x * wc[4 * c4] + x.y * wc[4 * c4 + 1] + x.z * wc[4 * c4 + 2] + x.w * wc[4 * c4 + 3]; }
        scr[kk * 33 + (lane & 31)] = a; }
    LDS_WAIT(); asm volatile("" ::: "memory");
    const int c = lane & 7;
#pragma unroll
    for (int j = 0; j < 4; ++j) { const int n = (lane >> 3) + 8 * j; const LAS float* sp = scr + (8 * c) * 33 + n;
        u32x4 o; o.x = pk2(sp[0 * 33], sp[1 * 33]); o.y = pk2(sp[2 * 33], sp[3 * 33]); o.z = pk2(sp[4 * 33], sp[5 * 33]); o.w = pk2(sp[6 * 33], sp[7 * 33]);
        *(u32x4*)(WT + (size_t)(32 * nb + n) * DM + k0 + 8 * c) = o; }
    LDS_WAIT(); asm volatile("" ::: "memory");
}
__device__ __forceinline__ void phase_prologue() {
    const KA A = ka_fresh(); const Ctx C = ctx_fresh();
    LAS float* scr = (LAS float*)(C.lds + C.wave * 16384);
    const int gw = C.bid * 8 + C.wave, NGW = C.G * 8, lane = C.lane;
    float* MODP = (float*)(A.ws() + WS_MODP);
    for (int it = gw; it < 2 * 96 * 8; it += NGW) {
        const int ks = it & 7, l = (it >> 3) / 96, j = ((it >> 3) % 96) * 64 + lane;
        const float* W = A.in(6) + ((size_t)l * DM + ks * 128) * 6144 + j;
        const float* c01 = A.in(1) + ks * 128; const float* c2p = A.in(3) + ks * 128;
        float a0 = 0.f, a1 = 0.f, a2 = 0.f;
#pragma unroll 16
        for (int k = 0; k < 128; ++k) {
            const float w = W[(size_t)k * 6144];
            const float c0 = c01[k], c1 = c01[DM + k], c2 = c2p[k];
            a0 += (c0 / (1.f + __expf(-c0))) * w; a1 += (c1 / (1.f + __expf(-c1))) * w; a2 += (c2 / (1.f + __expf(-c2))) * w;
        }
        float* mp = MODP + ((size_t)(l * 8 + ks) * 3) * 6144 + j;
        mp[0] = a0; mp[6144] = a1; mp[2 * 6144] = a2;
    }
    constexpr int I_IN = 16 * 64, I_UQ = 6 * 24, I_UKV = 4 * 32, I_OUT = 16 * 32, I_PQ = 16 * 64, I_L = I_IN + I_UQ + I_UKV + I_OUT + I_PQ;
    for (int it = gw; it < 2 * I_L; it += NGW) {
        const int l = it / I_L; int r = it % I_L;
        if (r < I_IN) {
            const int kb = r / 64, nb = r % 64;
            if (nb < 8) { p0_poolw_item(A.in(8) + (size_t)l * DM * 1968, A.in(9) + (size_t)l * 4 * 64 * 64, (bf16*)(A.ws() + WS_WIN) + (size_t)l * 2048 * DM, scr, kb, nb, lane); continue; }
            const int dst = nb < 29 ? 32 * nb : (nb < 61 ? 96 + 32 * nb : (nb == 61 ? 928 : (nb == 62 ? 960 : 992)));
            const int n0 = nb < 62 ? 32 * nb : 4096;
            p0_transpose_item(A.in(8) + (size_t)l * DM * 1968, DM, 1968, (bf16*)(A.ws() + WS_WIN) + (size_t)l * 2048 * DM, n0, dst, scr, kb, lane); continue; }
        r -= I_IN;
        if (r < I_UQ) { const int kb = r / 24, nb = r % 24; p0_transpose_item(A.in(13) + (size_t)l * 384 * 768, 384, 768, (bf16*)(A.ws() + WS_WUQ) + (size_t)l * 768 * 384, 32 * nb, 32 * nb, scr, kb, lane); continue; }
        r -= I_UQ;
        if (r < I_UKV) { const int kb = r / 32, nb = r % 32; p0_transpose_item(A.in(14) + (size_t)l * 256 * 1024, 256, 1024, (bf16*)(A.ws() + WS_WUKV) + (size_t)l * 1024 * 256, 32 * nb, 32 * nb, scr, kb, lane); continue; }
        r -= I_UKV;
        if (r < I_OUT) { const int kb = r / 32, nb = r % 32; p0_transpose_item(A.in(19) + (size_t)l * DM * DM, DM, DM, (bf16*)(A.ws() + WS_WOUT) + (size_t)l * DM * DM, 32 * nb, 32 * nb, scr, kb, lane); continue; }
        r -= I_OUT;
        { const int kb = r / 64, nb = r % 64; p0_transpose_item(A.in(20) + (size_t)l * DM * 2048, DM, 2048, (bf16*)(A.ws() + WS_WPQ) + (size_t)l * 2048 * DM, 32 * nb, 32 * nb, scr, kb, lane); }
    }
    const int gt = C.bid * 512 + C.tid, NT = C.G * 512;
    { const float* s = A.in(21); bf16* d = (bf16*)(A.ws() + WS_SUBK);
      for (int i = gt; i < 2 * 8 * 2 * 128 * 128 / 4; i += NT) { const f32x4 v = *(const f32x4*)(s + 4 * (size_t)i); u32x2 o; o.x = pk2(v.x, v.y); o.y = pk2(v.z, v.w); *(u32x2*)(d + 4 * (size_t)i) = o; } }
    { float* rp = (float*)(A.ws() + WS_ROPE);
      for (int i = gt; i < 256 * 8; i += NT) { const int p = i >> 3, f = i & 7;
          const float fr[8] = {1.0f, 0.31622776601683794f, 0.1f, 0.031622776601683794f, 0.01f, 0.0031622776601683794f, 0.001f, 0.00031622776601683794f};
          float fq = fr[0];
#pragma unroll
          for (int q = 1; q < 8; ++q) fq = (f == q) ? fr[q] : fq;
          const float ang = (float)p * fq;
          const double rev = (double)ang * 0.15915494309189535; const float fracr = (float)(rev - floor(rev));
          rp[2 * i] = __builtin_amdgcn_cosf(fracr); rp[2 * i + 1] = __builtin_amdgcn_sinf(fracr); } }
}

__device__ __forceinline__ void phase_modreduce() {
    const KA A = ka_fresh(); const Ctx C = ctx_fresh();
    const int gt = C.bid * 512 + C.tid, NT = C.G * 512;
    const float* MODP = (const float*)(A.ws() + WS_MODP); float* MOD = (float*)(A.ws() + WS_MOD);
    for (int i = gt; i < 2 * 3 * 6144; i += NT) { const int l = i / (3 * 6144), rem = i % (3 * 6144), j = rem % 6144;
        float a = A.in(7)[l * 6144 + j];
#pragma unroll
        for (int ks = 0; ks < 8; ++ks) a += MODP[((size_t)(l * 8 + ks) * 3) * 6144 + rem];
        MOD[i] = a; }
}
__device__ __forceinline__ void phase_norm(int l, int which) {
    const KA A = ka_fresh(); const Ctx C = ctx_fresh();
    const int gw = C.bid * 8 + C.wave, NGW = C.G * 8, lane = C.lane;
    const float* gain = A.in(which ? 5 : 4) + l * DM;
    const float* MOD = (const float*)(A.ws() + WS_MOD);
    bf16* XN = (bf16*)(A.ws() + WS_XN);
    const int nrows = (which == 1 && l == 1) ? RL : RT;
    for (int row = gw; row < nrows; row += NGW) {
        const float* xr = (which == 0) ? stream_in(A, C, l, row) : (const float*)stream_out(A, C, row);
        const int nsel = row < RL ? (row >> 14) : 2;
        const float* md = MOD + (l * 3 + nsel) * 6144 + which * 3072;
        f32x4 v[4]; float ss = 0.f;
#pragma unroll
        for (int i = 0; i < 4; ++i) { v[i] = *(const f32x4*)(xr + 4 * lane + 256 * i); ss += (v[i].x * v[i].x + v[i].y * v[i].y) + (v[i].z * v[i].z + v[i].w * v[i].w); }
        const float rs = 1.0f / sqrtf(wave_sum(ss, lane) * (1.f / DM) + EPS);
#pragma unroll
        for (int i = 0; i < 4; ++i) { const int j = 4 * lane + 256 * i;
            const f32x4 g = *(const f32x4*)(gain + j), sh = *(const f32x4*)(md + j), sc = *(const f32x4*)(md + 1024 + j);
            const f32x4 y = v[i] * rs * g * (sc + 1.0f) + sh;
            u32x2 o; o.x = pk2(y.x, y.y); o.y = pk2(y.z, y.w); *(u32x2*)(XN + (size_t)row * DM + j) = o; }
    }
}
constexpr float U_SCALE = 48.f, V_SCALE = 1.5f;
constexpr int TROW = 768;
struct __attribute__((packed, aligned(4))) U3 { unsigned a, b, c; };
__device__ __forceinline__ unsigned q_e2m3(float x) {
    const unsigned sg = (__builtin_bit_cast(unsigned, x) >> 31) << 5;
    const float a = fminf(fabsf(x), 7.5f);
    const float t = a * (a < 2.f ? 8.f : (a < 4.f ? 4.f : 2.f));
    return sg | ((unsigned)__builtin_rintf(t) + (a < 2.f ? 0u : (a < 4.f ? 8u : 16u)));
}
__device__ __forceinline__ void phase_tables(int l) {
    const KA A = ka_fresh(); const Ctx C = ctx_fresh();
    const size_t gt = (size_t)C.bid * 512 + C.tid, NT = (size_t)C.G * 512;
    const size_t n16 = (size_t)16384 * 1024 / 16;
#pragma unroll
    for (int w = 0; w < 2; ++w) {
        const float* s = A.in(22 + w) + (size_t)l * 16384 * 1024; unsigned char* d = A.ws() + (w ? WS_TABV : WS_TABU);
        const float sc = w ? V_SCALE : U_SCALE;
        for (size_t i = gt; i < n16; i += NT) {
            unsigned c[16];
#pragma unroll
            for (int q = 0; q < 4; ++q) { const f32x4 x = *(const f32x4*)(s + 16 * i + 4 * q);
                c[4 * q] = q_e2m3(x.x * sc); c[4 * q + 1] = q_e2m3(x.y * sc); c[4 * q + 2] = q_e2m3(x.z * sc); c[4 * q + 3] = q_e2m3(x.w * sc); }
            U3 o;
            o.a = c[0] | (c[1] << 6) | (c[2] << 12) | (c[3] << 18) | (c[4] << 24) | (c[5] << 30);
            o.b = (c[5] >> 2) | (c[6] << 4) | (c[7] << 10) | (c[8] << 16) | (c[9] << 22) | (c[10] << 28);
            o.c = (c[10] >> 4) | (c[11] << 2) | (c[12] << 8) | (c[13] << 14) | (c[14] << 20) | (c[15] << 26);
            *(U3*)(d + 12 * i) = o; }
    }
}

__device__ __forceinline__ void phase_post(int l) {
    const KA A = ka_fresh(); const Ctx C = ctx_fresh();
    const bf16* ZA = (const bf16*)(A.ws() + WS_ZA);
    bf16* MIX = (bf16*)(A.ws() + WS_MIX); bf16* QA = (bf16*)(A.ws() + WS_QA); bf16* KVA = (bf16*)(A.ws() + WS_KVA); bf16* KR = (bf16*)(A.ws() + WS_KR);
    float* GT = (float*)(A.ws() + WS_G);
    LAS float* U = (LAS float*)C.lds;
    const int tid = C.tid, lane = C.lane;
    for (int unit = C.bid; unit < RT / 32; unit += C.G) {
        const int r0 = unit * 32;
        int seq0, L;
        if (r0 < RL) { seq0 = (r0 >> 14) << 14; L = SEQ; } else { seq0 = RL + (((r0 - RL) >> 8) << 8); L = CTXL; }
        const int t0 = r0 - seq0;
        for (int idx = tid; idx < 48 * 32; idx += 512) { const int rr = idx >> 5, c8 = idx & 31; const int t = t0 - 8 + rr;
            u32x4 v = {0u, 0u, 0u, 0u};
            if (t >= 0 && t < L) v = *(const u32x4*)(ZA + (size_t)(seq0 + t) * 1024 + c8 * 8);
            LAS float* d = U + rr * 256 + c8 * 8;
            d[0] = bflo(v.x); d[1] = bfhi(v.x); d[2] = bflo(v.y); d[3] = bfhi(v.y); d[4] = bflo(v.z); d[5] = bfhi(v.z); d[6] = bflo(v.w); d[7] = bfhi(v.w); }
        __syncthreads();
        { const int ch = tid & 255, half = tid >> 8, hw = __builtin_amdgcn_readfirstlane(1 << (ch >> 6));
          const float sc = A.in(10)[l * 256 + ch];
          for (int i = half * 16; i < half * 16 + 16; ++i) { const int t = t0 + i; const int lo = max(t - hw, 0), hi = min(t + hw, L);
              float sm = 0.f; for (int tt = lo; tt < hi; ++tt) sm += U[(tt - t0 + 8) * 256 + ch];
              const float dv = sm / (float)(hi - lo) - U[(i + 8) * 256 + ch];
              MIX[(size_t)(r0 + i) * 1024 + ch] = (bf16)f2bf(dv * sc); } }
#pragma unroll
        for (int q = 0; q < 4; ++q) { const int row = r0 + C.wave * 4 + q; const bf16* za = ZA + (size_t)row * 1024;
            { float x[6]; float ss = 0.f;
#pragma unroll
              for (int i = 0; i < 3; ++i) { const unsigned w = *(const unsigned*)(za + 256 + 2 * lane + 128 * i); x[2 * i] = bflo(w); x[2 * i + 1] = bfhi(w); ss += x[2 * i] * x[2 * i] + x[2 * i + 1] * x[2 * i + 1]; }
              const float rs = 1.0f / sqrtf(wave_sum(ss, lane) * (1.f / 384.f) + EPS); const float* gq = A.in(11) + l * 384;
#pragma unroll
              for (int i = 0; i < 3; ++i) { const int j = 2 * lane + 128 * i; *(unsigned*)(QA + (size_t)row * 384 + j) = pk2(x[2 * i] * rs * gq[j], x[2 * i + 1] * rs * gq[j + 1]); } }
            { const u32x2 w = *(const u32x2*)(za + 640 + 4 * lane);
              const float x0 = bflo(w.x), x1 = bfhi(w.x), x2 = bflo(w.y), x3 = bfhi(w.y);
              const float rs = 1.0f / sqrtf(wave_sum(x0 * x0 + x1 * x1 + x2 * x2 + x3 * x3, lane) * (1.f / 256.f) + EPS); const float* gk = A.in(12) + l * 256 + 4 * lane;
              u32x2 o; o.x = pk2(x0 * rs * gk[0], x1 * rs * gk[1]); o.y = pk2(x2 * rs * gk[2], x3 * rs * gk[3]); *(u32x2*)(KVA + (size_t)row * 256 + 4 * lane) = o; }
            if (lane < 16) *(unsigned*)(KR + (size_t)row * 32 + 2 * lane) = *(const unsigned*)(za + 896 + 2 * lane);
            if (lane < 16) { float gv = bf2f(za[928 + lane]) + A.in(17)[l * 16 + lane];
                if ((lane >> 2) & 1) gv = fminf(gv, 0.f) - log1pf(__expf(-fabsf(gv)));
                GT[(size_t)row * 16 + lane] = gv; }
        }
        __syncthreads();
    }
}

__device__ __forceinline__ unsigned fp8x4(float a, float b, float c, float d) {
    a = __builtin_amdgcn_fmed3f(a, -448.f, 448.f); b = __builtin_amdgcn_fmed3f(b, -448.f, 448.f); c = __builtin_amdgcn_fmed3f(c, -448.f, 448.f); d = __builtin_amdgcn_fmed3f(d, -448.f, 448.f);
    int w = __builtin_amdgcn_cvt_pk_fp8_f32(a, b, 0, false); w = __builtin_amdgcn_cvt_pk_fp8_f32(c, d, w, true); return (unsigned)w;
}
__device__ __forceinline__ void qk_head(const bf16* src_lo, const bf16* src_hi, unsigned char* dst, int sw, const float* gn, bool rot, const float (&cs)[16], const float (&sn)[16], float oscale) {
    float ss = 0.f;
#pragma unroll 4
    for (int i = 0; i < 8; ++i) { const u32x4 w = *(const u32x4*)(src_lo + 8 * i);
        ss += (bflo(w.x) * bflo(w.x) + bfhi(w.x) * bfhi(w.x)) + (bflo(w.y) * bflo(w.y) + bfhi(w.y) * bfhi(w.y)) + (bflo(w.z) * bflo(w.z) + bfhi(w.z) * bfhi(w.z)) + (bflo(w.w) * bflo(w.w) + bfhi(w.w) * bfhi(w.w)); }
    u32x4 wr[4];
#pragma unroll
    for (int i = 0; i < 4; ++i) { wr[i] = *(const u32x4*)(src_hi + 8 * i); const u32x4 w = wr[i];
        ss += (bflo(w.x) * bflo(w.x) + bfhi(w.x) * bfhi(w.x)) + (bflo(w.y) * bflo(w.y) + bfhi(w.y) * bfhi(w.y)) + (bflo(w.z) * bflo(w.z) + bfhi(w.z) * bfhi(w.z)) + (bflo(w.w) * bflo(w.w) + bfhi(w.w) * bfhi(w.w)); }
    const float rs = oscale / sqrtf(ss * (1.f / 96.f) + EPS);
    __builtin_amdgcn_sched_barrier(0);
#pragma unroll 1
    for (int i = 0; i < 8; ++i) {
        const u32x4 w = *(const u32x4*)(src_lo + 8 * i); const f32x4 g0 = *(const f32x4*)(gn + 8 * i), g1 = *(const f32x4*)(gn + 8 * i + 4);
        u32x2 o; o.x = fp8x4(bflo(w.x) * rs * g0.x, bfhi(w.x) * rs * g0.y, bflo(w.y) * rs * g0.z, bfhi(w.y) * rs * g0.w);
        o.y = fp8x4(bflo(w.z) * rs * g1.x, bfhi(w.z) * rs * g1.y, bflo(w.w) * rs * g1.z, bfhi(w.w) * rs * g1.w);
        *(u32x2*)(dst + ((((i >> 1) ^ sw) << 4) + ((i & 1) << 3))) = o; }
    __builtin_amdgcn_sched_barrier(0);
#pragma unroll
    for (int i = 0; i < 2; ++i) {
        const u32x4 p = wr[i], q = wr[2 + i];
        const f32x4 ga = *(const f32x4*)(gn + 64 + 8 * i), gb = *(const f32x4*)(gn + 64 + 8 * i + 4), gc = *(const f32x4*)(gn + 80 + 8 * i), gd = *(const f32x4*)(gn + 80 + 8 * i + 4);
        float y1[8], y2[8];
        y1[0] = bflo(p.x) * rs * ga.x; y1[1] = bfhi(p.x) * rs * ga.y; y1[2] = bflo(p.y) * rs * ga.z; y1[3] = bfhi(p.y) * rs * ga.w; y1[4] = bflo(p.z) * rs * gb.x; y1[5] = bfhi(p.z) * rs * gb.y; y1[6] = bflo(p.w) * rs * gb.z; y1[7] = bfhi(p.w) * rs * gb.w;
        y2[0] = bflo(q.x) * rs * gc.x; y2[1] = bfhi(q.x) * rs * gc.y; y2[2] = bflo(q.y) * rs * gc.z; y2[3] = bfhi(q.y) * rs * gc.w; y2[4] = bflo(q.z) * rs * gd.x; y2[5] = bfhi(q.z) * rs * gd.y; y2[6] = bflo(q.w) * rs * gd.z; y2[7] = bfhi(q.w) * rs * gd.w;
        if (rot) {
#pragma unroll
            for (int j = 0; j < 8; ++j) { const float a = y1[j] * cs[8 * i + j] - y2[j] * sn[8 * i + j], bb = y2[j] * cs[8 * i + j] + y1[j] * sn[8 * i + j]; y1[j] = a; y2[j] = bb; }
        }
        u32x2 o; o.x = fp8x4(y1[0], y1[1], y1[2], y1[3]); o.y = fp8x4(y1[4], y1[5], y1[6], y1[7]); *(u32x2*)(dst + (((4 ^ sw) << 4) + (i << 3))) = o;
        u32x2 o2; o2.x = fp8x4(y2[0], y2[1], y2[2], y2[3]); o2.y = fp8x4(y2[4], y2[5], y2[6], y2[7]); *(u32x2*)(dst + (((5 ^ sw) << 4) + (i << 3))) = o2;
    }
    { u32x4 z; z.x = 0u; z.y = 0u; z.z = 0u; z.w = 0u; *(u32x4*)(dst + ((6 ^ sw) << 4)) = z; *(u32x4*)(dst + ((7 ^ sw) << 4)) = z; }
    __builtin_amdgcn_sched_barrier(0);
}
__device__ __forceinline__ void phase_qknorm(int l) {
    const KA A = ka_fresh(); const Ctx C = ctx_fresh();
    const int gw = C.bid * 8 + C.wave, NGW = C.G * 8, lane = C.lane;
    const bf16* Q = (const bf16*)(A.ws() + WS_Q); const bf16* KV = (const bf16*)(A.ws() + WS_KVRAW); const bf16* KR = (const bf16*)(A.ws() + WS_KR);
    unsigned char* KN = A.ws() + WS_KN; unsigned char* VT = A.ws() + WS_VT;
    const float* rope = (const float*)(A.ws() + WS_ROPE);
    const float* qg = A.in(15) + l * 96; const float* kg = A.in(16) + l * 96;
    for (int u = gw; u < (RT / 64) * 8; u += NGW) {
        const int h = u & 7, tl = u >> 3, row0 = tl * 64, row = row0 + lane;
        const bool lat = row0 < RL; int b, t0;
        if (lat) { b = row0 >> 14; t0 = row0 & (SEQ - 1); } else { b = (row0 - RL) >> 8; t0 = (row0 - RL) & 255; }
        const int ktile = lat ? (t0 >> 6) : (SEQ + t0) >> 6;
        float cs[16], sn[16];
#pragma unroll
        for (int i = 0; i < 16; ++i) { cs[i] = 1.f; sn[i] = 0.f; }
        if (lat) {
#pragma unroll
            for (int i = 0; i < 16; ++i) { const int p = (i < 8) ? (t0 >> 6) : lane; const float* rp = rope + (p * 8 + (i & 7)) * 2; cs[i] = rp[0]; sn[i] = rp[1]; }
        }
        { const bf16* qp = Q + (size_t)row * 768 + h * 96;
          qk_head(qp, qp + 64, A.ws() + WS_Q8 + (size_t)row * 1024 + h * 128, 0, qg, lat, cs, sn, QSCALE); }
        const bf16* kvp = KV + (size_t)row * 1024 + h * 128;
        qk_head(kvp, KR + (size_t)row * 32, KN + ((size_t)(b * 8 + h) * NKT + ktile) * KT_BYTES + lane * 128, (lane >> 1) & 7, kg, lat, cs, sn, 1.0f);
        { const int kap = lane & 15; const int pos = (lane & ~15) + 8 * ((kap >> 2) & 1) + 4 * (kap >> 3) + (kap & 3);
          bf16* vd = (bf16*)(VT + ((size_t)(b * 8 + h) * NKT + ktile) * VT_BYTES);
          const int pa = pos >> 3, pb = pos & 7;
#pragma unroll 1
          for (int i = 0; i < 8; ++i) { const u32x4 vv = *(const u32x4*)(kvp + 64 + 8 * i);
#pragma unroll
              for (int e = 0; e < 8; ++e) { const int d = 8 * i + e; const unsigned wd = (e >> 1) == 0 ? vv.x : ((e >> 1) == 1 ? vv.y : ((e >> 1) == 2 ? vv.z : vv.w)); const bf16 val = (bf16)((e & 1) ? (wd >> 16) : (wd & 0xffffu));
                  vd[(unsigned)(d * 64 + ((pa ^ ((d >> 1) & 7)) << 3) + pb)] = val; } } }
    }
}

__device__ __forceinline__ int ml_row(int b, int dir, int j, int s) {
    if (j < 4) { const int p = 64 * j + s; return RL + b * CTXL + (dir ? CTXL - 1 - p : p); }
    const int p = 64 * (j - 4) + s; return b * SEQ + (dir ? SEQ - 1 - p : p);
}
__device__ __forceinline__ void phase_ml_local() {
    const KA A = ka_fresh(); const Ctx C = ctx_fresh();
    const int gw = C.bid * 8 + C.wave, NGW = C.G * 8, lane = C.lane, r = lane & 31, hh = lane >> 5;
    const bf16* ZB = (const bf16*)(A.ws() + WS_ZB); const float* GT = (const float*)(A.ws() + WS_G);
    float* CST = (float*)(A.ws() + WS_CST); float* SC = (float*)(A.ws() + WS_SC);
    for (int u = gw; u < 16 * NCH; u += NGW) {
        const int sq = u / NCH, j = u % NCH, b = sq >> 3, h = (sq >> 1) & 3, dir = sq & 1;
        const int rowl = ml_row(b, dir, j, lane);
        const float gi = GT[(size_t)rowl * 16 + dir * 8 + h], lf = GT[(size_t)rowl * 16 + dir * 8 + 4 + h];
        float bs = lf;
#pragma unroll
        for (int o = 1; o < 64; o <<= 1) { const float tv = shfl_idx(bs, lane - o); if (lane >= o) bs += tv; }
        const float blast = shfl_idx(bs, 63);
        const float dec = blast + gi - bs;
        const float mloc = wave_max(dec, lane);
        const float w = __expf(dec - mloc);
        const int row0 = ml_row(b, dir, j, 0), rstep = dir ? -1 : 1;
        f32x16 acc[2][2];
#pragma unroll
        for (int vb = 0; vb < 2; ++vb)
#pragma unroll
            for (int db = 0; db < 2; ++db) acc[vb][db] = ML_ZERO16;
        float nacc0 = 0.f, nacc1 = 0.f;
#pragma unroll
        for (int st = 0; st < 4; ++st) {
            float ws[8]; unsigned rofs[8];
#pragma unroll
            for (int jj = 0; jj < 8; ++jj) { const int sidx = 16 * st + 8 * hh + jj; ws[jj] = shfl_idx(w, sidx); rofs[jj] = (unsigned)((row0 + rstep * sidx) * 1024 + h * 64 + r); }
            bf16x8 Af[2], Bf[2];
#pragma unroll
            for (int blk = 0; blk < 2; ++blk) {
                float kx[8];
#pragma unroll
                for (int jj = 0; jj < 8; ++jj) { kx[jj] = bf2f(ZB[rofs[jj] + 256 + 32 * blk]); Bf[blk][jj] = (short)ZB[rofs[jj] + 256 + 32 * blk]; }
                if (blk == 0) {
#pragma unroll
                    for (int jj = 0; jj < 8; ++jj) nacc0 += ws[jj] * kx[jj]; }
                else {
#pragma unroll
                    for (int jj = 0; jj < 8; ++jj) nacc1 += ws[jj] * kx[jj]; }
                float vx[8];
#pragma unroll
                for (int jj = 0; jj < 8; ++jj) vx[jj] = bf2f(ZB[rofs[jj] + 512 + 32 * blk]) * ws[jj];
                Af[blk] = pack8(vx[0], vx[1], vx[2], vx[3], vx[4], vx[5], vx[6], vx[7]);
            }
#pragma unroll
            for (int vb = 0; vb < 2; ++vb)
#pragma unroll
                for (int db = 0; db < 2; ++db) acc[vb][db] = MFMA32(Af[vb], Bf[db], acc[vb][db]);
            __builtin_amdgcn_sched_barrier(0);
        }
        float* cp = CST + (size_t)u * CSTF;
#pragma unroll
        for (int vb = 0; vb < 2; ++vb)
#pragma unroll
            for (int db = 0; db < 2; ++db)
#pragma unroll
                for (int g = 0; g < 16; ++g) cp[(32 * vb + crow(g, hh)) * 64 + 32 * db + r] = acc[vb][db][g];
        nacc0 += shfl_idx(nacc0, lane ^ 32); nacc1 += shfl_idx(nacc1, lane ^ 32);
        if (hh == 0) { cp[4096 + r] = nacc0; cp[4096 + 32 + r] = nacc1; }
        if (lane == 0) { SC[u * 2] = mloc; SC[u * 2 + 1] = blast; }
    }
}
__device__ __forceinline__ void phase_ml_scan() {
    const KA A = ka_fresh(); const Ctx C = ctx_fresh();
    const int gt = C.bid * 512 + C.tid, NT = C.G * 512;
    float* CST = (float*)(A.ws() + WS_CST); const float* SC = (const float*)(A.ws() + WS_SC); float* MS = (float*)(A.ws() + WS_MS);
    for (int e = gt; e < 16 * CSTF; e += NT) {
        const int sq = e / CSTF, el = e % CSTF;
        float* base = CST + (size_t)sq * NCH * CSTF + el;
        float cv = 0.f, m = -1e30f;
#pragma unroll 1
        for (int j0 = 0; j0 < NCH; j0 += 10) {
            float loc[10]; f32x2_t sc[10];
#pragma unroll
            for (int u = 0; u < 10; ++u) { loc[u] = base[(size_t)(j0 + u) * CSTF]; sc[u] = *(const f32x2_t*)(SC + (sq * NCH + j0 + u) * 2); }
#pragma unroll
            for (int u = 0; u < 10; ++u) {
                base[(size_t)(j0 + u) * CSTF] = cv;
                if (el == 0) MS[sq * NCH + j0 + u] = m;
                const float mn = fmaxf(sc[u].y + m, sc[u].x);
                cv = __expf(sc[u].y + m - mn) * cv + __expf(sc[u].x - mn) * loc[u]; m = mn;
            }
        }
    }
}
template <int DIR>
__device__ __forceinline__ void ml_sblock(f32x16& S, float& den, const bf16* ZB, const bf16x8 (&Qf)[4], int sb, int base_row, int h, int r, int hh, int jl, float a, float Mj) {
    S = ML_ZERO16;
    const int sr = 32 * sb + r; const int rows = base_row + (DIR ? 63 - sr : sr);
#pragma unroll
    for (int st = 0; st < 4; ++st) { const bf16x8 Kf = *(const bf16x8*)(ZB + (unsigned)(rows * 1024 + 256 + h * 64 + st * 16 + hh * 8)); S = MFMA32(Kf, Qf[st], S); }
#pragma unroll
    for (int g = 0; g < 16; ++g) { const int s = 32 * sb + crow(g, hh); const float as = shfl_idx(a, s);
        const float p = (s <= jl) ? S[g] * 0.125f * __expf(as - Mj) : 0.f; S[g] = p; den += p; }
}
template <int DIR>
__device__ __forceinline__ void ml_pv(f32x16& O, const f32x16& S, const bf16* ZB, int sb, int base_row, int h, int v, int hh) {
#pragma unroll
    for (int st2 = 0; st2 < 2; ++st2) {
        bf16x8 VA;
#pragma unroll
        for (int jj = 0; jj < 8; ++jj) { const int s = 32 * sb + 16 * st2 + 8 * (jj >> 2) + 4 * hh + (jj & 3); const int rows = base_row + (DIR ? 63 - s : s);
            VA[jj] = (short)ZB[(unsigned)(rows * 1024 + 512 + h * 64 + v)]; }
        const bf16x8 PB = pack8(S[8 * st2 + 0], S[8 * st2 + 1], S[8 * st2 + 2], S[8 * st2 + 3], S[8 * st2 + 4], S[8 * st2 + 5], S[8 * st2 + 6], S[8 * st2 + 7]);
        O = MFMA32(VA, PB, O);
        __builtin_amdgcn_sched_barrier(0);
    }
}
template <int DIR>
__device__ __forceinline__ void ml_out_dir(const KA& A, const Ctx& C, LAS float* H, int b, int h, int c, int base_row, int lane) {
    const bf16* ZB = (const bf16*)(A.ws() + WS_ZB); const float* GT = (const float*)(A.ws() + WS_G);
    const float* CST = (const float*)(A.ws() + WS_CST); const float* MS = (const float*)(A.ws() + WS_MS);
    const int r = lane & 31, hh = lane >> 5;
    const int j = DIR ? (c < 4 ? 3 - c : 263 - c) : c;
    const int sq = (b * 4 + h) * 2 + DIR;
    const float* Cp = CST + ((size_t)sq * NCH + j) * CSTF;
    const float m0 = MS[sq * NCH + j];
    const int rowl = base_row + (DIR ? 63 - lane : lane);
    const float gi = GT[(size_t)rowl * 16 + DIR * 8 + h], lf = GT[(size_t)rowl * 16 + DIR * 8 + 4 + h];
    float bs = lf;
#pragma unroll
    for (int o = 1; o < 64; o <<= 1) { const float tv = shfl_idx(bs, lane - o); if (lane >= o) bs += tv; }
    const float a = gi - bs;
    float pm = a;
#pragma unroll
    for (int o = 1; o < 64; o <<= 1) { const float tv = shfl_idx(pm, lane - o); if (lane >= o) pm = fmaxf(pm, tv); }
#pragma unroll 1
    for (int jb = 0; jb < 2; ++jb) {
        const int jl = 32 * jb + r;
        const float bj = shfl_idx(bs, jl), Mj = fmaxf(m0, shfl_idx(pm, jl));
        const int rowj = base_row + (DIR ? 63 - jl : jl);
        const int tok = DIR ? 63 - jl : jl;
        bf16x8 Qf[4];
#pragma unroll
        for (int st = 0; st < 4; ++st) Qf[st] = *(const bf16x8*)(ZB + (unsigned)(rowj * 1024 + h * 64 + st * 16 + hh * 8));
        f32x16 S0, S1 = ML_ZERO16; float den = 0.f;
        ml_sblock<DIR>(S0, den, ZB, Qf, 0, base_row, h, r, hh, jl, a, Mj);
        if (jb == 1) ml_sblock<DIR>(S1, den, ZB, Qf, 1, base_row, h, r, hh, jl, a, Mj);
        den += shfl_idx(den, lane ^ 32);
        const float wi = __expf(m0 - Mj) * 0.125f;
        float nq = 0.f;
#pragma unroll
        for (int st = 0; st < 4; ++st) { const f32x4 n0 = *(const f32x4*)(Cp + 4096 + st * 16 + hh * 8), n1 = *(const f32x4*)(Cp + 4096 + st * 16 + hh * 8 + 4);
            const u32x4 qw = __builtin_bit_cast(u32x4, Qf[st]);
            nq += n0.x * bflo(qw.x) + n0.y * bfhi(qw.x) + n0.z * bflo(qw.y) + n0.w * bfhi(qw.y) + n1.x * bflo(qw.z) + n1.y * bfhi(qw.z) + n1.z * bflo(qw.w) + n1.w * bfhi(qw.w); }
        nq += shfl_idx(nq, lane ^ 32);
        den += wi * nq;
        const float inv = 1.0f / fmaxf(fabsf(den), __expf(-(bj + Mj)));
#pragma unroll 1
        for (int vb = 0; vb < 2; ++vb) {
            const int v = 32 * vb + r;
            f32x16 O = ML_ZERO16;
            ml_pv<DIR>(O, S0, ZB, 0, base_row, h, v, hh);
            if (jb == 1) ml_pv<DIR>(O, S1, ZB, 1, base_row, h, v, hh);
            f32x16 I = ML_ZERO16;
#pragma unroll
            for (int st = 0; st < 4; ++st) { const float* cr = Cp + (size_t)v * 64 + st * 16 + hh * 8; const f32x4 c0 = *(const f32x4*)cr, c1 = *(const f32x4*)(cr + 4);
                const bf16x8 CA = pack8(c0.x, c0.y, c0.z, c0.w, c1.x, c1.y, c1.z, c1.w); I = MFMA32(CA, Qf[st], I); __builtin_amdgcn_sched_barrier(0); }
#pragma unroll
            for (int g = 0; g < 16; ++g) { const float hv = (O[g] + wi * I[g]) * inv; const int idx = (32 * vb + crow(g, hh)) * 65 + tok;
                if (DIR == 1) H[idx] = hv; else H[idx] += hv; }
        }
    }
}
__device__ __forceinline__ void phase_ml_out(int l) {
    const KA A = ka_fresh(); const Ctx C = ctx_fresh();
    const int gw = C.bid * 8 + C.wave, NGW = C.G * 8, lane = C.lane;
    const bf16* ZB = (const bf16*)(A.ws() + WS_ZB); bf16* MIX = (bf16*)(A.ws() + WS_MIX);
    LAS float* H = (LAS float*)(C.lds + C.wave * 16640);
    const int c_lo = (l == 1) ? 4 : 0, ncu = NCH - c_lo;
    for (int u = gw; u < 8 * ncu; u += NGW) {
        const int c = c_lo + u % ncu, bh = u / ncu, h = bh & 3, b = bh >> 2;
        const int base_row = c < 4 ? RL + b * CTXL + 64 * c : b * SEQ + 64 * (c - 4);
        ml_out_dir<1>(A, C, H, b, h, c, base_row, lane);
        LDS_WAIT(); asm volatile("" ::: "memory");
        ml_out_dir<0>(A, C, H, b, h, c, base_row, lane);
        LDS_WAIT(); asm volatile("" ::: "memory");
        float ss = 0.f;
#pragma unroll 8
        for (int v = 0; v < 64; ++v) { const float x = H[v * 65 + lane]; ss += x * x; }
        const float rs = 1.0f / sqrtf(ss * (1.f / 64.f) + EPS);
        const float gnv = A.in(18)[l * 256 + h * 64 + lane];
#pragma unroll 4
        for (int t = 0; t < 64; ++t) {
            const float rst = __builtin_bit_cast(float, __builtin_amdgcn_readlane(__builtin_bit_cast(int, rs), t));
            const size_t off = (size_t)(base_row + t) * 1024 + 768 + h * 64 + lane;
            const float o = bf2f(ZB[off]); const float sg = 1.0f / (1.0f + __expf(-o));
            MIX[off] = (bf16)f2bf(H[lane * 65 + t] * rst * gnv * sg);
        }
        LDS_WAIT(); asm volatile("" ::: "memory");
    }
}

__device__ __forceinline__ void glds16s(unsigned voff, const unsigned char* sbase, unsigned lds_dst) {
    unsigned keep;
    asm volatile("s_mov_b32 %0, m0\n\ts_mov_b32 m0, %3\n\ts_nop 0\n\tglobal_load_lds_dwordx4 %1, %2\n\ts_mov_b32 m0, %0" : "=&s"(keep) : "v"(voff), "s"(sbase), "s"(lds_dst) : "memory");
}
#define ATT_WAIT_BAR(N) asm volatile("s_waitcnt vmcnt(" #N ") lgkmcnt(0)\n\ts_barrier" ::: "memory")
constexpr int ATT_SLOT = 16384, ATT_NS = 6;
typedef int i32x8 __attribute__((ext_vector_type(8)));
#define MFMA8(a, b, c) __builtin_amdgcn_mfma_scale_f32_32x32x64_f8f6f4((a), (b), (c), 0, 0, 0, 127, 0, 127)
template <bool FIXEDREF>
__device__ __forceinline__ void attn_unit(const KA& A, const Ctx& C, int bh, int qrow0, int tile_lo, int ntiles) {
    int lane_ = C.lane; asm volatile("" : "+v"(lane_));
    const int lane = lane_, r = lane & 31, hh = lane >> 5, h = bh & 7;
    bf16* MIX = (bf16*)(A.ws() + WS_MIX);
    LAS unsigned char* lds = C.lds;
    const unsigned lds0 = (unsigned)(uintptr_t)lds;
    const int qrow = qrow0 + C.wave * 32 + r;
    const unsigned char* kg = A.ws() + WS_KN + ((size_t)bh * NKT + tile_lo) * KT_BYTES;
    const unsigned char* vg = A.ws() + WS_VT + ((size_t)bh * NKT + tile_lo) * VT_BYTES;
    const unsigned vo0 = (unsigned)(C.wave * 1024 + lane * 16);
    const unsigned d0 = lds0 + C.wave * 1024, d1 = d0 + 8192;
    int islot = 0;
#define ATT_ISSUE() do { const unsigned so_ = (unsigned)islot * ATT_SLOT; islot = (islot == ATT_NS - 1) ? 0 : islot + 1; \
        glds16s(vo0, kg, (unsigned)__builtin_amdgcn_readfirstlane(d0 + so_)); glds16s(vo0, vg, (unsigned)__builtin_amdgcn_readfirstlane(d1 + so_)); \
        kg += KT_BYTES; vg += VT_BYTES; } while (0)
    ATT_ISSUE(); ATT_ISSUE(); ATT_ISSUE();
    i32x8 qf[2];
    { const unsigned char* q8 = A.ws() + WS_Q8 + (size_t)qrow * 1024 + h * 128 + hh * 32;
#pragma unroll
      for (int st = 0; st < 2; ++st) { const u32x4 a = *(const u32x4*)(q8 + st * 64), b = *(const u32x4*)(q8 + st * 64 + 16);
          qf[st] = (i32x8){(int)a.x, (int)a.y, (int)a.z, (int)a.w, (int)b.x, (int)b.y, (int)b.z, (int)b.w}; } }
    f32x16 o0 = (f32x16){0.f, 0.f, 0.f, 0.f, 0.f, 0.f, 0.f, 0.f, 0.f, 0.f, 0.f, 0.f, 0.f, 0.f, 0.f, 0.f}, o1 = o0;
    float m = 0.f, lsum = 0.f;
    constexpr float THR = 8.f;
    const int ksw = (r >> 1) & 7;
    int cslot = 0, nslot = 1;
#define ATT_ADV() do { cslot = nslot; nslot = (nslot == ATT_NS - 1) ? 0 : nslot + 1; } while (0)
#define ATT_QKT(P0, P1, sl) do { const LAS unsigned char* Kb_ = lds + (sl) * ATT_SLOT + r * 128; P0 = ML_ZERO16; P1 = ML_ZERO16; \
        _Pragma("unroll") for (int st = 0; st < 2; ++st) { \
            const u32x4 a_ = *(const LAS u32x4*)(Kb_ + (((st * 4 + hh * 2) ^ ksw) << 4)), b_ = *(const LAS u32x4*)(Kb_ + (((st * 4 + hh * 2 + 1) ^ ksw) << 4)); \
            const u32x4 c_ = *(const LAS u32x4*)(Kb_ + 4096 + (((st * 4 + hh * 2) ^ ksw) << 4)), d_ = *(const LAS u32x4*)(Kb_ + 4096 + (((st * 4 + hh * 2 + 1) ^ ksw) << 4)); \
            P0 = MFMA8(((i32x8){(int)a_.x, (int)a_.y, (int)a_.z, (int)a_.w, (int)b_.x, (int)b_.y, (int)b_.z, (int)b_.w}), qf[st], P0); \
            P1 = MFMA8(((i32x8){(int)c_.x, (int)c_.y, (int)c_.z, (int)c_.w, (int)d_.x, (int)d_.y, (int)d_.z, (int)d_.w}), qf[st], P1); } } while (0)
#define ATT_H1(C0, C1, N0, N1, tt) do { \
        const bool more_ = (tt) + 1 < ntiles; \
        if ((tt) + 3 < ntiles) ATT_ISSUE(); \
        if (more_) ATT_QKT(N0, N1, nslot); \
        if (!FIXEDREF) { \
        float ta_ = __builtin_fmaxf(__builtin_fmaxf(C0[0], C0[1]), C0[2]), tb_ = __builtin_fmaxf(__builtin_fmaxf(C0[3], C0[4]), C0[5]), tc_ = __builtin_fmaxf(__builtin_fmaxf(C1[0], C1[1]), C1[2]), td_ = __builtin_fmaxf(__builtin_fmaxf(C1[3], C1[4]), C1[5]);     \
        _Pragma("unroll") for (int g = 6; g < 16; g += 2) { ta_ = __builtin_fmaxf(__builtin_fmaxf(ta_, C0[g]), C0[g + 1]); tc_ = __builtin_fmaxf(__builtin_fmaxf(tc_, C1[g]), C1[g + 1]); } \
        float tm_ = __builtin_fmaxf(__builtin_fmaxf(ta_, tb_), __builtin_fmaxf(tc_, td_)); \
        { const auto rr_ = __builtin_amdgcn_permlane32_swap(__builtin_bit_cast(unsigned, tm_), __builtin_bit_cast(unsigned, tm_), false, false);     \
          tm_ = __builtin_fmaxf(__builtin_bit_cast(float, rr_[0]), __builtin_bit_cast(float, rr_[1])); } \
        if ((tt) == 0) m = tm_;                             \
        else if (__any(tm_ - m > THR)) {                    \
            const float mn_ = __builtin_fmaxf(tm_, m), alpha_ = __builtin_amdgcn_exp2f(m - mn_); m = mn_; lsum *= alpha_; \
            _Pragma("unroll") for (int g = 0; g < 16; ++g) { o0[g] *= alpha_; o1[g] *= alpha_; } \
        } } } while (0)
#define ATT_H2(C0, C1, sl) do { \
        if (!FIXEDREF) { _Pragma("unroll") for (int g = 0; g < 16; ++g) { C0[g] -= m; C1[g] -= m; } } \
        float pa_ = 0.f, pb2_ = 0.f, pc_ = 0.f, pd_ = 0.f;                                      \
        _Pragma("unroll") for (int g = 0; g < 16; g += 2) { C0[g] = __builtin_amdgcn_exp2f(C0[g]); C0[g + 1] = __builtin_amdgcn_exp2f(C0[g + 1]); C1[g] = __builtin_amdgcn_exp2f(C1[g]); C1[g + 1] = __builtin_amdgcn_exp2f(C1[g + 1]); \
            pa_ += C0[g]; pb2_ += C0[g + 1]; pc_ += C1[g]; pd_ += C1[g + 1]; } \
        lsum += (pa_ + pb2_) + (pc_ + pd_); \
        bf16x8 pb_[2][2]; \
        pb_[0][0] = pack8(C0[0], C0[1], C0[2], C0[3], C0[4], C0[5], C0[6], C0[7]); pb_[0][1] = pack8(C0[8], C0[9], C0[10], C0[11], C0[12], C0[13], C0[14], C0[15]); \
        pb_[1][0] = pack8(C1[0], C1[1], C1[2], C1[3], C1[4], C1[5], C1[6], C1[7]); pb_[1][1] = pack8(C1[8], C1[9], C1[10], C1[11], C1[12], C1[13], C1[14], C1[15]); \
        const LAS unsigned char* Vb_ = lds + (sl) * ATT_SLOT + KT_BYTES; \
        { const int sw_ = (r >> 1) & 7; const LAS unsigned char* vrow_ = Vb_ + r * 128;        \
            _Pragma("unroll") for (int kb = 0; kb < 2; ++kb) _Pragma("unroll") for (int s2 = 0; s2 < 2; ++s2) { \
                const bf16x8 va_ = *(const LAS bf16x8*)(vrow_ + (((kb * 4 + s2 * 2 + hh) ^ sw_) << 4)), vb_ = *(const LAS bf16x8*)(vrow_ + 4096 + (((kb * 4 + s2 * 2 + hh) ^ sw_) << 4)); \
                o0 = MFMA32(va_, pb_[kb][s2], o0); o1 = MFMA32(vb_, pb_[kb][s2], o1); } } \
    } while (0)
#define ATT_SYNC(tt) do { if ((tt) + 2 < ntiles) ATT_WAIT_BAR(2); else ATT_WAIT_BAR(0); } while (0)
    f32x16 sA0, sA1, sB0, sB1;
    ATT_WAIT_BAR(4);
    ATT_QKT(sA0, sA1, 0);
    if (C.wave < 4) {
#pragma unroll 1
        for (int t = 0; t < ntiles; t += 2) {
            if (t + 1 < ntiles) ATT_SYNC(t);
            ATT_H1(sA0, sA1, sB0, sB1, t); ATT_H2(sA0, sA1, cslot); ATT_ADV();
            if (t + 2 < ntiles) ATT_SYNC(t + 1);
            ATT_H1(sB0, sB1, sA0, sA1, t + 1); ATT_H2(sB0, sB1, cslot); ATT_ADV();
        }
    } else {
        ATT_SYNC(0);
        ATT_H1(sA0, sA1, sB0, sB1, 0);
#pragma unroll 1
        for (int t = 1; t + 1 < ntiles; t += 2) {
            ATT_SYNC(t);
            ATT_H2(sA0, sA1, cslot); ATT_ADV(); ATT_H1(sB0, sB1, sA0, sA1, t);
            ATT_SYNC(t + 1);
            ATT_H2(sB0, sB1, cslot); ATT_ADV(); ATT_H1(sA0, sA1, sB0, sB1, t + 1);
        }
        ATT_H2(sA0, sA1, cslot); ATT_ADV(); ATT_H1(sB0, sB1, sA0, sA1, ntiles - 1);
        ATT_H2(sB0, sB1, cslot); ATT_ADV();
    }
#undef ATT_QKT
#undef ATT_H1
#undef ATT_H2
#undef ATT_SYNC
#undef ATT_ADV
    asm volatile("s_waitcnt lgkmcnt(0)\n\ts_barrier" ::: "memory");
#undef ATT_ISSUE
    lsum += shfl_idx(lsum, lane ^ 32);
    const float inv = 1.0f / lsum;
    { LAS bf16* stg = (LAS bf16*)(lds + ATT_NS * ATT_SLOT + C.wave * 4352);
#pragma unroll
      for (int g = 0; g < 16; ++g) { const int d = crow(g, hh); stg[r * 68 + d] = (bf16)f2bf(o0[g] * inv); stg[r * 68 + 32 + d] = (bf16)f2bf(o1[g] * inv); }
      LDS_WAIT(); asm volatile("" ::: "memory");
      bf16* ob = MIX + (size_t)(qrow0 + C.wave * 32) * 1024 + 256 + h * 64;
#pragma unroll
      for (int i = 0; i < 4; ++i) { const int row = i * 8 + (lane >> 3), ch = lane & 7;
          const u32x2 a = *(const LAS u32x2*)(stg + row * 68 + ch * 8), b = *(const LAS u32x2*)(stg + row * 68 + ch * 8 + 4);
          u32x4 v; v.x = a.x; v.y = a.y; v.z = b.x; v.w = b.y; *(u32x4*)(ob + (size_t)row * 1024 + ch * 8) = v; }
      LDS_WAIT(); asm volatile("" ::: "memory"); }
}
__device__ __forceinline__ void phase_attn(int l) {
    const KA A = ka_fresh(); const Ctx C = ctx_fresh();
    const int G = C.G;
    bool fixedref;
    { const int lane = C.lane; const float* qg = A.in(15) + l * 96; const float* kg = A.in(16) + l * 96;
      const float gq = wave_max(fmaxf(fabsf(qg[lane]), lane < 32 ? fabsf(qg[64 + lane]) : 0.f), lane), gk = wave_max(fmaxf(fabsf(kg[lane]), lane < 32 ? fabsf(kg[64 + lane]) : 0.f), lane);
      fixedref = (96.f * QSCALE * gq * gk) < 100.f; }
    for (int u = C.bid; u < 1024 + (l == 1 ? 0 : 16); u += G) {
        if (u < 1024) {
            int pair, qb;
            if (G == 256) { const int vcu = u & 255, rnd = u >> 8; pair = 2 * (vcu & 7) + (rnd >> 1); qb = (vcu >> 3) + 32 * (rnd & 1); }
            else { pair = u >> 6; qb = u & 63; }
            if (fixedref) attn_unit<true>(A, C, pair, (pair >> 3) * SEQ + qb * 256, 0, NKT); else attn_unit<false>(A, C, pair, (pair >> 3) * SEQ + qb * 256, 0, NKT);
        } else { const int pair = u - 1024;
            if (fixedref) attn_unit<true>(A, C, pair, RL + (pair >> 3) * CTXL, NKT - 4, 4); else attn_unit<false>(A, C, pair, RL + (pair >> 3) * CTXL, NKT - 4, 4); }
    }
}

__device__ __forceinline__ int f2key(float f) { const int b = __builtin_bit_cast(int, f); return b ^ ((b >> 31) & 0x7fffffff); }
__device__ __forceinline__ float key2f(int k) { return __builtin_bit_cast(float, k ^ ((k >> 31) & 0x7fffffff)); }
__device__ __forceinline__ void topk_ins(int (&lst)[16], int v) {
#pragma unroll
    for (int i = 0; i < 16; ++i) { const int hi = max(lst[i], v); v = min(lst[i], v); lst[i] = hi; }
}
__device__ __forceinline__ void bitonic_sort16_desc(int (&a)[16]) {
#pragma unroll
    for (int k = 2; k <= 16; k <<= 1)
#pragma unroll
        for (int j = k >> 1; j > 0; j >>= 1)
#pragma unroll
            for (int i = 0; i < 16; ++i) { const int p = i ^ j;
                if (p > i) { const int hi = max(a[i], a[p]), lo = min(a[i], a[p]); const bool desc = ((i & k) == 0) || (k == 16); a[i] = desc ? hi : lo; a[p] = desc ? lo : hi; } }
}
__device__ __forceinline__ void merge16_desc(int (&lst)[16], const int (&nw)[16]) {
#pragma unroll
    for (int i = 0; i < 16; ++i) lst[i] = max(lst[i], nw[15 - i]);
#pragma unroll
    for (int j = 8; j > 0; j >>= 1)
#pragma unroll
        for (int i = 0; i < 16; ++i) { const int p = i ^ j; if (p > i) { const int hi = max(lst[i], lst[p]), lo = min(lst[i], lst[p]); lst[i] = hi; lst[p] = lo; } }
}
__device__ __forceinline__ void topk_half(int (&lst)[16], const bf16* qp, const bf16* skp, int hh, int lane) {
    bf16x8 bq[8];
#pragma unroll
    for (int st = 0; st < 8; ++st) bq[st] = *(const bf16x8*)(qp + st * 16);
#pragma unroll
    for (int i = 0; i < 16; ++i) lst[i] = f2key(-3.0e38f);
    bf16x8 an[8];
#pragma unroll
    for (int st = 0; st < 8; ++st) an[st] = *(const bf16x8*)(skp + st * 16);
#pragma unroll 1
    for (int blk = 0; blk < 4; ++blk) {
        f32x16 acc = (f32x16){0.f, 0.f, 0.f, 0.f, 0.f, 0.f, 0.f, 0.f, 0.f, 0.f, 0.f, 0.f, 0.f, 0.f, 0.f, 0.f};
#pragma unroll
        for (int st = 0; st < 8; ++st) acc = MFMA32(an[st], bq[st], acc);
        if (blk < 3) {
#pragma unroll
            for (int st = 0; st < 8; ++st) an[st] = *(const bf16x8*)(skp + (blk + 1) * 32 * 128 + st * 16); }
        int nk[16];
#pragma unroll
        for (int g = 0; g < 16; ++g) { const unsigned n = (unsigned)(blk * 32 + crow(g, hh));
            const float sv = acc[g];
            nk[g] = f2key(__builtin_bit_cast(float, (__builtin_bit_cast(unsigned, sv) & ~127u) | n)); }
        bitonic_sort16_desc(nk);
        merge16_desc(lst, nk);
    }
    int oth[16];
#pragma unroll
    for (int i = 0; i < 16; ++i) oth[i] = shfl_idx(lst[i], lane ^ 32);
    merge16_desc(lst, oth);
}
__device__ __forceinline__ void phase_topk(int l) {
    const KA A = ka_fresh(); const Ctx C = ctx_fresh();
    const int gw = C.bid * 8 + C.wave, NGW = C.G * 8, lane = C.lane, r = lane & 31, hh = lane >> 5;
    const bf16* PQ = (const bf16*)(A.ws() + WS_PQ); const bf16* SK = (const bf16*)(A.ws() + WS_SUBK);
    int* EID = (int*)(A.ws() + WS_EID); float* GATE = (float*)(A.ws() + WS_GATE);
    const int nrows = (l == 1) ? RL : RT;
    for (int unit = gw; unit < (nrows / 32) * 8; unit += NGW) {
        const int h = unit & 7, r0 = (unit >> 3) * 32; const size_t row = (size_t)(r0 + r);
        int L[2][16];
        topk_half(L[0], PQ + row * 2048 + h * 256 + hh * 8, SK + ((size_t)((l * 8 + h) * 2 + 0) * 128 + r) * 128 + hh * 8, hh, lane);
        __builtin_amdgcn_sched_barrier(0);
        topk_half(L[1], PQ + row * 2048 + h * 256 + 128 + hh * 8, SK + ((size_t)((l * 8 + h) * 2 + 1) * 128 + r) * 128 + hh * 8, hh, lane);
        __builtin_amdgcn_sched_barrier(0);
        int best[16];
#pragma unroll
        for (int j = 0; j < 16; ++j) best[j] = f2key(__builtin_bit_cast(float, (__builtin_bit_cast(unsigned, key2f(L[0][0]) + key2f(L[1][j])) & ~255u) | (unsigned)j));
#pragma unroll
        for (int i = 1; i < 16; ++i)
#pragma unroll
            for (int j = 0; j < 16; ++j)
                if ((i + 1) * (j + 1) <= 16) topk_ins(best, f2key(__builtin_bit_cast(float, (__builtin_bit_cast(unsigned, key2f(L[0][i]) + key2f(L[1][j])) & ~255u) | (unsigned)(i * 16 + j))));
        float ev[16]; float esum = 0.f;
        const float mx = __builtin_bit_cast(float, __builtin_bit_cast(unsigned, key2f(best[0])) & ~255u);
#pragma unroll
        for (int k = 0; k < 16; ++k) { ev[k] = __expf(__builtin_bit_cast(float, __builtin_bit_cast(unsigned, key2f(best[k])) & ~255u) - mx); esum += ev[k]; }
        const float einv = 1.0f / esum;
#pragma unroll
        for (int k = 0; k < 8; ++k) {
            const int b_lo = best[k], b_hi = best[k + 8]; const float e_lo = ev[k], e_hi = ev[k + 8];
            const int bk = hh ? b_hi : b_lo; const float gk = (hh ? e_hi : e_lo) * einv;
            const unsigned code = __builtin_bit_cast(unsigned, key2f(bk)) & 255u;
            const unsigned ci = code >> 4, cj = code & 15u; unsigned n0 = 0u, n1 = 0u;
#pragma unroll
            for (int i = 0; i < 16; ++i) { n0 = (ci == (unsigned)i) ? (__builtin_bit_cast(unsigned, key2f(L[0][i])) & 127u) : n0; n1 = (cj == (unsigned)i) ? (__builtin_bit_cast(unsigned, key2f(L[1][i])) & 127u) : n1; }
            EID[row * 128 + h * 16 + hh * 8 + k] = (int)(n0 * 128u + n1); GATE[row * 128 + h * 16 + hh * 8 + k] = gk;
        }
    }
}
typedef float f32x2v __attribute__((ext_vector_type(2)));
typedef unsigned u32x6 __attribute__((ext_vector_type(6)));
typedef float f32x32 __attribute__((ext_vector_type(32)));
#ifndef FFN_B
#define FFN_B 8
#endif
__device__ __forceinline__ void phase_ffn(int l) {
    const KA A = ka_fresh(); const Ctx C = ctx_fresh();
    const int gw = C.bid * 8 + C.wave, NGW = C.G * 8, lane = C.lane;
    const bf16* XN = (const bf16*)(A.ws() + WS_XN); const unsigned char* TU = A.ws() + WS_TABU; const unsigned char* TV = A.ws() + WS_TABV;
    const int* EID = (const int*)(A.ws() + WS_EID); const float* GATE = (const float*)(A.ws() + WS_GATE);
    const float* MOD = (const float*)(A.ws() + WS_MOD);
    const int nrows = (l == 1) ? RL : RT;
    for (int row = gw; row < nrows; row += NGW) {
        f32x2_t hv[8];
        { const u32x4 a = *(const u32x4*)(XN + (size_t)row * DM + lane * 16), b = *(const u32x4*)(XN + (size_t)row * DM + lane * 16 + 8);
          hv[0] = (f32x2_t){bflo(a.x), bfhi(a.x)}; hv[1] = (f32x2_t){bflo(a.y), bfhi(a.y)}; hv[2] = (f32x2_t){bflo(a.z), bfhi(a.z)}; hv[3] = (f32x2_t){bflo(a.w), bfhi(a.w)};
          hv[4] = (f32x2_t){bflo(b.x), bfhi(b.x)}; hv[5] = (f32x2_t){bflo(b.y), bfhi(b.y)}; hv[6] = (f32x2_t){bflo(b.z), bfhi(b.z)}; hv[7] = (f32x2_t){bflo(b.w), bfhi(b.w)}; }
        f32x2_t out[8];
#pragma unroll
        for (int i = 0; i < 8; ++i) out[i] = (f32x2_t){0.f, 0.f};
        const int idA = EID[(size_t)row * 128 + lane], idB = EID[(size_t)row * 128 + 64 + lane]; const float gtA = GATE[(size_t)row * 128 + lane], gtB = GATE[(size_t)row * 128 + 64 + lane];
        int ln = lane; asm volatile("" : "+v"(ln));
        const bool b0 = ln & 1, b1 = ln & 2; const int q4 = ln >> 2, x16 = ln ^ 16, x32 = ln ^ 32;
        float dA = 0.f, dB = 0.f;
#define FFN_LOADU(UU, ID, e0) do { _Pragma("unroll") for (int k = 0; k < FFN_B; ++k) { const int id_ = __builtin_amdgcn_readlane(ID, (e0) + k); UU[k] = *(const U3*)(TU + (size_t)id_ * TROW + lane * 12); } } while (0)
#define FFN_DOT4(UU, DV, e0) do { _Pragma("unroll") for (int g4 = 0; g4 < FFN_B; g4 += 4) { float p_[4]; \
            _Pragma("unroll") for (int k = 0; k < 4; k += 2) { \
                const u32x6 us_ = {UU[g4 + k].a, UU[g4 + k].b, UU[g4 + k].c, UU[g4 + k + 1].a, UU[g4 + k + 1].b, UU[g4 + k + 1].c}; \
                const f32x32 uf_ = __builtin_amdgcn_cvt_scalef32_pk32_f32_fp6(us_, 1.0f);        \
                f32x2_t d0_ = {0.f, 0.f}, d1_ = {0.f, 0.f}; \
                _Pragma("unroll") for (int i = 0; i < 8; ++i) { d0_ = hv[i] * (f32x2_t){uf_[2 * i], uf_[2 * i + 1]} + d0_; d1_ = hv[i] * (f32x2_t){uf_[16 + 2 * i], uf_[17 + 2 * i]} + d1_; } \
                p_[k] = d0_.x + d0_.y; p_[k + 1] = d1_.x + d1_.y; } \
            float x01_ = b0 ? p_[1] : p_[0], y01_ = b0 ? p_[0] : p_[1], x23_ = b0 ? p_[3] : p_[2], y23_ = b0 ? p_[2] : p_[3]; \
            x01_ += __builtin_bit_cast(float, __builtin_amdgcn_update_dpp(0, __builtin_bit_cast(int, y01_), 0xB1, 0xf, 0xf, true)); \
            x23_ += __builtin_bit_cast(float, __builtin_amdgcn_update_dpp(0, __builtin_bit_cast(int, y23_), 0xB1, 0xf, 0xf, true)); \
            float x_ = b1 ? x23_ : x01_; const float y_ = b1 ? x01_ : x23_; \
            x_ += __builtin_bit_cast(float, __builtin_amdgcn_update_dpp(0, __builtin_bit_cast(int, y_), 0x4E, 0xf, 0xf, true)); \
            DPP_ADD(x_, 0x124); DPP_ADD(x_, 0x128);                  \
            x_ += shfl_idx(x_, x16); x_ += shfl_idx(x_, x32);       \
            DV = (q4 == (((e0) + g4) >> 2)) ? x_ : DV; } } while (0)
        { U3 ua[FFN_B], ub[FFN_B];
          FFN_LOADU(ua, idA, 0);
#pragma unroll 1
          for (int e = 0; e < 64; e += 2 * FFN_B) { FFN_LOADU(ub, idA, e + FFN_B); FFN_DOT4(ua, dA, e); if (e + 2 * FFN_B < 64) FFN_LOADU(ua, idA, e + 2 * FFN_B); else FFN_LOADU(ua, idB, 0); FFN_DOT4(ub, dA, e + FFN_B); }
#pragma unroll 1
          for (int e = 0; e < 64; e += 2 * FFN_B) { FFN_LOADU(ub, idB, e + FFN_B); FFN_DOT4(ua, dB, e); if (e + 2 * FFN_B < 64) FFN_LOADU(ua, idB, e + 2 * FFN_B); FFN_DOT4(ub, dB, e + FFN_B); } }
#undef FFN_LOADU
#undef FFN_DOT4
        const float wA = gtA * gelu_f(dA * (1.0f / U_SCALE)) * (1.0f / V_SCALE), wB = gtB * gelu_f(dB * (1.0f / U_SCALE)) * (1.0f / V_SCALE);
#define FFN_LOADV(VV, ID, e0) do { _Pragma("unroll") for (int k = 0; k < FFN_B; ++k) { const int id_ = __builtin_amdgcn_readlane(ID, (e0) + k); VV[k] = *(const U3*)(TV + (size_t)id_ * TROW + lane * 12); } } while (0)
#define FFN_ACC4(VV, WV, e0) do { _Pragma("unroll") for (int k = 0; k < FFN_B; k += 2) { \
            const float w0_ = __builtin_bit_cast(float, __builtin_amdgcn_readlane(__builtin_bit_cast(int, WV), (e0) + k)), w1_ = __builtin_bit_cast(float, __builtin_amdgcn_readlane(__builtin_bit_cast(int, WV), (e0) + k + 1)); \
            const u32x6 vs_ = {VV[k].a, VV[k].b, VV[k].c, VV[k + 1].a, VV[k + 1].b, VV[k + 1].c}; \
            const f32x32 vf_ = __builtin_amdgcn_cvt_scalef32_pk32_f32_fp6(vs_, 1.0f); \
            const f32x2_t w0p_ = {w0_, w0_}, w1p_ = {w1_, w1_}; \
            _Pragma("unroll") for (int i = 0; i < 8; ++i) { out[i] = w0p_ * (f32x2_t){vf_[2 * i], vf_[2 * i + 1]} + out[i]; out[i] = w1p_ * (f32x2_t){vf_[16 + 2 * i], vf_[17 + 2 * i]} + out[i]; } } } while (0)
        { U3 va[FFN_B], vb[FFN_B];
          FFN_LOADV(va, idA, 0);
#pragma unroll 1
          for (int e = 0; e < 64; e += 2 * FFN_B) { FFN_LOADV(vb, idA, e + FFN_B); FFN_ACC4(va, wA, e); if (e + 2 * FFN_B < 64) FFN_LOADV(va, idA, e + 2 * FFN_B); else FFN_LOADV(va, idB, 0); FFN_ACC4(vb, wA, e + FFN_B); }
#pragma unroll 1
          for (int e = 0; e < 64; e += 2 * FFN_B) { FFN_LOADV(vb, idB, e + FFN_B); FFN_ACC4(va, wB, e); if (e + 2 * FFN_B < 64) FFN_LOADV(va, idB, e + 2 * FFN_B); FFN_ACC4(vb, wB, e + FFN_B); } }
#undef FFN_LOADV
#undef FFN_ACC4
        const int nsel = row < RL ? (row >> 14) : 2;
        const float* gf = MOD + (l * 3 + nsel) * 6144 + 5 * 1024;
        float* xr = stream_out(A, C, row);
#pragma unroll
        for (int q = 0; q < 4; ++q) { const int j = lane * 16 + q * 4;
            const f32x4 x = *(const f32x4*)(xr + j); f32x4 g = *(const f32x4*)(gf + j);
            f32x4 o; o.x = x.x + g.x * out[q * 2].x; o.y = x.y + g.y * out[q * 2].y; o.z = x.z + g.z * out[q * 2 + 1].x; o.w = x.w + g.w * out[q * 2 + 1].y;
            *(f32x4*)(xr + j) = o; }
    }
}

template <class Epi>
__device__ __forceinline__ void run_gemm(const pg8::bf16_t* Amat, const pg8::bf16_t* Bt, int N, int K, const Epi& E, int M = RT) {
    const Ctx C = ctx_fresh();
    pg8::Gemm g{Amat, Bt, M, N, K}; pg8::StaticOrder S; S.init(M, N, C.G, C.bid);
    pg8::gemm_phase<Epi, pg8::StaticOrder, true, true>(C.lds, g, S, E);
}
__device__ __forceinline__ void seam() {
    const KA A = ka_fresh(); const Ctx C = ctx_fresh();
    XcdBarrier b; b.bar = (unsigned*)(A.ws() + WS_CTL) + CW_BAR; b.x = xb_xcc_id(); b.st = (volatile LAS unsigned*)(C.lds + MISC_OFF) + 8;
    xcd_barrier(b);
}
#define IN(k) (lo <= (k) && (k) < hi)
#define SEAM(k) do { if (IN(k) && IN((k) + 1)) seam(); } while (0)
template <int l>
__device__ __forceinline__ void layer_body(const int lo, const int hi) {
        const int p0 = 1 + NPH_L * l;
        if (IN(p0 + 0)) { phase_norm(l, 0); phase_tables(l); }
        SEAM(p0 + 0);
        if (IN(p0 + 1)) {
            const KA A = ka_fresh(); unsigned char* ws = A.ws();
            pg8::EpiBf16<0> E{(pg8::bf16_t*)(ws + WS_ZA), 1024, nullptr, 1024, (size_t)(WS_ZB - WS_ZA) / 2, 1.f};
            run_gemm(( const pg8::bf16_t*)(ws + WS_XN), (const pg8::bf16_t*)(ws + WS_WIN) + (size_t)l * 2048 * DM, 2048, DM, E);
        }
        SEAM(p0 + 1);
        if (IN(p0 + 2)) phase_post(l);
        SEAM(p0 + 2);
        if (IN(p0 + 3)) {
#pragma unroll 1
            for (int gi = 0; gi < 2; ++gi) {
                const KA A = ka_fresh(); unsigned char* ws = A.ws();
                const int N = gi ? 1024 : 768, K = gi ? 256 : 384;
                pg8::EpiBf16<0> E{(pg8::bf16_t*)(ws + (gi ? WS_KVRAW : WS_Q)), N, nullptr, 0, 0, 1.f};
                run_gemm((const pg8::bf16_t*)(ws + (gi ? WS_KVA : WS_QA)), (const pg8::bf16_t*)(ws + (gi ? WS_WUKV : WS_WUQ)) + (size_t)l * N * K, N, K, E);
            }
        }
        SEAM(p0 + 3);
        if (IN(p0 + 4)) phase_qknorm(l);
        SEAM(p0 + 4);
        if (IN(p0 + 5)) phase_ml_local();
        SEAM(p0 + 5);
        if (IN(p0 + 6)) phase_ml_scan();
        SEAM(p0 + 6);
        if (IN(p0 + 7)) {
            phase_ml_out(l);
            __syncthreads();
            phase_attn(l);
        }
        SEAM(p0 + 7);
        if (IN(p0 + 8)) {
            const KA A = ka_fresh(); unsigned char* ws = A.ws();
            pg8::EpiResGate E{l == 0 ? A.in(0) : (const float*)A.out(), l == 0 ? A.in(2) : (const float*)(ws + WS_CTXS), A.out(), (float*)(ws + WS_CTXS), (const float*)(ws + WS_MOD) + (size_t)l * 3 * 6144, 2 * 1024};
            run_gemm((const pg8::bf16_t*)(ws + WS_MIX), (const pg8::bf16_t*)(ws + WS_WOUT) + (size_t)l * DM * DM, DM, DM, E, l == 1 ? RL : RT);
        }
        SEAM(p0 + 8);
        if (IN(p0 + 9)) phase_norm(l, 1);
        SEAM(p0 + 9);

        if (IN(p0 + 10)) {
            const KA A = ka_fresh(); unsigned char* ws = A.ws();
            pg8::EpiBf16<0> E{(pg8::bf16_t*)(ws + WS_PQ), 2048, nullptr, 0, 0, 1.f};
            run_gemm((const pg8::bf16_t*)(ws + WS_XN), (const pg8::bf16_t*)(ws + WS_WPQ) + (size_t)l * 2048 * DM, 2048, DM, E, l == 1 ? RL : RT);
        }
        SEAM(p0 + 10);
                if (IN(p0 + 11)) phase_topk(l);
        SEAM(p0 + 11);
        if (IN(p0 + 12)) phase_ffn(l);
        if (l == 0) SEAM(p0 + 12);
    }
__global__ void __launch_bounds__(512, 2) mk_fwd(Args unused_args) {
    { const KA A = ka_fresh(); const Ctx C = ctx_fresh();
      volatile LAS unsigned* MISC = (volatile LAS unsigned*)(C.lds + MISC_OFF);
      if (C.tid < 64) MISC[C.tid] = 0u;
      __syncthreads();
      (void)xcd_barrier_post((unsigned*)(A.ws() + WS_CTL) + CW_BAR, MISC + 8); }
    int lo, hi;
    { const KA A = ka_fresh(); lo = A.ph_lo(); hi = A.ph_hi(); }
    if (IN(0)) phase_prologue();
    if (IN(0)) { if (lo == 0 && hi == NPHASES) seam(); }
    if (IN(0) && lo == 0 && hi == NPHASES) phase_modreduce();
    SEAM(0);
    layer_body<0>(lo, hi);
    layer_body<1>(lo, hi);
#undef IN
#undef SEAM
}

extern "C" void kernel_launch(void* const* d_in, const int* in_sizes, int n_in, void* d_out, int out_size, void* d_ws, size_t ws_size, hipStream_t stream) {
    static int grid = 0;
    if (grid == 0) {
        if (n_in != 24 || out_size != RL * DM || ws_size < WS_END) { fprintf(stderr, "kernel_launch: unexpected shapes (n_in %d, out %d, ws %zu)\n", n_in, out_size, ws_size); grid = -1; return; }
        int dev = 0, cus = 0, per_cu = 0;
        if (hipGetDevice(&dev) != hipSuccess || hipDeviceGetAttribute(&cus, hipDeviceAttributeMultiprocessorCount, dev) != hipSuccess) { grid = -1; return; }
        if (hipFuncSetAttribute((const void*)mk_fwd, hipFuncAttributeMaxDynamicSharedMemorySize, LDS_BYTES) != hipSuccess) { fprintf(stderr, "kernel_launch: hipFuncSetAttribute failed\n"); grid = -1; return; }
        if (hipOccupancyMaxActiveBlocksPerMultiprocessor(&per_cu, (const void*)mk_fwd, 512, LDS_BYTES) != hipSuccess || per_cu < 1) { fprintf(stderr, "kernel_launch: occupancy query says %d\n", per_cu); per_cu = 1; }
        (void)hipGetLastError();
        grid = cus;
    }
    if (grid < 0) return;
    (void)hipMemsetAsync((char*)d_ws + WS_CTL, 0, CTL_ZERO_BYTES, stream);
    Args a{};
    for (int i = 0; i < 24; ++i) a.in[i] = (const float*)d_in[i];
    a.out = (float*)d_out; a.ws = (unsigned char*)d_ws;
    a.ph_lo = 0; a.ph_hi = NPHASES;
    hipLaunchKernelGGL(mk_fwd, dim3(grid), dim3(512), LDS_BYTES, stream, a);
}
```

```cpp
#include <hip/hip_runtime.h>
#include <cstdio>
#include <cstdint>

namespace pg8 {
#define PG8_LAS __attribute__((address_space(3)))
typedef unsigned short bf16_t;
typedef short bf16x8 __attribute__((ext_vector_type(8)));
typedef float f32x4 __attribute__((ext_vector_type(4)));
typedef unsigned u32x4 __attribute__((ext_vector_type(4)));
constexpr int BM = 256, BK = 64, HALF = 128, HTB = HALF * BK * 2  , STAGE_BYTES = 8 * HTB, NXCD = 8, WGM = 8;

__host__ __device__ __forceinline__ int lds_byte(int r, int c) { const int st = (r >> 4) * 2 + (c >> 5), rr = r & 15, cc = c & 31, ob = rr * 64 + cc * 2; return st * 1024 + (ob ^ (((ob >> 9) & 1) << 5)); }
__host__ __device__ __forceinline__ void stage_rc(int b, int& R, int& C) { const int st = b / 1024, sb = b % 1024, swz = sb ^ (((sb >> 9) & 1) << 5); R = (st >> 1) * 16 + swz / 64; C = (st & 1) * 32 + (swz % 64) / 2; }
__host__ __device__ __forceinline__ int perm32(int rho) { const int n = rho >> 4, i = rho & 15; return 8 * (i >> 2) + 4 * n + (i & 3); }

struct Unit { int pm, pn; };
struct Gemm { const bf16_t* A; const bf16_t* Bt; int M, N, K; };

struct StaticOrder {
    int nM, nN, nwg, G, c;
    __host__ __device__ void init(int M, int N, int G_, int c_) { nM = M / BM; nN = N / BM; nwg = nM * nN; G = G_; c = c_; }
    __host__ __device__ bool next(int i, Unit& u) const {
        const long L = (long)i * G + c; if (L >= nwg) return false;
        int wgid = (int)L; { const int q = nwg / NXCD, r = nwg % NXCD, xcd = wgid % NXCD, off = wgid / NXCD; wgid = (xcd < r ? xcd * (q + 1) : r * (q + 1) + (xcd - r) * q) + off; }
        const int nig = WGM * nN, gid = wgid / nig, fm = gid * WGM, gsz = (nM - fm) < WGM ? (nM - fm) : WGM;
        u.pm = fm + ((wgid % nig) % gsz); u.pn = (wgid % nig) / gsz; return true;
    }
    __device__ __forceinline__ void a_ready(const Unit&) const {}
    __device__ __forceinline__ void done(const Unit&) const {}
};

__device__ __forceinline__ unsigned cvt_pk_bf16(float lo, float hi) { unsigned r; asm volatile("v_cvt_pk_bf16_f32 %0, %1, %2" : "=v"(r) : "v"(lo), "v"(hi)); return r; }
typedef float f32x2 __attribute__((ext_vector_type(2)));
__device__ __forceinline__ f32x2 gelu_pk(f32x2 v) {
    const f32x2 av = __builtin_elementwise_abs(v), d = av * 0.2316418882f + 1.0f;
    f32x2 t; t.x = __builtin_amdgcn_rcpf(d.x); t.y = __builtin_amdgcn_rcpf(d.y);
    f32x2 q = t * 0.5307027145f + (-0.7265760135f); q = q * t + 0.7107068705f; q = q * t + (-0.142248368f); q = q * t + 0.127414796f; q = q * t;
    const f32x2 s = (v * v) * (-0.72134752044f);
    f32x2 e; e.x = __builtin_amdgcn_exp2f(s.x); e.y = __builtin_amdgcn_exp2f(s.y);
    const f32x2 m = v * (q * e), r = v - m;
    f32x2 o; o.x = v.x < 0.f ? m.x : r.x; o.y = v.y < 0.f ? m.y : r.y; return o;
}

template <int ACT  > struct EpiBf16 {
    static constexpr bool PERM = true, AFTER_DRAIN = false; static_assert(ACT == 0 || ACT == 1, "EpiBf16: ACT is 0 (none) or 1 (gelu_pk)");
    bf16_t* O; int ldc; const float* bias; int split_cols; size_t split_stride; float scale0;
    __device__ __forceinline__ void operator()(const f32x4 (&acc)[2][2][4][2], const Unit& u, int wr, int wc, int fr, int fq) const {
        const int row0 = u.pm * BM + wr * 64 + fr; int colt = u.pn * BM; bf16_t* base = O;
        float sc = 1.f; if (split_cols) { const int t = colt / split_cols; base += (size_t)t * split_stride; colt -= t * split_cols; if (t == 0) sc = scale0; }
        const int col0 = colt + wc * 32 + 8 * fq, bcol0 = u.pn * BM + wc * 32 + 8 * fq;
        f32x4 bv[2][2];
#pragma unroll
        for (int bj = 0; bj < 2; ++bj)
#pragma unroll
            for (int n = 0; n < 2; ++n) bv[bj][n] = bias ? *(const f32x4*)(bias + bcol0 + bj * HALF + 4 * n) : (f32x4){0.f, 0.f, 0.f, 0.f};
#pragma unroll
        for (int ai = 0; ai < 2; ++ai)
#pragma unroll
            for (int m = 0; m < 4; ++m) { bf16_t* rowp = base + (size_t)(row0 + ai * HALF + m * 16) * ldc + col0;
#pragma unroll
                for (int bj = 0; bj < 2; ++bj) { f32x4 v0 = acc[ai][bj][m][0] + bv[bj][0], v1 = acc[ai][bj][m][1] + bv[bj][1];
                    if (ACT == 1) { f32x2 a = gelu_pk((f32x2){v0[0], v0[1]}), b = gelu_pk((f32x2){v0[2], v0[3]}), c = gelu_pk((f32x2){v1[0], v1[1]}), d = gelu_pk((f32x2){v1[2], v1[3]});
                        v0 = (f32x4){a.x, a.y, b.x, b.y}; v1 = (f32x4){c.x, c.y, d.x, d.y}; }
                    v0 = v0 * sc; v1 = v1 * sc; u32x4 w; w.x = cvt_pk_bf16(v0[0], v0[1]); w.y = cvt_pk_bf16(v0[2], v0[3]); w.z = cvt_pk_bf16(v1[0], v1[1]); w.w = cvt_pk_bf16(v1[2], v1[3]);
                    *(u32x4*)(rowp + bj * HALF) = w; } }
    }
};


struct EpiResGate {
    static constexpr bool PERM = false, AFTER_DRAIN = false;
    const float* base_lat; const float* base_ctx; float* out_lat; float* out_ctx; const float* gate;
    int goff;
    __device__ __forceinline__ void operator()(const f32x4 (&acc)[2][2][4][2], const Unit& u, int wr, int wc, int fr, int fq) const {
        const int rowt = u.pm * BM; const bool lat = rowt < 32768;
        const int nsel = lat ? (rowt >> 14) : 2;
        const float* bs = lat ? base_lat + (size_t)rowt * 1024 : base_ctx + (size_t)(rowt - 32768) * 1024;
        float* os = lat ? out_lat + (size_t)rowt * 1024 : out_ctx + (size_t)(rowt - 32768) * 1024;
        const float* gv = gate + nsel * 6144 + goff;
        const int rl = wr * 64 + fr, col0 = u.pn * BM + wc * 32 + 4 * fq;
        f32x4 g[2][2];
#pragma unroll
        for (int bj = 0; bj < 2; ++bj)
#pragma unroll
            for (int n = 0; n < 2; ++n) g[bj][n] = *(const f32x4*)(gv + col0 + bj * HALF + n * 16);
#pragma unroll
        for (int ai = 0; ai < 2; ++ai)
#pragma unroll
            for (int m = 0; m < 4; ++m) { const size_t ro = (size_t)(rl + ai * HALF + m * 16) * 1024 + col0;
#pragma unroll
                for (int bj = 0; bj < 2; ++bj)
#pragma unroll
                    for (int n = 0; n < 2; ++n) { const f32x4 b = *(const f32x4*)(bs + ro + bj * HALF + n * 16); *(f32x4*)(os + ro + bj * HALF + n * 16) = b + g[bj][n] * acc[ai][bj][m][n]; } }
    }
};

template <class Epi, class Sched, bool ALIGN_EPI = false, bool SP2 = false>
__device__ __forceinline__ void gemm_phase(PG8_LAS unsigned char* lds, const Gemm g, const Sched& S, const Epi& E) {
    int tid_l = threadIdx.x; asm volatile("" : "+v"(tid_l));
    const int tid = tid_l, wid = __builtin_amdgcn_readfirstlane(tid >> 6), lane = tid & 63, wr = wid >> 2, wc = wid & 3, fr = lane & 15, fq = lane >> 4;
    const int K = g.K, nt = K / BK;
    unsigned voffA[2], voffB[2];
#pragma unroll
    for (int i = 0; i < 2; ++i) { int R, C; stage_rc(tid * 16 + i * 8192, R, C); const int Rb = Epi::PERM ? ((R & ~31) + perm32(R & 31)) : R;
        voffA[i] = (unsigned)(R * K + C) * 2u; voffB[i] = (unsigned)(Rb * K + C) * 2u; }
    const size_t kstep = (size_t)(BK * 2);
    const size_t hstep = (size_t)HALF * K * 2;
    const size_t tstep = 2 * hstep;
    const unsigned ldsw = (unsigned)wid * 1024u;
    const int aoff = lds_byte(wr * 64 + fr, fq * 8), boff = lds_byte(wc * 32 + fr, fq * 8);
#define PG8_SA(b, h) (((b) * 2 + (h)) * HTB)
#define PG8_SB(b, h) ((4 + (b) * 2 + (h)) * HTB)
#define PG8_STAGE(bufoff, gbase, voff) do { _Pragma("unroll") for (int _i = 0; _i < 2; ++_i) \
        __builtin_amdgcn_global_load_lds((const unsigned*)((const char*)(gbase) + (voff)[_i]), (PG8_LAS unsigned*)(lds + (bufoff) + ldsw + _i * 8192), 16, 0, 0); } while (0)
#define PG8_LDA(dst, b, h) do { _Pragma("unroll") for (int m = 0; m < 4; ++m) _Pragma("unroll") for (int k = 0; k < 2; ++k) dst[m][k] = *(const PG8_LAS bf16x8*)(lds + PG8_SA(b, h) + aoff + m * 2048 + k * 1024); } while (0)
#define PG8_LDB(dst, b, h) do { _Pragma("unroll") for (int n = 0; n < 2; ++n) _Pragma("unroll") for (int k = 0; k < 2; ++k) dst[n][k] = *(const PG8_LAS bf16x8*)(lds + PG8_SB(b, h) + boff + n * 2048 + k * 1024); } while (0)
#define PG8_MMA(ai, bj, At, Bt) do { __builtin_amdgcn_s_setprio(1); _Pragma("unroll") for (int m = 0; m < 4; ++m) _Pragma("unroll") for (int n = 0; n < 2; ++n) _Pragma("unroll") for (int k = 0; k < 2; ++k) \
        acc[ai][bj][m][n] = __builtin_amdgcn_mfma_f32_16x16x32_bf16(Bt[n][k], At[m][k], acc[ai][bj][m][n], 0, 0, 0); __builtin_amdgcn_s_setprio(0); } while (0)
#define PG8_WAIT_V(n) asm volatile("s_waitcnt vmcnt(" #n ")" ::: "memory")
#define PG8_WAIT_L(n) asm volatile("s_waitcnt lgkmcnt(" #n ")" ::: "memory")
#define PG8_BAR __builtin_amdgcn_s_barrier()
#define PG8_SCHED __builtin_amdgcn_sched_barrier(0)
    Unit cur, nxt; int ui = 0;
    if (!S.next(0, cur)) return;
    f32x4 acc[2][2][4][2];
#pragma unroll
    for (int a = 0; a < 2; ++a)
#pragma unroll
        for (int b = 0; b < 2; ++b)
#pragma unroll
            for (int m = 0; m < 4; ++m)
#pragma unroll
                for (int n = 0; n < 2; ++n) acc[a][b][m][n] = (f32x4){0.f, 0.f, 0.f, 0.f};
    bf16x8 At[4][2], B0[2][2], B1[2][2];
    const char* cA = (const char*)g.A + (size_t)cur.pm * tstep; const char* cB = (const char*)g.Bt + (size_t)cur.pn * tstep;
    S.a_ready(cur);
    if constexpr (SP2) {
        PG8_STAGE(PG8_SB(0, 0), cB, voffB); PG8_STAGE(PG8_SB(0, 1), cB + hstep, voffB); PG8_STAGE(PG8_SA(0, 0), cA, voffA); PG8_STAGE(PG8_SA(0, 1), cA + hstep, voffA);
        if (wr == 1) PG8_BAR;
        PG8_WAIT_V(2); PG8_BAR;
        PG8_STAGE(PG8_SB(1, 0), cB + kstep, voffB); PG8_STAGE(PG8_SA(1, 0), cA + kstep, voffA); PG8_STAGE(PG8_SB(1, 1), cB + hstep + kstep, voffB);
        PG8_WAIT_V(6); PG8_BAR;
    } else {
        PG8_STAGE(PG8_SB(0, 0), cB, voffB); PG8_STAGE(PG8_SA(0, 0), cA, voffA); PG8_STAGE(PG8_SB(0, 1), cB + hstep, voffB); PG8_STAGE(PG8_SA(0, 1), cA + hstep, voffA);
        if (wr == 1) PG8_BAR;
        PG8_WAIT_V(4); PG8_BAR;
        PG8_STAGE(PG8_SB(1, 0), cB + kstep, voffB); PG8_STAGE(PG8_SA(1, 0), cA + kstep, voffA); PG8_STAGE(PG8_SB(1, 1), cB + hstep + kstep, voffB);
        PG8_WAIT_V(6); PG8_BAR;
    }
    for (;;) {
        const bool has_next = S.next(ui + 1, nxt);
        const char* nA = has_next ? (const char*)g.A + (size_t)nxt.pm * tstep : cA; const char* nB = has_next ? (const char*)g.Bt + (size_t)nxt.pn * tstep : cB;
        for (int t = 0; t < nt; t += 2) {
            const bool last = (t == nt - 2);
            const char* a1 = cA + (size_t)(t + 1) * kstep;
            const char* a2 = last ? nA : cA + (size_t)(t + 2) * kstep; const char* b2 = last ? nB : cB + (size_t)(t + 2) * kstep;
            const char* a3 = a2 + kstep; const char* b3 = b2 + kstep;
            if (last && has_next) S.a_ready(nxt);
            if constexpr (SP2) {
            PG8_LDB(B0, 0, 0); PG8_LDB(B1, 0, 1); PG8_SCHED; PG8_LDA(At, 0, 0); PG8_STAGE(PG8_SA(1, 1), a1 + hstep, voffA);
            PG8_WAIT_V(8); PG8_WAIT_L(0); PG8_BAR; PG8_MMA(0, 0, At, B0); PG8_MMA(0, 1, At, B1); PG8_BAR; PG8_SCHED;
            PG8_LDA(At, 0, 1); PG8_STAGE(PG8_SB(0, 0), b2, voffB); PG8_STAGE(PG8_SB(0, 1), b2 + hstep, voffB); PG8_STAGE(PG8_SA(0, 0), a2, voffA);
            PG8_WAIT_V(8); PG8_WAIT_L(0); PG8_BAR; PG8_MMA(1, 0, At, B0); PG8_MMA(1, 1, At, B1); PG8_BAR; PG8_SCHED;
            PG8_LDB(B0, 1, 0); PG8_LDB(B1, 1, 1); PG8_SCHED; PG8_LDA(At, 1, 0); PG8_STAGE(PG8_SA(0, 1), a2 + hstep, voffA);
            PG8_WAIT_V(8); PG8_WAIT_L(0); PG8_BAR; PG8_MMA(0, 0, At, B0); PG8_MMA(0, 1, At, B1); PG8_BAR; PG8_SCHED;
            PG8_LDA(At, 1, 1); PG8_STAGE(PG8_SB(1, 0), b3, voffB); PG8_STAGE(PG8_SB(1, 1), b3 + hstep, voffB); PG8_STAGE(PG8_SA(1, 0), a3, voffA);
            PG8_WAIT_V(8); PG8_WAIT_L(0); PG8_BAR; PG8_MMA(1, 0, At, B0); PG8_MMA(1, 1, At, B1); PG8_BAR; PG8_SCHED;
            } else {
            PG8_LDB(B0, 0, 0); PG8_SCHED; PG8_LDA(At, 0, 0); PG8_STAGE(PG8_SA(1, 1), a1 + hstep, voffA);
            PG8_WAIT_L(8); PG8_BAR; PG8_WAIT_L(0); PG8_MMA(0, 0, At, B0); PG8_BAR; PG8_SCHED;
            PG8_LDB(B1, 0, 1); PG8_STAGE(PG8_SB(0, 0), b2, voffB);
            PG8_BAR; PG8_WAIT_L(0); PG8_MMA(0, 1, At, B1); PG8_BAR;
            PG8_LDA(At, 0, 1); PG8_STAGE(PG8_SA(0, 0), a2, voffA);
            PG8_BAR; PG8_WAIT_L(0); PG8_MMA(1, 0, At, B0); PG8_BAR; PG8_SCHED;
            PG8_STAGE(PG8_SB(0, 1), b2 + hstep, voffB);
            PG8_WAIT_V(6); PG8_BAR; PG8_MMA(1, 1, At, B1); PG8_BAR;
            PG8_LDB(B0, 1, 0); PG8_SCHED; PG8_LDA(At, 1, 0); PG8_STAGE(PG8_SA(0, 1), a2 + hstep, voffA);
            PG8_WAIT_L(8); PG8_BAR; PG8_WAIT_L(0); PG8_MMA(0, 0, At, B0); PG8_BAR; PG8_SCHED;
            PG8_LDB(B1, 1, 1); PG8_STAGE(PG8_SB(1, 0), b3, voffB);
            PG8_BAR; PG8_WAIT_L(0); PG8_MMA(0, 1, At, B1); PG8_BAR;
            PG8_LDA(At, 1, 1); PG8_STAGE(PG8_SA(1, 0), a3, voffA);
            PG8_BAR; PG8_WAIT_L(0); PG8_MMA(1, 0, At, B0); PG8_BAR; PG8_SCHED;
            PG8_STAGE(PG8_SB(1, 1), b3 + hstep, voffB);
            PG8_WAIT_V(6); PG8_BAR; PG8_MMA(1, 1, At, B1); PG8_BAR;
            }
        }
        if constexpr (ALIGN_EPI) { if (wr == 0) PG8_BAR; }
        if constexpr (!Epi::AFTER_DRAIN) { E(acc, cur, wr, wc, fr, fq); S.done(cur); }
        if (!has_next) break;
#pragma unroll
        for (int a = 0; a < 2; ++a)
#pragma unroll
            for (int b = 0; b < 2; ++b)
#pragma unroll
                for (int m = 0; m < 4; ++m)
#pragma unroll
                    for (int n = 0; n < 2; ++n) acc[a][b][m][n] = (f32x4){0.f, 0.f, 0.f, 0.f};
        cur = nxt; cA = nA; cB = nB; ++ui;
        if constexpr (ALIGN_EPI) { if (wr == 1) PG8_BAR; }
    }
    PG8_WAIT_V(0);
    if constexpr (!ALIGN_EPI) { if (wr == 0) PG8_BAR; }
    PG8_BAR;
    if constexpr (Epi::AFTER_DRAIN) { E.fused(acc, cur, wr, wc, fr, fq, lds, wid, lane); S.done(cur); }
#undef PG8_SA
#undef PG8_SB
#undef PG8_STAGE
#undef PG8_LDA
#undef PG8_LDB
#undef PG8_MMA
#undef PG8_WAIT_V
#undef PG8_WAIT_L
#undef PG8_BAR
#undef PG8_SCHED
}
}

constexpr int DM = 1024, NB = 2, SEQ = 16384, CTXL = 256, RL = NB * SEQ, RC = NB * CTXL, RT = RL + RC;
constexpr int NKT = (SEQ + CTXL) / 64;
constexpr int KT_BYTES = 64 * 128, VT_BYTES = 64 * 128;
constexpr int NCH = 260, CSTF = 4160;
constexpr float EPS = 1e-6f;
constexpr float QSCALE = 0.10206207261596577f * 1.4426950408889634f;
constexpr int NPH_L = 13, NPHASES = 1 + 2 * NPH_L;


constexpr size_t MiB = 1u << 20;
constexpr size_t WS_CTL = 0, CTL_ZERO_BYTES = 64 * 1024;
constexpr size_t WS_WIN = 1 * MiB, WS_WUQ = 9 * MiB, WS_WUKV = 11 * MiB, WS_WOUT = 12 * MiB, WS_WPQ = 16 * MiB, WS_SUBK = 24 * MiB;
constexpr size_t WS_MOD = 25 * MiB, WS_ROPE = 25 * MiB + 256 * 1024, WS_SC = 25 * MiB + 512 * 1024, WS_MS = WS_SC + 64 * 1024;
constexpr size_t WS_CTXS = 26 * MiB, WS_G = 28 * MiB, WS_KR = 31 * MiB, WS_TABU = 34 * MiB, WS_TABV = 66 * MiB;
constexpr size_t WS_ZA = 98 * MiB, WS_ZB = 163 * MiB, WS_Q = WS_ZA, WS_PQ = WS_ZA;
constexpr size_t WS_XN = 228 * MiB, WS_QA = WS_XN, WS_KVA = 253 * MiB, WS_VT = WS_XN;
constexpr size_t WS_MIX = 293 * MiB, WS_R66 = 358 * MiB, WS_KVRAW = WS_R66, WS_CST = WS_R66, WS_EID = WS_R66, WS_GATE = WS_R66 + 17 * MiB;
constexpr size_t WS_KN = 425 * MiB, WS_Q8 = 458 * MiB, WS_MODP = 491 * MiB, WS_END = 493 * MiB;
static_assert(WS_QA + (size_t)RT * 384 * 2 <= WS_KVA && WS_KVA + (size_t)RT * 256 * 2 <= WS_MIX, "QA/KVA inside the XN region");
static_assert(WS_VT + (size_t)NB * 8 * NKT * VT_BYTES <= WS_MIX, "Vt inside the XN region");
static_assert(WS_CST + (size_t)16 * NCH * CSTF * 4 <= WS_KN && WS_KVRAW + (size_t)RT * 1024 * 2 <= WS_KN, "R66 region");
static_assert(WS_KN + (size_t)NB * 8 * NKT * KT_BYTES <= WS_Q8 && WS_Q8 + (size_t)RT * 1024 <= WS_MODP, "Kn / Q8 regions");
static_assert(WS_G + (size_t)RT * 16 * 4 <= WS_KR && WS_KR + (size_t)RT * 32 * 2 <= WS_TABU, "G/KR");
constexpr int CW_BAR = 1024;

constexpr int LDS_BYTES = 147456, MISC_OFF = 143360;

#define LAS __attribute__((address_space(3)))
typedef unsigned short bf16;
typedef short bf16x8 __attribute__((ext_vector_type(8)));
typedef float f32x4 __attribute__((ext_vector_type(4)));
typedef float f32x16 __attribute__((ext_vector_type(16)));
typedef unsigned u32x4 __attribute__((ext_vector_type(4)));
typedef unsigned u32x2 __attribute__((ext_vector_type(2)));
#define LDS_WAIT() asm volatile("s_waitcnt lgkmcnt(0)" ::: "memory")

typedef float f32x2_t __attribute__((ext_vector_type(2))); typedef __bf16 bf16x2_t __attribute__((ext_vector_type(2)));
__device__ __forceinline__ unsigned pk2(float lo, float hi) { f32x2_t v = {lo, hi}; bf16x2_t b = __builtin_convertvector(v, bf16x2_t); return __builtin_bit_cast(unsigned, b); }
__device__ __forceinline__ unsigned f2bf(float f) { return pk2(f, 0.f) & 0xffffu; }
__device__ __forceinline__ float bflo(unsigned w) { return __builtin_bit_cast(float, w << 16); }
__device__ __forceinline__ float bfhi(unsigned w) { return __builtin_bit_cast(float, w & 0xffff0000u); }
__device__ __forceinline__ float bf2f(bf16 v) { return __builtin_bit_cast(float, (unsigned)v << 16); }
__device__ __forceinline__ float shfl_idx(float v, int srclane) { return __builtin_bit_cast(float, __builtin_amdgcn_ds_bpermute(srclane << 2, __builtin_bit_cast(int, v))); }
__device__ __forceinline__ int shfl_idx(int v, int srclane) { return __builtin_amdgcn_ds_bpermute(srclane << 2, v); }
#define DPP_ADD(v, ctrl) (v) += __builtin_bit_cast(float, __builtin_amdgcn_update_dpp(0, __builtin_bit_cast(int, (v)), (ctrl), 0xf, 0xf, true))
__device__ __forceinline__ float wave_sum(float v, int lane) {
    (void)lane;
    DPP_ADD(v, 0xB1);
    DPP_ADD(v, 0x4E);
    DPP_ADD(v, 0x141);
    DPP_ADD(v, 0x140);
    const int b = __builtin_bit_cast(int, v);
    return (__builtin_bit_cast(float, __builtin_amdgcn_readlane(b, 0)) + __builtin_bit_cast(float, __builtin_amdgcn_readlane(b, 16))) +
           (__builtin_bit_cast(float, __builtin_amdgcn_readlane(b, 32)) + __builtin_bit_cast(float, __builtin_amdgcn_readlane(b, 48)));
}
__device__ __forceinline__ float wave_max(float v, int lane) {
#pragma unroll
    for (int o = 1; o < 64; o <<= 1) v = fmaxf(v, shfl_idx(v, lane ^ o));
    return v;
}
__device__ __forceinline__ int crow(int g, int hh) { return (g & 3) + 8 * (g >> 2) + 4 * hh; }
__device__ __forceinline__ bf16x8 pack8(float a0, float a1, float a2, float a3, float a4, float a5, float a6, float a7) {
    u32x4 w; w.x = pk2(a0, a1); w.y = pk2(a2, a3); w.z = pk2(a4, a5); w.w = pk2(a6, a7); return __builtin_bit_cast(bf16x8, w);
}
__device__ __forceinline__ float gelu_f(float v) {
    const float av = fabsf(v), d = av * 0.2316418882f + 1.0f; const float t = __builtin_amdgcn_rcpf(d);
    float q = t * 0.5307027145f + (-0.7265760135f); q = q * t + 0.7107068705f; q = q * t + (-0.142248368f); q = q * t + 0.127414796f; q = q * t;
    const float e = __builtin_amdgcn_exp2f(v * v * (-0.72134752044f));
    const float mm = v * (q * e); return v < 0.f ? mm : v - mm;
}
#define MFMA32(a, b, c) __builtin_amdgcn_mfma_f32_32x32x16_bf16((a), (b), (c), 0, 0, 0)
#define ML_ZERO16 (f32x16){0.f, 0.f, 0.f, 0.f, 0.f, 0.f, 0.f, 0.f, 0.f, 0.f, 0.f, 0.f, 0.f, 0.f, 0.f, 0.f}

#define XB_TMO      128
#define XB_XCNT(j)  (256  + 64 * (j))
#define XB_XSUB(j)  (1280 + 64 * (j))
#define XB_XGEN(j)  (2304 + 64 * (j))
#define XB_TOP      3328
#define XB_TOPGEN   3392
#define XCD_BAR_WORDS 3456
#define XB_SPIN_CAP (1u << 18)
__device__ __forceinline__ unsigned xb_ld(unsigned* p)              { return __hip_atomic_load(p, __ATOMIC_RELAXED, __HIP_MEMORY_SCOPE_AGENT); }
__device__ __forceinline__ unsigned xb_add(unsigned* p, unsigned v) { return __hip_atomic_fetch_add(p, v, __ATOMIC_RELAXED, __HIP_MEMORY_SCOPE_AGENT); }
__device__ __forceinline__ unsigned xb_xcc_id() { return (unsigned)__builtin_amdgcn_s_getreg((3 << 11) | 20) & 0xFu; }
#define XB_SPIN(cond, bar) do { unsigned _sp = 0; while (cond) { __builtin_amdgcn_s_sleep(1); \
    if ((++_sp & 255u) == 0u) { if (xb_ld(&(bar)[XB_TMO])) break; if (_sp > XB_SPIN_CAP) { atomicAdd(&(bar)[XB_TMO], 1u); break; } } } } while (0)
struct XcdBarrier { unsigned* bar; unsigned x; volatile LAS unsigned* st; };
__device__ __forceinline__ XcdBarrier xcd_barrier_post(unsigned* bar, volatile LAS unsigned* st) {
    XcdBarrier b; b.bar = bar; b.x = xb_xcc_id(); b.st = st;
    if (threadIdx.x == 0) (void)xb_add(&bar[XB_XCNT(b.x)], 1u);
    return b;
}
__device__ __forceinline__ void xcd_barrier_complete(unsigned* bar, unsigned x, unsigned& nloc, unsigned& nx) {
    const unsigned G = gridDim.x * gridDim.y * gridDim.z;
    unsigned sum, cnt, mine, sp = 0u;
    for (;;) {
        sum = 0u; cnt = 0u; mine = 0u;
#pragma unroll
        for (unsigned j = 0; j < 16; ++j) { const unsigned c = xb_ld(&bar[XB_XCNT(j)]); sum += c; cnt += (c > 0u) ? 1u : 0u; mine = (j == x) ? c : mine; }
        if (sum == G) break;
        __builtin_amdgcn_s_sleep(1);
        if ((++sp & 255u) == 0u) { if (xb_ld(&bar[XB_TMO])) break; if (sp > XB_SPIN_CAP) { atomicAdd(&bar[XB_TMO], 1u); break; } }
    }
    nloc = mine > 0u ? mine : 1u; nx = cnt > 0u ? cnt : 1u;
}
__device__ __forceinline__ void xcd_barrier(const XcdBarrier& b) {
    asm volatile("s_waitcnt vmcnt(0)" ::: "memory");
    __syncthreads();
    if (threadIdx.x == 0) {
        unsigned* bar = b.bar;
        __builtin_amdgcn_s_waitcnt(0);
        unsigned nloc = b.st[0], nx = b.st[1];
        if (nloc == 0u) { xcd_barrier_complete(bar, b.x, nloc, nx); b.st[0] = nloc; b.st[1] = nx; }
        const unsigned old = xb_add(&bar[XB_XSUB(b.x)], 1u);
        const unsigned gen = old / nloc;
        if (old + 1u == (gen + 1u) * nloc) {
            __builtin_amdgcn_fence(__ATOMIC_RELEASE, "agent");
            asm volatile("s_waitcnt vmcnt(0)" ::: "memory");
            const unsigned og = xb_add(&bar[XB_TOP], 1u);
            const unsigned tg = og / nx;
            if (og + 1u == (tg + 1u) * nx) xb_add(&bar[XB_TOPGEN], 1u);
            else XB_SPIN(xb_ld(&bar[XB_TOPGEN]) == tg, bar);
            __builtin_amdgcn_fence(__ATOMIC_ACQUIRE, "agent");
            xb_add(&bar[XB_XGEN(b.x)], 1u);
            asm volatile("s_waitcnt vmcnt(0)" ::: "memory");
        } else {
            XB_SPIN(xb_ld(&bar[XB_XGEN(b.x)]) == gen, bar);
            __builtin_amdgcn_fence(__ATOMIC_ACQUIRE, "agent");
            asm volatile("s_waitcnt vmcnt(0)" ::: "memory");
        }
    }
    __syncthreads();
}

struct Args { const float* in[24]; float* out; unsigned char* ws; int ph_lo, ph_hi; };
#define CAS __attribute__((address_space(4)))
typedef const CAS unsigned char* karg_t;
struct KA { karg_t p;
    __device__ __forceinline__ const float* in(int k) const { return *(const float* const CAS*)(p + 8 * k); }
    __device__ __forceinline__ float* out() const { return *(float* const CAS*)(p + 192); }
    __device__ __forceinline__ unsigned char* ws() const { return *(unsigned char* const CAS*)(p + 200); }
    __device__ __forceinline__ int ph_lo() const { return *(const int CAS*)(p + 208); }
    __device__ __forceinline__ int ph_hi() const { return *(const int CAS*)(p + 212); }
};
static_assert(sizeof(Args) == 216, "Args layout");
__device__ __forceinline__ KA ka_fresh() { KA a; a.p = (karg_t)__builtin_amdgcn_kernarg_segment_ptr(); asm volatile("" : "+s"(a.p)); return a; }
struct Ctx {
    LAS unsigned char* lds;
    int tid, lane, wave, G, bid;
};
__device__ __forceinline__ Ctx ctx_fresh() {
    extern __shared__ __attribute__((aligned(16))) unsigned char lds_raw[];
    Ctx C; C.lds = (LAS unsigned char*)lds_raw; int t = threadIdx.x; asm volatile("" : "+v"(t));
    C.tid = t; C.lane = t & 63; C.wave = __builtin_amdgcn_readfirstlane(t >> 6); C.G = gridDim.x; C.bid = blockIdx.x; return C;
}
__device__ __forceinline__ const float* stream_in(const KA& A, const Ctx& C, int l, int row) {
    if (row < RL) return (l == 0 ? A.in(0) : (const float*)A.out()) + (size_t)row * DM;
    return (l == 0 ? A.in(2) : (const float*)(A.ws() + WS_CTXS)) + (size_t)(row - RL) * DM;
}
__device__ __forceinline__ float* stream_out(const KA& A, const Ctx& C, int row) {
    if (row < RL) return A.out() + (size_t)row * DM;
    return (float*)(A.ws() + WS_CTXS) + (size_t)(row - RL) * DM;
}

__device__ __forceinline__ void p0_transpose_item(const float* W, int K, int N, bf16* WT, int n0, int dst_row0, LAS float* scr, int kb, int lane) {
    const int k0 = 64 * kb;
#pragma unroll 8
    for (int i = 0; i < 32; ++i) { const int kk = 2 * i + (lane >> 5); const int n = n0 + (lane & 31); scr[kk * 33 + (lane & 31)] = (n < N) ? W[(size_t)(k0 + kk) * N + n] : 0.f; }
    LDS_WAIT(); asm volatile("" ::: "memory");
    const int c = lane & 7;
#pragma unroll
    for (int j = 0; j < 4; ++j) { const int n = (lane >> 3) + 8 * j; const LAS float* s = scr + (8 * c) * 33 + n;
        u32x4 o; o.x = pk2(s[0 * 33], s[1 * 33]); o.y = pk2(s[2 * 33], s[3 * 33]); o.z = pk2(s[4 * 33], s[5 * 33]); o.w = pk2(s[6 * 33], s[7 * 33]);
        *(u32x4*)(WT + (size_t)(dst_row0 + n) * K + k0 + 8 * c) = o; }
    LDS_WAIT(); asm volatile("" ::: "memory");
}
__device__ __forceinline__ void p0_poolw_item(const float* Win, const float* Wp, bf16* WT, LAS float* scr, int kb, int nb, int lane) {
    const int k0 = 64 * kb, g = nb >> 1, e = (nb & 1) * 32 + (lane & 31);
    float wc[64];
#pragma unroll
    for (int c = 0; c < 64; ++c) wc[c] = Wp[((size_t)g * 64 + c) * 64 + e];
#pragma unroll 2
    for (int i = 0; i < 32; ++i) { const int kk = 2 * i + (lane >> 5); const float* wr = Win + (size_t)(k0 + kk) * 1968 + g * 64; float a = 0.f;
#pragma unroll
        for (int c4 = 0; c4 < 16; ++c4) { const f32x4 x = *(const f32x4*)(wr + 4 * c4); a += x.x * wc[4 * c4] + x.y * wc[4 * c4 + 1] + x.z * wc[4 * c4 + 2] + x.w * wc[4 * c4 + 3]; }
        scr[kk * 33 + (lane & 31)] = a; }
    LDS_WAIT(); asm volatile("" ::: "memory");
    const int c = lane & 7;
#pragma unroll
    for (int j = 0; j < 4; ++j) { const int n = (lane >> 3) + 8 * j; const LAS float* sp = scr + (8 * c) * 33 + n;
        u32x4 o; o.x = pk2(sp[0 * 33], sp[1 * 33]); o.y = pk2(sp[2 * 33], sp[3 * 33]); o.z = pk2(sp[4 * 33], sp[5 * 33]); o.w = pk2(sp[6 * 33], sp[7 * 33]);
        *(u32x4*)(WT + (size_t)(32 * nb + n) * DM + k0 + 8 * c) = o; }
    LDS_WAIT(); asm volatile("" ::: "memory");
}
__device__ __forceinline__ void phase_prologue() {
    const KA A = ka_fresh(); const Ctx C = ctx_fresh();
    LAS float* scr = (LAS float*)(C.lds + C.wave * 16384);
    const int gw = C.bid * 8 + C.wave, NGW = C.G * 8, lane = C.lane;
    float* MODP = (float*)(A.ws() + WS_MODP);
    for (int it = gw; it < 2 * 96 * 8; it += NGW) {
        const int ks = it & 7, l = (it >> 3) / 96, j = ((it >> 3) % 96) * 64 + lane;
        const float* W = A.in(6) + ((size_t)l * DM + ks * 128) * 6144 + j;
        const float* c01 = A.in(1) + ks * 128; const float* c2p = A.in(3) + ks * 128;
        float a0 = 0.f, a1 = 0.f, a2 = 0.f;
#pragma unroll 16
        for (int k = 0; k < 128; ++k) {
            const float w = W[(size_t)k * 6144];
            const float c0 = c01[k], c1 = c01[DM + k], c2 = c2p[k];
            a0 += (c0 / (1.f + __expf(-c0))) * w; a1 += (c1 / (1.f + __expf(-c1))) * w; a2 += (c2 / (1.f + __expf(-c2))) * w;
        }
        float* mp = MODP + ((size_t)(l * 8 + ks) * 3) * 6144 + j;
        mp[0] = a0; mp[6144] = a1; mp[2 * 6144] = a2;
    }
    constexpr int I_IN = 16 * 64, I_UQ = 6 * 24, I_UKV = 4 * 32, I_OUT = 16 * 32, I_PQ = 16 * 64, I_L = I_IN + I_UQ + I_UKV + I_OUT + I_PQ;
    for (int it = gw; it < 2 * I_L; it += NGW) {
        const int l = it / I_L; int r = it % I_L;
        if (r < I_IN) {
            const int kb = r / 64, nb = r % 64;
            if (nb < 8) { p0_poolw_item(A.in(8) + (size_t)l * DM * 1968, A.in(9) + (size_t)l * 4 * 64 * 64, (bf16*)(A.ws() + WS_WIN) + (size_t)l * 2048 * DM, scr, kb, nb, lane); continue; }
            const int dst = nb < 29 ? 32 * nb : (nb < 61 ? 96 + 32 * nb : (nb == 61 ? 928 : (nb == 62 ? 960 : 992)));
            const int n0 = nb < 62 ? 32 * nb : 4096;
            p0_transpose_item(A.in(8) + (size_t)l * DM * 1968, DM, 1968, (bf16*)(A.ws() + WS_WIN) + (size_t)l * 2048 * DM, n0, dst, scr, kb, lane); continue; }
        r -= I_IN;
        if (r < I_UQ) { const int kb = r / 24, nb = r % 24; p0_transpose_item(A.in(13) + (size_t)l * 384 * 768, 384, 768, (bf16*)(A.ws() + WS_WUQ) + (size_t)l * 768 * 384, 32 * nb, 32 * nb, scr, kb, lane); continue; }
        r -= I_UQ;
        if (r < I_UKV) { const int kb = r / 32, nb = r % 32; p0_transpose_item(A.in(14) + (size_t)l * 256 * 1024, 256, 1024, (bf16*)(A.ws() + WS_WUKV) + (size_t)l * 1024 * 256, 32 * nb, 32 * nb, scr, kb, lane); continue; }
        r -= I_UKV;
        if (r < I_OUT) { const int kb = r / 32, nb = r % 32; p0_transpose_item(A.in(19) + (size_t)l * DM * DM, DM, DM, (bf16*)(A.ws() + WS_WOUT) + (size_t)l * DM * DM, 32 * nb, 32 * nb, scr, kb, lane); continue; }
        r -= I_OUT;
        { const int kb = r / 64, nb = r % 64; p0_transpose_item(A.in(20) + (size_t)l * DM * 2048, DM, 2048, (bf16*)(A.ws() + WS_WPQ) + (size_t)l * 2048 * DM, 32 * nb, 32 * nb, scr, kb, lane); }
    }
    const int gt = C.bid * 512 + C.tid, NT = C.G * 512;
    { const float* s = A.in(21); bf16* d = (bf16*)(A.ws() + WS_SUBK);
      for (int i = gt; i < 2 * 8 * 2 * 128 * 128 / 4; i += NT) { const f32x4 v = *(const f32x4*)(s + 4 * (size_t)i); u32x2 o; o.x = pk2(v.x, v.y); o.y = pk2(v.z, v.w); *(u32x2*)(d + 4 * (size_t)i) = o; } }
    { float* rp = (float*)(A.ws() + WS_ROPE);
      for (int i = gt; i < 256 * 8; i += NT) { const int p = i >> 3, f = i & 7;
          const float fr[8] = {1.0f, 0.31622776601683794f, 0.1f, 0.031622776601683794f, 0.01f, 0.0031622776601683794f, 0.001f, 0.00031622776601683794f};
          float fq = fr[0];
#pragma unroll
          for (int q = 1; q < 8; ++q) fq = (f == q) ? fr[q] : fq;
          const float ang = (float)p * fq;
          const double rev = (double)ang * 0.15915494309189535; const float fracr = (float)(rev - floor(rev));
          rp[2 * i] = __builtin_amdgcn_cosf(fracr); rp[2 * i + 1] = __builtin_amdgcn_sinf(fracr); } }
}

__device__ __forceinline__ void phase_modreduce() {
    const KA A = ka_fresh(); const Ctx C = ctx_fresh();
    const int gt = C.bid * 512 + C.tid, NT = C.G * 512;
    const float* MODP = (const float*)(A.ws() + WS_MODP); float* MOD = (float*)(A.ws() + WS_MOD);
    for (int i = gt; i < 2 * 3 * 6144; i += NT) { const int l = i / (3 * 6144), rem = i % (3 * 6144), j = rem % 6144;
        float a = A.in(7)[l * 6144 + j];
#pragma unroll
        for (int ks = 0; ks < 8; ++ks) a += MODP[((size_t)(l * 8 + ks) * 3) * 6144 + rem];
        const int slot = j >> 10;
        if (slot == 1) a = A.in(4)[l * DM + (j & 1023)] * (1.0f + a); else if (slot == 4) a = A.in(5)[l * DM + (j & 1023)] * (1.0f + a);
        MOD[i] = a; }
}
__device__ __forceinline__ void phase_norm(int l, int which) {
    const KA A = ka_fresh(); const Ctx C = ctx_fresh();
    const int gw = C.bid * 8 + C.wave, NGW = C.G * 8, lane = C.lane;
    const float* MOD = (const float*)(A.ws() + WS_MOD);
    bf16* XN = (bf16*)(A.ws() + WS_XN);
    const int nrows = (which == 1 && l == 1) ? RL : RT;
    int cur = -1; f32x4 csh[4], cgs[4];
    for (int row = gw; row < nrows; row += NGW) {
        const float* xr = (which == 0) ? stream_in(A, C, l, row) : (const float*)stream_out(A, C, row);
        const int nsel = row < RL ? (row >> 14) : 2;
        if (nsel != cur) { cur = nsel; const float* md = MOD + (l * 3 + nsel) * 6144 + which * 3072;
#pragma unroll
            for (int i = 0; i < 4; ++i) { const int j = 4 * lane + 256 * i; csh[i] = *(const f32x4*)(md + j); cgs[i] = *(const f32x4*)(md + 1024 + j); } }
        f32x4 v[4]; float ss = 0.f;
#pragma unroll
        for (int i = 0; i < 4; ++i) { v[i] = *(const f32x4*)(xr + 4 * lane + 256 * i); ss += (v[i].x * v[i].x + v[i].y * v[i].y) + (v[i].z * v[i].z + v[i].w * v[i].w); }
        const float rs = 1.0f / sqrtf(wave_sum(ss, lane) * (1.f / DM) + EPS);
#pragma unroll
        for (int i = 0; i < 4; ++i) { const int j = 4 * lane + 256 * i;
            const f32x4 y = v[i] * rs * cgs[i] + csh[i];
            u32x2 o; o.x = pk2(y.x, y.y); o.y = pk2(y.z, y.w); *(u32x2*)(XN + (size_t)row * DM + j) = o; }
    }
}
constexpr float U_SCALE = 48.f, V_SCALE = 1.5f;
constexpr int TROW = 768;
struct __attribute__((packed, aligned(4))) U3 { unsigned a, b, c; };
__device__ __forceinline__ unsigned q_e2m3(float x) {
    const unsigned sg = (__builtin_bit_cast(unsigned, x) >> 31) << 5;
    const float a = fminf(fabsf(x), 7.5f);
    const float t = a * (a < 2.f ? 8.f : (a < 4.f ? 4.f : 2.f));
    return sg | ((unsigned)__builtin_rintf(t) + (a < 2.f ? 0u : (a < 4.f ? 8u : 16u)));
}
__device__ __forceinline__ void phase_tables(int l) {
    const KA A = ka_fresh(); const Ctx C = ctx_fresh();
    const size_t gt = (size_t)C.bid * 512 + C.tid, NT = (size_t)C.G * 512;
    const size_t n16 = (size_t)16384 * 1024 / 16;
#pragma unroll
    for (int w = 0; w < 2; ++w) {
        const float* s = A.in(22 + w) + (size_t)l * 16384 * 1024; unsigned char* d = A.ws() + (w ? WS_TABV : WS_TABU);
        const float sc = w ? V_SCALE : U_SCALE;
        for (size_t i = gt; i < n16; i += NT) {
            unsigned c[16];
#pragma unroll
            for (int q = 0; q < 4; ++q) { const f32x4 x = *(const f32x4*)(s + 16 * i + 4 * q);
                c[4 * q] = q_e2m3(x.x * sc); c[4 * q + 1] = q_e2m3(x.y * sc); c[4 * q + 2] = q_e2m3(x.z * sc); c[4 * q + 3] = q_e2m3(x.w * sc); }
            U3 o;
            o.a = c[0] | (c[1] << 6) | (c[2] << 12) | (c[3] << 18) | (c[4] << 24) | (c[5] << 30);
            o.b = (c[5] >> 2) | (c[6] << 4) | (c[7] << 10) | (c[8] << 16) | (c[9] << 22) | (c[10] << 28);
            o.c = (c[10] >> 4) | (c[11] << 2) | (c[12] << 8) | (c[13] << 14) | (c[14] << 20) | (c[15] << 26);
            *(U3*)(d + 12 * i) = o; }
    }
}

__device__ __forceinline__ void phase_post(int l) {
    const KA A = ka_fresh(); const Ctx C = ctx_fresh();
    const bf16* ZA = (const bf16*)(A.ws() + WS_ZA);
    bf16* MIX = (bf16*)(A.ws() + WS_MIX); bf16* QA = (bf16*)(A.ws() + WS_QA); bf16* KVA = (bf16*)(A.ws() + WS_KVA); bf16* KR = (bf16*)(A.ws() + WS_KR);
    float* GT = (float*)(A.ws() + WS_G);
    LAS float* U = (LAS float*)C.lds;
    const int tid = C.tid, lane = C.lane;
    for (int unit = C.bid; unit < RT / 32; unit += C.G) {
        const int r0 = unit * 32;
        int seq0, L;
        if (r0 < RL) { seq0 = (r0 >> 14) << 14; L = SEQ; } else { seq0 = RL + (((r0 - RL) >> 8) << 8); L = CTXL; }
        const int t0 = r0 - seq0;
        for (int idx = tid; idx < 48 * 32; idx += 512) { const int rr = idx >> 5, c8 = idx & 31; const int t = t0 - 8 + rr;
            u32x4 v = {0u, 0u, 0u, 0u};
            if (t >= 0 && t < L) v = *(const u32x4*)(ZA + (size_t)(seq0 + t) * 1024 + c8 * 8);
            LAS float* d = U + rr * 256 + c8 * 8;
            d[0] = bflo(v.x); d[1] = bfhi(v.x); d[2] = bflo(v.y); d[3] = bfhi(v.y); d[4] = bflo(v.z); d[5] = bfhi(v.z); d[6] = bflo(v.w); d[7] = bfhi(v.w); }
        __syncthreads();
        { const int ch = tid & 255, half = tid >> 8, hw = __builtin_amdgcn_readfirstlane(1 << (ch >> 6));
          const float sc = A.in(10)[l * 256 + ch];
          for (int i = half * 16; i < half * 16 + 16; ++i) { const int t = t0 + i; const int lo = max(t - hw, 0), hi = min(t + hw, L);
              float sm = 0.f; for (int tt = lo; tt < hi; ++tt) sm += U[(tt - t0 + 8) * 256 + ch];
              const float dv = sm / (float)(hi - lo) - U[(i + 8) * 256 + ch];
              MIX[(size_t)(r0 + i) * 1024 + ch] = (bf16)f2bf(dv * sc); } }
#pragma unroll
        for (int q = 0; q < 4; ++q) { const int row = r0 + C.wave * 4 + q; const bf16* za = ZA + (size_t)row * 1024;
            { float x[6]; float ss = 0.f;
#pragma unroll
              for (int i = 0; i < 3; ++i) { const unsigned w = *(const unsigned*)(za + 256 + 2 * lane + 128 * i); x[2 * i] = bflo(w); x[2 * i + 1] = bfhi(w); ss += x[2 * i] * x[2 * i] + x[2 * i + 1] * x[2 * i + 1]; }
              const float rs = 1.0f / sqrtf(wave_sum(ss, lane) * (1.f / 384.f) + EPS); const float* gq = A.in(11) + l * 384;
#pragma unroll
              for (int i = 0; i < 3; ++i) { const int j = 2 * lane + 128 * i; *(unsigned*)(QA + (size_t)row * 384 + j) = pk2(x[2 * i] * rs * gq[j], x[2 * i + 1] * rs * gq[j + 1]); } }
            { const u32x2 w = *(const u32x2*)(za + 640 + 4 * lane);
              const float x0 = bflo(w.x), x1 = bfhi(w.x), x2 = bflo(w.y), x3 = bfhi(w.y);
              const float rs = 1.0f / sqrtf(wave_sum(x0 * x0 + x1 * x1 + x2 * x2 + x3 * x3, lane) * (1.f / 256.f) + EPS); const float* gk = A.in(12) + l * 256 + 4 * lane;
              u32x2 o; o.x = pk2(x0 * rs * gk[0], x1 * rs * gk[1]); o.y = pk2(x2 * rs * gk[2], x3 * rs * gk[3]); *(u32x2*)(KVA + (size_t)row * 256 + 4 * lane) = o; }
            if (lane < 16) *(unsigned*)(KR + (size_t)row * 32 + 2 * lane) = *(const unsigned*)(za + 896 + 2 * lane);
            if (lane < 16) { float gv = bf2f(za[928 + lane]) + A.in(17)[l * 16 + lane];
                if ((lane >> 2) & 1) gv = fminf(gv, 0.f) - log1pf(__expf(-fabsf(gv)));
                GT[(size_t)row * 16 + lane] = gv; }
        }
        __syncthreads();
    }
}

__device__ __forceinline__ unsigned fp8x4(float a, float b, float c, float d) {
    a = __builtin_amdgcn_fmed3f(a, -448.f, 448.f); b = __builtin_amdgcn_fmed3f(b, -448.f, 448.f); c = __builtin_amdgcn_fmed3f(c, -448.f, 448.f); d = __builtin_amdgcn_fmed3f(d, -448.f, 448.f);
    int w = __builtin_amdgcn_cvt_pk_fp8_f32(a, b, 0, false); w = __builtin_amdgcn_cvt_pk_fp8_f32(c, d, w, true); return (unsigned)w;
}
__device__ __forceinline__ void qk_head(const bf16* src_lo, const bf16* src_hi, unsigned char* dst, int sw, const float* gn, bool rot, const float (&cs)[16], const float (&sn)[16], float oscale) {
    float ss = 0.f;
#pragma unroll 4
    for (int i = 0; i < 8; ++i) { const u32x4 w = *(const u32x4*)(src_lo + 8 * i);
        ss += (bflo(w.x) * bflo(w.x) + bfhi(w.x) * bfhi(w.x)) + (bflo(w.y) * bflo(w.y) + bfhi(w.y) * bfhi(w.y)) + (bflo(w.z) * bflo(w.z) + bfhi(w.z) * bfhi(w.z)) + (bflo(w.w) * bflo(w.w) + bfhi(w.w) * bfhi(w.w)); }
    u32x4 wr[4];
#pragma unroll
    for (int i = 0; i < 4; ++i) { wr[i] = *(const u32x4*)(src_hi + 8 * i); const u32x4 w = wr[i];
        ss += (bflo(w.x) * bflo(w.x) + bfhi(w.x) * bfhi(w.x)) + (bflo(w.y) * bflo(w.y) + bfhi(w.y) * bfhi(w.y)) + (bflo(w.z) * bflo(w.z) + bfhi(w.z) * bfhi(w.z)) + (bflo(w.w) * bflo(w.w) + bfhi(w.w) * bfhi(w.w)); }
    const float rs = oscale / sqrtf(ss * (1.f / 96.f) + EPS);
    __builtin_amdgcn_sched_barrier(0);
#pragma unroll 1
    for (int i = 0; i < 8; ++i) {
        const u32x4 w = *(const u32x4*)(src_lo + 8 * i); const f32x4 g0 = *(const f32x4*)(gn + 8 * i), g1 = *(const f32x4*)(gn + 8 * i + 4);
        u32x2 o; o.x = fp8x4(bflo(w.x) * rs * g0.x, bfhi(w.x) * rs * g0.y, bflo(w.y) * rs * g0.z, bfhi(w.y) * rs * g0.w);
        o.y = fp8x4(bflo(w.z) * rs * g1.x, bfhi(w.z) * rs * g1.y, bflo(w.w) * rs * g1.z, bfhi(w.w) * rs * g1.w);
        *(u32x2*)(dst + ((((i >> 1) ^ sw) << 4) + ((i & 1) << 3))) = o; }
    __builtin_amdgcn_sched_barrier(0);
#pragma unroll
    for (int i = 0; i < 2; ++i) {
        const u32x4 p = wr[i], q = wr[2 + i];
        const f32x4 ga = *(const f32x4*)(gn + 64 + 8 * i), gb = *(const f32x4*)(gn + 64 + 8 * i + 4), gc = *(const f32x4*)(gn + 80 + 8 * i), gd = *(const f32x4*)(gn + 80 + 8 * i + 4);
        float y1[8], y2[8];
        y1[0] = bflo(p.x) * rs * ga.x; y1[1] = bfhi(p.x) * rs * ga.y; y1[2] = bflo(p.y) * rs * ga.z; y1[3] = bfhi(p.y) * rs * ga.w; y1[4] = bflo(p.z) * rs * gb.x; y1[5] = bfhi(p.z) * rs * gb.y; y1[6] = bflo(p.w) * rs * gb.z; y1[7] = bfhi(p.w) * rs * gb.w;
        y2[0] = bflo(q.x) * rs * gc.x; y2[1] = bfhi(q.x) * rs * gc.y; y2[2] = bflo(q.y) * rs * gc.z; y2[3] = bfhi(q.y) * rs * gc.w; y2[4] = bflo(q.z) * rs * gd.x; y2[5] = bfhi(q.z) * rs * gd.y; y2[6] = bflo(q.w) * rs * gd.z; y2[7] = bfhi(q.w) * rs * gd.w;
        if (rot) {
#pragma unroll
            for (int j = 0; j < 8; ++j) { const float a = y1[j] * cs[8 * i + j] - y2[j] * sn[8 * i + j], bb = y2[j] * cs[8 * i + j] + y1[j] * sn[8 * i + j]; y1[j] = a; y2[j] = bb; }
        }
        u32x2 o; o.x = fp8x4(y1[0], y1[1], y1[2], y1[3]); o.y = fp8x4(y1[4], y1[5], y1[6], y1[7]); *(u32x2*)(dst + (((4 ^ sw) << 4) + (i << 3))) = o;
        u32x2 o2; o2.x = fp8x4(y2[0], y2[1], y2[2], y2[3]); o2.y = fp8x4(y2[4], y2[5], y2[6], y2[7]); *(u32x2*)(dst + (((5 ^ sw) << 4) + (i << 3))) = o2;
    }
    { u32x4 z; z.x = 0u; z.y = 0u; z.z = 0u; z.w = 0u; *(u32x4*)(dst + ((6 ^ sw) << 4)) = z; *(u32x4*)(dst + ((7 ^ sw) << 4)) = z; }
    __builtin_amdgcn_sched_barrier(0);
}
__device__ __forceinline__ void phase_qknorm(int l) {
    const KA A = ka_fresh(); const Ctx C = ctx_fresh();
    const int gw = C.bid * 8 + C.wave, NGW = C.G * 8, lane = C.lane;
    const bf16* Q = (const bf16*)(A.ws() + WS_Q); const bf16* KV = (const bf16*)(A.ws() + WS_KVRAW); const bf16* KR = (const bf16*)(A.ws() + WS_KR);
    unsigned char* KN = A.ws() + WS_KN; unsigned char* VT = A.ws() + WS_VT;
    const float* rope = (const float*)(A.ws() + WS_ROPE);
    const float* qg = A.in(15) + l * 96; const float* kg = A.in(16) + l * 96;
    for (int u = gw; u < (RT / 64) * 8; u += NGW) {
        const int h = u & 7, tl = u >> 3, row0 = tl * 64, row = row0 + lane;
        const bool lat = row0 < RL; int b, t0;
        if (lat) { b = row0 >> 14; t0 = row0 & (SEQ - 1); } else { b = (row0 - RL) >> 8; t0 = (row0 - RL) & 255; }
        const int ktile = lat ? (t0 >> 6) : (SEQ + t0) >> 6;
        float cs[16], sn[16];
#pragma unroll
        for (int i = 0; i < 16; ++i) { cs[i] = 1.f; sn[i] = 0.f; }
        if (lat) {
#pragma unroll
            for (int i = 0; i < 16; ++i) { const int p = (i < 8) ? (t0 >> 6) : lane; const float* rp = rope + (p * 8 + (i & 7)) * 2; cs[i] = rp[0]; sn[i] = rp[1]; }
        }
        { const bf16* qp = Q + (size_t)row * 768 + h * 96;
          qk_head(qp, qp + 64, A.ws() + WS_Q8 + (size_t)row * 1024 + h * 128, 0, qg, lat, cs, sn, QSCALE); }
        const bf16* kvp = KV + (size_t)row * 1024 + h * 128;
        qk_head(kvp, KR + (size_t)row * 32, KN + ((size_t)(b * 8 + h) * NKT + ktile) * KT_BYTES + lane * 128, (lane >> 1) & 7, kg, lat, cs, sn, 1.0f);
        { const int kap = lane & 15; const int pos = (lane & ~15) + 8 * ((kap >> 2) & 1) + 4 * (kap >> 3) + (kap & 3);
          bf16* vd = (bf16*)(VT + ((size_t)(b * 8 + h) * NKT + ktile) * VT_BYTES);
          const int pa = pos >> 3, pb = pos & 7;
#pragma unroll 1
          for (int i = 0; i < 8; ++i) { const u32x4 vv = *(const u32x4*)(kvp + 64 + 8 * i);
#pragma unroll
              for (int e = 0; e < 8; ++e) { const int d = 8 * i + e; const unsigned wd = (e >> 1) == 0 ? vv.x : ((e >> 1) == 1 ? vv.y : ((e >> 1) == 2 ? vv.z : vv.w)); const bf16 val = (bf16)((e & 1) ? (wd >> 16) : (wd & 0xffffu));
                  vd[(unsigned)(d * 64 + ((pa ^ ((d >> 1) & 7)) << 3) + pb)] = val; } } }
    }
}

__device__ __forceinline__ int ml_row(int b, int dir, int j, int s) {
    if (j < 4) { const int p = 64 * j + s; return RL + b * CTXL + (dir ? CTXL - 1 - p : p); }
    const int p = 64 * (j - 4) + s; return b * SEQ + (dir ? SEQ - 1 - p : p);
}
__device__ __forceinline__ void phase_ml_local() {
    const KA A = ka_fresh(); const Ctx C = ctx_fresh();
    const int gw = C.bid * 8 + C.wave, NGW = C.G * 8, lane = C.lane, r = lane & 31, hh = lane >> 5;
    const bf16* ZB = (const bf16*)(A.ws() + WS_ZB); const float* GT = (const float*)(A.ws() + WS_G);
    float* CST = (float*)(A.ws() + WS_CST); float* SC = (float*)(A.ws() + WS_SC);
    for (int u = gw; u < 16 * NCH; u += NGW) {
        const int sq = u / NCH, j = u % NCH, b = sq >> 3, h = (sq >> 1) & 3, dir = sq & 1;
        const int rowl = ml_row(b, dir, j, lane);
        const float gi = GT[(size_t)rowl * 16 + dir * 8 + h], lf = GT[(size_t)rowl * 16 + dir * 8 + 4 + h];
        float bs = lf;
#pragma unroll
        for (int o = 1; o < 64; o <<= 1) { const float tv = shfl_idx(bs, lane - o); if (lane >= o) bs += tv; }
        const float blast = shfl_idx(bs, 63);
        const float dec = blast + gi - bs;
        const float mloc = wave_max(dec, lane);
        const float w = __expf(dec - mloc);
        const int row0 = ml_row(b, dir, j, 0), rstep = dir ? -1 : 1;
        f32x16 acc[2][2];
#pragma unroll
        for (int vb = 0; vb < 2; ++vb)
#pragma unroll
            for (int db = 0; db < 2; ++db) acc[vb][db] = ML_ZERO16;
        float nacc0 = 0.f, nacc1 = 0.f;
#pragma unroll
        for (int st = 0; st < 4; ++st) {
            float ws[8]; unsigned rofs[8];
#pragma unroll
            for (int jj = 0; jj < 8; ++jj) { const int sidx = 16 * st + 8 * hh + jj; ws[jj] = shfl_idx(w, sidx); rofs[jj] = (unsigned)((row0 + rstep * sidx) * 1024 + h * 64 + r); }
            bf16x8 Af[2], Bf[2];
#pragma unroll
            for (int blk = 0; blk < 2; ++blk) {
                float kx[8];
#pragma unroll
                for (int jj = 0; jj < 8; ++jj) { kx[jj] = bf2f(ZB[rofs[jj] + 256 + 32 * blk]); Bf[blk][jj] = (short)ZB[rofs[jj] + 256 + 32 * blk]; }
                if (blk == 0) {
#pragma unroll
                    for (int jj = 0; jj < 8; ++jj) nacc0 += ws[jj] * kx[jj]; }
                else {
#pragma unroll
                    for (int jj = 0; jj < 8; ++jj) nacc1 += ws[jj] * kx[jj]; }
                float vx[8];
#pragma unroll
                for (int jj = 0; jj < 8; ++jj) vx[jj] = bf2f(ZB[rofs[jj] + 512 + 32 * blk]) * ws[jj];
                Af[blk] = pack8(vx[0], vx[1], vx[2], vx[3], vx[4], vx[5], vx[6], vx[7]);
            }
#pragma unroll
            for (int vb = 0; vb < 2; ++vb)
#pragma unroll
                for (int db = 0; db < 2; ++db) acc[vb][db] = MFMA32(Af[vb], Bf[db], acc[vb][db]);
            __builtin_amdgcn_sched_barrier(0);
        }
        float* cp = CST + (size_t)u * CSTF;
#pragma unroll
        for (int vb = 0; vb < 2; ++vb)
#pragma unroll
            for (int db = 0; db < 2; ++db)
#pragma unroll
                for (int g = 0; g < 16; ++g) cp[(32 * vb + crow(g, hh)) * 64 + 32 * db + r] = acc[vb][db][g];
        nacc0 += shfl_idx(nacc0, lane ^ 32); nacc1 += shfl_idx(nacc1, lane ^ 32);
        if (hh == 0) { cp[4096 + r] = nacc0; cp[4096 + 32 + r] = nacc1; }
        if (lane == 0) { SC[u * 2] = mloc; SC[u * 2 + 1] = blast; }
    }
}
__device__ __forceinline__ void phase_ml_scan() {
    const KA A = ka_fresh(); const Ctx C = ctx_fresh();
    const int gt = C.bid * 512 + C.tid, NT = C.G * 512;
    float* CST = (float*)(A.ws() + WS_CST); const float* SC = (const float*)(A.ws() + WS_SC); float* MS = (float*)(A.ws() + WS_MS);
    for (int e = gt; e < 16 * CSTF; e += NT) {
        const int sq = e / CSTF, el = e % CSTF;
        float* base = CST + (size_t)sq * NCH * CSTF + el;
        float cv = 0.f, m = -1e30f;
#pragma unroll 1
        for (int j0 = 0; j0 < NCH; j0 += 10) {
            float loc[10]; f32x2_t sc[10];
#pragma unroll
            for (int u = 0; u < 10; ++u) { loc[u] = base[(size_t)(j0 + u) * CSTF]; sc[u] = *(const f32x2_t*)(SC + (sq * NCH + j0 + u) * 2); }
#pragma unroll
            for (int u = 0; u < 10; ++u) {
                base[(size_t)(j0 + u) * CSTF] = cv;
                if (el == 0) MS[sq * NCH + j0 + u] = m;
                const float mn = fmaxf(sc[u].y + m, sc[u].x);
                cv = __expf(sc[u].y + m - mn) * cv + __expf(sc[u].x - mn) * loc[u]; m = mn;
            }
        }
    }
}
template <int DIR>
__device__ __forceinline__ void ml_sblock(f32x16& S, float& den, const bf16* ZB, const bf16x8 (&Qf)[4], int sb, int base_row, int h, int r, int hh, int jl, float a, float Mj) {
    S = ML_ZERO16;
    const int sr = 32 * sb + r; const int rows = base_row + (DIR ? 63 - sr : sr);
#pragma unroll
    for (int st = 0; st < 4; ++st) { const bf16x8 Kf = *(const bf16x8*)(ZB + (unsigned)(rows * 1024 + 256 + h * 64 + st * 16 + hh * 8)); S = MFMA32(Kf, Qf[st], S); }
#pragma unroll
    for (int g = 0; g < 16; ++g) { const int s = 32 * sb + crow(g, hh); const float as = shfl_idx(a, s);
        const float p = (s <= jl) ? S[g] * 0.125f * __expf(as - Mj) : 0.f; S[g] = p; den += p; }
}
template <int DIR>
__device__ __forceinline__ void ml_pv(f32x16& O, const f32x16& S, const bf16* ZB, int sb, int base_row, int h, int v, int hh) {
#pragma unroll
    for (int st2 = 0; st2 < 2; ++st2) {
        bf16x8 VA;
#pragma unroll
        for (int jj = 0; jj < 8; ++jj) { const int s = 32 * sb + 16 * st2 + 8 * (jj >> 2) + 4 * hh + (jj & 3); const int rows = base_row + (DIR ? 63 - s : s);
            VA[jj] = (short)ZB[(unsigned)(rows * 1024 + 512 + h * 64 + v)]; }
        const bf16x8 PB = pack8(S[8 * st2 + 0], S[8 * st2 + 1], S[8 * st2 + 2], S[8 * st2 + 3], S[8 * st2 + 4], S[8 * st2 + 5], S[8 * st2 + 6], S[8 * st2 + 7]);
        O = MFMA32(VA, PB, O);
        __builtin_amdgcn_sched_barrier(0);
    }
}
template <int DIR>
__device__ __forceinline__ void ml_out_dir(const KA& A, const Ctx& C, LAS float* H, int b, int h, int c, int base_row, int lane) {
    const bf16* ZB = (const bf16*)(A.ws() + WS_ZB); const float* GT = (const float*)(A.ws() + WS_G);
    const float* CST = (const float*)(A.ws() + WS_CST); const float* MS = (const float*)(A.ws() + WS_MS);
    const int r = lane & 31, hh = lane >> 5;
    const int j = DIR ? (c < 4 ? 3 - c : 263 - c) : c;
    const int sq = (b * 4 + h) * 2 + DIR;
    const float* Cp = CST + ((size_t)sq * NCH + j) * CSTF;
    const float m0 = MS[sq * NCH + j];
    const int rowl = base_row + (DIR ? 63 - lane : lane);
    const float gi = GT[(size_t)rowl * 16 + DIR * 8 + h], lf = GT[(size_t)rowl * 16 + DIR * 8 + 4 + h];
    float bs = lf;
#pragma unroll
    for (int o = 1; o < 64; o <<= 1) { const float tv = shfl_idx(bs, lane - o); if (lane >= o) bs += tv; }
    const float a = gi - bs;
    float pm = a;
#pragma unroll
    for (int o = 1; o < 64; o <<= 1) { const float tv = shfl_idx(pm, lane - o); if (lane >= o) pm = fmaxf(pm, tv); }
#pragma unroll 1
    for (int jb = 0; jb < 2; ++jb) {
        const int jl = 32 * jb + r;
        const float bj = shfl_idx(bs, jl), Mj = fmaxf(m0, shfl_idx(pm, jl));
        const int rowj = base_row + (DIR ? 63 - jl : jl);
        const int tok = DIR ? 63 - jl : jl;
        bf16x8 Qf[4];
#pragma unroll
        for (int st = 0; st < 4; ++st) Qf[st] = *(const bf16x8*)(ZB + (unsigned)(rowj * 1024 + h * 64 + st * 16 + hh * 8));
        f32x16 S0, S1 = ML_ZERO16; float den = 0.f;
        ml_sblock<DIR>(S0, den, ZB, Qf, 0, base_row, h, r, hh, jl, a, Mj);
        if (jb == 1) ml_sblock<DIR>(S1, den, ZB, Qf, 1, base_row, h, r, hh, jl, a, Mj);
        den += shfl_idx(den, lane ^ 32);
        const float wi = __expf(m0 - Mj) * 0.125f;
        float nq = 0.f;
#pragma unroll
        for (int st = 0; st < 4; ++st) { const f32x4 n0 = *(const f32x4*)(Cp + 4096 + st * 16 + hh * 8), n1 = *(const f32x4*)(Cp + 4096 + st * 16 + hh * 8 + 4);
            const u32x4 qw = __builtin_bit_cast(u32x4, Qf[st]);
            nq += n0.x * bflo(qw.x) + n0.y * bfhi(qw.x) + n0.z * bflo(qw.y) + n0.w * bfhi(qw.y) + n1.x * bflo(qw.z) + n1.y * bfhi(qw.z) + n1.z * bflo(qw.w) + n1.w * bfhi(qw.w); }
        nq += shfl_idx(nq, lane ^ 32);
        den += wi * nq;
        const float inv = 1.0f / fmaxf(fabsf(den), __expf(-(bj + Mj)));
#pragma unroll 1
        for (int vb = 0; vb < 2; ++vb) {
            const int v = 32 * vb + r;
            f32x16 O = ML_ZERO16;
            ml_pv<DIR>(O, S0, ZB, 0, base_row, h, v, hh);
            if (jb == 1) ml_pv<DIR>(O, S1, ZB, 1, base_row, h, v, hh);
            f32x16 I = ML_ZERO16;
#pragma unroll
            for (int st = 0; st < 4; ++st) { const float* cr = Cp + (size_t)v * 64 + st * 16 + hh * 8; const f32x4 c0 = *(const f32x4*)cr, c1 = *(const f32x4*)(cr + 4);
                const bf16x8 CA = pack8(c0.x, c0.y, c0.z, c0.w, c1.x, c1.y, c1.z, c1.w); I = MFMA32(CA, Qf[st], I); __builtin_amdgcn_sched_barrier(0); }
#pragma unroll
            for (int g = 0; g < 16; ++g) { const float hv = (O[g] + wi * I[g]) * inv; const int idx = (32 * vb + crow(g, hh)) * 65 + tok;
                if (DIR == 1) H[idx] = hv; else H[idx] += hv; }
        }
    }
}
__device__ __forceinline__ void phase_ml_out(int l) {
    const KA A = ka_fresh(); const Ctx C = ctx_fresh();
    const int gw = C.bid * 8 + C.wave, NGW = C.G * 8, lane = C.lane;
    const bf16* ZB = (const bf16*)(A.ws() + WS_ZB); bf16* MIX = (bf16*)(A.ws() + WS_MIX);
    LAS float* H = (LAS float*)(C.lds + C.wave * 16640);
    const int c_lo = (l == 1) ? 4 : 0, ncu = NCH - c_lo;
    for (int u = gw; u < 8 * ncu; u += NGW) {
        const int c = c_lo + u % ncu, bh = u / ncu, h = bh & 3, b = bh >> 2;
        const int base_row = c < 4 ? RL + b * CTXL + 64 * c : b * SEQ + 64 * (c - 4);
        ml_out_dir<1>(A, C, H, b, h, c, base_row, lane);
        LDS_WAIT(); asm volatile("" ::: "memory");
        ml_out_dir<0>(A, C, H, b, h, c, base_row, lane);
        LDS_WAIT(); asm volatile("" ::: "memory");
        float ss = 0.f;
#pragma unroll 8
        for (int v = 0; v < 64; ++v) { const float x = H[v * 65 + lane]; ss += x * x; }
        const float rs = 1.0f / sqrtf(ss * (1.f / 64.f) + EPS);
        const float gnv = A.in(18)[l * 256 + h * 64 + lane];
#pragma unroll 4
        for (int t = 0; t < 64; ++t) {
            const float rst = __builtin_bit_cast(float, __builtin_amdgcn_readlane(__builtin_bit_cast(int, rs), t));
            const size_t off = (size_t)(base_row + t) * 1024 + 768 + h * 64 + lane;
            const float o = bf2f(ZB[off]); const float sg = 1.0f / (1.0f + __expf(-o));
            MIX[off] = (bf16)f2bf(H[lane * 65 + t] * rst * gnv * sg);
        }
        LDS_WAIT(); asm volatile("" ::: "memory");
    }
}

__device__ __forceinline__ void glds16s(unsigned voff, const unsigned char* sbase, unsigned lds_dst) {
    unsigned keep;
    asm volatile("s_mov_b32 %0, m0\n\ts_mov_b32 m0, %3\n\ts_nop 0\n\tglobal_load_lds_dwordx4 %1, %2\n\ts_mov_b32 m0, %0" : "=&s"(keep) : "v"(voff), "s"(sbase), "s"(lds_dst) : "memory");
}
#define ATT_WAIT_BAR(N) asm volatile("s_waitcnt vmcnt(" #N ") lgkmcnt(0)\n\ts_barrier" ::: "memory")
constexpr int ATT_SLOT = 16384, ATT_NS = 6;
typedef int i32x8 __attribute__((ext_vector_type(8)));
#define MFMA8(a, b, c) __builtin_amdgcn_mfma_scale_f32_32x32x64_f8f6f4((a), (b), (c), 0, 0, 0, 127, 0, 127)
template <bool FIXEDREF>
__device__ __forceinline__ void attn_unit(const KA& A, const Ctx& C, int bh, int qrow0, int tile_lo, int ntiles) {
    int lane_ = C.lane; asm volatile("" : "+v"(lane_));
    const int lane = lane_, r = lane & 31, hh = lane >> 5, h = bh & 7;
    bf16* MIX = (bf16*)(A.ws() + WS_MIX);
    LAS unsigned char* lds = C.lds;
    const unsigned lds0 = (unsigned)(uintptr_t)lds;
    const int qrow = qrow0 + C.wave * 32 + r;
    const unsigned char* kg = A.ws() + WS_KN + ((size_t)bh * NKT + tile_lo) * KT_BYTES;
    const unsigned char* vg = A.ws() + WS_VT + ((size_t)bh * NKT + tile_lo) * VT_BYTES;
    const unsigned vo0 = (unsigned)(C.wave * 1024 + lane * 16);
    const unsigned d0 = lds0 + C.wave * 1024, d1 = d0 + 8192;
    int islot = 0;
#define ATT_ISSUE() do { const unsigned so_ = (unsigned)islot * ATT_SLOT; islot = (islot == ATT_NS - 1) ? 0 : islot + 1; \
        glds16s(vo0, kg, (unsigned)__builtin_amdgcn_readfirstlane(d0 + so_)); glds16s(vo0, vg, (unsigned)__builtin_amdgcn_readfirstlane(d1 + so_)); \
        kg += KT_BYTES; vg += VT_BYTES; } while (0)
    ATT_ISSUE(); ATT_ISSUE(); ATT_ISSUE();
    i32x8 qf[2];
    { const unsigned char* q8 = A.ws() + WS_Q8 + (size_t)qrow * 1024 + h * 128 + hh * 32;
#pragma unroll
      for (int st = 0; st < 2; ++st) { const u32x4 a = *(const u32x4*)(q8 + st * 64), b = *(const u32x4*)(q8 + st * 64 + 16);
          qf[st] = (i32x8){(int)a.x, (int)a.y, (int)a.z, (int)a.w, (int)b.x, (int)b.y, (int)b.z, (int)b.w}; } }
    f32x16 o0 = (f32x16){0.f, 0.f, 0.f, 0.f, 0.f, 0.f, 0.f, 0.f, 0.f, 0.f, 0.f, 0.f, 0.f, 0.f, 0.f, 0.f}, o1 = o0;
    float m = 0.f, lsum = 0.f;
    constexpr float THR = 8.f;
    const int ksw = (r >> 1) & 7;
    int cslot = 0, nslot = 1;
#define ATT_ADV() do { cslot = nslot; nslot = (nslot == ATT_NS - 1) ? 0 : nslot + 1; } while (0)
#define ATT_QKT(P0, P1, sl) do { const LAS unsigned char* Kb_ = lds + (sl) * ATT_SLOT + r * 128; P0 = ML_ZERO16; P1 = ML_ZERO16; \
        _Pragma("unroll") for (int st = 0; st < 2; ++st) { \
            const u32x4 a_ = *(const LAS u32x4*)(Kb_ + (((st * 4 + hh * 2) ^ ksw) << 4)), b_ = *(const LAS u32x4*)(Kb_ + (((st * 4 + hh * 2 + 1) ^ ksw) << 4)); \
            const u32x4 c_ = *(const LAS u32x4*)(Kb_ + 4096 + (((st * 4 + hh * 2) ^ ksw) << 4)), d_ = *(const LAS u32x4*)(Kb_ + 4096 + (((st * 4 + hh * 2 + 1) ^ ksw) << 4)); \
            P0 = MFMA8(((i32x8){(int)a_.x, (int)a_.y, (int)a_.z, (int)a_.w, (int)b_.x, (int)b_.y, (int)b_.z, (int)b_.w}), qf[st], P0); \
            P1 = MFMA8(((i32x8){(int)c_.x, (int)c_.y, (int)c_.z, (int)c_.w, (int)d_.x, (int)d_.y, (int)d_.z, (int)d_.w}), qf[st], P1); } } while (0)
#define ATT_H1(C0, C1, N0, N1, tt) do { \
        const bool more_ = (tt) + 1 < ntiles; \
        if ((tt) + 3 < ntiles) ATT_ISSUE(); \
        if (more_) ATT_QKT(N0, N1, nslot); \
        if (!FIXEDREF) { \
        float ta_ = __builtin_fmaxf(__builtin_fmaxf(C0[0], C0[1]), C0[2]), tb_ = __builtin_fmaxf(__builtin_fmaxf(C0[3], C0[4]), C0[5]), tc_ = __builtin_fmaxf(__builtin_fmaxf(C1[0], C1[1]), C1[2]), td_ = __builtin_fmaxf(__builtin_fmaxf(C1[3], C1[4]), C1[5]);     \
        _Pragma("unroll") for (int g = 6; g < 16; g += 2) { ta_ = __builtin_fmaxf(__builtin_fmaxf(ta_, C0[g]), C0[g + 1]); tc_ = __builtin_fmaxf(__builtin_fmaxf(tc_, C1[g]), C1[g + 1]); } \
        float tm_ = __builtin_fmaxf(__builtin_fmaxf(ta_, tb_), __builtin_fmaxf(tc_, td_)); \
        { const auto rr_ = __builtin_amdgcn_permlane32_swap(__builtin_bit_cast(unsigned, tm_), __builtin_bit_cast(unsigned, tm_), false, false);     \
          tm_ = __builtin_fmaxf(__builtin_bit_cast(float, rr_[0]), __builtin_bit_cast(float, rr_[1])); } \
        if ((tt) == 0) m = tm_;                             \
        else if (__any(tm_ - m > THR)) {                    \
            const float mn_ = __builtin_fmaxf(tm_, m), alpha_ = __builtin_amdgcn_exp2f(m - mn_); m = mn_; lsum *= alpha_; \
            _Pragma("unroll") for (int g = 0; g < 16; ++g) { o0[g] *= alpha_; o1[g] *= alpha_; } \
        } } } while (0)
#define ATT_H2(C0, C1, sl) do { \
        if (!FIXEDREF) { _Pragma("unroll") for (int g = 0; g < 16; ++g) { C0[g] -= m; C1[g] -= m; } } \
        float pa_ = 0.f, pb2_ = 0.f, pc_ = 0.f, pd_ = 0.f;                                      \
        _Pragma("unroll") for (int g = 0; g < 16; g += 2) { C0[g] = __builtin_amdgcn_exp2f(C0[g]); C0[g + 1] = __builtin_amdgcn_exp2f(C0[g + 1]); C1[g] = __builtin_amdgcn_exp2f(C1[g]); C1[g + 1] = __builtin_amdgcn_exp2f(C1[g + 1]); \
            pa_ += C0[g]; pb2_ += C0[g + 1]; pc_ += C1[g]; pd_ += C1[g + 1]; } \
        lsum += (pa_ + pb2_) + (pc_ + pd_); \
        bf16x8 pb_[2][2]; \
        pb_[0][0] = pack8(C0[0], C0[1], C0[2], C0[3], C0[4], C0[5], C0[6], C0[7]); pb_[0][1] = pack8(C0[8], C0[9], C0[10], C0[11], C0[12], C0[13], C0[14], C0[15]); \
        pb_[1][0] = pack8(C1[0], C1[1], C1[2], C1[3], C1[4], C1[5], C1[6], C1[7]); pb_[1][1] = pack8(C1[8], C1[9], C1[10], C1[11], C1[12], C1[13], C1[14], C1[15]); \
        const LAS unsigned char* Vb_ = lds + (sl) * ATT_SLOT + KT_BYTES; \
        { const int sw_ = (r >> 1) & 7; const LAS unsigned char* vrow_ = Vb_ + r * 128;        \
            _Pragma("unroll") for (int kb = 0; kb < 2; ++kb) _Pragma("unroll") for (int s2 = 0; s2 < 2; ++s2) { \
                const bf16x8 va_ = *(const LAS bf16x8*)(vrow_ + (((kb * 4 + s2 * 2 + hh) ^ sw_) << 4)), vb_ = *(const LAS bf16x8*)(vrow_ + 4096 + (((kb * 4 + s2 * 2 + hh) ^ sw_) << 4)); \
                o0 = MFMA32(va_, pb_[kb][s2], o0); o1 = MFMA32(vb_, pb_[kb][s2], o1); } } \
    } while (0)
#define ATT_SYNC(tt) do { if ((tt) + 2 < ntiles) ATT_WAIT_BAR(2); else ATT_WAIT_BAR(0); } while (0)
    f32x16 sA0, sA1, sB0, sB1;
    ATT_WAIT_BAR(4);
    ATT_QKT(sA0, sA1, 0);
    if (C.wave < 4) {
#pragma unroll 1
        for (int t = 0; t < ntiles; t += 2) {
            if (t + 1 < ntiles) ATT_SYNC(t);
            ATT_H1(sA0, sA1, sB0, sB1, t); ATT_H2(sA0, sA1, cslot); ATT_ADV();
            if (t + 2 < ntiles) ATT_SYNC(t + 1);
            ATT_H1(sB0, sB1, sA0, sA1, t + 1); ATT_H2(sB0, sB1, cslot); ATT_ADV();
        }
    } else {
        ATT_SYNC(0);
        ATT_H1(sA0, sA1, sB0, sB1, 0);
#pragma unroll 1
        for (int t = 1; t + 1 < ntiles; t += 2) {
            ATT_SYNC(t);
            ATT_H2(sA0, sA1, cslot); ATT_ADV(); ATT_H1(sB0, sB1, sA0, sA1, t);
            ATT_SYNC(t + 1);
            ATT_H2(sB0, sB1, cslot); ATT_ADV(); ATT_H1(sA0, sA1, sB0, sB1, t + 1);
        }
        ATT_H2(sA0, sA1, cslot); ATT_ADV(); ATT_H1(sB0, sB1, sA0, sA1, ntiles - 1);
        ATT_H2(sB0, sB1, cslot); ATT_ADV();
    }
#undef ATT_QKT
#undef ATT_H1
#undef ATT_H2
#undef ATT_SYNC
#undef ATT_ADV
    asm volatile("s_waitcnt lgkmcnt(0)\n\ts_barrier" ::: "memory");
#undef ATT_ISSUE
    lsum += shfl_idx(lsum, lane ^ 32);
    const float inv = 1.0f / lsum;
    { LAS bf16* stg = (LAS bf16*)(lds + ATT_NS * ATT_SLOT + C.wave * 4352);
#pragma unroll
      for (int g = 0; g < 16; ++g) { const int d = crow(g, hh); stg[r * 68 + d] = (bf16)f2bf(o0[g] * inv); stg[r * 68 + 32 + d] = (bf16)f2bf(o1[g] * inv); }
      LDS_WAIT(); asm volatile("" ::: "memory");
      bf16* ob = MIX + (size_t)(qrow0 + C.wave * 32) * 1024 + 256 + h * 64;
#pragma unroll
      for (int i = 0; i < 4; ++i) { const int row = i * 8 + (lane >> 3), ch = lane & 7;
          const u32x2 a = *(const LAS u32x2*)(stg + row * 68 + ch * 8), b = *(const LAS u32x2*)(stg + row * 68 + ch * 8 + 4);
          u32x4 v; v.x = a.x; v.y = a.y; v.z = b.x; v.w = b.y; *(u32x4*)(ob + (size_t)row * 1024 + ch * 8) = v; }
      LDS_WAIT(); asm volatile("" ::: "memory"); }
}
__device__ __forceinline__ void phase_attn(int l) {
    const KA A = ka_fresh(); const Ctx C = ctx_fresh();
    const int G = C.G;
    bool fixedref;
    { const int lane = C.lane; const float* qg = A.in(15) + l * 96; const float* kg = A.in(16) + l * 96;
      const float gq = wave_max(fmaxf(fabsf(qg[lane]), lane < 32 ? fabsf(qg[64 + lane]) : 0.f), lane), gk = wave_max(fmaxf(fabsf(kg[lane]), lane < 32 ? fabsf(kg[64 + lane]) : 0.f), lane);
      fixedref = (96.f * QSCALE * gq * gk) < 100.f; }
    for (int u = C.bid; u < 1024 + (l == 1 ? 0 : 16); u += G) {
        if (u < 1024) {
            int pair, qb;
            if (G == 256) { const int vcu = u & 255, rnd = u >> 8; pair = 2 * (vcu & 7) + (rnd >> 1); qb = (vcu >> 3) + 32 * (rnd & 1); }
            else { pair = u >> 6; qb = u & 63; }
            if (fixedref) attn_unit<true>(A, C, pair, (pair >> 3) * SEQ + qb * 256, 0, NKT); else attn_unit<false>(A, C, pair, (pair >> 3) * SEQ + qb * 256, 0, NKT);
        } else { const int pair = u - 1024;
            if (fixedref) attn_unit<true>(A, C, pair, RL + (pair >> 3) * CTXL, NKT - 4, 4); else attn_unit<false>(A, C, pair, RL + (pair >> 3) * CTXL, NKT - 4, 4); }
    }
}

__device__ __forceinline__ int f2key(float f) { const int b = __builtin_bit_cast(int, f); return b ^ ((b >> 31) & 0x7fffffff); }
__device__ __forceinline__ float key2f(int k) { return __builtin_bit_cast(float, k ^ ((k >> 31) & 0x7fffffff)); }
__device__ __forceinline__ void topk_ins(int (&lst)[16], int v) {
#pragma unroll
    for (int i = 0; i < 16; ++i) { const int hi = max(lst[i], v); v = min(lst[i], v); lst[i] = hi; }
}
__device__ __forceinline__ void bitonic_sort16_desc(int (&a)[16]) {
#pragma unroll
    for (int k = 2; k <= 16; k <<= 1)
#pragma unroll
        for (int j = k >> 1; j > 0; j >>= 1)
#pragma unroll
            for (int i = 0; i < 16; ++i) { const int p = i ^ j;
                if (p > i) { const int hi = max(a[i], a[p]), lo = min(a[i], a[p]); const bool desc = ((i & k) == 0) || (k == 16); a[i] = desc ? hi : lo; a[p] = desc ? lo : hi; } }
}
__device__ __forceinline__ void merge16_desc(int (&lst)[16], const int (&nw)[16]) {
#pragma unroll
    for (int i = 0; i < 16; ++i) lst[i] = max(lst[i], nw[15 - i]);
#pragma unroll
    for (int j = 8; j > 0; j >>= 1)
#pragma unroll
        for (int i = 0; i < 16; ++i) { const int p = i ^ j; if (p > i) { const int hi = max(lst[i], lst[p]), lo = min(lst[i], lst[p]); lst[i] = hi; lst[p] = lo; } }
}
__device__ __forceinline__ void topk_half(int (&lst)[16], const bf16* qp, const bf16* skp, int hh, int lane) {
    bf16x8 bq[8];
#pragma unroll
    for (int st = 0; st < 8; ++st) bq[st] = *(const bf16x8*)(qp + st * 16);
#pragma unroll
    for (int i = 0; i < 16; ++i) lst[i] = f2key(-3.0e38f);
    bf16x8 an[8];
#pragma unroll
    for (int st = 0; st < 8; ++st) an[st] = *(const bf16x8*)(skp + st * 16);
#pragma unroll 1
    for (int blk = 0; blk < 4; ++blk) {
        f32x16 acc = (f32x16){0.f, 0.f, 0.f, 0.f, 0.f, 0.f, 0.f, 0.f, 0.f, 0.f, 0.f, 0.f, 0.f, 0.f, 0.f, 0.f};
#pragma unroll
        for (int st = 0; st < 8; ++st) acc = MFMA32(an[st], bq[st], acc);
        if (blk < 3) {
#pragma unroll
            for (int st = 0; st < 8; ++st) an[st] = *(const bf16x8*)(skp + (blk + 1) * 32 * 128 + st * 16); }
        int nk[16];
#pragma unroll
        for (int g = 0; g < 16; ++g) { const unsigned n = (unsigned)(blk * 32 + crow(g, hh));
            const float sv = acc[g];
            nk[g] = f2key(__builtin_bit_cast(float, (__builtin_bit_cast(unsigned, sv) & ~127u) | n)); }
        bitonic_sort16_desc(nk);
        merge16_desc(lst, nk);
    }
    int oth[16];
#pragma unroll
    for (int i = 0; i < 16; ++i) oth[i] = shfl_idx(lst[i], lane ^ 32);
    merge16_desc(lst, oth);
}
__device__ __forceinline__ void phase_topk(int l) {
    const KA A = ka_fresh(); const Ctx C = ctx_fresh();
    const int gw = C.bid * 8 + C.wave, NGW = C.G * 8, lane = C.lane, r = lane & 31, hh = lane >> 5;
    const bf16* PQ = (const bf16*)(A.ws() + WS_PQ); const bf16* SK = (const bf16*)(A.ws() + WS_SUBK);
    int* EID = (int*)(A.ws() + WS_EID); float* GATE = (float*)(A.ws() + WS_GATE);
    const int nrows = (l == 1) ? RL : RT;
    for (int unit = gw; unit < (nrows / 32) * 8; unit += NGW) {
        const int h = unit & 7, r0 = (unit >> 3) * 32; const size_t row = (size_t)(r0 + r);
        int L[2][16];
        topk_half(L[0], PQ + row * 2048 + h * 256 + hh * 8, SK + ((size_t)((l * 8 + h) * 2 + 0) * 128 + r) * 128 + hh * 8, hh, lane);
        __builtin_amdgcn_sched_barrier(0);
        topk_half(L[1], PQ + row * 2048 + h * 256 + 128 + hh * 8, SK + ((size_t)((l * 8 + h) * 2 + 1) * 128 + r) * 128 + hh * 8, hh, lane);
        __builtin_amdgcn_sched_barrier(0);
        int best[16];
#pragma unroll
        for (int j = 0; j < 16; ++j) best[j] = f2key(__builtin_bit_cast(float, (__builtin_bit_cast(unsigned, key2f(L[0][0]) + key2f(L[1][j])) & ~255u) | (unsigned)j));
#pragma unroll
        for (int i = 1; i < 16; ++i)
#pragma unroll
            for (int j = 0; j < 16; ++j)
                if ((i + 1) * (j + 1) <= 16) topk_ins(best, f2key(__builtin_bit_cast(float, (__builtin_bit_cast(unsigned, key2f(L[0][i]) + key2f(L[1][j])) & ~255u) | (unsigned)(i * 16 + j))));
        float ev[16]; float esum = 0.f;
        const float mx = __builtin_bit_cast(float, __builtin_bit_cast(unsigned, key2f(best[0])) & ~255u);
#pragma unroll
        for (int k = 0; k < 16; ++k) { ev[k] = __expf(__builtin_bit_cast(float, __builtin_bit_cast(unsigned, key2f(best[k])) & ~255u) - mx); esum += ev[k]; }
        const float einv = 1.0f / esum;
#pragma unroll
        for (int k = 0; k < 8; ++k) {
            const int b_lo = best[k], b_hi = best[k + 8]; const float e_lo = ev[k], e_hi = ev[k + 8];
            const int bk = hh ? b_hi : b_lo; const float gk = (hh ? e_hi : e_lo) * einv;
            const unsigned code = __builtin_bit_cast(unsigned, key2f(bk)) & 255u;
            const unsigned ci = code >> 4, cj = code & 15u; unsigned n0 = 0u, n1 = 0u;
#pragma unroll
            for (int i = 0; i < 16; ++i) { n0 = (ci == (unsigned)i) ? (__builtin_bit_cast(unsigned, key2f(L[0][i])) & 127u) : n0; n1 = (cj == (unsigned)i) ? (__builtin_bit_cast(unsigned, key2f(L[1][i])) & 127u) : n1; }
            EID[row * 128 + h * 16 + hh * 8 + k] = (int)(n0 * 128u + n1); GATE[row * 128 + h * 16 + hh * 8 + k] = gk;
        }
    }
}
typedef float f32x2v __attribute__((ext_vector_type(2)));
typedef unsigned u32x6 __attribute__((ext_vector_type(6)));
typedef float f32x32 __attribute__((ext_vector_type(32)));
#ifndef FFN_B
#define FFN_B 8
#endif
__device__ __forceinline__ void phase_ffn(int l) {
    const KA A = ka_fresh(); const Ctx C = ctx_fresh();
    const int gw = C.bid * 8 + C.wave, NGW = C.G * 8, lane = C.lane;
    const bf16* XN = (const bf16*)(A.ws() + WS_XN); const unsigned char* TU = A.ws() + WS_TABU; const unsigned char* TV = A.ws() + WS_TABV;
    const int* EID = (const int*)(A.ws() + WS_EID); const float* GATE = (const float*)(A.ws() + WS_GATE);
    const float* MOD = (const float*)(A.ws() + WS_MOD);
    const int nrows = (l == 1) ? RL : RT;
    for (int row = gw; row < nrows; row += NGW) {
        f32x2_t hv[8];
        { const u32x4 a = *(const u32x4*)(XN + (size_t)row * DM + lane * 16), b = *(const u32x4*)(XN + (size_t)row * DM + lane * 16 + 8);
          hv[0] = (f32x2_t){bflo(a.x), bfhi(a.x)}; hv[1] = (f32x2_t){bflo(a.y), bfhi(a.y)}; hv[2] = (f32x2_t){bflo(a.z), bfhi(a.z)}; hv[3] = (f32x2_t){bflo(a.w), bfhi(a.w)};
          hv[4] = (f32x2_t){bflo(b.x), bfhi(b.x)}; hv[5] = (f32x2_t){bflo(b.y), bfhi(b.y)}; hv[6] = (f32x2_t){bflo(b.z), bfhi(b.z)}; hv[7] = (f32x2_t){bflo(b.w), bfhi(b.w)}; }
        f32x2_t out[8];
#pragma unroll
        for (int i = 0; i < 8; ++i) out[i] = (f32x2_t){0.f, 0.f};
        const int idA = EID[(size_t)row * 128 + lane], idB = EID[(size_t)row * 128 + 64 + lane]; const float gtA = GATE[(size_t)row * 128 + lane], gtB = GATE[(size_t)row * 128 + 64 + lane];
        int ln = lane; asm volatile("" : "+v"(ln));
        const bool b0 = ln & 1, b1 = ln & 2; const int q4 = ln >> 2, x16 = ln ^ 16, x32 = ln ^ 32;
        float dA = 0.f, dB = 0.f;
#define FFN_LOADU(UU, ID, e0) do { _Pragma("unroll") for (int k = 0; k < FFN_B; ++k) { const int id_ = __builtin_amdgcn_readlane(ID, (e0) + k); UU[k] = *(const U3*)(TU + (size_t)id_ * TROW + lane * 12); } } while (0)
#define FFN_DOT4(UU, DV, e0) do { _Pragma("unroll") for (int g4 = 0; g4 < FFN_B; g4 += 4) { float p_[4]; \
            _Pragma("unroll") for (int k = 0; k < 4; k += 2) { \
                const u32x6 us_ = {UU[g4 + k].a, UU[g4 + k].b, UU[g4 + k].c, UU[g4 + k + 1].a, UU[g4 + k + 1].b, UU[g4 + k + 1].c}; \
                const f32x32 uf_ = __builtin_amdgcn_cvt_scalef32_pk32_f32_fp6(us_, 1.0f);        \
                f32x2_t d0_ = {0.f, 0.f}, d1_ = {0.f, 0.f}; \
                _Pragma("unroll") for (int i = 0; i < 8; ++i) { d0_ = hv[i] * (f32x2_t){uf_[2 * i], uf_[2 * i + 1]} + d0_; d1_ = hv[i] * (f32x2_t){uf_[16 + 2 * i], uf_[17 + 2 * i]} + d1_; } \
                p_[k] = d0_.x + d0_.y; p_[k + 1] = d1_.x + d1_.y; } \
            float x01_ = b0 ? p_[1] : p_[0], y01_ = b0 ? p_[0] : p_[1], x23_ = b0 ? p_[3] : p_[2], y23_ = b0 ? p_[2] : p_[3]; \
            x01_ += __builtin_bit_cast(float, __builtin_amdgcn_update_dpp(0, __builtin_bit_cast(int, y01_), 0xB1, 0xf, 0xf, true)); \
            x23_ += __builtin_bit_cast(float, __builtin_amdgcn_update_dpp(0, __builtin_bit_cast(int, y23_), 0xB1, 0xf, 0xf, true)); \
            float x_ = b1 ? x23_ : x01_; const float y_ = b1 ? x01_ : x23_; \
            x_ += __builtin_bit_cast(float, __builtin_amdgcn_update_dpp(0, __builtin_bit_cast(int, y_), 0x4E, 0xf, 0xf, true)); \
            DPP_ADD(x_, 0x124); DPP_ADD(x_, 0x128);                  \
            x_ += shfl_idx(x_, x16); x_ += shfl_idx(x_, x32);       \
            DV = (q4 == (((e0) + g4) >> 2)) ? x_ : DV; } } while (0)
        { U3 ua[FFN_B], ub[FFN_B];
          FFN_LOADU(ua, idA, 0);
#pragma unroll 1
          for (int e = 0; e < 64; e += 2 * FFN_B) { FFN_LOADU(ub, idA, e + FFN_B); FFN_DOT4(ua, dA, e); if (e + 2 * FFN_B < 64) FFN_LOADU(ua, idA, e + 2 * FFN_B); else FFN_LOADU(ua, idB, 0); FFN_DOT4(ub, dA, e + FFN_B); }
#pragma unroll 1
          for (int e = 0; e < 64; e += 2 * FFN_B) { FFN_LOADU(ub, idB, e + FFN_B); FFN_DOT4(ua, dB, e); if (e + 2 * FFN_B < 64) FFN_LOADU(ua, idB, e + 2 * FFN_B); FFN_DOT4(ub, dB, e + FFN_B); } }
#undef FFN_LOADU
#undef FFN_DOT4
        const float wA = gtA * gelu_f(dA * (1.0f / U_SCALE)) * (1.0f / V_SCALE), wB = gtB * gelu_f(dB * (1.0f / U_SCALE)) * (1.0f / V_SCALE);
#define FFN_LOADV(VV, ID, e0) do { _Pragma("unroll") for (int k = 0; k < FFN_B; ++k) { const int id_ = __builtin_amdgcn_readlane(ID, (e0) + k); VV[k] = *(const U3*)(TV + (size_t)id_ * TROW + lane * 12); } } while (0)
#define FFN_ACC4(VV, WV, e0) do { _Pragma("unroll") for (int k = 0; k < FFN_B; k += 2) { \
            const float w0_ = __builtin_bit_cast(float, __builtin_amdgcn_readlane(__builtin_bit_cast(int, WV), (e0) + k)), w1_ = __builtin_bit_cast(float, __builtin_amdgcn_readlane(__builtin_bit_cast(int, WV), (e0) + k + 1)); \
            const u32x6 vs_ = {VV[k].a, VV[k].b, VV[k].c, VV[k + 1].a, VV[k + 1].b, VV[k + 1].c}; \
            const f32x32 vf_ = __builtin_amdgcn_cvt_scalef32_pk32_f32_fp6(vs_, 1.0f); \
            const f32x2_t w0p_ = {w0_, w0_}, w1p_ = {w1_, w1_}; \
            _Pragma("unroll") for (int i = 0; i < 8; ++i) { out[i] = w0p_ * (f32x2_t){vf_[2 * i], vf_[2 * i + 1]} + out[i]; out[i] = w1p_ * (f32x2_t){vf_[16 + 2 * i], vf_[17 + 2 * i]} + out[i]; } } } while (0)
        { U3 va[FFN_B], vb[FFN_B];
          FFN_LOADV(va, idA, 0);
#pragma unroll 1
          for (int e = 0; e < 64; e += 2 * FFN_B) { FFN_LOADV(vb, idA, e + FFN_B); FFN_ACC4(va, wA, e); if (e + 2 * FFN_B < 64) FFN_LOADV(va, idA, e + 2 * FFN_B); else FFN_LOADV(va, idB, 0); FFN_ACC4(vb, wA, e + FFN_B); }
#pragma unroll 1
          for (int e = 0; e < 64; e += 2 * FFN_B) { FFN_LOADV(vb, idB, e + FFN_B); FFN_ACC4(va, wB, e); if (e + 2 * FFN_B < 64) FFN_LOADV(va, idB, e + 2 * FFN_B); FFN_ACC4(vb, wB, e + FFN_B); } }
#undef FFN_LOADV
#undef FFN_ACC4
        const int nsel = row < RL ? (row >> 14) : 2;
        const float* gf = MOD + (l * 3 + nsel) * 6144 + 5 * 1024;
        float* xr = stream_out(A, C, row);
#pragma unroll
        for (int q = 0; q < 4; ++q) { const int j = lane * 16 + q * 4;
            const f32x4 x = *(const f32x4*)(xr + j); f32x4 g = *(const f32x4*)(gf + j);
            f32x4 o; o.x = x.x + g.x * out[q * 2].x; o.y = x.y + g.y * out[q * 2].y; o.z = x.z + g.z * out[q * 2 + 1].x; o.w = x.w + g.w * out[q * 2 + 1].y;
            *(f32x4*)(xr + j) = o; }
    }
}

template <class Epi>
__device__ __forceinline__ void run_gemm(const pg8::bf16_t* Amat, const pg8::bf16_t* Bt, int N, int K, const Epi& E, int M = RT) {
    const Ctx C = ctx_fresh();
    pg8::Gemm g{Amat, Bt, M, N, K}; pg8::StaticOrder S; S.init(M, N, C.G, C.bid);
    pg8::gemm_phase<Epi, pg8::StaticOrder, true, true>(C.lds, g, S, E);
}
__device__ __forceinline__ void seam() {
    const KA A = ka_fresh(); const Ctx C = ctx_fresh();
    XcdBarrier b; b.bar = (unsigned*)(A.ws() + WS_CTL) + CW_BAR; b.x = xb_xcc_id(); b.st = (volatile LAS unsigned*)(C.lds + MISC_OFF) + 8;
    xcd_barrier(b);
}
#define IN(k) (lo <= (k) && (k) < hi)
#define SEAM(k) do { if (IN(k) && IN((k) + 1)) seam(); } while (0)
template <int l>
__device__ __forceinline__ void layer_body(const int lo, const int hi) {
        const int p0 = 1 + NPH_L * l;
        if (IN(p0 + 0)) { phase_norm(l, 0); phase_tables(l); }
        SEAM(p0 + 0);
        if (IN(p0 + 1)) {
            const KA A = ka_fresh(); unsigned char* ws = A.ws();
            pg8::EpiBf16<0> E{(pg8::bf16_t*)(ws + WS_ZA), 1024, nullptr, 1024, (size_t)(WS_ZB - WS_ZA) / 2, 1.f};
            run_gemm(( const pg8::bf16_t*)(ws + WS_XN), (const pg8::bf16_t*)(ws + WS_WIN) + (size_t)l * 2048 * DM, 2048, DM, E);
        }
        SEAM(p0 + 1);
        if (IN(p0 + 2)) phase_post(l);
        SEAM(p0 + 2);
        if (IN(p0 + 3)) {
#pragma unroll 1
            for (int gi = 0; gi < 2; ++gi) {
                const KA A = ka_fresh(); unsigned char* ws = A.ws();
                const int N = gi ? 1024 : 768, K = gi ? 256 : 384;
                pg8::EpiBf16<0> E{(pg8::bf16_t*)(ws + (gi ? WS_KVRAW : WS_Q)), N, nullptr, 0, 0, 1.f};
                run_gemm((const pg8::bf16_t*)(ws + (gi ? WS_KVA : WS_QA)), (const pg8::bf16_t*)(ws + (gi ? WS_WUKV : WS_WUQ)) + (size_t)l * N * K, N, K, E);
            }
        }
        SEAM(p0 + 3);
        if (IN(p0 + 4)) phase_qknorm(l);
        SEAM(p0 + 4);
        if (IN(p0 + 5)) phase_ml_local();
        SEAM(p0 + 5);
        if (IN(p0 + 6)) phase_ml_scan();
        SEAM(p0 + 6);
        if (IN(p0 + 7)) {
            phase_ml_out(l);
            __syncthreads();
            phase_attn(l);
        }
        SEAM(p0 + 7);
        if (IN(p0 + 8)) {
            const KA A = ka_fresh(); unsigned char* ws = A.ws();
            pg8::EpiResGate E{l == 0 ? A.in(0) : (const float*)A.out(), l == 0 ? A.in(2) : (const float*)(ws + WS_CTXS), A.out(), (float*)(ws + WS_CTXS), (const float*)(ws + WS_MOD) + (size_t)l * 3 * 6144, 2 * 1024};
            run_gemm((const pg8::bf16_t*)(ws + WS_MIX), (const pg8::bf16_t*)(ws + WS_WOUT) + (size_t)l * DM * DM, DM, DM, E, l == 1 ? RL : RT);
        }
        SEAM(p0 + 8);
        if (IN(p0 + 9)) phase_norm(l, 1);
        SEAM(p0 + 9);

        if (IN(p0 + 10)) {
            const KA A = ka_fresh(); unsigned char* ws = A.ws();
            pg8::EpiBf16<0> E{(pg8::bf16_t*)(ws + WS_PQ), 2048, nullptr, 0, 0, 1.f};
            run_gemm((const pg8::bf16_t*)(ws + WS_XN), (const pg8::bf16_t*)(ws + WS_WPQ) + (size_t)l * 2048 * DM, 2048, DM, E, l == 1 ? RL : RT);
        }
        SEAM(p0 + 10);
                if (IN(p0 + 11)) phase_topk(l);
        SEAM(p0 + 11);
        if (IN(p0 + 12)) phase_ffn(l);
        if (l == 0) SEAM(p0 + 12);
    }
__global__ void __launch_bounds__(512, 2) mk_fwd(Args unused_args) {
    { const KA A = ka_fresh(); const Ctx C = ctx_fresh();
      volatile LAS unsigned* MISC = (volatile LAS unsigned*)(C.lds + MISC_OFF);
      if (C.tid < 64) MISC[C.tid] = 0u;
      __syncthreads();
      (void)xcd_barrier_post((unsigned*)(A.ws() + WS_CTL) + CW_BAR, MISC + 8); }
    int lo, hi;
    { const KA A = ka_fresh(); lo = A.ph_lo(); hi = A.ph_hi(); }
    if (IN(0)) phase_prologue();
    if (IN(0)) { if (lo == 0 && hi == NPHASES) seam(); }
    if (IN(0) && lo == 0 && hi == NPHASES) phase_modreduce();
    SEAM(0);
    layer_body<0>(lo, hi);
    layer_body<1>(lo, hi);
#undef IN
#undef SEAM
}

extern "C" void kernel_launch(void* const* d_in, const int* in_sizes, int n_in, void* d_out, int out_size, void* d_ws, size_t ws_size, hipStream_t stream) {
    static int grid = 0;
    if (grid == 0) {
        if (n_in != 24 || out_size != RL * DM || ws_size < WS_END) { fprintf(stderr, "kernel_launch: unexpected shapes (n_in %d, out %d, ws %zu)\n", n_in, out_size, ws_size); grid = -1; return; }
        int dev = 0, cus = 0, per_cu = 0;
        if (hipGetDevice(&dev) != hipSuccess || hipDeviceGetAttribute(&cus, hipDeviceAttributeMultiprocessorCount, dev) != hipSuccess) { grid = -1; return; }
        if (hipFuncSetAttribute((const void*)mk_fwd, hipFuncAttributeMaxDynamicSharedMemorySize, LDS_BYTES) != hipSuccess) { fprintf(stderr, "kernel_launch: hipFuncSetAttribute failed\n"); grid = -1; return; }
        if (hipOccupancyMaxActiveBlocksPerMultiprocessor(&per_cu, (const void*)mk_fwd, 512, LDS_BYTES) != hipSuccess || per_cu < 1) { fprintf(stderr, "kernel_launch: occupancy query says %d\n", per_cu); per_cu = 1; }
        (void)hipGetLastError();
        grid = cus;
    }
    if (grid < 0) return;
    (void)hipMemsetAsync((char*)d_ws + WS_CTL, 0, CTL_ZERO_BYTES, stream);
    Args a{};
    for (int i = 0; i < 24; ++i) a.in[i] = (const float*)d_in[i];
    a.out = (float*)d_out; a.ws = (unsigned char*)d_ws;
    a.ph_lo = 0; a.ph_hi = NPHASES;
    hipLaunchKernelGGL(mk_fwd, dim3(grid), dim3(512), LDS_BYTES, stream, a);
}
```

```cpp
#include <hip/hip_runtime.h>
#include <cstdio>
#include <cstdint>

namespace pg8 {
#define PG8_LAS __attribute__((address_space(3)))
typedef unsigned short bf16_t;
typedef short bf16x8 __attribute__((ext_vector_type(8)));
typedef float f32x4 __attribute__((ext_vector_type(4)));
typedef unsigned u32x4 __attribute__((ext_vector_type(4)));
constexpr int BM = 256, BK = 64, HALF = 128, HTB = HALF * BK * 2  , STAGE_BYTES = 8 * HTB, NXCD = 8, WGM = 8;

__host__ __device__ __forceinline__ int lds_byte(int r, int c) { const int st = (r >> 4) * 2 + (c >> 5), rr = r & 15, cc = c & 31, ob = rr * 64 + cc * 2; return st * 1024 + (ob ^ (((ob >> 9) & 1) << 5)); }
__host__ __device__ __forceinline__ void stage_rc(int b, int& R, int& C) { const int st = b / 1024, sb = b % 1024, swz = sb ^ (((sb >> 9) & 1) << 5); R = (st >> 1) * 16 + swz / 64; C = (st & 1) * 32 + (swz % 64) / 2; }
__host__ __device__ __forceinline__ int perm32(int rho) { const int n = rho >> 4, i = rho & 15; return 8 * (i >> 2) + 4 * n + (i & 3); }

struct Unit { int pm, pn; };
struct Gemm { const bf16_t* A; const bf16_t* Bt; int M, N, K; };

struct StaticOrder {
    int nM, nN, nwg, G, c;
    __host__ __device__ void init(int M, int N, int G_, int c_) { nM = M / BM; nN = N / BM; nwg = nM * nN; G = G_; c = c_; }
    __host__ __device__ bool next(int i, Unit& u) const {
        const long L = (long)i * G + c; if (L >= nwg) return false;
        int wgid = (int)L; { const int q = nwg / NXCD, r = nwg % NXCD, xcd = wgid % NXCD, off = wgid / NXCD; wgid = (xcd < r ? xcd * (q + 1) : r * (q + 1) + (xcd - r) * q) + off; }
        const int nig = WGM * nN, gid = wgid / nig, fm = gid * WGM, gsz = (nM - fm) < WGM ? (nM - fm) : WGM;
        u.pm = fm + ((wgid % nig) % gsz); u.pn = (wgid % nig) / gsz; return true;
    }
    __device__ __forceinline__ void a_ready(const Unit&) const {}
    __device__ __forceinline__ void done(const Unit&) const {}
};

__device__ __forceinline__ unsigned cvt_pk_bf16(float lo, float hi) { unsigned r; asm volatile("v_cvt_pk_bf16_f32 %0, %1, %2" : "=v"(r) : "v"(lo), "v"(hi)); return r; }
typedef float f32x2 __attribute__((ext_vector_type(2)));
__device__ __forceinline__ f32x2 gelu_pk(f32x2 v) {
    const f32x2 av = __builtin_elementwise_abs(v), d = av * 0.2316418882f + 1.0f;
    f32x2 t; t.x = __builtin_amdgcn_rcpf(d.x); t.y = __builtin_amdgcn_rcpf(d.y);
    f32x2 q = t * 0.5307027145f + (-0.7265760135f); q = q * t + 0.7107068705f; q = q * t + (-0.142248368f); q = q * t + 0.127414796f; q = q * t;
    const f32x2 s = (v * v) * (-0.72134752044f);
    f32x2 e; e.x = __builtin_amdgcn_exp2f(s.x); e.y = __builtin_amdgcn_exp2f(s.y);
    const f32x2 m = v * (q * e), r = v - m;
    f32x2 o; o.x = v.x < 0.f ? m.x : r.x; o.y = v.y < 0.f ? m.y : r.y; return o;
}

template <int ACT  > struct EpiBf16 {
    static constexpr bool PERM = true, AFTER_DRAIN = false; static_assert(ACT == 0 || ACT == 1, "EpiBf16: ACT is 0 (none) or 1 (gelu_pk)");
    bf16_t* O; int ldc; const float* bias; int split_cols; size_t split_stride; float scale0;
    __device__ __forceinline__ void operator()(const f32x4 (&acc)[2][2][4][2], const Unit& u, int wr, int wc, int fr, int fq) const {
        const int row0 = u.pm * BM + wr * 64 + fr; int colt = u.pn * BM; bf16_t* base = O;
        float sc = 1.f; if (split_cols) { const int t = colt / split_cols; base += (size_t)t * split_stride; colt -= t * split_cols; if (t == 0) sc = scale0; }
        const int col0 = colt + wc * 32 + 8 * fq, bcol0 = u.pn * BM + wc * 32 + 8 * fq;
        f32x4 bv[2][2];
#pragma unroll
        for (int bj = 0; bj < 2; ++bj)
#pragma unroll
            for (int n = 0; n < 2; ++n) bv[bj][n] = bias ? *(const f32x4*)(bias + bcol0 + bj * HALF + 4 * n) : (f32x4){0.f, 0.f, 0.f, 0.f};
#pragma unroll
        for (int ai = 0; ai < 2; ++ai)
#pragma unroll
            for (int m = 0; m < 4; ++m) { bf16_t* rowp = base + (size_t)(row0 + ai * HALF + m * 16) * ldc + col0;
#pragma unroll
                for (int bj = 0; bj < 2; ++bj) { f32x4 v0 = acc[ai][bj][m][0] + bv[bj][0], v1 = acc[ai][bj][m][1] + bv[bj][1];
                    if (ACT == 1) { f32x2 a = gelu_pk((f32x2){v0[0], v0[1]}), b = gelu_pk((f32x2){v0[2], v0[3]}), c = gelu_pk((f32x2){v1[0], v1[1]}), d = gelu_pk((f32x2){v1[2], v1[3]});
                        v0 = (f32x4){a.x, a.y, b.x, b.y}; v1 = (f32x4){c.x, c.y, d.x, d.y}; }
                    v0 = v0 * sc; v1 = v1 * sc; u32x4 w; w.x = cvt_pk_bf16(v0[0], v0[1]); w.y = cvt_pk_bf16(v0[2], v0[3]); w.z = cvt_pk_bf16(v1[0], v1[1]); w.w = cvt_pk_bf16(v1[2], v1[3]);
                    *(u32x4*)(rowp + bj * HALF) = w; } }
    }
};


struct EpiResGate {
    static constexpr bool PERM = false, AFTER_DRAIN = false;
    const float* base_lat; const float* base_ctx; float* out_lat; float* out_ctx; const float* gate;
    int goff;
    __device__ __forceinline__ void operator()(const f32x4 (&acc)[2][2][4][2], const Unit& u, int wr, int wc, int fr, int fq) const {
        const int rowt = u.pm * BM; const bool lat = rowt < 32768;
        const int nsel = lat ? (rowt >> 14) : 2;
        const float* bs = lat ? base_lat + (size_t)rowt * 1024 : base_ctx + (size_t)(rowt - 32768) * 1024;
        float* os = lat ? out_lat + (size_t)rowt * 1024 : out_ctx + (size_t)(rowt - 32768) * 1024;
        const float* gv = gate + nsel * 6144 + goff;
        const int rl = wr * 64 + fr, col0 = u.pn * BM + wc * 32 + 4 * fq;
        f32x4 g[2][2];
#pragma unroll
        for (int bj = 0; bj < 2; ++bj)
#pragma unroll
            for (int n = 0; n < 2; ++n) g[bj][n] = *(const f32x4*)(gv + col0 + bj * HALF + n * 16);
#pragma unroll
        for (int ai = 0; ai < 2; ++ai)
#pragma unroll
            for (int m = 0; m < 4; ++m) { const size_t ro = (size_t)(rl + ai * HALF + m * 16) * 1024 + col0;
#pragma unroll
                for (int bj = 0; bj < 2; ++bj)
#pragma unroll
                    for (int n = 0; n < 2; ++n) { const f32x4 b = *(const f32x4*)(bs + ro + bj * HALF + n * 16); *(f32x4*)(os + ro + bj * HALF + n * 16) = b + g[bj][n] * acc[ai][bj][m][n]; } }
    }
};

template <class Epi, class Sched, bool ALIGN_EPI = false, bool SP2 = false>
__device__ __forceinline__ void gemm_phase(PG8_LAS unsigned char* lds, const Gemm g, const Sched& S, const Epi& E) {
    int tid_l = threadIdx.x; asm volatile("" : "+v"(tid_l));
    const int tid = tid_l, wid = __builtin_amdgcn_readfirstlane(tid >> 6), lane = tid & 63, wr = wid >> 2, wc = wid & 3, fr = lane & 15, fq = lane >> 4;
    const int K = g.K, nt = K / BK;
    unsigned voffA[2], voffB[2];
#pragma unroll
    for (int i = 0; i < 2; ++i) { int R, C; stage_rc(tid * 16 + i * 8192, R, C); const int Rb = Epi::PERM ? ((R & ~31) + perm32(R & 31)) : R;
        voffA[i] = (unsigned)(R * K + C) * 2u; voffB[i] = (unsigned)(Rb * K + C) * 2u; }
    const size_t kstep = (size_t)(BK * 2);
    const size_t hstep = (size_t)HALF * K * 2;
    const size_t tstep = 2 * hstep;
    const unsigned ldsw = (unsigned)wid * 1024u;
    const int aoff = lds_byte(wr * 64 + fr, fq * 8), boff = lds_byte(wc * 32 + fr, fq * 8);
#define PG8_SA(b, h) (((b) * 2 + (h)) * HTB)
#define PG8_SB(b, h) ((4 + (b) * 2 + (h)) * HTB)
#define PG8_STAGE(bufoff, gbase, voff) do { _Pragma("unroll") for (int _i = 0; _i < 2; ++_i) \
        __builtin_amdgcn_global_load_lds((const unsigned*)((const char*)(gbase) + (voff)[_i]), (PG8_LAS unsigned*)(lds + (bufoff) + ldsw + _i * 8192), 16, 0, 0); } while (0)
#define PG8_LDA(dst, b, h) do { _Pragma("unroll") for (int m = 0; m < 4; ++m) _Pragma("unroll") for (int k = 0; k < 2; ++k) dst[m][k] = *(const PG8_LAS bf16x8*)(lds + PG8_SA(b, h) + aoff + m * 2048 + k * 1024); } while (0)
#define PG8_LDB(dst, b, h) do { _Pragma("unroll") for (int n = 0; n < 2; ++n) _Pragma("unroll") for (int k = 0; k < 2; ++k) dst[n][k] = *(const PG8_LAS bf16x8*)(lds + PG8_SB(b, h) + boff + n * 2048 + k * 1024); } while (0)
#define PG8_MMA(ai, bj, At, Bt) do { __builtin_amdgcn_s_setprio(1); _Pragma("unroll") for (int m = 0; m < 4; ++m) _Pragma("unroll") for (int n = 0; n < 2; ++n) _Pragma("unroll") for (int k = 0; k < 2; ++k) \
        acc[ai][bj][m][n] = __builtin_amdgcn_mfma_f32_16x16x32_bf16(Bt[n][k], At[m][k], acc[ai][bj][m][n], 0, 0, 0); __builtin_amdgcn_s_setprio(0); } while (0)
#define PG8_WAIT_V(n) asm volatile("s_waitcnt vmcnt(" #n ")" ::: "memory")
#define PG8_WAIT_L(n) asm volatile("s_waitcnt lgkmcnt(" #n ")" ::: "memory")
#define PG8_BAR __builtin_amdgcn_s_barrier()
#define PG8_SCHED __builtin_amdgcn_sched_barrier(0)
    Unit cur, nxt; int ui = 0;
    if (!S.next(0, cur)) return;
    f32x4 acc[2][2][4][2];
#pragma unroll
    for (int a = 0; a < 2; ++a)
#pragma unroll
        for (int b = 0; b < 2; ++b)
#pragma unroll
            for (int m = 0; m < 4; ++m)
#pragma unroll
                for (int n = 0; n < 2; ++n) acc[a][b][m][n] = (f32x4){0.f, 0.f, 0.f, 0.f};
    bf16x8 At[4][2], B0[2][2], B1[2][2];
    const char* cA = (const char*)g.A + (size_t)cur.pm * tstep; const char* cB = (const char*)g.Bt + (size_t)cur.pn * tstep;
    S.a_ready(cur);
    if constexpr (SP2) {
        PG8_STAGE(PG8_SB(0, 0), cB, voffB); PG8_STAGE(PG8_SB(0, 1), cB + hstep, voffB); PG8_STAGE(PG8_SA(0, 0), cA, voffA); PG8_STAGE(PG8_SA(0, 1), cA + hstep, voffA);
        if (wr == 1) PG8_BAR;
        PG8_WAIT_V(2); PG8_BAR;
        PG8_STAGE(PG8_SB(1, 0), cB + kstep, voffB); PG8_STAGE(PG8_SA(1, 0), cA + kstep, voffA); PG8_STAGE(PG8_SB(1, 1), cB + hstep + kstep, voffB);
        PG8_WAIT_V(6); PG8_BAR;
    } else {
        PG8_STAGE(PG8_SB(0, 0), cB, voffB); PG8_STAGE(PG8_SA(0, 0), cA, voffA); PG8_STAGE(PG8_SB(0, 1), cB + hstep, voffB); PG8_STAGE(PG8_SA(0, 1), cA + hstep, voffA);
        if (wr == 1) PG8_BAR;
        PG8_WAIT_V(4); PG8_BAR;
        PG8_STAGE(PG8_SB(1, 0), cB + kstep, voffB); PG8_STAGE(PG8_SA(1, 0), cA + kstep, voffA); PG8_STAGE(PG8_SB(1, 1), cB + hstep + kstep, voffB);
        PG8_WAIT_V(6); PG8_BAR;
    }
    for (;;) {
        const bool has_next = S.next(ui + 1, nxt);
        const char* nA = has_next ? (const char*)g.A + (size_t)nxt.pm * tstep : cA; const char* nB = has_next ? (const char*)g.Bt + (size_t)nxt.pn * tstep : cB;
        for (int t = 0; t < nt; t += 2) {
            const bool last = (t == nt - 2);
            const char* a1 = cA + (size_t)(t + 1) * kstep;
            const char* a2 = last ? nA : cA + (size_t)(t + 2) * kstep; const char* b2 = last ? nB : cB + (size_t)(t + 2) * kstep;
            const char* a3 = a2 + kstep; const char* b3 = b2 + kstep;
            if (last && has_next) S.a_ready(nxt);
            if constexpr (SP2) {
            PG8_LDB(B0, 0, 0); PG8_LDB(B1, 0, 1); PG8_SCHED; PG8_LDA(At, 0, 0); PG8_STAGE(PG8_SA(1, 1), a1 + hstep, voffA);
            PG8_WAIT_V(8); PG8_WAIT_L(0); PG8_BAR; PG8_MMA(0, 0, At, B0); PG8_MMA(0, 1, At, B1); PG8_BAR; PG8_SCHED;
            PG8_LDA(At, 0, 1); PG8_STAGE(PG8_SB(0, 0), b2, voffB); PG8_STAGE(PG8_SB(0, 1), b2 + hstep, voffB); PG8_STAGE(PG8_SA(0, 0), a2, voffA);
            PG8_WAIT_V(8); PG8_WAIT_L(0); PG8_BAR; PG8_MMA(1, 0, At, B0); PG8_MMA(1, 1, At, B1); PG8_BAR; PG8_SCHED;
            PG8_LDB(B0, 1, 0); PG8_LDB(B1, 1, 1); PG8_SCHED; PG8_LDA(At, 1, 0); PG8_STAGE(PG8_SA(0, 1), a2 + hstep, voffA);
            PG8_WAIT_V(8); PG8_WAIT_L(0); PG8_BAR; PG8_MMA(0, 0, At, B0); PG8_MMA(0, 1, At, B1); PG8_BAR; PG8_SCHED;
            PG8_LDA(At, 1, 1); PG8_STAGE(PG8_SB(1, 0), b3, voffB); PG8_STAGE(PG8_SB(1, 1), b3 + hstep, voffB); PG8_STAGE(PG8_SA(1, 0), a3, voffA);
            PG8_WAIT_V(8); PG8_WAIT_L(0); PG8_BAR; PG8_MMA(1, 0, At, B0); PG8_MMA(1, 1, At, B1); PG8_BAR; PG8_SCHED;
            } else {
            PG8_LDB(B0, 0, 0); PG8_SCHED; PG8_LDA(At, 0, 0); PG8_STAGE(PG8_SA(1, 1), a1 + hstep, voffA);
            PG8_WAIT_L(8); PG8_BAR; PG8_WAIT_L(0); PG8_MMA(0, 0, At, B0); PG8_BAR; PG8_SCHED;
            PG8_LDB(B1, 0, 1); PG8_STAGE(PG8_SB(0, 0), b2, voffB);
            PG8_BAR; PG8_WAIT_L(0); PG8_MMA(0, 1, At, B1); PG8_BAR;
            PG8_LDA(At, 0, 1); PG8_STAGE(PG8_SA(0, 0), a2, voffA);
            PG8_BAR; PG8_WAIT_L(0); PG8_MMA(1, 0, At, B0); PG8_BAR; PG8_SCHED;
            PG8_STAGE(PG8_SB(0, 1), b2 + hstep, voffB);
            PG8_WAIT_V(6); PG8_BAR; PG8_MMA(1, 1, At, B1); PG8_BAR;
            PG8_LDB(B0, 1, 0); PG8_SCHED; PG8_LDA(At, 1, 0); PG8_STAGE(PG8_SA(0, 1), a2 + hstep, voffA);
            PG8_WAIT_L(8); PG8_BAR; PG8_WAIT_L(0); PG8_MMA(0, 0, At, B0); PG8_BAR; PG8_SCHED;
            PG8_LDB(B1, 1, 1); PG8_STAGE(PG8_SB(1, 0), b3, voffB);
            PG8_BAR; PG8_WAIT_L(0); PG8_MMA(0, 1, At, B1); PG8_BAR;
            PG8_LDA(At, 1, 1); PG8_STAGE(PG8_SA(1, 0), a3, voffA);
            PG8_BAR; PG8_WAIT_L(0); PG8_MMA(1, 0, At, B0); PG8_BAR; PG8_SCHED;
            PG8_STAGE(PG8_SB(1, 1), b3 + hstep, voffB);
            PG8_WAIT_V(6); PG8_BAR; PG8_MMA(1, 1, At, B1); PG8_BAR;
            }
        }
        if constexpr (ALIGN_EPI) { if (wr == 0) PG8_BAR; }
        if constexpr (!Epi::AFTER_DRAIN) { E(acc, cur, wr, wc, fr, fq); S.done(cur); }
        if (!has_next) break;
#pragma unroll
        for (int a = 0; a < 2; ++a)
#pragma unroll
            for (int b = 0; b < 2; ++b)
#pragma unroll
                for (int m = 0; m < 4; ++m)
#pragma unroll
                    for (int n = 0; n < 2; ++n) acc[a][b][m][n] = (f32x4){0.f, 0.f, 0.f, 0.f};
        cur = nxt; cA = nA; cB = nB; ++ui;
        if constexpr (ALIGN_EPI) { if (wr == 1) PG8_BAR; }
    }
    PG8_WAIT_V(0);
    if constexpr (!ALIGN_EPI) { if (wr == 0) PG8_BAR; }
    PG8_BAR;
    if constexpr (Epi::AFTER_DRAIN) { E.fused(acc, cur, wr, wc, fr, fq, lds, wid, lane); S.done(cur); }
#undef PG8_SA
#undef PG8_SB
#undef PG8_STAGE
#undef PG8_LDA
#undef PG8_LDB
#undef PG8_MMA
#undef PG8_WAIT_V
#undef PG8_WAIT_L
#undef PG8_BAR
#undef PG8_SCHED
}
}

constexpr int DM = 1024, NB = 2, SEQ = 16384, CTXL = 256, RL = NB * SEQ, RC = NB * CTXL, RT = RL + RC;
constexpr int NKT = (SEQ + CTXL) / 64;
constexpr int KT_BYTES = 64 * 128, VT_BYTES = 64 * 128;
constexpr int NCH = 260, CSTF = 4160;
constexpr float EPS = 1e-6f;
constexpr float QSCALE = 0.10206207261596577f * 1.4426950408889634f;
constexpr int NPH_L = 13, NPHASES = 1 + 2 * NPH_L;


constexpr size_t MiB = 1u << 20;
constexpr size_t WS_CTL = 0, CTL_ZERO_BYTES = 64 * 1024;
constexpr size_t WS_WIN = 1 * MiB, WS_WUQ = 9 * MiB, WS_WUKV = 11 * MiB, WS_WOUT = 12 * MiB, WS_WPQ = 16 * MiB, WS_SUBK = 24 * MiB;
constexpr size_t WS_MOD = 25 * MiB, WS_ROPE = 25 * MiB + 256 * 1024, WS_SC = 25 * MiB + 512 * 1024, WS_MS = WS_SC + 64 * 1024;
constexpr size_t WS_CTXS = 26 * MiB, WS_G = 28 * MiB, WS_KR = 31 * MiB, WS_TABU = 34 * MiB, WS_TABV = 66 * MiB;
constexpr size_t WS_ZA = 98 * MiB, WS_ZB = 163 * MiB, WS_Q = WS_ZA, WS_PQ = WS_ZA;
constexpr size_t WS_XN = 228 * MiB, WS_QA = WS_XN, WS_KVA = 253 * MiB, WS_VT = WS_XN;
constexpr size_t WS_MIX = 293 * MiB, WS_R66 = 358 * MiB, WS_KVRAW = WS_R66, WS_CST = WS_R66, WS_EID = WS_R66, WS_GATE = WS_R66 + 17 * MiB;
constexpr size_t WS_KN = 425 * MiB, WS_Q8 = 458 * MiB, WS_MODP = 491 * MiB, WS_END = 493 * MiB;
static_assert(WS_QA + (size_t)RT * 384 * 2 <= WS_KVA && WS_KVA + (size_t)RT * 256 * 2 <= WS_MIX, "QA/KVA inside the XN region");
static_assert(WS_VT + (size_t)NB * 8 * NKT * VT_BYTES <= WS_MIX, "Vt inside the XN region");
static_assert(WS_CST + (size_t)16 * NCH * CSTF * 4 <= WS_KN && WS_KVRAW + (size_t)RT * 1024 * 2 <= WS_KN, "R66 region");
static_assert(WS_KN + (size_t)NB * 8 * NKT * KT_BYTES <= WS_Q8 && WS_Q8 + (size_t)RT * 1024 <= WS_MODP, "Kn / Q8 regions");
static_assert(WS_G + (size_t)RT * 16 * 4 <= WS_KR && WS_KR + (size_t)RT * 32 * 2 <= WS_TABU, "G/KR");
constexpr int CW_BAR = 1024;

constexpr int LDS_BYTES = 147456, MISC_OFF = 143360;

#define LAS __attribute__((address_space(3)))
typedef unsigned short bf16;
typedef short bf16x8 __attribute__((ext_vector_type(8)));
typedef float f32x4 __attribute__((ext_vector_type(4)));
typedef float f32x16 __attribute__((ext_vector_type(16)));
typedef unsigned u32x4 __attribute__((ext_vector_type(4)));
typedef unsigned u32x2 __attribute__((ext_vector_type(2)));
#define LDS_WAIT() asm volatile("s_waitcnt lgkmcnt(0)" ::: "memory")

typedef float f32x2_t __attribute__((ext_vector_type(2))); typedef __bf16 bf16x2_t __attribute__((ext_vector_type(2)));
__device__ __forceinline__ unsigned pk2(float lo, float hi) { f32x2_t v = {lo, hi}; bf16x2_t b = __builtin_convertvector(v, bf16x2_t); return __builtin_bit_cast(unsigned, b); }
__device__ __forceinline__ unsigned f2bf(float f) { return pk2(f, 0.f) & 0xffffu; }
__device__ __forceinline__ float bflo(unsigned w) { return __builtin_bit_cast(float, w << 16); }
__device__ __forceinline__ float bfhi(unsigned w) { return __builtin_bit_cast(float, w & 0xffff0000u); }
__device__ __forceinline__ float bf2f(bf16 v) { return __builtin_bit_cast(float, (unsigned)v << 16); }
__device__ __forceinline__ float shfl_idx(float v, int srclane) { return __builtin_bit_cast(float, __builtin_amdgcn_ds_bpermute(srclane << 2, __builtin_bit_cast(int, v))); }
__device__ __forceinline__ int shfl_idx(int v, int srclane) { return __builtin_amdgcn_ds_bpermute(srclane << 2, v); }
#define DPP_ADD(v, ctrl) (v) += __builtin_bit_cast(float, __builtin_amdgcn_update_dpp(0, __builtin_bit_cast(int, (v)), (ctrl), 0xf, 0xf, true))
__device__ __forceinline__ float wave_sum(float v, int lane) {
    (void)lane;
    DPP_ADD(v, 0xB1);
    DPP_ADD(v, 0x4E);
    DPP_ADD(v, 0x141);
    DPP_ADD(v, 0x140);
    const int b = __builtin_bit_cast(int, v);
    return (__builtin_bit_cast(float, __builtin_amdgcn_readlane(b, 0)) + __builtin_bit_cast(float, __builtin_amdgcn_readlane(b, 16))) +
           (__builtin_bit_cast(float, __builtin_amdgcn_readlane(b, 32)) + __builtin_bit_cast(float, __builtin_amdgcn_readlane(b, 48)));
}
__device__ __forceinline__ float wave_max(float v, int lane) {
#pragma unroll
    for (int o = 1; o < 64; o <<= 1) v = fmaxf(v, shfl_idx(v, lane ^ o));
    return v;
}
__device__ __forceinline__ int crow(int g, int hh) { return (g & 3) + 8 * (g >> 2) + 4 * hh; }
__device__ __forceinline__ bf16x8 pack8(float a0, float a1, float a2, float a3, float a4, float a5, float a6, float a7) {
    u32x4 w; w.x = pk2(a0, a1); w.y = pk2(a2, a3); w.z = pk2(a4, a5); w.w = pk2(a6, a7); return __builtin_bit_cast(bf16x8, w);
}
__device__ __forceinline__ float gelu_f(float v) {
    const float av = fabsf(v), d = av * 0.2316418882f + 1.0f; const float t = __builtin_amdgcn_rcpf(d);
    float q = t * 0.5307027145f + (-0.7265760135f); q = q * t + 0.7107068705f; q = q * t + (-0.142248368f); q = q * t + 0.127414796f; q = q * t;
    const float e = __builtin_amdgcn_exp2f(v * v * (-0.72134752044f));
    const float mm = v * (q * e); return v < 0.f ? mm : v - mm;
}
#define MFMA32(a, b, c) __builtin_amdgcn_mfma_f32_32x32x16_bf16((a), (b), (c), 0, 0, 0)
#define ML_ZERO16 (f32x16){0.f, 0.f, 0.f, 0.f, 0.f, 0.f, 0.f, 0.f, 0.f, 0.f, 0.f, 0.f, 0.f, 0.f, 0.f, 0.f}

#define XB_TMO      128
#define XB_XCNT(j)  (256  + 64 * (j))
#define XB_XSUB(j)  (1280 + 64 * (j))
#define XB_XGEN(j)  (2304 + 64 * (j))
#define XB_TOP      3328
#define XB_TOPGEN   3392
#define XCD_BAR_WORDS 3456
#define XB_SPIN_CAP (1u << 18)
__device__ __forceinline__ unsigned xb_ld(unsigned* p)              { return __hip_atomic_load(p, __ATOMIC_RELAXED, __HIP_MEMORY_SCOPE_AGENT); }
__device__ __forceinline__ unsigned xb_add(unsigned* p, unsigned v) { return __hip_atomic_fetch_add(p, v, __ATOMIC_RELAXED, __HIP_MEMORY_SCOPE_AGENT); }
__device__ __forceinline__ unsigned xb_xcc_id() { return (unsigned)__builtin_amdgcn_s_getreg((3 << 11) | 20) & 0xFu; }
#define XB_SPIN(cond, bar) do { unsigned _sp = 0; while (cond) { __builtin_amdgcn_s_sleep(1); \
    if ((++_sp & 255u) == 0u) { if (xb_ld(&(bar)[XB_TMO])) break; if (_sp > XB_SPIN_CAP) { atomicAdd(&(bar)[XB_TMO], 1u); break; } } } } while (0)
struct XcdBarrier { unsigned* bar; unsigned x; volatile LAS unsigned* st; };
__device__ __forceinline__ XcdBarrier xcd_barrier_post(unsigned* bar, volatile LAS unsigned* st) {
    XcdBarrier b; b.bar = bar; b.x = xb_xcc_id(); b.st = st;
    if (threadIdx.x == 0) (void)xb_add(&bar[XB_XCNT(b.x)], 1u);
    return b;
}
__device__ __forceinline__ void xcd_barrier_complete(unsigned* bar, unsigned x, unsigned& nloc, unsigned& nx) {
    const unsigned G = gridDim.x * gridDim.y * gridDim.z;
    unsigned sum, cnt, mine, sp = 0u;
    for (;;) {
        sum = 0u; cnt = 0u; mine = 0u;
#pragma unroll
        for (unsigned j = 0; j < 16; ++j) { const unsigned c = xb_ld(&bar[XB_XCNT(j)]); sum += c; cnt += (c > 0u) ? 1u : 0u; mine = (j == x) ? c : mine; }
        if (sum == G) break;
        __builtin_amdgcn_s_sleep(1);
        if ((++sp & 255u) == 0u) { if (xb_ld(&bar[XB_TMO])) break; if (sp > XB_SPIN_CAP) { atomicAdd(&bar[XB_TMO], 1u); break; } }
    }
    nloc = mine > 0u ? mine : 1u; nx = cnt > 0u ? cnt : 1u;
}
__device__ __forceinline__ void xcd_barrier(const XcdBarrier& b) {
    asm volatile("s_waitcnt vmcnt(0)" ::: "memory");
    __syncthreads();
    if (threadIdx.x == 0) {
        unsigned* bar = b.bar;
        __builtin_amdgcn_s_waitcnt(0);
        unsigned nloc = b.st[0], nx = b.st[1];
        if (nloc == 0u) { xcd_barrier_complete(bar, b.x, nloc, nx); b.st[0] = nloc; b.st[1] = nx; }
        const unsigned old = xb_add(&bar[XB_XSUB(b.x)], 1u);
        const unsigned gen = old / nloc;
        if (old + 1u == (gen + 1u) * nloc) {
            __builtin_amdgcn_fence(__ATOMIC_RELEASE, "agent");
            asm volatile("s_waitcnt vmcnt(0)" ::: "memory");
            const unsigned og = xb_add(&bar[XB_TOP], 1u);
            const unsigned tg = og / nx;
            if (og + 1u == (tg + 1u) * nx) xb_add(&bar[XB_TOPGEN], 1u);
            else XB_SPIN(xb_ld(&bar[XB_TOPGEN]) == tg, bar);
            __builtin_amdgcn_fence(__ATOMIC_ACQUIRE, "agent");
            xb_add(&bar[XB_XGEN(b.x)], 1u);
            asm volatile("s_waitcnt vmcnt(0)" ::: "memory");
        } else {
            XB_SPIN(xb_ld(&bar[XB_XGEN(b.x)]) == gen, bar);
            __builtin_amdgcn_fence(__ATOMIC_ACQUIRE, "agent");
            asm volatile("s_waitcnt vmcnt(0)" ::: "memory");
        }
    }
    __syncthreads();
}

struct Args { const float* in[24]; float* out; unsigned char* ws; int ph_lo, ph_hi; };
#define CAS __attribute__((address_space(4)))
typedef const CAS unsigned char* karg_t;
struct KA { karg_t p;
    __device__ __forceinline__ const float* in(int k) const { return *(const float* const CAS*)(p + 8 * k); }
    __device__ __forceinline__ float* out() const { return *(float* const CAS*)(p + 192); }
    __device__ __forceinline__ unsigned char* ws() const { return *(unsigned char* const CAS*)(p + 200); }
    __device__ __forceinline__ int ph_lo() const { return *(const int CAS*)(p + 208); }
    __device__ __forceinline__ int ph_hi() const { return *(const int CAS*)(p + 212); }
};
static_assert(sizeof(Args) == 216, "Args layout");
__device__ __forceinline__ KA ka_fresh() { KA a; a.p = (karg_t)__builtin_amdgcn_kernarg_segment_ptr(); asm volatile("" : "+s"(a.p)); return a; }
struct Ctx {
    LAS unsigned char* lds;
    int tid, lane, wave, G, bid;
};
__device__ __forceinline__ Ctx ctx_fresh() {
    extern __shared__ __attribute__((aligned(16))) unsigned char lds_raw[];
    Ctx C; C.lds = (LAS unsigned char*)lds_raw; int t = threadIdx.x; asm volatile("" : "+v"(t));
    C.tid = t; C.lane = t & 63; C.wave = __builtin_amdgcn_readfirstlane(t >> 6); C.G = gridDim.x; C.bid = blockIdx.x; return C;
}
__device__ __forceinline__ const float* stream_in(const KA& A, const Ctx& C, int l, int row) {
    if (row < RL) return (l == 0 ? A.in(0) : (const float*)A.out()) + (size_t)row * DM;
    return (l == 0 ? A.in(2) : (const float*)(A.ws() + WS_CTXS)) + (size_t)(row - RL) * DM;
}
__device__ __forceinline__ float* stream_out(const KA& A, const Ctx& C, int row) {
    if (row < RL) return A.out() + (size_t)row * DM;
    return (float*)(A.ws() + WS_CTXS) + (size_t)(row - RL) * DM;
}

__device__ __forceinline__ void p0_transpose_item(const float* W, int K, int N, bf16* WT, int n0, int dst_row0, LAS float* scr, int kb, int lane) {
    const int k0 = 64 * kb;
#pragma unroll 8
    for (int i = 0; i < 32; ++i) { const int kk = 2 * i + (lane >> 5); const int n = n0 + (lane & 31); scr[kk * 33 + (lane & 31)] = (n < N) ? W[(size_t)(k0 + kk) * N + n] : 0.f; }
    LDS_WAIT(); asm volatile("" ::: "memory");
    const int c = lane & 7;
#pragma unroll
    for (int j = 0; j < 4; ++j) { const int n = (lane >> 3) + 8 * j; const LAS float* s = scr + (8 * c) * 33 + n;
        u32x4 o; o.x = pk2(s[0 * 33], s[1 * 33]); o.y = pk2(s[2 * 33], s[3 * 33]); o.z = pk2(s[4 * 33], s[5 * 33]); o.w = pk2(s[6 * 33], s[7 * 33]);
        *(u32x4*)(WT + (size_t)(dst_row0 + n) * K + k0 + 8 * c) = o; }
    LDS_WAIT(); asm volatile("" ::: "memory");
}
__device__ __forceinline__ void p0_poolw_item(const float* Win, const float* Wp, bf16* WT, LAS float* scr, int kb, int nb, int lane) {
    const int k0 = 64 * kb, g = nb >> 1, e = (nb & 1) * 32 + (lane & 31);
    float wc[64];
#pragma unroll
    for (int c = 0; c < 64; ++c) wc[c] = Wp[((size_t)g * 64 + c) * 64 + e];
#pragma unroll 2
    for (int i = 0; i < 32; ++i) { const int kk = 2 * i + (lane >> 5); const float* wr = Win + (size_t)(k0 + kk) * 1968 + g * 64; float a = 0.f;
#pragma unroll
        for (int c4 = 0; c4 < 16; ++c4) { const f32x4 x = *(const f32x4*)(wr + 4 * c4); a += x.x * wc[4 * c4] + x.y * wc[4 * c4 + 1] + x.z * wc[4 * c4 + 2] + x.w * wc[4 * c4 + 3]; }
        scr[kk * 33 + (lane & 31)] = a; }
    LDS_WAIT(); asm volatile("" ::: "memory");
    const int c = lane & 7;
#pragma unroll
    for (int j = 0; j < 4; ++j) { const int n = (lane >> 3) + 8 * j; const LAS float* sp = scr + (8 * c) * 33 + n;
        u32x4 o; o.x = pk2(sp[0 * 33], sp[1 * 33]); o.y = pk2(sp[2 * 33], sp[3 * 33]); o.z = pk2(sp[4 * 33], sp[5 * 33]); o.w = pk2(sp[6 * 33], sp[7 * 33]);
        *(u32x4*)(WT + (size_t)(32 * nb + n) * DM + k0 + 8 * c) = o; }
    LDS_WAIT(); asm volatile("" ::: "memory");
}
__device__ __forceinline__ void phase_prologue() {
    const KA A = ka_fresh(); const Ctx C = ctx_fresh();
    LAS float* scr = (LAS float*)(C.lds + C.wave * 16384);
    const int gw = C.bid * 8 + C.wave, NGW = C.G * 8, lane = C.lane;
    float* MODP = (float*)(A.ws() + WS_MODP);
    for (int it = gw; it < 2 * 96 * 8; it += NGW) {
        const int ks = it & 7, l = (it >> 3) / 96, j = ((it >> 3) % 96) * 64 + lane;
        const float* W = A.in(6) + ((size_t)l * DM + ks * 128) * 6144 + j;
        const float* c01 = A.in(1) + ks * 128; const float* c2p = A.in(3) + ks * 128;
        float a0 = 0.f, a1 = 0.f, a2 = 0.f;
#pragma unroll 16
        for (int k = 0; k < 128; ++k) {
            const float w = W[(size_t)k * 6144];
            const float c0 = c01[k], c1 = c01[DM + k], c2 = c2p[k];
            a0 += (c0 / (1.f + __expf(-c0))) * w; a1 += (c1 / (1.f + __expf(-c1))) * w; a2 += (c2 / (1.f + __expf(-c2))) * w;
        }
        float* mp = MODP + ((size_t)(l * 8 + ks) * 3) * 6144 + j;
        mp[0] = a0; mp[6144] = a1; mp[2 * 6144] = a2;
    }
    constexpr int I_IN = 16 * 64, I_UQ = 6 * 24, I_UKV = 4 * 32, I_OUT = 16 * 32, I_PQ = 16 * 64, I_L = I_IN + I_UQ + I_UKV + I_OUT + I_PQ;
    for (int it = gw; it < 2 * I_L; it += NGW) {
        const int l = it / I_L; int r = it % I_L;
        if (r < I_IN) {
            const int kb = r / 64, nb = r % 64;
            if (nb < 8) { p0_poolw_item(A.in(8) + (size_t)l * DM * 1968, A.in(9) + (size_t)l * 4 * 64 * 64, (bf16*)(A.ws() + WS_WIN) + (size_t)l * 2048 * DM, scr, kb, nb, lane); continue; }
            const int dst = nb < 29 ? 32 * nb : (nb < 61 ? 96 + 32 * nb : (nb == 61 ? 928 : (nb == 62 ? 960 : 992)));
            const int n0 = nb < 62 ? 32 * nb : 4096;
            p0_transpose_item(A.in(8) + (size_t)l * DM * 1968, DM, 1968, (bf16*)(A.ws() + WS_WIN) + (size_t)l * 2048 * DM, n0, dst, scr, kb, lane); continue; }
        r -= I_IN;
        if (r < I_UQ) { const int kb = r / 24, nb = r % 24; p0_transpose_item(A.in(13) + (size_t)l * 384 * 768, 384, 768, (bf16*)(A.ws() + WS_WUQ) + (size_t)l * 768 * 384, 32 * nb, 32 * nb, scr, kb, lane); continue; }
        r -= I_UQ;
        if (r < I_UKV) { const int kb = r / 32, nb = r % 32; p0_transpose_item(A.in(14) + (size_t)l * 256 * 1024, 256, 1024, (bf16*)(A.ws() + WS_WUKV) + (size_t)l * 1024 * 256, 32 * nb, 32 * nb, scr, kb, lane); continue; }
        r -= I_UKV;
        if (r < I_OUT) { const int kb = r / 32, nb = r % 32; p0_transpose_item(A.in(19) + (size_t)l * DM * DM, DM, DM, (bf16*)(A.ws() + WS_WOUT) + (size_t)l * DM * DM, 32 * nb, 32 * nb, scr, kb, lane); continue; }
        r -= I_OUT;
        { const int kb = r / 64, nb = r % 64; p0_transpose_item(A.in(20) + (size_t)l * DM * 2048, DM, 2048, (bf16*)(A.ws() + WS_WPQ) + (size_t)l * 2048 * DM, 32 * nb, 32 * nb, scr, kb, lane); }
    }
    const int gt = C.bid * 512 + C.tid, NT = C.G * 512;
    { const float* s = A.in(21); bf16* d = (bf16*)(A.ws() + WS_SUBK);
      for (int i = gt; i < 2 * 8 * 2 * 128 * 128 / 4; i += NT) { const f32x4 v = *(const f32x4*)(s + 4 * (size_t)i); u32x2 o; o.x = pk2(v.x, v.y); o.y = pk2(v.z, v.w); *(u32x2*)(d + 4 * (size_t)i) = o; } }
    { float* rp = (float*)(A.ws() + WS_ROPE);
      for (int i = gt; i < 256 * 8; i += NT) { const int p = i >> 3, f = i & 7;
          const float fr[8] = {1.0f, 0.31622776601683794f, 0.1f, 0.031622776601683794f, 0.01f, 0.0031622776601683794f, 0.001f, 0.00031622776601683794f};
          float fq = fr[0];
#pragma unroll
          for (int q = 1; q < 8; ++q) fq = (f == q) ? fr[q] : fq;
          const float ang = (float)p * fq;
          const double rev = (double)ang * 0.15915494309189535; const float fracr = (float)(rev - floor(rev));
          rp[2 * i] = __builtin_amdgcn_cosf(fracr); rp[2 * i + 1] = __builtin_amdgcn_sinf(fracr); } }
}

__device__ __forceinline__ void phase_modreduce() {
    const KA A = ka_fresh(); const Ctx C = ctx_fresh();
    const int gt = C.bid * 512 + C.tid, NT = C.G * 512;
    const float* MODP = (const float*)(A.ws() + WS_MODP); float* MOD = (float*)(A.ws() + WS_MOD);
    for (int i = gt; i < 2 * 3 * 6144; i += NT) { const int l = i / (3 * 6144), rem = i % (3 * 6144), j = rem % 6144;
        float a = A.in(7)[l * 6144 + j];
#pragma unroll
        for (int ks = 0; ks < 8; ++ks) a += MODP[((size_t)(l * 8 + ks) * 3) * 6144 + rem];
        const int slot = j >> 10;
        if (slot == 1) a = A.in(4)[l * DM + (j & 1023)] * (1.0f + a); else if (slot == 4) a = A.in(5)[l * DM + (j & 1023)] * (1.0f + a);
        MOD[i] = a; }
}
__device__ __forceinline__ void phase_norm(int l, int which) {
    const KA A = ka_fresh(); const Ctx C = ctx_fresh();
    const int gw = C.bid * 8 + C.wave, NGW = C.G * 8, lane = C.lane;
    const float* MOD = (const float*)(A.ws() + WS_MOD);
    bf16* XN = (bf16*)(A.ws() + WS_XN);
    const int nrows = (which == 1 && l == 1) ? RL : RT;
    int cur = -1; f32x4 csh[4], cgs[4];
    for (int row = gw; row < nrows; row += NGW) {
        const float* xr = (which == 0) ? stream_in(A, C, l, row) : (const float*)stream_out(A, C, row);
        const int nsel = row < RL ? (row >> 14) : 2;
        if (nsel != cur) { cur = nsel; const float* md = MOD + (l * 3 + nsel) * 6144 + which * 3072;
#pragma unroll
            for (int i = 0; i < 4; ++i) { const int j = 4 * lane + 256 * i; csh[i] = *(const f32x4*)(md + j); cgs[i] = *(const f32x4*)(md + 1024 + j); } }
        f32x4 v[4]; float ss = 0.f;
#pragma unroll
        for (int i = 0; i < 4; ++i) { v[i] = *(const f32x4*)(xr + 4 * lane + 256 * i); ss += (v[i].x * v[i].x + v[i].y * v[i].y) + (v[i].z * v[i].z + v[i].w * v[i].w); }
        const float rs = 1.0f / sqrtf(wave_sum(ss, lane) * (1.f / DM) + EPS);
#pragma unroll
        for (int i = 0; i < 4; ++i) { const int j = 4 * lane + 256 * i;
            const f32x4 y = v[i] * rs * cgs[i] + csh[i];
            u32x2 o; o.x = pk2(y.x, y.y); o.y = pk2(y.z, y.w); *(u32x2*)(XN + (size_t)row * DM + j) = o; }
    }
}
constexpr float U_SCALE = 48.f, V_SCALE = 1.5f;
constexpr int TROW = 768;
struct __attribute__((packed, aligned(4))) U3 { unsigned a, b, c; };
__device__ __forceinline__ unsigned q_e2m3(float x) {
    const unsigned sg = (__builtin_bit_cast(unsigned, x) >> 31) << 5;
    const float a = fminf(fabsf(x), 7.5f);
    const float t = a * (a < 2.f ? 8.f : (a < 4.f ? 4.f : 2.f));
    return sg | ((unsigned)__builtin_rintf(t) + (a < 2.f ? 0u : (a < 4.f ? 8u : 16u)));
}
__device__ __forceinline__ void phase_tables(int l) {
    const KA A = ka_fresh(); const Ctx C = ctx_fresh();
    const size_t gt = (size_t)C.bid * 512 + C.tid, NT = (size_t)C.G * 512;
    const size_t n16 = (size_t)16384 * 1024 / 16;
#pragma unroll
    for (int w = 0; w < 2; ++w) {
        const float* s = A.in(22 + w) + (size_t)l * 16384 * 1024; unsigned char* d = A.ws() + (w ? WS_TABV : WS_TABU);
        const float sc = w ? V_SCALE : U_SCALE;
        for (size_t i = gt; i < n16; i += NT) {
            unsigned c[16];
#pragma unroll
            for (int q = 0; q < 4; ++q) { const f32x4 x = *(const f32x4*)(s + 16 * i + 4 * q);
                c[4 * q] = q_e2m3(x.x * sc); c[4 * q + 1] = q_e2m3(x.y * sc); c[4 * q + 2] = q_e2m3(x.z * sc); c[4 * q + 3] = q_e2m3(x.w * sc); }
            U3 o;
            o.a = c[0] | (c[1] << 6) | (c[2] << 12) | (c[3] << 18) | (c[4] << 24) | (c[5] << 30);
            o.b = (c[5] >> 2) | (c[6] << 4) | (c[7] << 10) | (c[8] << 16) | (c[9] << 22) | (c[10] << 28);
            o.c = (c[10] >> 4) | (c[11] << 2) | (c[12] << 8) | (c[13] << 14) | (c[14] << 20) | (c[15] << 26);
            *(U3*)(d + 12 * i) = o; }
    }
}

__device__ __forceinline__ void phase_post(int l) {
    const KA A = ka_fresh(); const Ctx C = ctx_fresh();
    const bf16* ZA = (const bf16*)(A.ws() + WS_ZA);
    bf16* MIX = (bf16*)(A.ws() + WS_MIX); bf16* QA = (bf16*)(A.ws() + WS_QA); bf16* KVA = (bf16*)(A.ws() + WS_KVA); bf16* KR = (bf16*)(A.ws() + WS_KR);
    float* GT = (float*)(A.ws() + WS_G);
    LAS float* U = (LAS float*)C.lds;
    const int tid = C.tid, lane = C.lane;
    for (int unit = C.bid; unit < RT / 32; unit += C.G) {
        const int r0 = unit * 32;
        int seq0, L;
        if (r0 < RL) { seq0 = (r0 >> 14) << 14; L = SEQ; } else { seq0 = RL + (((r0 - RL) >> 8) << 8); L = CTXL; }
        const int t0 = r0 - seq0;
        for (int idx = tid; idx < 48 * 32; idx += 512) { const int rr = idx >> 5, c8 = idx & 31; const int t = t0 - 8 + rr;
            u32x4 v = {0u, 0u, 0u, 0u};
            if (t >= 0 && t < L) v = *(const u32x4*)(ZA + (size_t)(seq0 + t) * 1024 + c8 * 8);
            LAS float* d = U + rr * 256 + c8 * 8;
            d[0] = bflo(v.x); d[1] = bfhi(v.x); d[2] = bflo(v.y); d[3] = bfhi(v.y); d[4] = bflo(v.z); d[5] = bfhi(v.z); d[6] = bflo(v.w); d[7] = bfhi(v.w); }
        __syncthreads();
        { const int ch = tid & 255, half = tid >> 8, hw = __builtin_amdgcn_readfirstlane(1 << (ch >> 6));
          const float sc = A.in(10)[l * 256 + ch];
          for (int i = half * 16; i < half * 16 + 16; ++i) { const int t = t0 + i; const int lo = max(t - hw, 0), hi = min(t + hw, L);
              float sm = 0.f; for (int tt = lo; tt < hi; ++tt) sm += U[(tt - t0 + 8) * 256 + ch];
              const float dv = sm / (float)(hi - lo) - U[(i + 8) * 256 + ch];
              MIX[(size_t)(r0 + i) * 1024 + ch] = (bf16)f2bf(dv * sc); } }
#pragma unroll
        for (int q = 0; q < 4; ++q) { const int row = r0 + C.wave * 4 + q; const bf16* za = ZA + (size_t)row * 1024;
            { float x[6]; float ss = 0.f;
#pragma unroll
              for (int i = 0; i < 3; ++i) { const unsigned w = *(const unsigned*)(za + 256 + 2 * lane + 128 * i); x[2 * i] = bflo(w); x[2 * i + 1] = bfhi(w); ss += x[2 * i] * x[2 * i] + x[2 * i + 1] * x[2 * i + 1]; }
              const float rs = 1.0f / sqrtf(wave_sum(ss, lane) * (1.f / 384.f) + EPS); const float* gq = A.in(11) + l * 384;
#pragma unroll
              for (int i = 0; i < 3; ++i) { const int j = 2 * lane + 128 * i; *(unsigned*)(QA + (size_t)row * 384 + j) = pk2(x[2 * i] * rs * gq[j], x[2 * i + 1] * rs * gq[j + 1]); } }
            { const u32x2 w = *(const u32x2*)(za + 640 + 4 * lane);
              const float x0 = bflo(w.x), x1 = bfhi(w.x), x2 = bflo(w.y), x3 = bfhi(w.y);
              const float rs = 1.0f / sqrtf(wave_sum(x0 * x0 + x1 * x1 + x2 * x2 + x3 * x3, lane) * (1.f / 256.f) + EPS); const float* gk = A.in(12) + l * 256 + 4 * lane;
              u32x2 o; o.x = pk2(x0 * rs * gk[0], x1 * rs * gk[1]); o.y = pk2(x2 * rs * gk[2], x3 * rs * gk[3]); *(u32x2*)(KVA + (size_t)row * 256 + 4 * lane) = o; }
            if (lane < 16) *(unsigned*)(KR + (size_t)row * 32 + 2 * lane) = *(const unsigned*)(za + 896 + 2 * lane);
            if (lane < 16) { float gv = bf2f(za[928 + lane]) + A.in(17)[l * 16 + lane];
                if ((lane >> 2) & 1) gv = fminf(gv, 0.f) - log1pf(__expf(-fabsf(gv)));
                GT[(size_t)row * 16 + lane] = gv; }
        }
        __syncthreads();
    }
}

__device__ __forceinline__ unsigned fp8x4(float a, float b, float c, float d) {
    a = __builtin_amdgcn_fmed3f(a, -448.f, 448.f); b = __builtin_amdgcn_fmed3f(b, -448.f, 448.f); c = __builtin_amdgcn_fmed3f(c, -448.f, 448.f); d = __builtin_amdgcn_fmed3f(d, -448.f, 448.f);
    int w = __builtin_amdgcn_cvt_pk_fp8_f32(a, b, 0, false); w = __builtin_amdgcn_cvt_pk_fp8_f32(c, d, w, true); return (unsigned)w;
}
__device__ __forceinline__ void qk_head(const bf16* src_lo, const bf16* src_hi, unsigned char* dst, int sw, const float* gn, bool rot, const float (&cs)[16], const float (&sn)[16], float oscale) {
    float ss = 0.f;
#pragma unroll 4
    for (int i = 0; i < 8; ++i) { const u32x4 w = *(const u32x4*)(src_lo + 8 * i);
        ss += (bflo(w.x) * bflo(w.x) + bfhi(w.x) * bfhi(w.x)) + (bflo(w.y) * bflo(w.y) + bfhi(w.y) * bfhi(w.y)) + (bflo(w.z) * bflo(w.z) + bfhi(w.z) * bfhi(w.z)) + (bflo(w.w) * bflo(w.w) + bfhi(w.w) * bfhi(w.w)); }
    u32x4 wr[4];
#pragma unroll
    for (int i = 0; i < 4; ++i) { wr[i] = *(const u32x4*)(src_hi + 8 * i); const u32x4 w = wr[i];
        ss += (bflo(w.x) * bflo(w.x) + bfhi(w.x) * bfhi(w.x)) + (bflo(w.y) * bflo(w.y) + bfhi(w.y) * bfhi(w.y)) + (bflo(w.z) * bflo(w.z) + bfhi(w.z) * bfhi(w.z)) + (bflo(w.w) * bflo(w.w) + bfhi(w.w) * bfhi(w.w)); }
    const float rs = oscale / sqrtf(ss * (1.f / 96.f) + EPS);
    __builtin_amdgcn_sched_barrier(0);
#pragma unroll 1
    for (int i = 0; i < 8; ++i) {
        const u32x4 w = *(const u32x4*)(src_lo + 8 * i); const f32x4 g0 = *(const f32x4*)(gn + 8 * i), g1 = *(const f32x4*)(gn + 8 * i + 4);
        u32x2 o; o.x = fp8x4(bflo(w.x) * rs * g0.x, bfhi(w.x) * rs * g0.y, bflo(w.y) * rs * g0.z, bfhi(w.y) * rs * g0.w);
        o.y = fp8x4(bflo(w.z) * rs * g1.x, bfhi(w.z) * rs * g1.y, bflo(w.w) * rs * g1.z, bfhi(w.w) * rs * g1.w);
        *(u32x2*)(dst + ((((i >> 1) ^ sw) << 4) + ((i & 1) << 3))) = o; }
    __builtin_amdgcn_sched_barrier(0);
#pragma unroll
    for (int i = 0; i < 2; ++i) {
        const u32x4 p = wr[i], q = wr[2 + i];
        const f32x4 ga = *(const f32x4*)(gn + 64 + 8 * i), gb = *(const f32x4*)(gn + 64 + 8 * i + 4), gc = *(const f32x4*)(gn + 80 + 8 * i), gd = *(const f32x4*)(gn + 80 + 8 * i + 4);
        float y1[8], y2[8];
        y1[0] = bflo(p.x) * rs * ga.x; y1[1] = bfhi(p.x) * rs * ga.y; y1[2] = bflo(p.y) * rs * ga.z; y1[3] = bfhi(p.y) * rs * ga.w; y1[4] = bflo(p.z) * rs * gb.x; y1[5] = bfhi(p.z) * rs * gb.y; y1[6] = bflo(p.w) * rs * gb.z; y1[7] = bfhi(p.w) * rs * gb.w;
        y2[0] = bflo(q.x) * rs * gc.x; y2[1] = bfhi(q.x) * rs * gc.y; y2[2] = bflo(q.y) * rs * gc.z; y2[3] = bfhi(q.y) * rs * gc.w; y2[4] = bflo(q.z) * rs * gd.x; y2[5] = bfhi(q.z) * rs * gd.y; y2[6] = bflo(q.w) * rs * gd.z; y2[7] = bfhi(q.w) * rs * gd.w;
        if (rot) {
#pragma unroll
            for (int j = 0; j < 8; ++j) { const float a = y1[j] * cs[8 * i + j] - y2[j] * sn[8 * i + j], bb = y2[j] * cs[8 * i + j] + y1[j] * sn[8 * i + j]; y1[j] = a; y2[j] = bb; }
        }
        u32x2 o; o.x = fp8x4(y1[0], y1[1], y1[2], y1[3]); o.y = fp8x4(y1[4], y1[5], y1[6], y1[7]); *(u32x2*)(dst + (((4 ^ sw) << 4) + (i << 3))) = o;
        u32x2 o2; o2.x = fp8x4(y2[0], y2[1], y2[2], y2[3]); o2.y = fp8x4(y2[4], y2[5], y2[6], y2[7]); *(u32x2*)(dst + (((5 ^ sw) << 4) + (i << 3))) = o2;
    }
    { u32x4 z; z.x = 0u; z.y = 0u; z.z = 0u; z.w = 0u; *(u32x4*)(dst + ((6 ^ sw) << 4)) = z; *(u32x4*)(dst + ((7 ^ sw) << 4)) = z; }
    __builtin_amdgcn_sched_barrier(0);
}
__device__ __forceinline__ void phase_qknorm(int l) {
    const KA A = ka_fresh(); const Ctx C = ctx_fresh();
    const int gw = C.bid * 8 + C.wave, NGW = C.G * 8, lane = C.lane;
    const bf16* Q = (const bf16*)(A.ws() + WS_Q); const bf16* KV = (const bf16*)(A.ws() + WS_KVRAW); const bf16* KR = (const bf16*)(A.ws() + WS_KR);
    unsigned char* KN = A.ws() + WS_KN; unsigned char* VT = A.ws() + WS_VT;
    const float* rope = (const float*)(A.ws() + WS_ROPE);
    const float* qg = A.in(15) + l * 96; const float* kg = A.in(16) + l * 96;
    for (int u3 = gw; u3 < (RT / 64) * 8 * 3; u3 += NGW) {
        const int part = u3 % 3, u = u3 / 3;
        const int h = u & 7, tl = u >> 3, row0 = tl * 64, row = row0 + lane;
        const bool lat = row0 < RL; int b, t0;
        if (lat) { b = row0 >> 14; t0 = row0 & (SEQ - 1); } else { b = (row0 - RL) >> 8; t0 = (row0 - RL) & 255; }
        const int ktile = lat ? (t0 >> 6) : (SEQ + t0) >> 6;
        float cs[16], sn[16];
#pragma unroll
        for (int i = 0; i < 16; ++i) { cs[i] = 1.f; sn[i] = 0.f; }
        if (lat && part < 2) {
#pragma unroll
            for (int i = 0; i < 16; ++i) { const int p = (i < 8) ? (t0 >> 6) : lane; const float* rp = rope + (p * 8 + (i & 7)) * 2; cs[i] = rp[0]; sn[i] = rp[1]; }
        }
        const bf16* kvp = KV + (size_t)row * 1024 + h * 128;
        if (part == 0) { const bf16* qp = Q + (size_t)row * 768 + h * 96;
          qk_head(qp, qp + 64, A.ws() + WS_Q8 + (size_t)row * 1024 + h * 128, 0, qg, lat, cs, sn, QSCALE); }
        else if (part == 1) qk_head(kvp, KR + (size_t)row * 32, KN + ((size_t)(b * 8 + h) * NKT + ktile) * KT_BYTES + lane * 128, (lane >> 1) & 7, kg, lat, cs, sn, 1.0f);
        else { const int kap = lane & 15; const int pos = (lane & ~15) + 8 * ((kap >> 2) & 1) + 4 * (kap >> 3) + (kap & 3);
          bf16* vd = (bf16*)(VT + ((size_t)(b * 8 + h) * NKT + ktile) * VT_BYTES);
          const int pa = pos >> 3, pb = pos & 7;
#pragma unroll 1
          for (int i = 0; i < 8; ++i) { const u32x4 vv = *(const u32x4*)(kvp + 64 + 8 * i);
#pragma unroll
              for (int e = 0; e < 8; ++e) { const int d = 8 * i + e; const unsigned wd = (e >> 1) == 0 ? vv.x : ((e >> 1) == 1 ? vv.y : ((e >> 1) == 2 ? vv.z : vv.w)); const bf16 val = (bf16)((e & 1) ? (wd >> 16) : (wd & 0xffffu));
                  vd[(unsigned)(d * 64 + ((pa ^ ((d >> 1) & 7)) << 3) + pb)] = val; } } }
    }
}

__device__ __forceinline__ int ml_row(int b, int dir, int j, int s) {
    if (j < 4) { const int p = 64 * j + s; return RL + b * CTXL + (dir ? CTXL - 1 - p : p); }
    const int p = 64 * (j - 4) + s; return b * SEQ + (dir ? SEQ - 1 - p : p);
}
__device__ __forceinline__ void phase_ml_local() {
    const KA A = ka_fresh(); const Ctx C = ctx_fresh();
    const int gw = C.bid * 8 + C.wave, NGW = C.G * 8, lane = C.lane, r = lane & 31, hh = lane >> 5;
    const bf16* ZB = (const bf16*)(A.ws() + WS_ZB); const float* GT = (const float*)(A.ws() + WS_G);
    float* CST = (float*)(A.ws() + WS_CST); float* SC = (float*)(A.ws() + WS_SC);
    for (int u = gw; u < 16 * NCH; u += NGW) {
        const int sq = u / NCH, j = u % NCH, b = sq >> 3, h = (sq >> 1) & 3, dir = sq & 1;
        const int rowl = ml_row(b, dir, j, lane);
        const float gi = GT[(size_t)rowl * 16 + dir * 8 + h], lf = GT[(size_t)rowl * 16 + dir * 8 + 4 + h];
        float bs = lf;
#pragma unroll
        for (int o = 1; o < 64; o <<= 1) { const float tv = shfl_idx(bs, lane - o); if (lane >= o) bs += tv; }
        const float blast = shfl_idx(bs, 63);
        const float dec = blast + gi - bs;
        const float mloc = wave_max(dec, lane);
        const float w = __expf(dec - mloc);
        const int row0 = ml_row(b, dir, j, 0), rstep = dir ? -1 : 1;
        f32x16 acc[2][2];
#pragma unroll
        for (int vb = 0; vb < 2; ++vb)
#pragma unroll
            for (int db = 0; db < 2; ++db) acc[vb][db] = ML_ZERO16;
        float nacc0 = 0.f, nacc1 = 0.f;
#pragma unroll
        for (int st = 0; st < 4; ++st) {
            float ws[8]; unsigned rofs[8];
#pragma unroll
            for (int jj = 0; jj < 8; ++jj) { const int sidx = 16 * st + 8 * hh + jj; ws[jj] = shfl_idx(w, sidx); rofs[jj] = (unsigned)((row0 + rstep * sidx) * 1024 + h * 64 + r); }
            bf16x8 Af[2], Bf[2];
#pragma unroll
            for (int blk = 0; blk < 2; ++blk) {
                float kx[8];
#pragma unroll
                for (int jj = 0; jj < 8; ++jj) { kx[jj] = bf2f(ZB[rofs[jj] + 256 + 32 * blk]); Bf[blk][jj] = (short)ZB[rofs[jj] + 256 + 32 * blk]; }
                if (blk == 0) {
#pragma unroll
                    for (int jj = 0; jj < 8; ++jj) nacc0 += ws[jj] * kx[jj]; }
                else {
#pragma unroll
                    for (int jj = 0; jj < 8; ++jj) nacc1 += ws[jj] * kx[jj]; }
                float vx[8];
#pragma unroll
                for (int jj = 0; jj < 8; ++jj) vx[jj] = bf2f(ZB[rofs[jj] + 512 + 32 * blk]) * ws[jj];
                Af[blk] = pack8(vx[0], vx[1], vx[2], vx[3], vx[4], vx[5], vx[6], vx[7]);
            }
#pragma unroll
            for (int vb = 0; vb < 2; ++vb)
#pragma unroll
                for (int db = 0; db < 2; ++db) acc[vb][db] = MFMA32(Af[vb], Bf[db], acc[vb][db]);
            __builtin_amdgcn_sched_barrier(0);
        }
        float* cp = CST + (size_t)u * CSTF;
#pragma unroll
        for (int vb = 0; vb < 2; ++vb)
#pragma unroll
            for (int db = 0; db < 2; ++db)
#pragma unroll
                for (int g = 0; g < 16; ++g) cp[(32 * vb + crow(g, hh)) * 64 + 32 * db + r] = acc[vb][db][g];
        nacc0 += shfl_idx(nacc0, lane ^ 32); nacc1 += shfl_idx(nacc1, lane ^ 32);
        if (hh == 0) { cp[4096 + r] = nacc0; cp[4096 + 32 + r] = nacc1; }
        if (lane == 0) { SC[u * 2] = mloc; SC[u * 2 + 1] = blast; }
    }
}
__device__ __forceinline__ void phase_ml_scan() {
    const KA A = ka_fresh(); const Ctx C = ctx_fresh();
    const int gt = C.bid * 512 + C.tid, NT = C.G * 512;
    float* CST = (float*)(A.ws() + WS_CST); const float* SC = (const float*)(A.ws() + WS_SC); float* MS = (float*)(A.ws() + WS_MS);
    for (int e = gt; e < 16 * CSTF; e += NT) {
        const int sq = e / CSTF, el = e % CSTF;
        float* base = CST + (size_t)sq * NCH * CSTF + el;
        float cv = 0.f, m = -1e30f;
#pragma unroll 1
        for (int j0 = 0; j0 < NCH; j0 += 10) {
            float loc[10]; f32x2_t sc[10];
#pragma unroll
            for (int u = 0; u < 10; ++u) { loc[u] = base[(size_t)(j0 + u) * CSTF]; sc[u] = *(const f32x2_t*)(SC + (sq * NCH + j0 + u) * 2); }
#pragma unroll
            for (int u = 0; u < 10; ++u) {
                base[(size_t)(j0 + u) * CSTF] = cv;
                if (el == 0) MS[sq * NCH + j0 + u] = m;
                const float mn = fmaxf(sc[u].y + m, sc[u].x);
                cv = __expf(sc[u].y + m - mn) * cv + __expf(sc[u].x - mn) * loc[u]; m = mn;
            }
        }
    }
}
template <int DIR>
__device__ __forceinline__ void ml_sblock(f32x16& S, float& den, const bf16* ZB, const bf16x8 (&Qf)[4], int sb, int base_row, int h, int r, int hh, int jl, float a, float Mj) {
    S = ML_ZERO16;
    const int sr = 32 * sb + r; const int rows = base_row + (DIR ? 63 - sr : sr);
#pragma unroll
    for (int st = 0; st < 4; ++st) { const bf16x8 Kf = *(const bf16x8*)(ZB + (unsigned)(rows * 1024 + 256 + h * 64 + st * 16 + hh * 8)); S = MFMA32(Kf, Qf[st], S); }
#pragma unroll
    for (int g = 0; g < 16; ++g) { const int s = 32 * sb + crow(g, hh); const float as = shfl_idx(a, s);
        const float p = (s <= jl) ? S[g] * 0.125f * __expf(as - Mj) : 0.f; S[g] = p; den += p; }
}
template <int DIR>
__device__ __forceinline__ void ml_pv(f32x16& O, const f32x16& S, const bf16* ZB, int sb, int base_row, int h, int v, int hh) {
#pragma unroll
    for (int st2 = 0; st2 < 2; ++st2) {
        bf16x8 VA;
#pragma unroll
        for (int jj = 0; jj < 8; ++jj) { const int s = 32 * sb + 16 * st2 + 8 * (jj >> 2) + 4 * hh + (jj & 3); const int rows = base_row + (DIR ? 63 - s : s);
            VA[jj] = (short)ZB[(unsigned)(rows * 1024 + 512 + h * 64 + v)]; }
        const bf16x8 PB = pack8(S[8 * st2 + 0], S[8 * st2 + 1], S[8 * st2 + 2], S[8 * st2 + 3], S[8 * st2 + 4], S[8 * st2 + 5], S[8 * st2 + 6], S[8 * st2 + 7]);
        O = MFMA32(VA, PB, O);
        __builtin_amdgcn_sched_barrier(0);
    }
}
template <int DIR>
__device__ __forceinline__ void ml_out_dir(const KA& A, const Ctx& C, LAS float* H, int b, int h, int c, int base_row, int lane) {
    const bf16* ZB = (const bf16*)(A.ws() + WS_ZB); const float* GT = (const float*)(A.ws() + WS_G);
    const float* CST = (const float*)(A.ws() + WS_CST); const float* MS = (const float*)(A.ws() + WS_MS);
    const int r = lane & 31, hh = lane >> 5;
    const int j = DIR ? (c < 4 ? 3 - c : 263 - c) : c;
    const int sq = (b * 4 + h) * 2 + DIR;
    const float* Cp = CST + ((size_t)sq * NCH + j) * CSTF;
    const float m0 = MS[sq * NCH + j];
    const int rowl = base_row + (DIR ? 63 - lane : lane);
    const float gi = GT[(size_t)rowl * 16 + DIR * 8 + h], lf = GT[(size_t)rowl * 16 + DIR * 8 + 4 + h];
    float bs = lf;
#pragma unroll
    for (int o = 1; o < 64; o <<= 1) { const float tv = shfl_idx(bs, lane - o); if (lane >= o) bs += tv; }
    const float a = gi - bs;
    float pm = a;
#pragma unroll
    for (int o = 1; o < 64; o <<= 1) { const float tv = shfl_idx(pm, lane - o); if (lane >= o) pm = fmaxf(pm, tv); }
#pragma unroll 1
    for (int jb = 0; jb < 2; ++jb) {
        const int jl = 32 * jb + r;
        const float bj = shfl_idx(bs, jl), Mj = fmaxf(m0, shfl_idx(pm, jl));
        const int rowj = base_row + (DIR ? 63 - jl : jl);
        const int tok = DIR ? 63 - jl : jl;
        bf16x8 Qf[4];
#pragma unroll
        for (int st = 0; st < 4; ++st) Qf[st] = *(const bf16x8*)(ZB + (unsigned)(rowj * 1024 + h * 64 + st * 16 + hh * 8));
        f32x16 S0, S1 = ML_ZERO16; float den = 0.f;
        ml_sblock<DIR>(S0, den, ZB, Qf, 0, base_row, h, r, hh, jl, a, Mj);
        if (jb == 1) ml_sblock<DIR>(S1, den, ZB, Qf, 1, base_row, h, r, hh, jl, a, Mj);
        den += shfl_idx(den, lane ^ 32);
        const float wi = __expf(m0 - Mj) * 0.125f;
        float nq = 0.f;
#pragma unroll
        for (int st = 0; st < 4; ++st) { const f32x4 n0 = *(const f32x4*)(Cp + 4096 + st * 16 + hh * 8), n1 = *(const f32x4*)(Cp + 4096 + st * 16 + hh * 8 + 4);
            const u32x4 qw = __builtin_bit_cast(u32x4, Qf[st]);
            nq += n0.x * bflo(qw.x) + n0.y * bfhi(qw.x) + n0.z * bflo(qw.y) + n0.w * bfhi(qw.y) + n1.x * bflo(qw.z) + n1.y * bfhi(qw.z) + n1.z * bflo(qw.w) + n1.w * bfhi(qw.w); }
        nq += shfl_idx(nq, lane ^ 32);
        den += wi * nq;
        const float inv = 1.0f / fmaxf(fabsf(den), __expf(-(bj + Mj)));
#pragma unroll 1
        for (int vb = 0; vb < 2; ++vb) {
            const int v = 32 * vb + r;
            f32x16 O = ML_ZERO16;
            ml_pv<DIR>(O, S0, ZB, 0, base_row, h, v, hh);
            if (jb == 1) ml_pv<DIR>(O, S1, ZB, 1, base_row, h, v, hh);
            f32x16 I = ML_ZERO16;
#pragma unroll
            for (int st = 0; st < 4; ++st) { const float* cr = Cp + (size_t)v * 64 + st * 16 + hh * 8; const f32x4 c0 = *(const f32x4*)cr, c1 = *(const f32x4*)(cr + 4);
                const bf16x8 CA = pack8(c0.x, c0.y, c0.z, c0.w, c1.x, c1.y, c1.z, c1.w); I = MFMA32(CA, Qf[st], I); __builtin_amdgcn_sched_barrier(0); }
#pragma unroll
            for (int g = 0; g < 16; ++g) { const float hv = (O[g] + wi * I[g]) * inv; const int idx = (32 * vb + crow(g, hh)) * 65 + tok;
                if (DIR == 1) H[idx] = hv; else H[idx] += hv; }
        }
    }
}
__device__ __forceinline__ void phase_ml_out(int l) {
    const KA A = ka_fresh(); const Ctx C = ctx_fresh();
    const int gw = C.bid * 8 + C.wave, NGW = C.G * 8, lane = C.lane;
    const bf16* ZB = (const bf16*)(A.ws() + WS_ZB); bf16* MIX = (bf16*)(A.ws() + WS_MIX);
    LAS float* H = (LAS float*)(C.lds + C.wave * 16640);
    const int c_lo = (l == 1) ? 4 : 0, ncu = NCH - c_lo;
    for (int u = gw; u < 8 * ncu; u += NGW) {
        const int c = c_lo + u % ncu, bh = u / ncu, h = bh & 3, b = bh >> 2;
        const int base_row = c < 4 ? RL + b * CTXL + 64 * c : b * SEQ + 64 * (c - 4);
        ml_out_dir<1>(A, C, H, b, h, c, base_row, lane);
        LDS_WAIT(); asm volatile("" ::: "memory");
        ml_out_dir<0>(A, C, H, b, h, c, base_row, lane);
        LDS_WAIT(); asm volatile("" ::: "memory");
        float ss = 0.f;
#pragma unroll 8
        for (int v = 0; v < 64; ++v) { const float x = H[v * 65 + lane]; ss += x * x; }
        const float rs = 1.0f / sqrtf(ss * (1.f / 64.f) + EPS);
        const float gnv = A.in(18)[l * 256 + h * 64 + lane];
#pragma unroll 4
        for (int t = 0; t < 64; ++t) {
            const float rst = __builtin_bit_cast(float, __builtin_amdgcn_readlane(__builtin_bit_cast(int, rs), t));
            const size_t off = (size_t)(base_row + t) * 1024 + 768 + h * 64 + lane;
            const float o = bf2f(ZB[off]); const float sg = 1.0f / (1.0f + __expf(-o));
            MIX[off] = (bf16)f2bf(H[lane * 65 + t] * rst * gnv * sg);
        }
        LDS_WAIT(); asm volatile("" ::: "memory");
    }
}

__device__ __forceinline__ void glds16s(unsigned voff, const unsigned char* sbase, unsigned lds_dst) {
    unsigned keep;
    asm volatile("s_mov_b32 %0, m0\n\ts_mov_b32 m0, %3\n\ts_nop 0\n\tglobal_load_lds_dwordx4 %1, %2\n\ts_mov_b32 m0, %0" : "=&s"(keep) : "v"(voff), "s"(sbase), "s"(lds_dst) : "memory");
}
#define ATT_WAIT_BAR(N) asm volatile("s_waitcnt vmcnt(" #N ") lgkmcnt(0)\n\ts_barrier" ::: "memory")
constexpr int ATT_SLOT = 16384, ATT_NS = 6;
typedef int i32x8 __attribute__((ext_vector_type(8)));
#define MFMA8(a, b, c) __builtin_amdgcn_mfma_scale_f32_32x32x64_f8f6f4((a), (b), (c), 0, 0, 0, 127, 0, 127)
template <bool FIXEDREF>
__device__ __forceinline__ void attn_unit(const KA& A, const Ctx& C, int bh, int qrow0, int tile_lo, int ntiles) {
    int lane_ = C.lane; asm volatile("" : "+v"(lane_));
    const int lane = lane_, r = lane & 31, hh = lane >> 5, h = bh & 7;
    bf16* MIX = (bf16*)(A.ws() + WS_MIX);
    LAS unsigned char* lds = C.lds;
    const unsigned lds0 = (unsigned)(uintptr_t)lds;
    const int qrow = qrow0 + C.wave * 32 + r;
    const unsigned char* kg = A.ws() + WS_KN + ((size_t)bh * NKT + tile_lo) * KT_BYTES;
    const unsigned char* vg = A.ws() + WS_VT + ((size_t)bh * NKT + tile_lo) * VT_BYTES;
    const unsigned vo0 = (unsigned)(C.wave * 1024 + lane * 16);
    const unsigned d0 = lds0 + C.wave * 1024, d1 = d0 + 8192;
    int islot = 0;
#define ATT_ISSUE() do { const unsigned so_ = (unsigned)islot * ATT_SLOT; islot = (islot == ATT_NS - 1) ? 0 : islot + 1; \
        glds16s(vo0, kg, (unsigned)__builtin_amdgcn_readfirstlane(d0 + so_)); glds16s(vo0, vg, (unsigned)__builtin_amdgcn_readfirstlane(d1 + so_)); \
        kg += KT_BYTES; vg += VT_BYTES; } while (0)
    ATT_ISSUE(); ATT_ISSUE(); ATT_ISSUE();
    i32x8 qf[2];
    { const unsigned char* q8 = A.ws() + WS_Q8 + (size_t)qrow * 1024 + h * 128 + hh * 32;
#pragma unroll
      for (int st = 0; st < 2; ++st) { const u32x4 a = *(const u32x4*)(q8 + st * 64), b = *(const u32x4*)(q8 + st * 64 + 16);
          qf[st] = (i32x8){(int)a.x, (int)a.y, (int)a.z, (int)a.w, (int)b.x, (int)b.y, (int)b.z, (int)b.w}; } }
    f32x16 o0 = (f32x16){0.f, 0.f, 0.f, 0.f, 0.f, 0.f, 0.f, 0.f, 0.f, 0.f, 0.f, 0.f, 0.f, 0.f, 0.f, 0.f}, o1 = o0;
    float m = 0.f, lsum = 0.f;
    constexpr float THR = 8.f;
    const int ksw = (r >> 1) & 7;
    int cslot = 0, nslot = 1;
#define ATT_ADV() do { cslot = nslot; nslot = (nslot == ATT_NS - 1) ? 0 : nslot + 1; } while (0)
#define ATT_QKT(P0, P1, sl) do { const LAS unsigned char* Kb_ = lds + (sl) * ATT_SLOT + r * 128; P0 = ML_ZERO16; P1 = ML_ZERO16; \
        _Pragma("unroll") for (int st = 0; st < 2; ++st) { \
            const u32x4 a_ = *(const LAS u32x4*)(Kb_ + (((st * 4 + hh * 2) ^ ksw) << 4)), b_ = *(const LAS u32x4*)(Kb_ + (((st * 4 + hh * 2 + 1) ^ ksw) << 4)); \
            const u32x4 c_ = *(const LAS u32x4*)(Kb_ + 4096 + (((st * 4 + hh * 2) ^ ksw) << 4)), d_ = *(const LAS u32x4*)(Kb_ + 4096 + (((st * 4 + hh * 2 + 1) ^ ksw) << 4)); \
            P0 = MFMA8(((i32x8){(int)a_.x, (int)a_.y, (int)a_.z, (int)a_.w, (int)b_.x, (int)b_.y, (int)b_.z, (int)b_.w}), qf[st], P0); \
            P1 = MFMA8(((i32x8){(int)c_.x, (int)c_.y, (int)c_.z, (int)c_.w, (int)d_.x, (int)d_.y, (int)d_.z, (int)d_.w}), qf[st], P1); } } while (0)
#define ATT_H1(C0, C1, N0, N1, tt) do { \
        const bool more_ = (tt) + 1 < ntiles; \
        if ((tt) + 3 < ntiles) ATT_ISSUE(); \
        if (more_) ATT_QKT(N0, N1, nslot); \
        if (!FIXEDREF) { \
        float ta_ = __builtin_fmaxf(__builtin_fmaxf(C0[0], C0[1]), C0[2]), tb_ = __builtin_fmaxf(__builtin_fmaxf(C0[3], C0[4]), C0[5]), tc_ = __builtin_fmaxf(__builtin_fmaxf(C1[0], C1[1]), C1[2]), td_ = __builtin_fmaxf(__builtin_fmaxf(C1[3], C1[4]), C1[5]);     \
        _Pragma("unroll") for (int g = 6; g < 16; g += 2) { ta_ = __builtin_fmaxf(__builtin_fmaxf(ta_, C0[g]), C0[g + 1]); tc_ = __builtin_fmaxf(__builtin_fmaxf(tc_, C1[g]), C1[g + 1]); } \
        float tm_ = __builtin_fmaxf(__builtin_fmaxf(ta_, tb_), __builtin_fmaxf(tc_, td_)); \
        { const auto rr_ = __builtin_amdgcn_permlane32_swap(__builtin_bit_cast(unsigned, tm_), __builtin_bit_cast(unsigned, tm_), false, false);     \
          tm_ = __builtin_fmaxf(__builtin_bit_cast(float, rr_[0]), __builtin_bit_cast(float, rr_[1])); } \
        if ((tt) == 0) m = tm_;                             \
        else if (__any(tm_ - m > THR)) {                    \
            const float mn_ = __builtin_fmaxf(tm_, m), alpha_ = __builtin_amdgcn_exp2f(m - mn_); m = mn_; lsum *= alpha_; \
            _Pragma("unroll") for (int g = 0; g < 16; ++g) { o0[g] *= alpha_; o1[g] *= alpha_; } \
        } } } while (0)
#define ATT_H2(C0, C1, sl) do { \
        if (!FIXEDREF) { _Pragma("unroll") for (int g = 0; g < 16; ++g) { C0[g] -= m; C1[g] -= m; } } \
        float pa_ = 0.f, pb2_ = 0.f, pc_ = 0.f, pd_ = 0.f;                                      \
        _Pragma("unroll") for (int g = 0; g < 16; g += 2) { C0[g] = __builtin_amdgcn_exp2f(C0[g]); C0[g + 1] = __builtin_amdgcn_exp2f(C0[g + 1]); C1[g] = __builtin_amdgcn_exp2f(C1[g]); C1[g + 1] = __builtin_amdgcn_exp2f(C1[g + 1]); \
            pa_ += C0[g]; pb2_ += C0[g + 1]; pc_ += C1[g]; pd_ += C1[g + 1]; } \
        lsum += (pa_ + pb2_) + (pc_ + pd_); \
        bf16x8 pb_[2][2]; \
        pb_[0][0] = pack8(C0[0], C0[1], C0[2], C0[3], C0[4], C0[5], C0[6], C0[7]); pb_[0][1] = pack8(C0[8], C0[9], C0[10], C0[11], C0[12], C0[13], C0[14], C0[15]); \
        pb_[1][0] = pack8(C1[0], C1[1], C1[2], C1[3], C1[4], C1[5], C1[6], C1[7]); pb_[1][1] = pack8(C1[8], C1[9], C1[10], C1[11], C1[12], C1[13], C1[14], C1[15]); \
        const LAS unsigned char* Vb_ = lds + (sl) * ATT_SLOT + KT_BYTES; \
        { const int sw_ = (r >> 1) & 7; const LAS unsigned char* vrow_ = Vb_ + r * 128;        \
            _Pragma("unroll") for (int kb = 0; kb < 2; ++kb) _Pragma("unroll") for (int s2 = 0; s2 < 2; ++s2) { \
                const bf16x8 va_ = *(const LAS bf16x8*)(vrow_ + (((kb * 4 + s2 * 2 + hh) ^ sw_) << 4)), vb_ = *(const LAS bf16x8*)(vrow_ + 4096 + (((kb * 4 + s2 * 2 + hh) ^ sw_) << 4)); \
                o0 = MFMA32(va_, pb_[kb][s2], o0); o1 = MFMA32(vb_, pb_[kb][s2], o1); } } \
    } while (0)
#define ATT_SYNC(tt) do { if ((tt) + 2 < ntiles) ATT_WAIT_BAR(2); else ATT_WAIT_BAR(0); } while (0)
    f32x16 sA0, sA1, sB0, sB1;
    ATT_WAIT_BAR(4);
    ATT_QKT(sA0, sA1, 0);
    if (C.wave < 4) {
#pragma unroll 1
        for (int t = 0; t < ntiles; t += 2) {
            if (t + 1 < ntiles) ATT_SYNC(t);
            ATT_H1(sA0, sA1, sB0, sB1, t); ATT_H2(sA0, sA1, cslot); ATT_ADV();
            if (t + 2 < ntiles) ATT_SYNC(t + 1);
            ATT_H1(sB0, sB1, sA0, sA1, t + 1); ATT_H2(sB0, sB1, cslot); ATT_ADV();
        }
    } else {
        ATT_SYNC(0);
        ATT_H1(sA0, sA1, sB0, sB1, 0);
#pragma unroll 1
        for (int t = 1; t + 1 < ntiles; t += 2) {
            ATT_SYNC(t);
            ATT_H2(sA0, sA1, cslot); ATT_ADV(); ATT_H1(sB0, sB1, sA0, sA1, t);
            ATT_SYNC(t + 1);
            ATT_H2(sB0, sB1, cslot); ATT_ADV(); ATT_H1(sA0, sA1, sB0, sB1, t + 1);
        }
        ATT_H2(sA0, sA1, cslot); ATT_ADV(); ATT_H1(sB0, sB1, sA0, sA1, ntiles - 1);
        ATT_H2(sB0, sB1, cslot); ATT_ADV();
    }
#undef ATT_QKT
#undef ATT_H1
#undef ATT_H2
#undef ATT_SYNC
#undef ATT_ADV
    asm volatile("s_waitcnt lgkmcnt(0)\n\ts_barrier" ::: "memory");
#undef ATT_ISSUE
    lsum += shfl_idx(lsum, lane ^ 32);
    const float inv = 1.0f / lsum;
    { LAS bf16* stg = (LAS bf16*)(lds + ATT_NS * ATT_SLOT + C.wave * 4352);
#pragma unroll
      for (int g = 0; g < 16; ++g) { const int d = crow(g, hh); stg[r * 68 + d] = (bf16)f2bf(o0[g] * inv); stg[r * 68 + 32 + d] = (bf16)f2bf(o1[g] * inv); }
      LDS_WAIT(); asm volatile("" ::: "memory");
      bf16* ob = MIX + (size_t)(qrow0 + C.wave * 32) * 1024 + 256 + h * 64;
#pragma unroll
      for (int i = 0; i < 4; ++i) { const int row = i * 8 + (lane >> 3), ch = lane & 7;
          const u32x2 a = *(const LAS u32x2*)(stg + row * 68 + ch * 8), b = *(const LAS u32x2*)(stg + row * 68 + ch * 8 + 4);
          u32x4 v; v.x = a.x; v.y = a.y; v.z = b.x; v.w = b.y; *(u32x4*)(ob + (size_t)row * 1024 + ch * 8) = v; }
      LDS_WAIT(); asm volatile("" ::: "memory"); }
}
__device__ __forceinline__ void phase_attn(int l) {
    const KA A = ka_fresh(); const Ctx C = ctx_fresh();
    const int G = C.G;
    bool fixedref;
    { const int lane = C.lane; const float* qg = A.in(15) + l * 96; const float* kg = A.in(16) + l * 96;
      const float gq = wave_max(fmaxf(fabsf(qg[lane]), lane < 32 ? fabsf(qg[64 + lane]) : 0.f), lane), gk = wave_max(fmaxf(fabsf(kg[lane]), lane < 32 ? fabsf(kg[64 + lane]) : 0.f), lane);
      fixedref = (96.f * QSCALE * gq * gk) < 100.f; }
    for (int u = C.bid; u < 1024 + (l == 1 ? 0 : 16); u += G) {
        if (u < 1024) {
            int pair, qb;
            if (G == 256) { const int vcu = u & 255, rnd = u >> 8; pair = 2 * (vcu & 7) + (rnd >> 1); qb = (vcu >> 3) + 32 * (rnd & 1); }
            else { pair = u >> 6; qb = u & 63; }
            if (fixedref) attn_unit<true>(A, C, pair, (pair >> 3) * SEQ + qb * 256, 0, NKT); else attn_unit<false>(A, C, pair, (pair >> 3) * SEQ + qb * 256, 0, NKT);
        } else { const int pair = u - 1024;
            if (fixedref) attn_unit<true>(A, C, pair, RL + (pair >> 3) * CTXL, NKT - 4, 4); else attn_unit<false>(A, C, pair, RL + (pair >> 3) * CTXL, NKT - 4, 4); }
    }
}

__device__ __forceinline__ int f2key(float f) { const int b = __builtin_bit_cast(int, f); return b ^ ((b >> 31) & 0x7fffffff); }
__device__ __forceinline__ float key2f(int k) { return __builtin_bit_cast(float, k ^ ((k >> 31) & 0x7fffffff)); }
__device__ __forceinline__ void topk_ins(int (&lst)[16], int v) {
#pragma unroll
    for (int i = 0; i < 16; ++i) { const int hi = max(lst[i], v); v = min(lst[i], v); lst[i] = hi; }
}
__device__ __forceinline__ void bitonic_sort16_desc(int (&a)[16]) {
#pragma unroll
    for (int k = 2; k <= 16; k <<= 1)
#pragma unroll
        for (int j = k >> 1; j > 0; j >>= 1)
#pragma unroll
            for (int i = 0; i < 16; ++i) { const int p = i ^ j;
                if (p > i) { const int hi = max(a[i], a[p]), lo = min(a[i], a[p]); const bool desc = ((i & k) == 0) || (k == 16); a[i] = desc ? hi : lo; a[p] = desc ? lo : hi; } }
}
__device__ __forceinline__ void merge16_desc(int (&lst)[16], const int (&nw)[16]) {
#pragma unroll
    for (int i = 0; i < 16; ++i) lst[i] = max(lst[i], nw[15 - i]);
#pragma unroll
    for (int j = 8; j > 0; j >>= 1)
#pragma unroll
        for (int i = 0; i < 16; ++i) { const int p = i ^ j; if (p > i) { const int hi = max(lst[i], lst[p]), lo = min(lst[i], lst[p]); lst[i] = hi; lst[p] = lo; } }
}
__device__ __forceinline__ void topk_half(int (&lst)[16], const bf16* qp, const bf16* skp, int hh, int lane) {
    bf16x8 bq[8];
#pragma unroll
    for (int st = 0; st < 8; ++st) bq[st] = *(const bf16x8*)(qp + st * 16);
#pragma unroll
    for (int i = 0; i < 16; ++i) lst[i] = f2key(-3.0e38f);
    bf16x8 an[8];
#pragma unroll
    for (int st = 0; st < 8; ++st) an[st] = *(const bf16x8*)(skp + st * 16);
#pragma unroll 1
    for (int blk = 0; blk < 4; ++blk) {
        f32x16 acc = (f32x16){0.f, 0.f, 0.f, 0.f, 0.f, 0.f, 0.f, 0.f, 0.f, 0.f, 0.f, 0.f, 0.f, 0.f, 0.f, 0.f};
#pragma unroll
        for (int st = 0; st < 8; ++st) acc = MFMA32(an[st], bq[st], acc);
        if (blk < 3) {
#pragma unroll
            for (int st = 0; st < 8; ++st) an[st] = *(const bf16x8*)(skp + (blk + 1) * 32 * 128 + st * 16); }
        int nk[16];
#pragma unroll
        for (int g = 0; g < 16; ++g) { const unsigned n = (unsigned)(blk * 32 + crow(g, hh));
            const float sv = acc[g];
            nk[g] = f2key(__builtin_bit_cast(float, (__builtin_bit_cast(unsigned, sv) & ~127u) | n)); }
        bitonic_sort16_desc(nk);
        merge16_desc(lst, nk);
    }
    int oth[16];
#pragma unroll
    for (int i = 0; i < 16; ++i) oth[i] = shfl_idx(lst[i], lane ^ 32);
    merge16_desc(lst, oth);
}
__device__ __forceinline__ void phase_topk(int l) {
    const KA A = ka_fresh(); const Ctx C = ctx_fresh();
    const int gw = C.bid * 8 + C.wave, NGW = C.G * 8, lane = C.lane, r = lane & 31, hh = lane >> 5;
    const bf16* PQ = (const bf16*)(A.ws() + WS_PQ); const bf16* SK = (const bf16*)(A.ws() + WS_SUBK);
    int* EID = (int*)(A.ws() + WS_EID); float* GATE = (float*)(A.ws() + WS_GATE);
    const int nrows = (l == 1) ? RL : RT;
    for (int unit = gw; unit < (nrows / 32) * 8; unit += NGW) {
        const int h = unit & 7, r0 = (unit >> 3) * 32; const size_t row = (size_t)(r0 + r);
        int L[2][16];
        topk_half(L[0], PQ + row * 2048 + h * 256 + hh * 8, SK + ((size_t)((l * 8 + h) * 2 + 0) * 128 + r) * 128 + hh * 8, hh, lane);
        __builtin_amdgcn_sched_barrier(0);
        topk_half(L[1], PQ + row * 2048 + h * 256 + 128 + hh * 8, SK + ((size_t)((l * 8 + h) * 2 + 1) * 128 + r) * 128 + hh * 8, hh, lane);
        __builtin_amdgcn_sched_barrier(0);
        int best[16];
#pragma unroll
        for (int j = 0; j < 16; ++j) best[j] = f2key(__builtin_bit_cast(float, (__builtin_bit_cast(unsigned, key2f(L[0][0]) + key2f(L[1][j])) & ~255u) | (unsigned)j));
#pragma unroll
        for (int i = 1; i < 16; ++i)
#pragma unroll
            for (int j = 0; j < 16; ++j)
                if ((i + 1) * (j + 1) <= 16) topk_ins(best, f2key(__builtin_bit_cast(float, (__builtin_bit_cast(unsigned, key2f(L[0][i]) + key2f(L[1][j])) & ~255u) | (unsigned)(i * 16 + j))));
        float ev[16]; float esum = 0.f;
        const float mx = __builtin_bit_cast(float, __builtin_bit_cast(unsigned, key2f(best[0])) & ~255u);
#pragma unroll
        for (int k = 0; k < 16; ++k) { ev[k] = __expf(__builtin_bit_cast(float, __builtin_bit_cast(unsigned, key2f(best[k])) & ~255u) - mx); esum += ev[k]; }
        const float einv = 1.0f / esum;
#pragma unroll
        for (int k = 0; k < 8; ++k) {
            const int b_lo = best[k], b_hi = best[k + 8]; const float e_lo = ev[k], e_hi = ev[k + 8];
            const int bk = hh ? b_hi : b_lo; const float gk = (hh ? e_hi : e_lo) * einv;
            const unsigned code = __builtin_bit_cast(unsigned, key2f(bk)) & 255u;
            const unsigned ci = code >> 4, cj = code & 15u; unsigned n0 = 0u, n1 = 0u;
#pragma unroll
            for (int i = 0; i < 16; ++i) { n0 = (ci == (unsigned)i) ? (__builtin_bit_cast(unsigned, key2f(L[0][i])) & 127u) : n0; n1 = (cj == (unsigned)i) ? (__builtin_bit_cast(unsigned, key2f(L[1][i])) & 127u) : n1; }
            EID[row * 128 + h * 16 + hh * 8 + k] = (int)(n0 * 128u + n1); GATE[row * 128 + h * 16 + hh * 8 + k] = gk;
        }
    }
}
typedef float f32x2v __attribute__((ext_vector_type(2)));
typedef unsigned u32x6 __attribute__((ext_vector_type(6)));
typedef float f32x32 __attribute__((ext_vector_type(32)));
#ifndef FFN_B
#define FFN_B 8
#endif
__device__ __forceinline__ void phase_ffn(int l) {
    const KA A = ka_fresh(); const Ctx C = ctx_fresh();
    const int gw = C.bid * 8 + C.wave, NGW = C.G * 8, lane = C.lane;
    const bf16* XN = (const bf16*)(A.ws() + WS_XN); const unsigned char* TU = A.ws() + WS_TABU; const unsigned char* TV = A.ws() + WS_TABV;
    const int* EID = (const int*)(A.ws() + WS_EID); const float* GATE = (const float*)(A.ws() + WS_GATE);
    const float* MOD = (const float*)(A.ws() + WS_MOD);
    const int nrows = (l == 1) ? RL : RT;
    for (int row = gw; row < nrows; row += NGW) {
        f32x2_t hv[8];
        { const u32x4 a = *(const u32x4*)(XN + (size_t)row * DM + lane * 16), b = *(const u32x4*)(XN + (size_t)row * DM + lane * 16 + 8);
          hv[0] = (f32x2_t){bflo(a.x), bfhi(a.x)}; hv[1] = (f32x2_t){bflo(a.y), bfhi(a.y)}; hv[2] = (f32x2_t){bflo(a.z), bfhi(a.z)}; hv[3] = (f32x2_t){bflo(a.w), bfhi(a.w)};
          hv[4] = (f32x2_t){bflo(b.x), bfhi(b.x)}; hv[5] = (f32x2_t){bflo(b.y), bfhi(b.y)}; hv[6] = (f32x2_t){bflo(b.z), bfhi(b.z)}; hv[7] = (f32x2_t){bflo(b.w), bfhi(b.w)}; }
        f32x2_t out[8];
#pragma unroll
        for (int i = 0; i < 8; ++i) out[i] = (f32x2_t){0.f, 0.f};
        const int idA = EID[(size_t)row * 128 + lane], idB = EID[(size_t)row * 128 + 64 + lane]; const float gtA = GATE[(size_t)row * 128 + lane], gtB = GATE[(size_t)row * 128 + 64 + lane];
        int ln = lane; asm volatile("" : "+v"(ln));
        const bool b0 = ln & 1, b1 = ln & 2; const int q4 = ln >> 2, x16 = ln ^ 16, x32 = ln ^ 32;
        float dA = 0.f, dB = 0.f;
#define FFN_LOADU(UU, ID, e0) do { _Pragma("unroll") for (int k = 0; k < FFN_B; ++k) { const int id_ = __builtin_amdgcn_readlane(ID, (e0) + k); UU[k] = *(const U3*)(TU + (size_t)id_ * TROW + lane * 12); } } while (0)
#define FFN_DOT4(UU, DV, e0) do { _Pragma("unroll") for (int g4 = 0; g4 < FFN_B; g4 += 4) { float p_[4]; \
            _Pragma("unroll") for (int k = 0; k < 4; k += 2) { \
                const u32x6 us_ = {UU[g4 + k].a, UU[g4 + k].b, UU[g4 + k].c, UU[g4 + k + 1].a, UU[g4 + k + 1].b, UU[g4 + k + 1].c}; \
                const f32x32 uf_ = __builtin_amdgcn_cvt_scalef32_pk32_f32_fp6(us_, 1.0f);        \
                f32x2_t d0_ = {0.f, 0.f}, d1_ = {0.f, 0.f}; \
                _Pragma("unroll") for (int i = 0; i < 8; ++i) { d0_ = hv[i] * (f32x2_t){uf_[2 * i], uf_[2 * i + 1]} + d0_; d1_ = hv[i] * (f32x2_t){uf_[16 + 2 * i], uf_[17 + 2 * i]} + d1_; } \
                p_[k] = d0_.x + d0_.y; p_[k + 1] = d1_.x + d1_.y; } \
            float x01_ = b0 ? p_[1] : p_[0], y01_ = b0 ? p_[0] : p_[1], x23_ = b0 ? p_[3] : p_[2], y23_ = b0 ? p_[2] : p_[3]; \
            x01_ += __builtin_bit_cast(float, __builtin_amdgcn_update_dpp(0, __builtin_bit_cast(int, y01_), 0xB1, 0xf, 0xf, true)); \
            x23_ += __builtin_bit_cast(float, __builtin_amdgcn_update_dpp(0, __builtin_bit_cast(int, y23_), 0xB1, 0xf, 0xf, true)); \
            float x_ = b1 ? x23_ : x01_; const float y_ = b1 ? x01_ : x23_; \
            x_ += __builtin_bit_cast(float, __builtin_amdgcn_update_dpp(0, __builtin_bit_cast(int, y_), 0x4E, 0xf, 0xf, true)); \
            DPP_ADD(x_, 0x124); DPP_ADD(x_, 0x128);                  \
            x_ += shfl_idx(x_, x16); x_ += shfl_idx(x_, x32);       \
            DV = (q4 == (((e0) + g4) >> 2)) ? x_ : DV; } } while (0)
        { U3 ua[FFN_B], ub[FFN_B];
          FFN_LOADU(ua, idA, 0);
#pragma unroll 1
          for (int e = 0; e < 64; e += 2 * FFN_B) { FFN_LOADU(ub, idA, e + FFN_B); FFN_DOT4(ua, dA, e); if (e + 2 * FFN_B < 64) FFN_LOADU(ua, idA, e + 2 * FFN_B); else FFN_LOADU(ua, idB, 0); FFN_DOT4(ub, dA, e + FFN_B); }
#pragma unroll 1
          for (int e = 0; e < 64; e += 2 * FFN_B) { FFN_LOADU(ub, idB, e + FFN_B); FFN_DOT4(ua, dB, e); if (e + 2 * FFN_B < 64) FFN_LOADU(ua, idB, e + 2 * FFN_B); FFN_DOT4(ub, dB, e + FFN_B); } }
#undef FFN_LOADU
#undef FFN_DOT4
        const float wA = gtA * gelu_f(dA * (1.0f / U_SCALE)) * (1.0f / V_SCALE), wB = gtB * gelu_f(dB * (1.0f / U_SCALE)) * (1.0f / V_SCALE);
#define FFN_LOADV(VV, ID, e0) do { _Pragma("unroll") for (int k = 0; k < FFN_B; ++k) { const int id_ = __builtin_amdgcn_readlane(ID, (e0) + k); VV[k] = *(const U3*)(TV + (size_t)id_ * TROW + lane * 12); } } while (0)
#define FFN_ACC4(VV, WV, e0) do { _Pragma("unroll") for (int k = 0; k < FFN_B; k += 2) { \
            const float w0_ = __builtin_bit_cast(float, __builtin_amdgcn_readlane(__builtin_bit_cast(int, WV), (e0) + k)), w1_ = __builtin_bit_cast(float, __builtin_amdgcn_readlane(__builtin_bit_cast(int, WV), (e0) + k + 1)); \
            const u32x6 vs_ = {VV[k].a, VV[k].b, VV[k].c, VV[k + 1].a, VV[k + 1].b, VV[k + 1].c}; \
            const f32x32 vf_ = __builtin_amdgcn_cvt_scalef32_pk32_f32_fp6(vs_, 1.0f); \
            const f32x2_t w0p_ = {w0_, w0_}, w1p_ = {w1_, w1_}; \
            _Pragma("unroll") for (int i = 0; i < 8; ++i) { out[i] = w0p_ * (f32x2_t){vf_[2 * i], vf_[2 * i + 1]} + out[i]; out[i] = w1p_ * (f32x2_t){vf_[16 + 2 * i], vf_[17 + 2 * i]} + out[i]; } } } while (0)
        { U3 va[FFN_B], vb[FFN_B];
          FFN_LOADV(va, idA, 0);
#pragma unroll 1
          for (int e = 0; e < 64; e += 2 * FFN_B) { FFN_LOADV(vb, idA, e + FFN_B); FFN_ACC4(va, wA, e); if (e + 2 * FFN_B < 64) FFN_LOADV(va, idA, e + 2 * FFN_B); else FFN_LOADV(va, idB, 0); FFN_ACC4(vb, wA, e + FFN_B); }
#pragma unroll 1
          for (int e = 0; e < 64; e += 2 * FFN_B) { FFN_LOADV(vb, idB, e + FFN_B); FFN_ACC4(va, wB, e); if (e + 2 * FFN_B < 64) FFN_LOADV(va, idB, e + 2 * FFN_B); FFN_ACC4(vb, wB, e + FFN_B); } }
#undef FFN_LOADV
#undef FFN_ACC4
        const int nsel = row < RL ? (row >> 14) : 2;
        const float* gf = MOD + (l * 3 + nsel) * 6144 + 5 * 1024;
        float* xr = stream_out(A, C, row);
#pragma unroll
        for (int q = 0; q < 4; ++q) { const int j = lane * 16 + q * 4;
            const f32x4 x = *(const f32x4*)(xr + j); f32x4 g = *(const f32x4*)(gf + j);
            f32x4 o; o.x = x.x + g.x * out[q * 2].x; o.y = x.y + g.y * out[q * 2].y; o.z = x.z + g.z * out[q * 2 + 1].x; o.w = x.w + g.w * out[q * 2 + 1].y;
            *(f32x4*)(xr + j) = o; }
    }
}

template <class Epi>
__device__ __forceinline__ void run_gemm(const pg8::bf16_t* Amat, const pg8::bf16_t* Bt, int N, int K, const Epi& E, int M = RT) {
    const Ctx C = ctx_fresh();
    pg8::Gemm g{Amat, Bt, M, N, K}; pg8::StaticOrder S; S.init(M, N, C.G, C.bid);
    pg8::gemm_phase<Epi, pg8::StaticOrder, true, true>(C.lds, g, S, E);
}
__device__ __forceinline__ void seam() {
    const KA A = ka_fresh(); const Ctx C = ctx_fresh();
    XcdBarrier b; b.bar = (unsigned*)(A.ws() + WS_CTL) + CW_BAR; b.x = xb_xcc_id(); b.st = (volatile LAS unsigned*)(C.lds + MISC_OFF) + 8;
    xcd_barrier(b);
}
#define IN(k) (lo <= (k) && (k) < hi)
#define SEAM(k) do { if (IN(k) && IN((k) + 1)) seam(); } while (0)
template <int l>
__device__ __forceinline__ void layer_body(const int lo, const int hi) {
        const int p0 = 1 + NPH_L * l;
        if (IN(p0 + 0)) { phase_norm(l, 0); phase_tables(l); }
        SEAM(p0 + 0);
        if (IN(p0 + 1)) {
            const KA A = ka_fresh(); unsigned char* ws = A.ws();
            pg8::EpiBf16<0> E{(pg8::bf16_t*)(ws + WS_ZA), 1024, nullptr, 1024, (size_t)(WS_ZB - WS_ZA) / 2, 1.f};
            run_gemm(( const pg8::bf16_t*)(ws + WS_XN), (const pg8::bf16_t*)(ws + WS_WIN) + (size_t)l * 2048 * DM, 2048, DM, E);
        }
        SEAM(p0 + 1);
        if (IN(p0 + 2)) phase_post(l);
        SEAM(p0 + 2);
        if (IN(p0 + 3)) {
#pragma unroll 1
            for (int gi = 0; gi < 2; ++gi) {
                const KA A = ka_fresh(); unsigned char* ws = A.ws();
                const int N = gi ? 1024 : 768, K = gi ? 256 : 384;
                pg8::EpiBf16<0> E{(pg8::bf16_t*)(ws + (gi ? WS_KVRAW : WS_Q)), N, nullptr, 0, 0, 1.f};
                run_gemm((const pg8::bf16_t*)(ws + (gi ? WS_KVA : WS_QA)), (const pg8::bf16_t*)(ws + (gi ? WS_WUKV : WS_WUQ)) + (size_t)l * N * K, N, K, E);
            }
        }
        SEAM(p0 + 3);
        if (IN(p0 + 4)) phase_qknorm(l);
        SEAM(p0 + 4);
        if (IN(p0 + 5)) phase_ml_local();
        SEAM(p0 + 5);
        if (IN(p0 + 6)) phase_ml_scan();
        SEAM(p0 + 6);
        if (IN(p0 + 7)) {
            phase_ml_out(l);
            __syncthreads();
            phase_attn(l);
        }
        SEAM(p0 + 7);
        if (IN(p0 + 8)) {
            const KA A = ka_fresh(); unsigned char* ws = A.ws();
            pg8::EpiResGate E{l == 0 ? A.in(0) : (const float*)A.out(), l == 0 ? A.in(2) : (const float*)(ws + WS_CTXS), A.out(), (float*)(ws + WS_CTXS), (const float*)(ws + WS_MOD) + (size_t)l * 3 * 6144, 2 * 1024};
            run_gemm((const pg8::bf16_t*)(ws + WS_MIX), (const pg8::bf16_t*)(ws + WS_WOUT) + (size_t)l * DM * DM, DM, DM, E, l == 1 ? RL : RT);
        }
        SEAM(p0 + 8);
        if (IN(p0 + 9)) phase_norm(l, 1);
        SEAM(p0 + 9);

        if (IN(p0 + 10)) {
            const KA A = ka_fresh(); unsigned char* ws = A.ws();
            pg8::EpiBf16<0> E{(pg8::bf16_t*)(ws + WS_PQ), 2048, nullptr, 0, 0, 1.f};
            run_gemm((const pg8::bf16_t*)(ws + WS_XN), (const pg8::bf16_t*)(ws + WS_WPQ) + (size_t)l * 2048 * DM, 2048, DM, E, l == 1 ? RL : RT);
        }
        SEAM(p0 + 10);
                if (IN(p0 + 11)) phase_topk(l);
        SEAM(p0 + 11);
        if (IN(p0 + 12)) phase_ffn(l);
        if (l == 0) SEAM(p0 + 12);
    }
__global__ void __launch_bounds__(512, 2) mk_fwd(Args unused_args) {
    { const KA A = ka_fresh(); const Ctx C = ctx_fresh();
      volatile LAS unsigned* MISC = (volatile LAS unsigned*)(C.lds + MISC_OFF);
      if (C.tid < 64) MISC[C.tid] = 0u;
      __syncthreads();
      (void)xcd_barrier_post((unsigned*)(A.ws() + WS_CTL) + CW_BAR, MISC + 8); }
    int lo, hi;
    { const KA A = ka_fresh(); lo = A.ph_lo(); hi = A.ph_hi(); }
    if (IN(0)) phase_prologue();
    if (IN(0)) { if (lo == 0 && hi == NPHASES) seam(); }
    if (IN(0) && lo == 0 && hi == NPHASES) phase_modreduce();
    SEAM(0);
    layer_body<0>(lo, hi);
    layer_body<1>(lo, hi);
#undef IN
#undef SEAM
}

extern "C" void kernel_launch(void* const* d_in, const int* in_sizes, int n_in, void* d_out, int out_size, void* d_ws, size_t ws_size, hipStream_t stream) {
    static int grid = 0;
    if (grid == 0) {
        if (n_in != 24 || out_size != RL * DM || ws_size < WS_END) { fprintf(stderr, "kernel_launch: unexpected shapes (n_in %d, out %d, ws %zu)\n", n_in, out_size, ws_size); grid = -1; return; }
        int dev = 0, cus = 0, per_cu = 0;
        if (hipGetDevice(&dev) != hipSuccess || hipDeviceGetAttribute(&cus, hipDeviceAttributeMultiprocessorCount, dev) != hipSuccess) { grid = -1; return; }
        if (hipFuncSetAttribute((const void*)mk_fwd, hipFuncAttributeMaxDynamicSharedMemorySize, LDS_BYTES) != hipSuccess) { fprintf(stderr, "kernel_launch: hipFuncSetAttribute failed\n"); grid = -1; return; }
        if (hipOccupancyMaxActiveBlocksPerMultiprocessor(&per_cu, (const void*)mk_fwd, 512, LDS_BYTES) != hipSuccess || per_cu < 1) { fprintf(stderr, "kernel_launch: occupancy query says %d\n", per_cu); per_cu = 1; }
        (void)hipGetLastError();
        grid = cus;
    }
    if (grid < 0) return;
    (void)hipMemsetAsync((char*)d_ws + WS_CTL, 0, CTL_ZERO_BYTES, stream);
    Args a{};
    for (int i = 0; i < 24; ++i) a.in[i] = (const float*)d_in[i];
    a.out = (float*)d_out; a.ws = (unsigned char*)d_ws;
    a.ph_lo = 0; a.ph_hi = NPHASES;
    hipLaunchKernelGGL(mk_fwd, dim3(grid), dim3(512), LDS_BYTES, stream, a);
}
```

```cpp
#include <hip/hip_runtime.h>
#include <cstdio>
#include <cstdint>

namespace pg8 {
#define PG8_LAS __attribute__((address_space(3)))
typedef unsigned short bf16_t;
typedef short bf16x8 __attribute__((ext_vector_type(8)));
typedef float f32x4 __attribute__((ext_vector_type(4)));
typedef unsigned u32x4 __attribute__((ext_vector_type(4)));
constexpr int BM = 256, BK = 64, HALF = 128, HTB = HALF * BK * 2  , STAGE_BYTES = 8 * HTB, NXCD = 8, WGM = 8;

__host__ __device__ __forceinline__ int lds_byte(int r, int c) { const int st = (r >> 4) * 2 + (c >> 5), rr = r & 15, cc = c & 31, ob = rr * 64 + cc * 2; return st * 1024 + (ob ^ (((ob >> 9) & 1) << 5)); }
__host__ __device__ __forceinline__ void stage_rc(int b, int& R, int& C) { const int st = b / 1024, sb = b % 1024, swz = sb ^ (((sb >> 9) & 1) << 5); R = (st >> 1) * 16 + swz / 64; C = (st & 1) * 32 + (swz % 64) / 2; }
__host__ __device__ __forceinline__ int perm32(int rho) { const int n = rho >> 4, i = rho & 15; return 8 * (i >> 2) + 4 * n + (i & 3); }

struct Unit { int pm, pn; };
struct Gemm { const bf16_t* A; const bf16_t* Bt; int M, N, K; };

struct StaticOrder {
    int nM, nN, nwg, G, c;
    __host__ __device__ void init(int M, int N, int G_, int c_) { nM = M / BM; nN = N / BM; nwg = nM * nN; G = G_; c = c_; }
    __host__ __device__ bool next(int i, Unit& u) const {
        const long L = (long)i * G + c; if (L >= nwg) return false;
        int wgid = (int)L; { const int q = nwg / NXCD, r = nwg % NXCD, xcd = wgid % NXCD, off = wgid / NXCD; wgid = (xcd < r ? xcd * (q + 1) : r * (q + 1) + (xcd - r) * q) + off; }
        const int nig = WGM * nN, gid = wgid / nig, fm = gid * WGM, gsz = (nM - fm) < WGM ? (nM - fm) : WGM;
        u.pm = fm + ((wgid % nig) % gsz); u.pn = (wgid % nig) / gsz; return true;
    }
    __device__ __forceinline__ void a_ready(const Unit&) const {}
    __device__ __forceinline__ void done(const Unit&) const {}
};

__device__ __forceinline__ unsigned cvt_pk_bf16(float lo, float hi) { unsigned r; asm volatile("v_cvt_pk_bf16_f32 %0, %1, %2" : "=v"(r) : "v"(lo), "v"(hi)); return r; }
typedef float f32x2 __attribute__((ext_vector_type(2)));
__device__ __forceinline__ f32x2 gelu_pk(f32x2 v) {
    const f32x2 av = __builtin_elementwise_abs(v), d = av * 0.2316418882f + 1.0f;
    f32x2 t; t.x = __builtin_amdgcn_rcpf(d.x); t.y = __builtin_amdgcn_rcpf(d.y);
    f32x2 q = t * 0.5307027145f + (-0.7265760135f); q = q * t + 0.7107068705f; q = q * t + (-0.142248368f); q = q * t + 0.127414796f; q = q * t;
    const f32x2 s = (v * v) * (-0.72134752044f);
    f32x2 e; e.x = __builtin_amdgcn_exp2f(s.x); e.y = __builtin_amdgcn_exp2f(s.y);
    const f32x2 m = v * (q * e), r = v - m;
    f32x2 o; o.x = v.x < 0.f ? m.x : r.x; o.y = v.y < 0.f ? m.y : r.y; return o;
}

template <int ACT  > struct EpiBf16 {
    static constexpr bool PERM = true, AFTER_DRAIN = false; static_assert(ACT == 0 || ACT == 1, "EpiBf16: ACT is 0 (none) or 1 (gelu_pk)");
    bf16_t* O; int ldc; const float* bias; int split_cols; size_t split_stride; float scale0;
    __device__ __forceinline__ void operator()(const f32x4 (&acc)[2][2][4][2], const Unit& u, int wr, int wc, int fr, int fq) const {
        const int row0 = u.pm * BM + wr * 64 + fr; int colt = u.pn * BM; bf16_t* base = O;
        float sc = 1.f; if (split_cols) { const int t = colt / split_cols; base += (size_t)t * split_stride; colt -= t * split_cols; if (t == 0) sc = scale0; }
        const int col0 = colt + wc * 32 + 8 * fq, bcol0 = u.pn * BM + wc * 32 + 8 * fq;
        f32x4 bv[2][2];
#pragma unroll
        for (int bj = 0; bj < 2; ++bj)
#pragma unroll
            for (int n = 0; n < 2; ++n) bv[bj][n] = bias ? *(const f32x4*)(bias + bcol0 + bj * HALF + 4 * n) : (f32x4){0.f, 0.f, 0.f, 0.f};
#pragma unroll
        for (int ai = 0; ai < 2; ++ai)
#pragma unroll
            for (int m = 0; m < 4; ++m) { bf16_t* rowp = base + (size_t)(row0 + ai * HALF + m * 16) * ldc + col0;
#pragma unroll
                for (int bj = 0; bj < 2; ++bj) { f32x4 v0 = acc[ai][bj][m][0] + bv[bj][0], v1 = acc[ai][bj][m][1] + bv[bj][1];
                    if (ACT == 1) { f32x2 a = gelu_pk((f32x2){v0[0], v0[1]}), b = gelu_pk((f32x2){v0[2], v0[3]}), c = gelu_pk((f32x2){v1[0], v1[1]}), d = gelu_pk((f32x2){v1[2], v1[3]});
                        v0 = (f32x4){a.x, a.y, b.x, b.y}; v1 = (f32x4){c.x, c.y, d.x, d.y}; }
                    v0 = v0 * sc; v1 = v1 * sc; u32x4 w; w.x = cvt_pk_bf16(v0[0], v0[1]); w.y = cvt_pk_bf16(v0[2], v0[3]); w.z = cvt_pk_bf16(v1[0], v1[1]); w.w = cvt_pk_bf16(v1[2], v1[3]);
                    *(u32x4*)(rowp + bj * HALF) = w; } }
    }
};


struct EpiResGate {
    static constexpr bool PERM = false, AFTER_DRAIN = false;
    const float* base_lat; const float* base_ctx; float* out_lat; float* out_ctx; const float* gate;
    int goff;
    __device__ __forceinline__ void operator()(const f32x4 (&acc)[2][2][4][2], const Unit& u, int wr, int wc, int fr, int fq) const {
        const int rowt = u.pm * BM; const bool lat = rowt < 32768;
        const int nsel = lat ? (rowt >> 14) : 2;
        const float* bs = lat ? base_lat + (size_t)rowt * 1024 : base_ctx + (size_t)(rowt - 32768) * 1024;
        float* os = lat ? out_lat + (size_t)rowt * 1024 : out_ctx + (size_t)(rowt - 32768) * 1024;
        const float* gv = gate + nsel * 6144 + goff;
        const int rl = wr * 64 + fr, col0 = u.pn * BM + wc * 32 + 4 * fq;
        f32x4 g[2][2];
#pragma unroll
        for (int bj = 0; bj < 2; ++bj)
#pragma unroll
            for (int n = 0; n < 2; ++n) g[bj][n] = *(const f32x4*)(gv + col0 + bj * HALF + n * 16);
#pragma unroll
        for (int ai = 0; ai < 2; ++ai)
#pragma unroll
            for (int m = 0; m < 4; ++m) { const size_t ro = (size_t)(rl + ai * HALF + m * 16) * 1024 + col0;
#pragma unroll
                for (int bj = 0; bj < 2; ++bj)
#pragma unroll
                    for (int n = 0; n < 2; ++n) { const f32x4 b = *(const f32x4*)(bs + ro + bj * HALF + n * 16); *(f32x4*)(os + ro + bj * HALF + n * 16) = b + g[bj][n] * acc[ai][bj][m][n]; } }
    }
};

template <class Epi, class Sched, bool ALIGN_EPI = false, bool SP2 = false>
__device__ __forceinline__ void gemm_phase(PG8_LAS unsigned char* lds, const Gemm g, const Sched& S, const Epi& E) {
    int tid_l = threadIdx.x; asm volatile("" : "+v"(tid_l));
    const int tid = tid_l, wid = __builtin_amdgcn_readfirstlane(tid >> 6), lane = tid & 63, wr = wid >> 2, wc = wid & 3, fr = lane & 15, fq = lane >> 4;
    const int K = g.K, nt = K / BK;
    unsigned voffA[2], voffB[2];
#pragma unroll
    for (int i = 0; i < 2; ++i) { int R, C; stage_rc(tid * 16 + i * 8192, R, C); const int Rb = Epi::PERM ? ((R & ~31) + perm32(R & 31)) : R;
        voffA[i] = (unsigned)(R * K + C) * 2u; voffB[i] = (unsigned)(Rb * K + C) * 2u; }
    const size_t kstep = (size_t)(BK * 2);
    const size_t hstep = (size_t)HALF * K * 2;
    const size_t tstep = 2 * hstep;
    const unsigned ldsw = (unsigned)wid * 1024u;
    const int aoff = lds_byte(wr * 64 + fr, fq * 8), boff = lds_byte(wc * 32 + fr, fq * 8);
#define PG8_SA(b, h) (((b) * 2 + (h)) * HTB)
#define PG8_SB(b, h) ((4 + (b) * 2 + (h)) * HTB)
#define PG8_STAGE(bufoff, gbase, voff) do { _Pragma("unroll") for (int _i = 0; _i < 2; ++_i) \
        __builtin_amdgcn_global_load_lds((const unsigned*)((const char*)(gbase) + (voff)[_i]), (PG8_LAS unsigned*)(lds + (bufoff) + ldsw + _i * 8192), 16, 0, 0); } while (0)
#define PG8_LDA(dst, b, h) do { _Pragma("unroll") for (int m = 0; m < 4; ++m) _Pragma("unroll") for (int k = 0; k < 2; ++k) dst[m][k] = *(const PG8_LAS bf16x8*)(lds + PG8_SA(b, h) + aoff + m * 2048 + k * 1024); } while (0)
#define PG8_LDB(dst, b, h) do { _Pragma("unroll") for (int n = 0; n < 2; ++n) _Pragma("unroll") for (int k = 0; k < 2; ++k) dst[n][k] = *(const PG8_LAS bf16x8*)(lds + PG8_SB(b, h) + boff + n * 2048 + k * 1024); } while (0)
#define PG8_MMA(ai, bj, At, Bt) do { __builtin_amdgcn_s_setprio(1); _Pragma("unroll") for (int m = 0; m < 4; ++m) _Pragma("unroll") for (int n = 0; n < 2; ++n) _Pragma("unroll") for (int k = 0; k < 2; ++k) \
        acc[ai][bj][m][n] = __builtin_amdgcn_mfma_f32_16x16x32_bf16(Bt[n][k], At[m][k], acc[ai][bj][m][n], 0, 0, 0); __builtin_amdgcn_s_setprio(0); } while (0)
#define PG8_WAIT_V(n) asm volatile("s_waitcnt vmcnt(" #n ")" ::: "memory")
#define PG8_WAIT_L(n) asm volatile("s_waitcnt lgkmcnt(" #n ")" ::: "memory")
#define PG8_BAR __builtin_amdgcn_s_barrier()
#define PG8_SCHED __builtin_amdgcn_sched_barrier(0)
    Unit cur, nxt; int ui = 0;
    if (!S.next(0, cur)) return;
    f32x4 acc[2][2][4][2];
#pragma unroll
    for (int a = 0; a < 2; ++a)
#pragma unroll
        for (int b = 0; b < 2; ++b)
#pragma unroll
            for (int m = 0; m < 4; ++m)
#pragma unroll
                for (int n = 0; n < 2; ++n) acc[a][b][m][n] = (f32x4){0.f, 0.f, 0.f, 0.f};
    bf16x8 At[4][2], B0[2][2], B1[2][2];
    const char* cA = (const char*)g.A + (size_t)cur.pm * tstep; const char* cB = (const char*)g.Bt + (size_t)cur.pn * tstep;
    S.a_ready(cur);
    if constexpr (SP2) {
        PG8_STAGE(PG8_SB(0, 0), cB, voffB); PG8_STAGE(PG8_SB(0, 1), cB + hstep, voffB); PG8_STAGE(PG8_SA(0, 0), cA, voffA); PG8_STAGE(PG8_SA(0, 1), cA + hstep, voffA);
        if (wr == 1) PG8_BAR;
        PG8_WAIT_V(2); PG8_BAR;
        PG8_STAGE(PG8_SB(1, 0), cB + kstep, voffB); PG8_STAGE(PG8_SA(1, 0), cA + kstep, voffA); PG8_STAGE(PG8_SB(1, 1), cB + hstep + kstep, voffB);
        PG8_WAIT_V(6); PG8_BAR;
    } else {
        PG8_STAGE(PG8_SB(0, 0), cB, voffB); PG8_STAGE(PG8_SA(0, 0), cA, voffA); PG8_STAGE(PG8_SB(0, 1), cB + hstep, voffB); PG8_STAGE(PG8_SA(0, 1), cA + hstep, voffA);
        if (wr == 1) PG8_BAR;
        PG8_WAIT_V(4); PG8_BAR;
        PG8_STAGE(PG8_SB(1, 0), cB + kstep, voffB); PG8_STAGE(PG8_SA(1, 0), cA + kstep, voffA); PG8_STAGE(PG8_SB(1, 1), cB + hstep + kstep, voffB);
        PG8_WAIT_V(6); PG8_BAR;
    }
    for (;;) {
        const bool has_next = S.next(ui + 1, nxt);
        const char* nA = has_next ? (const char*)g.A + (size_t)nxt.pm * tstep : cA; const char* nB = has_next ? (const char*)g.Bt + (size_t)nxt.pn * tstep : cB;
        for (int t = 0; t < nt; t += 2) {
            const bool last = (t == nt - 2);
            const char* a1 = cA + (size_t)(t + 1) * kstep;
            const char* a2 = last ? nA : cA + (size_t)(t + 2) * kstep; const char* b2 = last ? nB : cB + (size_t)(t + 2) * kstep;
            const char* a3 = a2 + kstep; const char* b3 = b2 + kstep;
            if (last && has_next) S.a_ready(nxt);
            if constexpr (SP2) {
            PG8_LDB(B0, 0, 0); PG8_LDB(B1, 0, 1); PG8_SCHED; PG8_LDA(At, 0, 0); PG8_STAGE(PG8_SA(1, 1), a1 + hstep, voffA);
            PG8_WAIT_V(8); PG8_WAIT_L(0); PG8_BAR; PG8_MMA(0, 0, At, B0); PG8_MMA(0, 1, At, B1); PG8_BAR; PG8_SCHED;
            PG8_LDA(At, 0, 1); PG8_STAGE(PG8_SB(0, 0), b2, voffB); PG8_STAGE(PG8_SB(0, 1), b2 + hstep, voffB); PG8_STAGE(PG8_SA(0, 0), a2, voffA);
            PG8_WAIT_V(8); PG8_WAIT_L(0); PG8_BAR; PG8_MMA(1, 0, At, B0); PG8_MMA(1, 1, At, B1); PG8_BAR; PG8_SCHED;
            PG8_LDB(B0, 1, 0); PG8_LDB(B1, 1, 1); PG8_SCHED; PG8_LDA(At, 1, 0); PG8_STAGE(PG8_SA(0, 1), a2 + hstep, voffA);
            PG8_WAIT_V(8); PG8_WAIT_L(0); PG8_BAR; PG8_MMA(0, 0, At, B0); PG8_MMA(0, 1, At, B1); PG8_BAR; PG8_SCHED;
            PG8_LDA(At, 1, 1); PG8_STAGE(PG8_SB(1, 0), b3, voffB); PG8_STAGE(PG8_SB(1, 1), b3 + hstep, voffB); PG8_STAGE(PG8_SA(1, 0), a3, voffA);
            PG8_WAIT_V(8); PG8_WAIT_L(0); PG8_BAR; PG8_MMA(1, 0, At, B0); PG8_MMA(1, 1, At, B1); PG8_BAR; PG8_SCHED;
            } else {
            PG8_LDB(B0, 0, 0); PG8_SCHED; PG8_LDA(At, 0, 0); PG8_STAGE(PG8_SA(1, 1), a1 + hstep, voffA);
            PG8_WAIT_L(8); PG8_BAR; PG8_WAIT_L(0); PG8_MMA(0, 0, At, B0); PG8_BAR; PG8_SCHED;
            PG8_LDB(B1, 0, 1); PG8_STAGE(PG8_SB(0, 0), b2, voffB);
            PG8_BAR; PG8_WAIT_L(0); PG8_MMA(0, 1, At, B1); PG8_BAR;
            PG8_LDA(At, 0, 1); PG8_STAGE(PG8_SA(0, 0), a2, voffA);
            PG8_BAR; PG8_WAIT_L(0); PG8_MMA(1, 0, At, B0); PG8_BAR; PG8_SCHED;
            PG8_STAGE(PG8_SB(0, 1), b2 + hstep, voffB);
            PG8_WAIT_V(6); PG8_BAR; PG8_MMA(1, 1, At, B1); PG8_BAR;
            PG8_LDB(B0, 1, 0); PG8_SCHED; PG8_LDA(At, 1, 0); PG8_STAGE(PG8_SA(0, 1), a2 + hstep, voffA);
            PG8_WAIT_L(8); PG8_BAR; PG8_WAIT_L(0); PG8_MMA(0, 0, At, B0); PG8_BAR; PG8_SCHED;
            PG8_LDB(B1, 1, 1); PG8_STAGE(PG8_SB(1, 0), b3, voffB);
            PG8_BAR; PG8_WAIT_L(0); PG8_MMA(0, 1, At, B1); PG8_BAR;
            PG8_LDA(At, 1, 1); PG8_STAGE(PG8_SA(1, 0), a3, voffA);
            PG8_BAR; PG8_WAIT_L(0); PG8_MMA(1, 0, At, B0); PG8_BAR; PG8_SCHED;
            PG8_STAGE(PG8_SB(1, 1), b3 + hstep, voffB);
            PG8_WAIT_V(6); PG8_BAR; PG8_MMA(1, 1, At, B1); PG8_BAR;
            }
        }
        if constexpr (ALIGN_EPI) { if (wr == 0) PG8_BAR; }
        if constexpr (!Epi::AFTER_DRAIN) { E(acc, cur, wr, wc, fr, fq); S.done(cur); }
        if (!has_next) break;
#pragma unroll
        for (int a = 0; a < 2; ++a)
#pragma unroll
            for (int b = 0; b < 2; ++b)
#pragma unroll
                for (int m = 0; m < 4; ++m)
#pragma unroll
                    for (int n = 0; n < 2; ++n) acc[a][b][m][n] = (f32x4){0.f, 0.f, 0.f, 0.f};
        cur = nxt; cA = nA; cB = nB; ++ui;
        if constexpr (ALIGN_EPI) { if (wr == 1) PG8_BAR; }
    }
    PG8_WAIT_V(0);
    if constexpr (!ALIGN_EPI) { if (wr == 0) PG8_BAR; }
    PG8_BAR;
    if constexpr (Epi::AFTER_DRAIN) { E.fused(acc, cur, wr, wc, fr, fq, lds, wid, lane); S.done(cur); }
#undef PG8_SA
#undef PG8_SB
#undef PG8_STAGE
#undef PG8_LDA
#undef PG8_LDB
#undef PG8_MMA
#undef PG8_WAIT_V
#undef PG8_WAIT_L
#undef PG8_BAR
#undef PG8_SCHED
}
}

constexpr int DM = 1024, NB = 2, SEQ = 16384, CTXL = 256, RL = NB * SEQ, RC = NB * CTXL, RT = RL + RC;
constexpr int NKT = (SEQ + CTXL) / 64;
constexpr int KT_BYTES = 64 * 128, VT_BYTES = 64 * 128;
constexpr int NCH = 260, CSTF = 4160;
constexpr float EPS = 1e-6f;
constexpr float QSCALE = 0.10206207261596577f * 1.4426950408889634f;
constexpr int NPH_L = 13, NPHASES = 1 + 2 * NPH_L;


constexpr size_t MiB = 1u << 20;
constexpr size_t WS_CTL = 0, CTL_ZERO_BYTES = 64 * 1024;
constexpr size_t WS_WIN = 1 * MiB, WS_WUQ = 9 * MiB, WS_WUKV = 11 * MiB, WS_WOUT = 12 * MiB, WS_WPQ = 16 * MiB, WS_SUBK = 24 * MiB;
constexpr size_t WS_MOD = 25 * MiB, WS_ROPE = 25 * MiB + 256 * 1024, WS_SC = 25 * MiB + 512 * 1024, WS_MS = WS_SC + 64 * 1024;
constexpr size_t WS_CTXS = 26 * MiB, WS_G = 28 * MiB, WS_KR = 31 * MiB, WS_TABU = 34 * MiB, WS_TABV = 66 * MiB;
constexpr size_t WS_ZA = 98 * MiB, WS_ZB = 163 * MiB, WS_Q = WS_ZA, WS_PQ = WS_ZA;
constexpr size_t WS_XN = 228 * MiB, WS_QA = WS_XN, WS_KVA = 253 * MiB, WS_VT = WS_XN;
constexpr size_t WS_MIX = 293 * MiB, WS_R66 = 358 * MiB, WS_KVRAW = WS_R66, WS_CST = WS_R66, WS_EID = WS_R66, WS_GATE = WS_R66 + 17 * MiB;
constexpr size_t WS_KN = 425 * MiB, WS_Q8 = 458 * MiB, WS_MODP = 491 * MiB, WS_END = 493 * MiB;
static_assert(WS_QA + (size_t)RT * 384 * 2 <= WS_KVA && WS_KVA + (size_t)RT * 256 * 2 <= WS_MIX, "QA/KVA inside the XN region");
static_assert(WS_VT + (size_t)NB * 8 * NKT * VT_BYTES <= WS_MIX, "Vt inside the XN region");
static_assert(WS_CST + (size_t)16 * NCH * CSTF * 4 <= WS_KN && WS_KVRAW + (size_t)RT * 1024 * 2 <= WS_KN, "R66 region");
static_assert(WS_KN + (size_t)NB * 8 * NKT * KT_BYTES <= WS_Q8 && WS_Q8 + (size_t)RT * 1024 <= WS_MODP, "Kn / Q8 regions");
static_assert(WS_G + (size_t)RT * 16 * 4 <= WS_KR && WS_KR + (size_t)RT * 32 * 2 <= WS_TABU, "G/KR");
constexpr int CW_BAR = 1024;

constexpr int LDS_BYTES = 147456, MISC_OFF = 143360;

#define LAS __attribute__((address_space(3)))
typedef unsigned short bf16;
typedef short bf16x8 __attribute__((ext_vector_type(8)));
typedef float f32x4 __attribute__((ext_vector_type(4)));
typedef float f32x16 __attribute__((ext_vector_type(16)));
typedef unsigned u32x4 __attribute__((ext_vector_type(4)));
typedef unsigned u32x2 __attribute__((ext_vector_type(2)));
#define LDS_WAIT() asm volatile("s_waitcnt lgkmcnt(0)" ::: "memory")

typedef float f32x2_t __attribute__((ext_vector_type(2))); typedef __bf16 bf16x2_t __attribute__((ext_vector_type(2)));
__device__ __forceinline__ unsigned pk2(float lo, float hi) { f32x2_t v = {lo, hi}; bf16x2_t b = __builtin_convertvector(v, bf16x2_t); return __builtin_bit_cast(unsigned, b); }
__device__ __forceinline__ unsigned f2bf(float f) { return pk2(f, 0.f) & 0xffffu; }
__device__ __forceinline__ float bflo(unsigned w) { return __builtin_bit_cast(float, w << 16); }
__device__ __forceinline__ float bfhi(unsigned w) { return __builtin_bit_cast(float, w & 0xffff0000u); }
__device__ __forceinline__ float bf2f(bf16 v) { return __builtin_bit_cast(float, (unsigned)v << 16); }
__device__ __forceinline__ float shfl_idx(float v, int srclane) { return __builtin_bit_cast(float, __builtin_amdgcn_ds_bpermute(srclane << 2, __builtin_bit_cast(int, v))); }
__device__ __forceinline__ int shfl_idx(int v, int srclane) { return __builtin_amdgcn_ds_bpermute(srclane << 2, v); }
#define DPP_ADD(v, ctrl) (v) += __builtin_bit_cast(float, __builtin_amdgcn_update_dpp(0, __builtin_bit_cast(int, (v)), (ctrl), 0xf, 0xf, true))
__device__ __forceinline__ float wave_sum(float v, int lane) {
    (void)lane;
    DPP_ADD(v, 0xB1);
    DPP_ADD(v, 0x4E);
    DPP_ADD(v, 0x141);
    DPP_ADD(v, 0x140);
    const int b = __builtin_bit_cast(int, v);
    return (__builtin_bit_cast(float, __builtin_amdgcn_readlane(b, 0)) + __builtin_bit_cast(float, __builtin_amdgcn_readlane(b, 16))) +
           (__builtin_bit_cast(float, __builtin_amdgcn_readlane(b, 32)) + __builtin_bit_cast(float, __builtin_amdgcn_readlane(b, 48)));
}
__device__ __forceinline__ float wave_max(float v, int lane) {
#pragma unroll
    for (int o = 1; o < 64; o <<= 1) v = fmaxf(v, shfl_idx(v, lane ^ o));
    return v;
}
__device__ __forceinline__ int crow(int g, int hh) { return (g & 3) + 8 * (g >> 2) + 4 * hh; }
__device__ __forceinline__ bf16x8 pack8(float a0, float a1, float a2, float a3, float a4, float a5, float a6, float a7) {
    u32x4 w; w.x = pk2(a0, a1); w.y = pk2(a2, a3); w.z = pk2(a4, a5); w.w = pk2(a6, a7); return __builtin_bit_cast(bf16x8, w);
}
__device__ __forceinline__ float gelu_f(float v) {
    const float av = fabsf(v), d = av * 0.2316418882f + 1.0f; const float t = __builtin_amdgcn_rcpf(d);
    float q = t * 0.5307027145f + (-0.7265760135f); q = q * t + 0.7107068705f; q = q * t + (-0.142248368f); q = q * t + 0.127414796f; q = q * t;
    const float e = __builtin_amdgcn_exp2f(v * v * (-0.72134752044f));
    const float mm = v * (q * e); return v < 0.f ? mm : v - mm;
}
#define MFMA32(a, b, c) __builtin_amdgcn_mfma_f32_32x32x16_bf16((a), (b), (c), 0, 0, 0)
#define ML_ZERO16 (f32x16){0.f, 0.f, 0.f, 0.f, 0.f, 0.f, 0.f, 0.f, 0.f, 0.f, 0.f, 0.f, 0.f, 0.f, 0.f, 0.f}

#define XB_TMO      128
#define XB_XCNT(j)  (256  + 64 * (j))
#define XB_XSUB(j)  (1280 + 64 * (j))
#define XB_XGEN(j)  (2304 + 64 * (j))
#define XB_TOP      3328
#define XB_TOPGEN   3392
#define XCD_BAR_WORDS 3456
#define XB_SPIN_CAP (1u << 18)
__device__ __forceinline__ unsigned xb_ld(unsigned* p)              { return __hip_atomic_load(p, __ATOMIC_RELAXED, __HIP_MEMORY_SCOPE_AGENT); }
__device__ __forceinline__ unsigned xb_add(unsigned* p, unsigned v) { return __hip_atomic_fetch_add(p, v, __ATOMIC_RELAXED, __HIP_MEMORY_SCOPE_AGENT); }
__device__ __forceinline__ unsigned xb_xcc_id() { return (unsigned)__builtin_amdgcn_s_getreg((3 << 11) | 20) & 0xFu; }
#define XB_SPIN(cond, bar) do { unsigned _sp = 0; while (cond) { __builtin_amdgcn_s_sleep(1); \
    if ((++_sp & 255u) == 0u) { if (xb_ld(&(bar)[XB_TMO])) break; if (_sp > XB_SPIN_CAP) { atomicAdd(&(bar)[XB_TMO], 1u); break; } } } } while (0)
struct XcdBarrier { unsigned* bar; unsigned x; volatile LAS unsigned* st; };
__device__ __forceinline__ XcdBarrier xcd_barrier_post(unsigned* bar, volatile LAS unsigned* st) {
    XcdBarrier b; b.bar = bar; b.x = xb_xcc_id(); b.st = st;
    if (threadIdx.x == 0) (void)xb_add(&bar[XB_XCNT(b.x)], 1u);
    return b;
}
__device__ __forceinline__ void xcd_barrier_complete(unsigned* bar, unsigned x, unsigned& nloc, unsigned& nx) {
    const unsigned G = gridDim.x * gridDim.y * gridDim.z;
    unsigned sum, cnt, mine, sp = 0u;
    for (;;) {
        sum = 0u; cnt = 0u; mine = 0u;
#pragma unroll
        for (unsigned j = 0; j < 16; ++j) { const unsigned c = xb_ld(&bar[XB_XCNT(j)]); sum += c; cnt += (c > 0u) ? 1u : 0u; mine = (j == x) ? c : mine; }
        if (sum == G) break;
        __builtin_amdgcn_s_sleep(1);
        if ((++sp & 255u) == 0u) { if (xb_ld(&bar[XB_TMO])) break; if (sp > XB_SPIN_CAP) { atomicAdd(&bar[XB_TMO], 1u); break; } }
    }
    nloc = mine > 0u ? mine : 1u; nx = cnt > 0u ? cnt : 1u;
}
__device__ __forceinline__ void xcd_barrier(const XcdBarrier& b) {
    asm volatile("s_waitcnt vmcnt(0)" ::: "memory");
    __syncthreads();
    if (threadIdx.x == 0) {
        unsigned* bar = b.bar;
        __builtin_amdgcn_s_waitcnt(0);
        unsigned nloc = b.st[0], nx = b.st[1];
        if (nloc == 0u) { xcd_barrier_complete(bar, b.x, nloc, nx); b.st[0] = nloc; b.st[1] = nx; }
        const unsigned old = xb_add(&bar[XB_XSUB(b.x)], 1u);
        const unsigned gen = old / nloc;
        if (old + 1u == (gen + 1u) * nloc) {
            __builtin_amdgcn_fence(__ATOMIC_RELEASE, "agent");
            asm volatile("s_waitcnt vmcnt(0)" ::: "memory");
            const unsigned og = xb_add(&bar[XB_TOP], 1u);
            const unsigned tg = og / nx;
            if (og + 1u == (tg + 1u) * nx) xb_add(&bar[XB_TOPGEN], 1u);
            else XB_SPIN(xb_ld(&bar[XB_TOPGEN]) == tg, bar);
            __builtin_amdgcn_fence(__ATOMIC_ACQUIRE, "agent");
            xb_add(&bar[XB_XGEN(b.x)], 1u);
            asm volatile("s_waitcnt vmcnt(0)" ::: "memory");
        } else {
            XB_SPIN(xb_ld(&bar[XB_XGEN(b.x)]) == gen, bar);
            __builtin_amdgcn_fence(__ATOMIC_ACQUIRE, "agent");
            asm volatile("s_waitcnt vmcnt(0)" ::: "memory");
        }
    }
    __syncthreads();
}

struct Args { const float* in[24]; float* out; unsigned char* ws; int ph_lo, ph_hi; };
#define CAS __attribute__((address_space(4)))
typedef const CAS unsigned char* karg_t;
struct KA { karg_t p;
    __device__ __forceinline__ const float* in(int k) const { return *(const float* const CAS*)(p + 8 * k); }
    __device__ __forceinline__ float* out() const { return *(float* const CAS*)(p + 192); }
    __device__ __forceinline__ unsigned char* ws() const { return *(unsigned char* const CAS*)(p + 200); }
    __device__ __forceinline__ int ph_lo() const { return *(const int CAS*)(p + 208); }
    __device__ __forceinline__ int ph_hi() const { return *(const int CAS*)(p + 212); }
};
static_assert(sizeof(Args) == 216, "Args layout");
__device__ __forceinline__ KA ka_fresh() { KA a; a.p = (karg_t)__builtin_amdgcn_kernarg_segment_ptr(); asm volatile("" : "+s"(a.p)); return a; }
struct Ctx {
    LAS unsigned char* lds;
    int tid, lane, wave, G, bid;
};
__device__ __forceinline__ Ctx ctx_fresh() {
    extern __shared__ __attribute__((aligned(16))) unsigned char lds_raw[];
    Ctx C; C.lds = (LAS unsigned char*)lds_raw; int t = threadIdx.x; asm volatile("" : "+v"(t));
    C.tid = t; C.lane = t & 63; C.wave = __builtin_amdgcn_readfirstlane(t >> 6); C.G = gridDim.x; C.bid = blockIdx.x; return C;
}
__device__ __forceinline__ const float* stream_in(const KA& A, const Ctx& C, int l, int row) {
    if (row < RL) return (l == 0 ? A.in(0) : (const float*)A.out()) + (size_t)row * DM;
    return (l == 0 ? A.in(2) : (const float*)(A.ws() + WS_CTXS)) + (size_t)(row - RL) * DM;
}
__device__ __forceinline__ float* stream_out(const KA& A, const Ctx& C, int row) {
    if (row < RL) return A.out() + (size_t)row * DM;
    return (float*)(A.ws() + WS_CTXS) + (size_t)(row - RL) * DM;
}

__device__ __forceinline__ void p0_transpose_item(const float* W, int K, int N, bf16* WT, int n0, int dst_row0, LAS float* scr, int kb, int lane) {
    const int k0 = 64 * kb;
#pragma unroll 8
    for (int i = 0; i < 32; ++i) { const int kk = 2 * i + (lane >> 5); const int n = n0 + (lane & 31); scr[kk * 33 + (lane & 31)] = (n < N) ? W[(size_t)(k0 + kk) * N + n] : 0.f; }
    LDS_WAIT(); asm volatile("" ::: "memory");
    const int c = lane & 7;
#pragma unroll
    for (int j = 0; j < 4; ++j) { const int n = (lane >> 3) + 8 * j; const LAS float* s = scr + (8 * c) * 33 + n;
        u32x4 o; o.x = pk2(s[0 * 33], s[1 * 33]); o.y = pk2(s[2 * 33], s[3 * 33]); o.z = pk2(s[4 * 33], s[5 * 33]); o.w = pk2(s[6 * 33], s[7 * 33]);
        *(u32x4*)(WT + (size_t)(dst_row0 + n) * K + k0 + 8 * c) = o; }
    LDS_WAIT(); asm volatile("" ::: "memory");
}
__device__ __forceinline__ void p0_poolw_item(const float* Win, const float* Wp, bf16* WT, LAS float* scr, int kb, int nb, int lane) {
    const int k0 = 64 * kb, g = nb >> 1, e = (nb & 1) * 32 + (lane & 31);
    float wc[64];
#pragma unroll
    for (int c = 0; c < 64; ++c) wc[c] = Wp[((size_t)g * 64 + c) * 64 + e];
#pragma unroll 2
    for (int i = 0; i < 32; ++i) { const int kk = 2 * i + (lane >> 5); const float* wr = Win + (size_t)(k0 + kk) * 1968 + g * 64; float a = 0.f;
#pragma unroll
        for (int c4 = 0; c4 < 16; ++c4) { const f32x4 x = *(const f32x4*)(wr + 4 * c4); a += x.x * wc[4 * c4] + x.y * wc[4 * c4 + 1] + x.z * wc[4 * c4 + 2] + x.w * wc[4 * c4 + 3]; }
        scr[kk * 33 + (lane & 31)] = a; }
    LDS_WAIT(); asm volatile("" ::: "memory");
    const int c = lane & 7;
#pragma unroll
    for (int j = 0; j < 4; ++j) { const int n = (lane >> 3) + 8 * j; const LAS float* sp = scr + (8 * c) * 33 + n;
        u32x4 o; o.x = pk2(sp[0 * 33], sp[1 * 33]); o.y = pk2(sp[2 * 33], sp[3 * 33]); o.z = pk2(sp[4 * 33], sp[5 * 33]); o.w = pk2(sp[6 * 33], sp[7 * 33]);
        *(u32x4*)(WT + (size_t)(32 * nb + n) * DM + k0 + 8 * c) = o; }
    LDS_WAIT(); asm volatile("" ::: "memory");
}
__device__ __forceinline__ void phase_prologue() {
    const KA A = ka_fresh(); const Ctx C = ctx_fresh();
    LAS float* scr = (LAS float*)(C.lds + C.wave * 16384);
    const int gw = C.bid * 8 + C.wave, NGW = C.G * 8, lane = C.lane;
    float* MODP = (float*)(A.ws() + WS_MODP);
    for (int it = gw; it < 2 * 96 * 8; it += NGW) {
        const int ks = it & 7, l = (it >> 3) / 96, j = ((it >> 3) % 96) * 64 + lane;
        const float* W = A.in(6) + ((size_t)l * DM + ks * 128) * 6144 + j;
        const float* c01 = A.in(1) + ks * 128; const float* c2p = A.in(3) + ks * 128;
        float a0 = 0.f, a1 = 0.f, a2 = 0.f;
#pragma unroll 16
        for (int k = 0; k < 128; ++k) {
            const float w = W[(size_t)k * 6144];
            const float c0 = c01[k], c1 = c01[DM + k], c2 = c2p[k];
            a0 += (c0 / (1.f + __expf(-c0))) * w; a1 += (c1 / (1.f + __expf(-c1))) * w; a2 += (c2 / (1.f + __expf(-c2))) * w;
        }
        float* mp = MODP + ((size_t)(l * 8 + ks) * 3) * 6144 + j;
        mp[0] = a0; mp[6144] = a1; mp[2 * 6144] = a2;
    }
    constexpr int I_IN = 16 * 64, I_UQ = 6 * 24, I_UKV = 4 * 32, I_OUT = 16 * 32, I_PQ = 16 * 64, I_L = I_IN + I_UQ + I_UKV + I_OUT + I_PQ;
    for (int it = gw; it < 2 * I_L; it += NGW) {
        const int l = it / I_L; int r = it % I_L;
        if (r < I_IN) {
            const int kb = r / 64, nb = r % 64;
            if (nb < 8) { p0_poolw_item(A.in(8) + (size_t)l * DM * 1968, A.in(9) + (size_t)l * 4 * 64 * 64, (bf16*)(A.ws() + WS_WIN) + (size_t)l * 2048 * DM, scr, kb, nb, lane); continue; }
            const int dst = nb < 29 ? 32 * nb : (nb < 61 ? 96 + 32 * nb : (nb == 61 ? 928 : (nb == 62 ? 960 : 992)));
            const int n0 = nb < 62 ? 32 * nb : 4096;
            p0_transpose_item(A.in(8) + (size_t)l * DM * 1968, DM, 1968, (bf16*)(A.ws() + WS_WIN) + (size_t)l * 2048 * DM, n0, dst, scr, kb, lane); continue; }
        r -= I_IN;
        if (r < I_UQ) { const int kb = r / 24, nb = r % 24; p0_transpose_item(A.in(13) + (size_t)l * 384 * 768, 384, 768, (bf16*)(A.ws() + WS_WUQ) + (size_t)l * 768 * 384, 32 * nb, 32 * nb, scr, kb, lane); continue; }
        r -= I_UQ;
        if (r < I_UKV) { const int kb = r / 32, nb = r % 32; p0_transpose_item(A.in(14) + (size_t)l * 256 * 1024, 256, 1024, (bf16*)(A.ws() + WS_WUKV) + (size_t)l * 1024 * 256, 32 * nb, 32 * nb, scr, kb, lane); continue; }
        r -= I_UKV;
        if (r < I_OUT) { const int kb = r / 32, nb = r % 32; p0_transpose_item(A.in(19) + (size_t)l * DM * DM, DM, DM, (bf16*)(A.ws() + WS_WOUT) + (size_t)l * DM * DM, 32 * nb, 32 * nb, scr, kb, lane); continue; }
        r -= I_OUT;
        { const int kb = r / 64, nb = r % 64; p0_transpose_item(A.in(20) + (size_t)l * DM * 2048, DM, 2048, (bf16*)(A.ws() + WS_WPQ) + (size_t)l * 2048 * DM, 32 * nb, 32 * nb, scr, kb, lane); }
    }
    const int gt = C.bid * 512 + C.tid, NT = C.G * 512;
    { const float* s = A.in(21); bf16* d = (bf16*)(A.ws() + WS_SUBK);
      for (int i = gt; i < 2 * 8 * 2 * 128 * 128 / 4; i += NT) { const f32x4 v = *(const f32x4*)(s + 4 * (size_t)i); u32x2 o; o.x = pk2(v.x, v.y); o.y = pk2(v.z, v.w); *(u32x2*)(d + 4 * (size_t)i) = o; } }
    { float* rp = (float*)(A.ws() + WS_ROPE);
      for (int i = gt; i < 256 * 8; i += NT) { const int p = i >> 3, f = i & 7;
          const float fr[8] = {1.0f, 0.31622776601683794f, 0.1f, 0.031622776601683794f, 0.01f, 0.0031622776601683794f, 0.001f, 0.00031622776601683794f};
          float fq = fr[0];
#pragma unroll
          for (int q = 1; q < 8; ++q) fq = (f == q) ? fr[q] : fq;
          const float ang = (float)p * fq;
          const double rev = (double)ang * 0.15915494309189535; const float fracr = (float)(rev - floor(rev));
          rp[2 * i] = __builtin_amdgcn_cosf(fracr); rp[2 * i + 1] = __builtin_amdgcn_sinf(fracr); } }
}

__device__ __forceinline__ void phase_modreduce() {
    const KA A = ka_fresh(); const Ctx C = ctx_fresh();
    const int gt = C.bid * 512 + C.tid, NT = C.G * 512;
    const float* MODP = (const float*)(A.ws() + WS_MODP); float* MOD = (float*)(A.ws() + WS_MOD);
    for (int i = gt; i < 2 * 3 * 6144; i += NT) { const int l = i / (3 * 6144), rem = i % (3 * 6144), j = rem % 6144;
        float a = A.in(7)[l * 6144 + j];
#pragma unroll
        for (int ks = 0; ks < 8; ++ks) a += MODP[((size_t)(l * 8 + ks) * 3) * 6144 + rem];
        const int slot = j >> 10;
        if (slot == 1) a = A.in(4)[l * DM + (j & 1023)] * (1.0f + a); else if (slot == 4) a = A.in(5)[l * DM + (j & 1023)] * (1.0f + a);
        MOD[i] = a; }
}
__device__ __forceinline__ void phase_norm(int l, int which) {
    const KA A = ka_fresh(); const Ctx C = ctx_fresh();
    const int gw = C.bid * 8 + C.wave, NGW = C.G * 8, lane = C.lane;
    const float* MOD = (const float*)(A.ws() + WS_MOD);
    bf16* XN = (bf16*)(A.ws() + WS_XN);
    const int nrows = (which == 1 && l == 1) ? RL : RT;
    int cur = -1; f32x4 csh[4], cgs[4];
    for (int row = gw; row < nrows; row += NGW) {
        const float* xr = (which == 0) ? stream_in(A, C, l, row) : (const float*)stream_out(A, C, row);
        const int nsel = row < RL ? (row >> 14) : 2;
        if (nsel != cur) { cur = nsel; const float* md = MOD + (l * 3 + nsel) * 6144 + which * 3072;
#pragma unroll
            for (int i = 0; i < 4; ++i) { const int j = 4 * lane + 256 * i; csh[i] = *(const f32x4*)(md + j); cgs[i] = *(const f32x4*)(md + 1024 + j); } }
        f32x4 v[4]; float ss = 0.f;
#pragma unroll
        for (int i = 0; i < 4; ++i) { v[i] = *(const f32x4*)(xr + 4 * lane + 256 * i); ss += (v[i].x * v[i].x + v[i].y * v[i].y) + (v[i].z * v[i].z + v[i].w * v[i].w); }
        const float rs = 1.0f / sqrtf(wave_sum(ss, lane) * (1.f / DM) + EPS);
#pragma unroll
        for (int i = 0; i < 4; ++i) { const int j = 4 * lane + 256 * i;
            const f32x4 y = v[i] * rs * cgs[i] + csh[i];
            u32x2 o; o.x = pk2(y.x, y.y); o.y = pk2(y.z, y.w); *(u32x2*)(XN + (size_t)row * DM + j) = o; }
    }
}
constexpr float U_SCALE = 48.f, V_SCALE = 1.5f;
constexpr int TROW = 768;
struct __attribute__((packed, aligned(4))) U3 { unsigned a, b, c; };
__device__ __forceinline__ unsigned q_e2m3(float x) {
    const unsigned sg = (__builtin_bit_cast(unsigned, x) >> 31) << 5;
    const float a = fminf(fabsf(x), 7.5f);
    const float t = a * (a < 2.f ? 8.f : (a < 4.f ? 4.f : 2.f));
    return sg | ((unsigned)__builtin_rintf(t) + (a < 2.f ? 0u : (a < 4.f ? 8u : 16u)));
}
__device__ __forceinline__ void phase_tables(int l) {
    const KA A = ka_fresh(); const Ctx C = ctx_fresh();
    const size_t gt = (size_t)C.bid * 512 + C.tid, NT = (size_t)C.G * 512;
    const size_t n16 = (size_t)16384 * 1024 / 16;
#pragma unroll
    for (int w = 0; w < 2; ++w) {
        const float* s = A.in(22 + w) + (size_t)l * 16384 * 1024; unsigned char* d = A.ws() + (w ? WS_TABV : WS_TABU);
        const float sc = w ? V_SCALE : U_SCALE;
        for (size_t i = gt; i < n16; i += NT) {
            unsigned c[16];
#pragma unroll
            for (int q = 0; q < 4; ++q) { const f32x4 x = *(const f32x4*)(s + 16 * i + 4 * q);
                c[4 * q] = q_e2m3(x.x * sc); c[4 * q + 1] = q_e2m3(x.y * sc); c[4 * q + 2] = q_e2m3(x.z * sc); c[4 * q + 3] = q_e2m3(x.w * sc); }
            U3 o;
            o.a = c[0] | (c[1] << 6) | (c[2] << 12) | (c[3] << 18) | (c[4] << 24) | (c[5] << 30);
            o.b = (c[5] >> 2) | (c[6] << 4) | (c[7] << 10) | (c[8] << 16) | (c[9] << 22) | (c[10] << 28);
            o.c = (c[10] >> 4) | (c[11] << 2) | (c[12] << 8) | (c[13] << 14) | (c[14] << 20) | (c[15] << 26);
            *(U3*)(d + 12 * i) = o; }
    }
}

__device__ __forceinline__ void phase_post(int l) {
    const KA A = ka_fresh(); const Ctx C = ctx_fresh();
    const bf16* ZA = (const bf16*)(A.ws() + WS_ZA);
    bf16* MIX = (bf16*)(A.ws() + WS_MIX); bf16* QA = (bf16*)(A.ws() + WS_QA); bf16* KVA = (bf16*)(A.ws() + WS_KVA); bf16* KR = (bf16*)(A.ws() + WS_KR);
    float* GT = (float*)(A.ws() + WS_G);
    LAS float* U = (LAS float*)C.lds;
    const int tid = C.tid, lane = C.lane;
    for (int unit = C.bid; unit < RT / 32; unit += C.G) {
        const int r0 = unit * 32;
        int seq0, L;
        if (r0 < RL) { seq0 = (r0 >> 14) << 14; L = SEQ; } else { seq0 = RL + (((r0 - RL) >> 8) << 8); L = CTXL; }
        const int t0 = r0 - seq0;
        for (int idx = tid; idx < 48 * 32; idx += 512) { const int rr = idx >> 5, c8 = idx & 31; const int t = t0 - 8 + rr;
            u32x4 v = {0u, 0u, 0u, 0u};
            if (t >= 0 && t < L) v = *(const u32x4*)(ZA + (size_t)(seq0 + t) * 1024 + c8 * 8);
            LAS float* d = U + rr * 256 + c8 * 8;
            d[0] = bflo(v.x); d[1] = bfhi(v.x); d[2] = bflo(v.y); d[3] = bfhi(v.y); d[4] = bflo(v.z); d[5] = bfhi(v.z); d[6] = bflo(v.w); d[7] = bfhi(v.w); }
        __syncthreads();
        { const int ch = tid & 255, half = tid >> 8, hw = __builtin_amdgcn_readfirstlane(1 << (ch >> 6));
          const float sc = A.in(10)[l * 256 + ch];
          for (int i = half * 16; i < half * 16 + 16; ++i) { const int t = t0 + i; const int lo = max(t - hw, 0), hi = min(t + hw, L);
              float sm = 0.f; for (int tt = lo; tt < hi; ++tt) sm += U[(tt - t0 + 8) * 256 + ch];
              const float dv = sm / (float)(hi - lo) - U[(i + 8) * 256 + ch];
              MIX[(size_t)(r0 + i) * 1024 + ch] = (bf16)f2bf(dv * sc); } }
#pragma unroll
        for (int q = 0; q < 4; ++q) { const int row = r0 + C.wave * 4 + q; const bf16* za = ZA + (size_t)row * 1024;
            { float x[6]; float ss = 0.f;
#pragma unroll
              for (int i = 0; i < 3; ++i) { const unsigned w = *(const unsigned*)(za + 256 + 2 * lane + 128 * i); x[2 * i] = bflo(w); x[2 * i + 1] = bfhi(w); ss += x[2 * i] * x[2 * i] + x[2 * i + 1] * x[2 * i + 1]; }
              const float rs = 1.0f / sqrtf(wave_sum(ss, lane) * (1.f / 384.f) + EPS); const float* gq = A.in(11) + l * 384;
#pragma unroll
              for (int i = 0; i < 3; ++i) { const int j = 2 * lane + 128 * i; *(unsigned*)(QA + (size_t)row * 384 + j) = pk2(x[2 * i] * rs * gq[j], x[2 * i + 1] * rs * gq[j + 1]); } }
            { const u32x2 w = *(const u32x2*)(za + 640 + 4 * lane);
              const float x0 = bflo(w.x), x1 = bfhi(w.x), x2 = bflo(w.y), x3 = bfhi(w.y);
              const float rs = 1.0f / sqrtf(wave_sum(x0 * x0 + x1 * x1 + x2 * x2 + x3 * x3, lane) * (1.f / 256.f) + EPS); const float* gk = A.in(12) + l * 256 + 4 * lane;
              u32x2 o; o.x = pk2(x0 * rs * gk[0], x1 * rs * gk[1]); o.y = pk2(x2 * rs * gk[2], x3 * rs * gk[3]); *(u32x2*)(KVA + (size_t)row * 256 + 4 * lane) = o; }
            if (lane < 16) *(unsigned*)(KR + (size_t)row * 32 + 2 * lane) = *(const unsigned*)(za + 896 + 2 * lane);
            if (lane < 16) { float gv = bf2f(za[928 + lane]) + A.in(17)[l * 16 + lane];
                if ((lane >> 2) & 1) gv = fminf(gv, 0.f) - log1pf(__expf(-fabsf(gv)));
                GT[(size_t)row * 16 + lane] = gv; }
        }
        __syncthreads();
    }
}

__device__ __forceinline__ unsigned fp8x4(float a, float b, float c, float d) {
    a = __builtin_amdgcn_fmed3f(a, -448.f, 448.f); b = __builtin_amdgcn_fmed3f(b, -448.f, 448.f); c = __builtin_amdgcn_fmed3f(c, -448.f, 448.f); d = __builtin_amdgcn_fmed3f(d, -448.f, 448.f);
    int w = __builtin_amdgcn_cvt_pk_fp8_f32(a, b, 0, false); w = __builtin_amdgcn_cvt_pk_fp8_f32(c, d, w, true); return (unsigned)w;
}
__device__ __forceinline__ void qk_head(const bf16* src_lo, const bf16* src_hi, unsigned char* dst, int sw, const float* gn, bool rot, const float (&cs)[16], const float (&sn)[16], float oscale) {
    float ss = 0.f;
#pragma unroll 4
    for (int i = 0; i < 8; ++i) { const u32x4 w = *(const u32x4*)(src_lo + 8 * i);
        ss += (bflo(w.x) * bflo(w.x) + bfhi(w.x) * bfhi(w.x)) + (bflo(w.y) * bflo(w.y) + bfhi(w.y) * bfhi(w.y)) + (bflo(w.z) * bflo(w.z) + bfhi(w.z) * bfhi(w.z)) + (bflo(w.w) * bflo(w.w) + bfhi(w.w) * bfhi(w.w)); }
    u32x4 wr[4];
#pragma unroll
    for (int i = 0; i < 4; ++i) { wr[i] = *(const u32x4*)(src_hi + 8 * i); const u32x4 w = wr[i];
        ss += (bflo(w.x) * bflo(w.x) + bfhi(w.x) * bfhi(w.x)) + (bflo(w.y) * bflo(w.y) + bfhi(w.y) * bfhi(w.y)) + (bflo(w.z) * bflo(w.z) + bfhi(w.z) * bfhi(w.z)) + (bflo(w.w) * bflo(w.w) + bfhi(w.w) * bfhi(w.w)); }
    const float rs = oscale / sqrtf(ss * (1.f / 96.f) + EPS);
    __builtin_amdgcn_sched_barrier(0);
#pragma unroll 1
    for (int i = 0; i < 8; ++i) {
        const u32x4 w = *(const u32x4*)(src_lo + 8 * i); const f32x4 g0 = *(const f32x4*)(gn + 8 * i), g1 = *(const f32x4*)(gn + 8 * i + 4);
        u32x2 o; o.x = fp8x4(bflo(w.x) * rs * g0.x, bfhi(w.x) * rs * g0.y, bflo(w.y) * rs * g0.z, bfhi(w.y) * rs * g0.w);
        o.y = fp8x4(bflo(w.z) * rs * g1.x, bfhi(w.z) * rs * g1.y, bflo(w.w) * rs * g1.z, bfhi(w.w) * rs * g1.w);
        *(u32x2*)(dst + ((((i >> 1) ^ sw) << 4) + ((i & 1) << 3))) = o; }
    __builtin_amdgcn_sched_barrier(0);
#pragma unroll
    for (int i = 0; i < 2; ++i) {
        const u32x4 p = wr[i], q = wr[2 + i];
        const f32x4 ga = *(const f32x4*)(gn + 64 + 8 * i), gb = *(const f32x4*)(gn + 64 + 8 * i + 4), gc = *(const f32x4*)(gn + 80 + 8 * i), gd = *(const f32x4*)(gn + 80 + 8 * i + 4);
        float y1[8], y2[8];
        y1[0] = bflo(p.x) * rs * ga.x; y1[1] = bfhi(p.x) * rs * ga.y; y1[2] = bflo(p.y) * rs * ga.z; y1[3] = bfhi(p.y) * rs * ga.w; y1[4] = bflo(p.z) * rs * gb.x; y1[5] = bfhi(p.z) * rs * gb.y; y1[6] = bflo(p.w) * rs * gb.z; y1[7] = bfhi(p.w) * rs * gb.w;
        y2[0] = bflo(q.x) * rs * gc.x; y2[1] = bfhi(q.x) * rs * gc.y; y2[2] = bflo(q.y) * rs * gc.z; y2[3] = bfhi(q.y) * rs * gc.w; y2[4] = bflo(q.z) * rs * gd.x; y2[5] = bfhi(q.z) * rs * gd.y; y2[6] = bflo(q.w) * rs * gd.z; y2[7] = bfhi(q.w) * rs * gd.w;
        if (rot) {
#pragma unroll
            for (int j = 0; j < 8; ++j) { const float a = y1[j] * cs[8 * i + j] - y2[j] * sn[8 * i + j], bb = y2[j] * cs[8 * i + j] + y1[j] * sn[8 * i + j]; y1[j] = a; y2[j] = bb; }
        }
        u32x2 o; o.x = fp8x4(y1[0], y1[1], y1[2], y1[3]); o.y = fp8x4(y1[4], y1[5], y1[6], y1[7]); *(u32x2*)(dst + (((4 ^ sw) << 4) + (i << 3))) = o;
        u32x2 o2; o2.x = fp8x4(y2[0], y2[1], y2[2], y2[3]); o2.y = fp8x4(y2[4], y2[5], y2[6], y2[7]); *(u32x2*)(dst + (((5 ^ sw) << 4) + (i << 3))) = o2;
    }
    { u32x4 z; z.x = 0u; z.y = 0u; z.z = 0u; z.w = 0u; *(u32x4*)(dst + ((6 ^ sw) << 4)) = z; *(u32x4*)(dst + ((7 ^ sw) << 4)) = z; }
    __builtin_amdgcn_sched_barrier(0);
}
__device__ __forceinline__ void phase_qknorm(int l) {
    const KA A = ka_fresh(); const Ctx C = ctx_fresh();
    const int gw = C.bid * 8 + C.wave, NGW = C.G * 8, lane = C.lane;
    const bf16* Q = (const bf16*)(A.ws() + WS_Q); const bf16* KV = (const bf16*)(A.ws() + WS_KVRAW); const bf16* KR = (const bf16*)(A.ws() + WS_KR);
    unsigned char* KN = A.ws() + WS_KN; unsigned char* VT = A.ws() + WS_VT;
    const float* rope = (const float*)(A.ws() + WS_ROPE);
    const float* qg = A.in(15) + l * 96; const float* kg = A.in(16) + l * 96;
    for (int u3 = gw; u3 < (RT / 64) * 8 * 3; u3 += NGW) {
        const int part = u3 % 3, u = u3 / 3;
        const int h = u & 7, tl = u >> 3, row0 = tl * 64, row = row0 + lane;
        const bool lat = row0 < RL; int b, t0;
        if (lat) { b = row0 >> 14; t0 = row0 & (SEQ - 1); } else { b = (row0 - RL) >> 8; t0 = (row0 - RL) & 255; }
        const int ktile = lat ? (t0 >> 6) : (SEQ + t0) >> 6;
        float cs[16], sn[16];
#pragma unroll
        for (int i = 0; i < 16; ++i) { cs[i] = 1.f; sn[i] = 0.f; }
        if (lat && part < 2) {
#pragma unroll
            for (int i = 0; i < 16; ++i) { const int p = (i < 8) ? (t0 >> 6) : lane; const float* rp = rope + (p * 8 + (i & 7)) * 2; cs[i] = rp[0]; sn[i] = rp[1]; }
        }
        const bf16* kvp = KV + (size_t)row * 1024 + h * 128;
        if (part == 0) { const bf16* qp = Q + (size_t)row * 768 + h * 96;
          qk_head(qp, qp + 64, A.ws() + WS_Q8 + (size_t)row * 1024 + h * 128, 0, qg, lat, cs, sn, QSCALE); }
        else if (part == 1) qk_head(kvp, KR + (size_t)row * 32, KN + ((size_t)(b * 8 + h) * NKT + ktile) * KT_BYTES + lane * 128, (lane >> 1) & 7, kg, lat, cs, sn, 1.0f);
        else { const int kap = lane & 15; const int pos = (lane & ~15) + 8 * ((kap >> 2) & 1) + 4 * (kap >> 3) + (kap & 3);
          bf16* vd = (bf16*)(VT + ((size_t)(b * 8 + h) * NKT + ktile) * VT_BYTES);
          const int pa = pos >> 3, pb = pos & 7;
#pragma unroll 1
          for (int i = 0; i < 8; ++i) { const u32x4 vv = *(const u32x4*)(kvp + 64 + 8 * i);
#pragma unroll
              for (int e = 0; e < 8; ++e) { const int d = 8 * i + e; const unsigned wd = (e >> 1) == 0 ? vv.x : ((e >> 1) == 1 ? vv.y : ((e >> 1) == 2 ? vv.z : vv.w)); const bf16 val = (bf16)((e & 1) ? (wd >> 16) : (wd & 0xffffu));
                  vd[(unsigned)(d * 64 + ((pa ^ ((d >> 1) & 7)) << 3) + pb)] = val; } } }
    }
}

__device__ __forceinline__ int ml_row(int b, int dir, int j, int s) {
    if (j < 4) { const int p = 64 * j + s; return RL + b * CTXL + (dir ? CTXL - 1 - p : p); }
    const int p = 64 * (j - 4) + s; return b * SEQ + (dir ? SEQ - 1 - p : p);
}
__device__ __forceinline__ void phase_ml_local() {
    const KA A = ka_fresh(); const Ctx C = ctx_fresh();
    const int gw = C.bid * 8 + C.wave, NGW = C.G * 8, lane = C.lane, r = lane & 31, hh = lane >> 5;
    const bf16* ZB = (const bf16*)(A.ws() + WS_ZB); const float* GT = (const float*)(A.ws() + WS_G);
    float* CST = (float*)(A.ws() + WS_CST); float* SC = (float*)(A.ws() + WS_SC);
    for (int u = gw; u < 16 * NCH; u += NGW) {
        const int sq = u / NCH, j = u % NCH, b = sq >> 3, h = (sq >> 1) & 3, dir = sq & 1;
        const int rowl = ml_row(b, dir, j, lane);
        const float gi = GT[(size_t)rowl * 16 + dir * 8 + h], lf = GT[(size_t)rowl * 16 + dir * 8 + 4 + h];
        float bs = lf;
#pragma unroll
        for (int o = 1; o < 64; o <<= 1) { const float tv = shfl_idx(bs, lane - o); if (lane >= o) bs += tv; }
        const float blast = shfl_idx(bs, 63);
        const float dec = blast + gi - bs;
        const float mloc = wave_max(dec, lane);
        const float w = __expf(dec - mloc);
        const int row0 = ml_row(b, dir, j, 0), rstep = dir ? -1 : 1;
        f32x16 acc[2][2];
#pragma unroll
        for (int vb = 0; vb < 2; ++vb)
#pragma unroll
            for (int db = 0; db < 2; ++db) acc[vb][db] = ML_ZERO16;
        float nacc0 = 0.f, nacc1 = 0.f;
#pragma unroll
        for (int st = 0; st < 4; ++st) {
            float ws[8]; unsigned rofs[8];
#pragma unroll
            for (int jj = 0; jj < 8; ++jj) { const int sidx = 16 * st + 8 * hh + jj; ws[jj] = shfl_idx(w, sidx); rofs[jj] = (unsigned)((row0 + rstep * sidx) * 1024 + h * 64 + r); }
            bf16x8 Af[2], Bf[2];
#pragma unroll
            for (int blk = 0; blk < 2; ++blk) {
                float kx[8];
#pragma unroll
                for (int jj = 0; jj < 8; ++jj) { kx[jj] = bf2f(ZB[rofs[jj] + 256 + 32 * blk]); Bf[blk][jj] = (short)ZB[rofs[jj] + 256 + 32 * blk]; }
                if (blk == 0) {
#pragma unroll
                    for (int jj = 0; jj < 8; ++jj) nacc0 += ws[jj] * kx[jj]; }
                else {
#pragma unroll
                    for (int jj = 0; jj < 8; ++jj) nacc1 += ws[jj] * kx[jj]; }
                float vx[8];
#pragma unroll
                for (int jj = 0; jj < 8; ++jj) vx[jj] = bf2f(ZB[rofs[jj] + 512 + 32 * blk]) * ws[jj];
                Af[blk] = pack8(vx[0], vx[1], vx[2], vx[3], vx[4], vx[5], vx[6], vx[7]);
            }
#pragma unroll
            for (int vb = 0; vb < 2; ++vb)
#pragma unroll
                for (int db = 0; db < 2; ++db) acc[vb][db] = MFMA32(Af[vb], Bf[db], acc[vb][db]);
            __builtin_amdgcn_sched_barrier(0);
        }
        float* cp = CST + (size_t)u * CSTF;
#pragma unroll
        for (int vb = 0; vb < 2; ++vb)
#pragma unroll
            for (int db = 0; db < 2; ++db)
#pragma unroll
                for (int g = 0; g < 16; ++g) cp[(32 * vb + crow(g, hh)) * 64 + 32 * db + r] = acc[vb][db][g];
        nacc0 += shfl_idx(nacc0, lane ^ 32); nacc1 += shfl_idx(nacc1, lane ^ 32);
        if (hh == 0) { cp[4096 + r] = nacc0; cp[4096 + 32 + r] = nacc1; }
        if (lane == 0) { SC[u * 2] = mloc; SC[u * 2 + 1] = blast; }
    }
}
__device__ __forceinline__ void phase_ml_scan() {
    const KA A = ka_fresh(); const Ctx C = ctx_fresh();
    const int gt = C.bid * 512 + C.tid, NT = C.G * 512;
    float* CST = (float*)(A.ws() + WS_CST); const float* SC = (const float*)(A.ws() + WS_SC); float* MS = (float*)(A.ws() + WS_MS);
    for (int e = gt; e < 16 * CSTF; e += NT) {
        const int sq = e / CSTF, el = e % CSTF;
        float* base = CST + (size_t)sq * NCH * CSTF + el;
        float cv = 0.f, m = -1e30f;
#pragma unroll 1
        for (int j0 = 0; j0 < NCH; j0 += 10) {
            float loc[10]; f32x2_t sc[10];
#pragma unroll
            for (int u = 0; u < 10; ++u) { loc[u] = base[(size_t)(j0 + u) * CSTF]; sc[u] = *(const f32x2_t*)(SC + (sq * NCH + j0 + u) * 2); }
#pragma unroll
            for (int u = 0; u < 10; ++u) {
                base[(size_t)(j0 + u) * CSTF] = cv;
                if (el == 0) MS[sq * NCH + j0 + u] = m;
                const float mn = fmaxf(sc[u].y + m, sc[u].x);
                cv = __expf(sc[u].y + m - mn) * cv + __expf(sc[u].x - mn) * loc[u]; m = mn;
            }
        }
    }
}
template <int DIR>
__device__ __forceinline__ void ml_sblock(f32x16& S, float& den, const bf16* ZB, const bf16x8 (&Qf)[4], int sb, int base_row, int h, int r, int hh, int jl, float a, float Mj) {
    S = ML_ZERO16;
    const int sr = 32 * sb + r; const int rows = base_row + (DIR ? 63 - sr : sr);
#pragma unroll
    for (int st = 0; st < 4; ++st) { const bf16x8 Kf = *(const bf16x8*)(ZB + (unsigned)(rows * 1024 + 256 + h * 64 + st * 16 + hh * 8)); S = MFMA32(Kf, Qf[st], S); }
#pragma unroll
    for (int g = 0; g < 16; ++g) { const int s = 32 * sb + crow(g, hh); const float as = shfl_idx(a, s);
        const float p = (s <= jl) ? S[g] * 0.125f * __expf(as - Mj) : 0.f; S[g] = p; den += p; }
}
template <int DIR>
__device__ __forceinline__ void ml_pv(f32x16& O, const f32x16& S, const bf16* ZB, int sb, int base_row, int h, int v, int hh) {
#pragma unroll
    for (int st2 = 0; st2 < 2; ++st2) {
        bf16x8 VA;
#pragma unroll
        for (int jj = 0; jj < 8; ++jj) { const int s = 32 * sb + 16 * st2 + 8 * (jj >> 2) + 4 * hh + (jj & 3); const int rows = base_row + (DIR ? 63 - s : s);
            VA[jj] = (short)ZB[(unsigned)(rows * 1024 + 512 + h * 64 + v)]; }
        const bf16x8 PB = pack8(S[8 * st2 + 0], S[8 * st2 + 1], S[8 * st2 + 2], S[8 * st2 + 3], S[8 * st2 + 4], S[8 * st2 + 5], S[8 * st2 + 6], S[8 * st2 + 7]);
        O = MFMA32(VA, PB, O);
        __builtin_amdgcn_sched_barrier(0);
    }
}
template <int DIR>
__device__ __forceinline__ void ml_out_dir(const KA& A, const Ctx& C, LAS float* H, int b, int h, int c, int base_row, int lane) {
    const bf16* ZB = (const bf16*)(A.ws() + WS_ZB); const float* GT = (const float*)(A.ws() + WS_G);
    const float* CST = (const float*)(A.ws() + WS_CST); const float* MS = (const float*)(A.ws() + WS_MS);
    const int r = lane & 31, hh = lane >> 5;
    const int j = DIR ? (c < 4 ? 3 - c : 263 - c) : c;
    const int sq = (b * 4 + h) * 2 + DIR;
    const float* Cp = CST + ((size_t)sq * NCH + j) * CSTF;
    const float m0 = MS[sq * NCH + j];
    const int rowl = base_row + (DIR ? 63 - lane : lane);
    const float gi = GT[(size_t)rowl * 16 + DIR * 8 + h], lf = GT[(size_t)rowl * 16 + DIR * 8 + 4 + h];
    float bs = lf;
#pragma unroll
    for (int o = 1; o < 64; o <<= 1) { const float tv = shfl_idx(bs, lane - o); if (lane >= o) bs += tv; }
    const float a = gi - bs;
    float pm = a;
#pragma unroll
    for (int o = 1; o < 64; o <<= 1) { const float tv = shfl_idx(pm, lane - o); if (lane >= o) pm = fmaxf(pm, tv); }
#pragma unroll 1
    for (int jb = 0; jb < 2; ++jb) {
        const int jl = 32 * jb + r;
        const float bj = shfl_idx(bs, jl), Mj = fmaxf(m0, shfl_idx(pm, jl));
        const int rowj = base_row + (DIR ? 63 - jl : jl);
        const int tok = DIR ? 63 - jl : jl;
        bf16x8 Qf[4];
#pragma unroll
        for (int st = 0; st < 4; ++st) Qf[st] = *(const bf16x8*)(ZB + (unsigned)(rowj * 1024 + h * 64 + st * 16 + hh * 8));
        f32x16 S0, S1 = ML_ZERO16; float den = 0.f;
        ml_sblock<DIR>(S0, den, ZB, Qf, 0, base_row, h, r, hh, jl, a, Mj);
        if (jb == 1) ml_sblock<DIR>(S1, den, ZB, Qf, 1, base_row, h, r, hh, jl, a, Mj);
        den += shfl_idx(den, lane ^ 32);
        const float wi = __expf(m0 - Mj) * 0.125f;
        float nq = 0.f;
#pragma unroll
        for (int st = 0; st < 4; ++st) { const f32x4 n0 = *(const f32x4*)(Cp + 4096 + st * 16 + hh * 8), n1 = *(const f32x4*)(Cp + 4096 + st * 16 + hh * 8 + 4);
            const u32x4 qw = __builtin_bit_cast(u32x4, Qf[st]);
            nq += n0.x * bflo(qw.x) + n0.y * bfhi(qw.x) + n0.z * bflo(qw.y) + n0.w * bfhi(qw.y) + n1.x * bflo(qw.z) + n1.y * bfhi(qw.z) + n1.z * bflo(qw.w) + n1.w * bfhi(qw.w); }
        nq += shfl_idx(nq, lane ^ 32);
        den += wi * nq;
        const float inv = 1.0f / fmaxf(fabsf(den), __expf(-(bj + Mj)));
#pragma unroll 1
        for (int vb = 0; vb < 2; ++vb) {
            const int v = 32 * vb + r;
            f32x16 O = ML_ZERO16;
            ml_pv<DIR>(O, S0, ZB, 0, base_row, h, v, hh);
            if (jb == 1) ml_pv<DIR>(O, S1, ZB, 1, base_row, h, v, hh);
            f32x16 I = ML_ZERO16;
#pragma unroll
            for (int st = 0; st < 4; ++st) { const float* cr = Cp + (size_t)v * 64 + st * 16 + hh * 8; const f32x4 c0 = *(const f32x4*)cr, c1 = *(const f32x4*)(cr + 4);
                const bf16x8 CA = pack8(c0.x, c0.y, c0.z, c0.w, c1.x, c1.y, c1.z, c1.w); I = MFMA32(CA, Qf[st], I); __builtin_amdgcn_sched_barrier(0); }
#pragma unroll
            for (int g = 0; g < 16; ++g) { const float hv = (O[g] + wi * I[g]) * inv; const int idx = (32 * vb + crow(g, hh)) * 65 + tok;
                if (DIR == 1) H[idx] = hv; else H[idx] += hv; }
        }
    }
}
__device__ __forceinline__ void phase_ml_out(int l) {
    const KA A = ka_fresh(); const Ctx C = ctx_fresh();
    const int gw = C.bid * 8 + C.wave, NGW = C.G * 8, lane = C.lane;
    const bf16* ZB = (const bf16*)(A.ws() + WS_ZB); bf16* MIX = (bf16*)(A.ws() + WS_MIX);
    LAS float* H = (LAS float*)(C.lds + C.wave * 16640);
    const int c_lo = (l == 1) ? 4 : 0, ncu = NCH - c_lo;
    for (int u = gw; u < 8 * ncu; u += NGW) {
        const int c = c_lo + u % ncu, bh = u / ncu, h = bh & 3, b = bh >> 2;
        const int base_row = c < 4 ? RL + b * CTXL + 64 * c : b * SEQ + 64 * (c - 4);
        ml_out_dir<1>(A, C, H, b, h, c, base_row, lane);
        LDS_WAIT(); asm volatile("" ::: "memory");
        ml_out_dir<0>(A, C, H, b, h, c, base_row, lane);
        LDS_WAIT(); asm volatile("" ::: "memory");
        float ss = 0.f;
#pragma unroll 8
        for (int v = 0; v < 64; ++v) { const float x = H[v * 65 + lane]; ss += x * x; }
        const float rs = 1.0f / sqrtf(ss * (1.f / 64.f) + EPS);
        const float gnv = A.in(18)[l * 256 + h * 64 + lane];
#pragma unroll 4
        for (int t = 0; t < 64; ++t) {
            const float rst = __builtin_bit_cast(float, __builtin_amdgcn_readlane(__builtin_bit_cast(int, rs), t));
            const size_t off = (size_t)(base_row + t) * 1024 + 768 + h * 64 + lane;
            const float o = bf2f(ZB[off]); const float sg = 1.0f / (1.0f + __expf(-o));
            MIX[off] = (bf16)f2bf(H[lane * 65 + t] * rst * gnv * sg);
        }
        LDS_WAIT(); asm volatile("" ::: "memory");
    }
}

__device__ __forceinline__ void glds16s(unsigned voff, const unsigned char* sbase, unsigned lds_dst) {
    unsigned keep;
    asm volatile("s_mov_b32 %0, m0\n\ts_mov_b32 m0, %3\n\ts_nop 0\n\tglobal_load_lds_dwordx4 %1, %2\n\ts_mov_b32 m0, %0" : "=&s"(keep) : "v"(voff), "s"(sbase), "s"(lds_dst) : "memory");
}
#define ATT_WAIT_BAR(N) asm volatile("s_waitcnt vmcnt(" #N ") lgkmcnt(0)\n\ts_barrier" ::: "memory")
constexpr int ATT_SLOT = 16384, ATT_NS = 6;
typedef int i32x8 __attribute__((ext_vector_type(8)));
#define MFMA8(a, b, c) __builtin_amdgcn_mfma_scale_f32_32x32x64_f8f6f4((a), (b), (c), 0, 0, 0, 127, 0, 127)
template <bool FIXEDREF>
__device__ __forceinline__ void attn_unit(const KA& A, const Ctx& C, int bh, int qrow0, int tile_lo, int ntiles) {
    int lane_ = C.lane; asm volatile("" : "+v"(lane_));
    const int lane = lane_, r = lane & 31, hh = lane >> 5, h = bh & 7;
    bf16* MIX = (bf16*)(A.ws() + WS_MIX);
    LAS unsigned char* lds = C.lds;
    const unsigned lds0 = (unsigned)(uintptr_t)lds;
    const int qrow = qrow0 + C.wave * 32 + r;
    const unsigned char* kg = A.ws() + WS_KN + ((size_t)bh * NKT + tile_lo) * KT_BYTES;
    const unsigned char* vg = A.ws() + WS_VT + ((size_t)bh * NKT + tile_lo) * VT_BYTES;
    const unsigned vo0 = (unsigned)(C.wave * 1024 + lane * 16);
    const unsigned d0 = lds0 + C.wave * 1024, d1 = d0 + 8192;
    int islot = 0;
#define ATT_ISSUE() do { const unsigned so_ = (unsigned)islot * ATT_SLOT; islot = (islot == ATT_NS - 1) ? 0 : islot + 1; \
        glds16s(vo0, kg, (unsigned)__builtin_amdgcn_readfirstlane(d0 + so_)); glds16s(vo0, vg, (unsigned)__builtin_amdgcn_readfirstlane(d1 + so_)); \
        kg += KT_BYTES; vg += VT_BYTES; } while (0)
    ATT_ISSUE(); ATT_ISSUE(); ATT_ISSUE();
    i32x8 qf[2];
    { const unsigned char* q8 = A.ws() + WS_Q8 + (size_t)qrow * 1024 + h * 128 + hh * 32;
#pragma unroll
      for (int st = 0; st < 2; ++st) { const u32x4 a = *(const u32x4*)(q8 + st * 64), b = *(const u32x4*)(q8 + st * 64 + 16);
          qf[st] = (i32x8){(int)a.x, (int)a.y, (int)a.z, (int)a.w, (int)b.x, (int)b.y, (int)b.z, (int)b.w}; } }
    f32x16 o0 = (f32x16){0.f, 0.f, 0.f, 0.f, 0.f, 0.f, 0.f, 0.f, 0.f, 0.f, 0.f, 0.f, 0.f, 0.f, 0.f, 0.f}, o1 = o0;
    float m = 0.f, lsum = 0.f;
    constexpr float THR = 8.f;
    const int ksw = (r >> 1) & 7;
    int cslot = 0, nslot = 1;
#define ATT_ADV() do { cslot = nslot; nslot = (nslot == ATT_NS - 1) ? 0 : nslot + 1; } while (0)
#define ATT_QKT(P0, P1, sl) do { const LAS unsigned char* Kb_ = lds + (sl) * ATT_SLOT + r * 128; P0 = ML_ZERO16; P1 = ML_ZERO16; \
        _Pragma("unroll") for (int st = 0; st < 2; ++st) { \
            const u32x4 a_ = *(const LAS u32x4*)(Kb_ + (((st * 4 + hh * 2) ^ ksw) << 4)), b_ = *(const LAS u32x4*)(Kb_ + (((st * 4 + hh * 2 + 1) ^ ksw) << 4)); \
            const u32x4 c_ = *(const LAS u32x4*)(Kb_ + 4096 + (((st * 4 + hh * 2) ^ ksw) << 4)), d_ = *(const LAS u32x4*)(Kb_ + 4096 + (((st * 4 + hh * 2 + 1) ^ ksw) << 4)); \
            P0 = MFMA8(((i32x8){(int)a_.x, (int)a_.y, (int)a_.z, (int)a_.w, (int)b_.x, (int)b_.y, (int)b_.z, (int)b_.w}), qf[st], P0); \
            P1 = MFMA8(((i32x8){(int)c_.x, (int)c_.y, (int)c_.z, (int)c_.w, (int)d_.x, (int)d_.y, (int)d_.z, (int)d_.w}), qf[st], P1); } } while (0)
#define ATT_H1(C0, C1, N0, N1, tt) do { \
        const bool more_ = (tt) + 1 < ntiles; \
        if ((tt) + 3 < ntiles) ATT_ISSUE(); \
        if (more_) ATT_QKT(N0, N1, nslot); \
        if (!FIXEDREF) { \
        float ta_ = __builtin_fmaxf(__builtin_fmaxf(C0[0], C0[1]), C0[2]), tb_ = __builtin_fmaxf(__builtin_fmaxf(C0[3], C0[4]), C0[5]), tc_ = __builtin_fmaxf(__builtin_fmaxf(C1[0], C1[1]), C1[2]), td_ = __builtin_fmaxf(__builtin_fmaxf(C1[3], C1[4]), C1[5]);     \
        _Pragma("unroll") for (int g = 6; g < 16; g += 2) { ta_ = __builtin_fmaxf(__builtin_fmaxf(ta_, C0[g]), C0[g + 1]); tc_ = __builtin_fmaxf(__builtin_fmaxf(tc_, C1[g]), C1[g + 1]); } \
        float tm_ = __builtin_fmaxf(__builtin_fmaxf(ta_, tb_), __builtin_fmaxf(tc_, td_)); \
        { const auto rr_ = __builtin_amdgcn_permlane32_swap(__builtin_bit_cast(unsigned, tm_), __builtin_bit_cast(unsigned, tm_), false, false);     \
          tm_ = __builtin_fmaxf(__builtin_bit_cast(float, rr_[0]), __builtin_bit_cast(float, rr_[1])); } \
        if ((tt) == 0) m = tm_;                             \
        else if (__any(tm_ - m > THR)) {                    \
            const float mn_ = __builtin_fmaxf(tm_, m), alpha_ = __builtin_amdgcn_exp2f(m - mn_); m = mn_; lsum *= alpha_; \
            _Pragma("unroll") for (int g = 0; g < 16; ++g) { o0[g] *= alpha_; o1[g] *= alpha_; } \
        } } } while (0)
#define ATT_H2(C0, C1, sl) do { \
        if (!FIXEDREF) { _Pragma("unroll") for (int g = 0; g < 16; ++g) { C0[g] -= m; C1[g] -= m; } } \
        float pa_ = 0.f, pb2_ = 0.f, pc_ = 0.f, pd_ = 0.f;                                      \
        _Pragma("unroll") for (int g = 0; g < 16; g += 2) { C0[g] = __builtin_amdgcn_exp2f(C0[g]); C0[g + 1] = __builtin_amdgcn_exp2f(C0[g + 1]); C1[g] = __builtin_amdgcn_exp2f(C1[g]); C1[g + 1] = __builtin_amdgcn_exp2f(C1[g + 1]); \
            pa_ += C0[g]; pb2_ += C0[g + 1]; pc_ += C1[g]; pd_ += C1[g + 1]; } \
        lsum += (pa_ + pb2_) + (pc_ + pd_); \
        bf16x8 pb_[2][2]; \
        pb_[0][0] = pack8(C0[0], C0[1], C0[2], C0[3], C0[4], C0[5], C0[6], C0[7]); pb_[0][1] = pack8(C0[8], C0[9], C0[10], C0[11], C0[12], C0[13], C0[14], C0[15]); \
        pb_[1][0] = pack8(C1[0], C1[1], C1[2], C1[3], C1[4], C1[5], C1[6], C1[7]); pb_[1][1] = pack8(C1[8], C1[9], C1[10], C1[11], C1[12], C1[13], C1[14], C1[15]); \
        const LAS unsigned char* Vb_ = lds + (sl) * ATT_SLOT + KT_BYTES; \
        { const int sw_ = (r >> 1) & 7; const LAS unsigned char* vrow_ = Vb_ + r * 128;        \
            _Pragma("unroll") for (int kb = 0; kb < 2; ++kb) _Pragma("unroll") for (int s2 = 0; s2 < 2; ++s2) { \
                const bf16x8 va_ = *(const LAS bf16x8*)(vrow_ + (((kb * 4 + s2 * 2 + hh) ^ sw_) << 4)), vb_ = *(const LAS bf16x8*)(vrow_ + 4096 + (((kb * 4 + s2 * 2 + hh) ^ sw_) << 4)); \
                o0 = MFMA32(va_, pb_[kb][s2], o0); o1 = MFMA32(vb_, pb_[kb][s2], o1); } } \
    } while (0)
#define ATT_SYNC(tt) do { if ((tt) + 2 < ntiles) ATT_WAIT_BAR(2); else ATT_WAIT_BAR(0); } while (0)
    f32x16 sA0, sA1, sB0, sB1;
    ATT_WAIT_BAR(4);
    ATT_QKT(sA0, sA1, 0);
    if (C.wave < 4) {
#pragma unroll 1
        for (int t = 0; t < ntiles; t += 2) {
            if (t + 1 < ntiles) ATT_SYNC(t);
            ATT_H1(sA0, sA1, sB0, sB1, t); ATT_H2(sA0, sA1, cslot); ATT_ADV();
            if (t + 2 < ntiles) ATT_SYNC(t + 1);
            ATT_H1(sB0, sB1, sA0, sA1, t + 1); ATT_H2(sB0, sB1, cslot); ATT_ADV();
        }
    } else {
        ATT_SYNC(0);
        ATT_H1(sA0, sA1, sB0, sB1, 0);
#pragma unroll 1
        for (int t = 1; t + 1 < ntiles; t += 2) {
            ATT_SYNC(t);
            ATT_H2(sA0, sA1, cslot); ATT_ADV(); ATT_H1(sB0, sB1, sA0, sA1, t);
            ATT_SYNC(t + 1);
            ATT_H2(sB0, sB1, cslot); ATT_ADV(); ATT_H1(sA0, sA1, sB0, sB1, t + 1);
        }
        ATT_H2(sA0, sA1, cslot); ATT_ADV(); ATT_H1(sB0, sB1, sA0, sA1, ntiles - 1);
        ATT_H2(sB0, sB1, cslot); ATT_ADV();
    }
#undef ATT_QKT
#undef ATT_H1
#undef ATT_H2
#undef ATT_SYNC
#undef ATT_ADV
    asm volatile("s_waitcnt lgkmcnt(0)\n\ts_barrier" ::: "memory");
#undef ATT_ISSUE
    lsum += shfl_idx(lsum, lane ^ 32);
    const float inv = 1.0f / lsum;
    { LAS bf16* stg = (LAS bf16*)(lds + ATT_NS * ATT_SLOT + C.wave * 4352);
#pragma unroll
      for (int g = 0; g < 16; ++g) { const int d = crow(g, hh); stg[r * 68 + d] = (bf16)f2bf(o0[g] * inv); stg[r * 68 + 32 + d] = (bf16)f2bf(o1[g] * inv); }
      LDS_WAIT(); asm volatile("" ::: "memory");
      bf16* ob = MIX + (size_t)(qrow0 + C.wave * 32) * 1024 + 256 + h * 64;
#pragma unroll
      for (int i = 0; i < 4; ++i) { const int row = i * 8 + (lane >> 3), ch = lane & 7;
          const u32x2 a = *(const LAS u32x2*)(stg + row * 68 + ch * 8), b = *(const LAS u32x2*)(stg + row * 68 + ch * 8 + 4);
          u32x4 v; v.x = a.x; v.y = a.y; v.z = b.x; v.w = b.y; *(u32x4*)(ob + (size_t)row * 1024 + ch * 8) = v; }
      LDS_WAIT(); asm volatile("" ::: "memory"); }
}
__device__ __forceinline__ void phase_attn(int l) {
    const KA A = ka_fresh(); const Ctx C = ctx_fresh();
    const int G = C.G;
    bool fixedref;
    { const int lane = C.lane; const float* qg = A.in(15) + l * 96; const float* kg = A.in(16) + l * 96;
      const float gq = wave_max(fmaxf(fabsf(qg[lane]), lane < 32 ? fabsf(qg[64 + lane]) : 0.f), lane), gk = wave_max(fmaxf(fabsf(kg[lane]), lane < 32 ? fabsf(kg[64 + lane]) : 0.f), lane);
      fixedref = (96.f * QSCALE * gq * gk) < 100.f; }
    for (int u = C.bid; u < 1024 + (l == 1 ? 0 : 16); u += G) {
        if (u < 1024) {
            int pair, qb;
            if (G == 256) { const int vcu = u & 255, rnd = u >> 8; pair = 2 * (vcu & 7) + (rnd >> 1); qb = (vcu >> 3) + 32 * (rnd & 1); }
            else { pair = u >> 6; qb = u & 63; }
            if (fixedref) attn_unit<true>(A, C, pair, (pair >> 3) * SEQ + qb * 256, 0, NKT); else attn_unit<false>(A, C, pair, (pair >> 3) * SEQ + qb * 256, 0, NKT);
        } else { const int pair = u - 1024;
            if (fixedref) attn_unit<true>(A, C, pair, RL + (pair >> 3) * CTXL, NKT - 4, 4); else attn_unit<false>(A, C, pair, RL + (pair >> 3) * CTXL, NKT - 4, 4); }
    }
}

__device__ __forceinline__ int dealt_unit(int k, int gw, int ngw, int n) {
    const int R = n / ngw;
    if (k < R) return gw + k * ngw;
    if (k > R || (gw & 4)) return -1;
    const int e = (gw >> 3) * 4 + (gw & 3);
    return (R * ngw + e < n) ? R * ngw + e : -1;
}
__device__ __forceinline__ int f2key(float f) { const int b = __builtin_bit_cast(int, f); return b ^ ((b >> 31) & 0x7fffffff); }
__device__ __forceinline__ float key2f(int k) { return __builtin_bit_cast(float, k ^ ((k >> 31) & 0x7fffffff)); }
__device__ __forceinline__ void topk_ins(int (&lst)[16], int v) {
#pragma unroll
    for (int i = 0; i < 16; ++i) { const int hi = max(lst[i], v); v = min(lst[i], v); lst[i] = hi; }
}
__device__ __forceinline__ void bitonic_sort16_desc(int (&a)[16]) {
#pragma unroll
    for (int k = 2; k <= 16; k <<= 1)
#pragma unroll
        for (int j = k >> 1; j > 0; j >>= 1)
#pragma unroll
            for (int i = 0; i < 16; ++i) { const int p = i ^ j;
                if (p > i) { const int hi = max(a[i], a[p]), lo = min(a[i], a[p]); const bool desc = ((i & k) == 0) || (k == 16); a[i] = desc ? hi : lo; a[p] = desc ? lo : hi; } }
}
__device__ __forceinline__ void merge16_desc(int (&lst)[16], const int (&nw)[16]) {
#pragma unroll
    for (int i = 0; i < 16; ++i) lst[i] = max(lst[i], nw[15 - i]);
#pragma unroll
    for (int j = 8; j > 0; j >>= 1)
#pragma unroll
        for (int i = 0; i < 16; ++i) { const int p = i ^ j; if (p > i) { const int hi = max(lst[i], lst[p]), lo = min(lst[i], lst[p]); lst[i] = hi; lst[p] = lo; } }
}
__device__ __forceinline__ void topk_half(int (&lst)[16], const bf16* qp, const bf16* skp, int hh, int lane) {
    bf16x8 bq[8];
#pragma unroll
    for (int st = 0; st < 8; ++st) bq[st] = *(const bf16x8*)(qp + st * 16);
#pragma unroll
    for (int i = 0; i < 16; ++i) lst[i] = f2key(-3.0e38f);
    bf16x8 an[8];
#pragma unroll
    for (int st = 0; st < 8; ++st) an[st] = *(const bf16x8*)(skp + st * 16);
#pragma unroll 1
    for (int blk = 0; blk < 4; ++blk) {
        f32x16 acc = (f32x16){0.f, 0.f, 0.f, 0.f, 0.f, 0.f, 0.f, 0.f, 0.f, 0.f, 0.f, 0.f, 0.f, 0.f, 0.f, 0.f};
#pragma unroll
        for (int st = 0; st < 8; ++st) acc = MFMA32(an[st], bq[st], acc);
        if (blk < 3) {
#pragma unroll
            for (int st = 0; st < 8; ++st) an[st] = *(const bf16x8*)(skp + (blk + 1) * 32 * 128 + st * 16); }
        int nk[16];
#pragma unroll
        for (int g = 0; g < 16; ++g) { const unsigned n = (unsigned)(blk * 32 + crow(g, hh));
            const float sv = acc[g];
            nk[g] = f2key(__builtin_bit_cast(float, (__builtin_bit_cast(unsigned, sv) & ~127u) | n)); }
        bitonic_sort16_desc(nk);
        merge16_desc(lst, nk);
    }
    int oth[16];
#pragma unroll
    for (int i = 0; i < 16; ++i) oth[i] = shfl_idx(lst[i], lane ^ 32);
    merge16_desc(lst, oth);
}
__device__ __forceinline__ void phase_topk(int l) {
    const KA A = ka_fresh(); const Ctx C = ctx_fresh();
    const int gw = C.bid * 8 + C.wave, NGW = C.G * 8, lane = C.lane, r = lane & 31, hh = lane >> 5;
    const bf16* PQ = (const bf16*)(A.ws() + WS_PQ); const bf16* SK = (const bf16*)(A.ws() + WS_SUBK);
    int* EID = (int*)(A.ws() + WS_EID); float* GATE = (float*)(A.ws() + WS_GATE);
    const int nrows = (l == 1) ? RL : RT;
    for (int k = 0;; ++k) { const int unit = dealt_unit(k, gw, NGW, (nrows / 32) * 8); if (unit < 0) break;
        const int h = unit & 7, r0 = (unit >> 3) * 32; const size_t row = (size_t)(r0 + r);
        int L[2][16];
        topk_half(L[0], PQ + row * 2048 + h * 256 + hh * 8, SK + ((size_t)((l * 8 + h) * 2 + 0) * 128 + r) * 128 + hh * 8, hh, lane);
        __builtin_amdgcn_sched_barrier(0);
        topk_half(L[1], PQ + row * 2048 + h * 256 + 128 + hh * 8, SK + ((size_t)((l * 8 + h) * 2 + 1) * 128 + r) * 128 + hh * 8, hh, lane);
        __builtin_amdgcn_sched_barrier(0);
        int best[16];
#pragma unroll
        for (int j = 0; j < 16; ++j) best[j] = f2key(__builtin_bit_cast(float, (__builtin_bit_cast(unsigned, key2f(L[0][0]) + key2f(L[1][j])) & ~255u) | (unsigned)j));
#pragma unroll
        for (int i = 1; i < 16; ++i)
#pragma unroll
            for (int j = 0; j < 16; ++j)
                if ((i + 1) * (j + 1) <= 16) topk_ins(best, f2key(__builtin_bit_cast(float, (__builtin_bit_cast(unsigned, key2f(L[0][i]) + key2f(L[1][j])) & ~255u) | (unsigned)(i * 16 + j))));
        float ev[16]; float esum = 0.f;
        const float mx = __builtin_bit_cast(float, __builtin_bit_cast(unsigned, key2f(best[0])) & ~255u);
#pragma unroll
        for (int k = 0; k < 16; ++k) { ev[k] = __expf(__builtin_bit_cast(float, __builtin_bit_cast(unsigned, key2f(best[k])) & ~255u) - mx); esum += ev[k]; }
        const float einv = 1.0f / esum;
#pragma unroll
        for (int k = 0; k < 8; ++k) {
            const int b_lo = best[k], b_hi = best[k + 8]; const float e_lo = ev[k], e_hi = ev[k + 8];
            const int bk = hh ? b_hi : b_lo; const float gk = (hh ? e_hi : e_lo) * einv;
            const unsigned code = __builtin_bit_cast(unsigned, key2f(bk)) & 255u;
            const unsigned ci = code >> 4, cj = code & 15u; unsigned n0 = 0u, n1 = 0u;
#pragma unroll
            for (int i = 0; i < 16; ++i) { n0 = (ci == (unsigned)i) ? (__builtin_bit_cast(unsigned, key2f(L[0][i])) & 127u) : n0; n1 = (cj == (unsigned)i) ? (__builtin_bit_cast(unsigned, key2f(L[1][i])) & 127u) : n1; }
            EID[row * 128 + h * 16 + hh * 8 + k] = (int)(n0 * 128u + n1); GATE[row * 128 + h * 16 + hh * 8 + k] = gk;
        }
    }
}
typedef float f32x2v __attribute__((ext_vector_type(2)));
typedef unsigned u32x6 __attribute__((ext_vector_type(6)));
typedef float f32x32 __attribute__((ext_vector_type(32)));
#ifndef FFN_B
#define FFN_B 8
#endif
__device__ __forceinline__ void phase_ffn(int l) {
    const KA A = ka_fresh(); const Ctx C = ctx_fresh();
    const int gw = C.bid * 8 + C.wave, NGW = C.G * 8, lane = C.lane;
    const bf16* XN = (const bf16*)(A.ws() + WS_XN); const unsigned char* TU = A.ws() + WS_TABU; const unsigned char* TV = A.ws() + WS_TABV;
    const int* EID = (const int*)(A.ws() + WS_EID); const float* GATE = (const float*)(A.ws() + WS_GATE);
    const float* MOD = (const float*)(A.ws() + WS_MOD);
    const int nrows = (l == 1) ? RL : RT;
    for (int k = 0;; ++k) { const int row = dealt_unit(k, gw, NGW, nrows); if (row < 0) break;
        f32x2_t hv[8];
        { const u32x4 a = *(const u32x4*)(XN + (size_t)row * DM + lane * 16), b = *(const u32x4*)(XN + (size_t)row * DM + lane * 16 + 8);
          hv[0] = (f32x2_t){bflo(a.x), bfhi(a.x)}; hv[1] = (f32x2_t){bflo(a.y), bfhi(a.y)}; hv[2] = (f32x2_t){bflo(a.z), bfhi(a.z)}; hv[3] = (f32x2_t){bflo(a.w), bfhi(a.w)};
          hv[4] = (f32x2_t){bflo(b.x), bfhi(b.x)}; hv[5] = (f32x2_t){bflo(b.y), bfhi(b.y)}; hv[6] = (f32x2_t){bflo(b.z), bfhi(b.z)}; hv[7] = (f32x2_t){bflo(b.w), bfhi(b.w)}; }
        f32x2_t out[8];
#pragma unroll
        for (int i = 0; i < 8; ++i) out[i] = (f32x2_t){0.f, 0.f};
        const int idA = EID[(size_t)row * 128 + lane], idB = EID[(size_t)row * 128 + 64 + lane]; const float gtA = GATE[(size_t)row * 128 + lane], gtB = GATE[(size_t)row * 128 + 64 + lane];
        int ln = lane; asm volatile("" : "+v"(ln));
        const bool b0 = ln & 1, b1 = ln & 2; const int q4 = ln >> 2, x16 = ln ^ 16, x32 = ln ^ 32;
        float dA = 0.f, dB = 0.f;
#define FFN_LOADU(UU, ID, e0) do { _Pragma("unroll") for (int k = 0; k < FFN_B; ++k) { const int id_ = __builtin_amdgcn_readlane(ID, (e0) + k); UU[k] = *(const U3*)(TU + (size_t)id_ * TROW + lane * 12); } } while (0)
#define FFN_DOT4(UU, DV, e0) do { _Pragma("unroll") for (int g4 = 0; g4 < FFN_B; g4 += 4) { float p_[4]; \
            _Pragma("unroll") for (int k = 0; k < 4; k += 2) { \
                const u32x6 us_ = {UU[g4 + k].a, UU[g4 + k].b, UU[g4 + k].c, UU[g4 + k + 1].a, UU[g4 + k + 1].b, UU[g4 + k + 1].c}; \
                const f32x32 uf_ = __builtin_amdgcn_cvt_scalef32_pk32_f32_fp6(us_, 1.0f);        \
                f32x2_t d0_ = {0.f, 0.f}, d1_ = {0.f, 0.f}; \
                _Pragma("unroll") for (int i = 0; i < 8; ++i) { d0_ = hv[i] * (f32x2_t){uf_[2 * i], uf_[2 * i + 1]} + d0_; d1_ = hv[i] * (f32x2_t){uf_[16 + 2 * i], uf_[17 + 2 * i]} + d1_; } \
                p_[k] = d0_.x + d0_.y; p_[k + 1] = d1_.x + d1_.y; } \
            float x01_ = b0 ? p_[1] : p_[0], y01_ = b0 ? p_[0] : p_[1], x23_ = b0 ? p_[3] : p_[2], y23_ = b0 ? p_[2] : p_[3]; \
            x01_ += __builtin_bit_cast(float, __builtin_amdgcn_update_dpp(0, __builtin_bit_cast(int, y01_), 0xB1, 0xf, 0xf, true)); \
            x23_ += __builtin_bit_cast(float, __builtin_amdgcn_update_dpp(0, __builtin_bit_cast(int, y23_), 0xB1, 0xf, 0xf, true)); \
            float x_ = b1 ? x23_ : x01_; const float y_ = b1 ? x01_ : x23_; \
            x_ += __builtin_bit_cast(float, __builtin_amdgcn_update_dpp(0, __builtin_bit_cast(int, y_), 0x4E, 0xf, 0xf, true)); \
            DPP_ADD(x_, 0x124); DPP_ADD(x_, 0x128);                  \
            x_ += shfl_idx(x_, x16); x_ += shfl_idx(x_, x32);       \
            DV = (q4 == (((e0) + g4) >> 2)) ? x_ : DV; } } while (0)
        { U3 ua[FFN_B], ub[FFN_B];
          FFN_LOADU(ua, idA, 0);
#pragma unroll 1
          for (int e = 0; e < 64; e += 2 * FFN_B) { FFN_LOADU(ub, idA, e + FFN_B); FFN_DOT4(ua, dA, e); if (e + 2 * FFN_B < 64) FFN_LOADU(ua, idA, e + 2 * FFN_B); else FFN_LOADU(ua, idB, 0); FFN_DOT4(ub, dA, e + FFN_B); }
#pragma unroll 1
          for (int e = 0; e < 64; e += 2 * FFN_B) { FFN_LOADU(ub, idB, e + FFN_B); FFN_DOT4(ua, dB, e); if (e + 2 * FFN_B < 64) FFN_LOADU(ua, idB, e + 2 * FFN_B); FFN_DOT4(ub, dB, e + FFN_B); } }
#undef FFN_LOADU
#undef FFN_DOT4
        const float wA = gtA * gelu_f(dA * (1.0f / U_SCALE)) * (1.0f / V_SCALE), wB = gtB * gelu_f(dB * (1.0f / U_SCALE)) * (1.0f / V_SCALE);
#define FFN_LOADV(VV, ID, e0) do { _Pragma("unroll") for (int k = 0; k < FFN_B; ++k) { const int id_ = __builtin_amdgcn_readlane(ID, (e0) + k); VV[k] = *(const U3*)(TV + (size_t)id_ * TROW + lane * 12); } } while (0)
#define FFN_ACC4(VV, WV, e0) do { _Pragma("unroll") for (int k = 0; k < FFN_B; k += 2) { \
            const float w0_ = __builtin_bit_cast(float, __builtin_amdgcn_readlane(__builtin_bit_cast(int, WV), (e0) + k)), w1_ = __builtin_bit_cast(float, __builtin_amdgcn_readlane(__builtin_bit_cast(int, WV), (e0) + k + 1)); \
            const u32x6 vs_ = {VV[k].a, VV[k].b, VV[k].c, VV[k + 1].a, VV[k + 1].b, VV[k + 1].c}; \
            const f32x32 vf_ = __builtin_amdgcn_cvt_scalef32_pk32_f32_fp6(vs_, 1.0f); \
            const f32x2_t w0p_ = {w0_, w0_}, w1p_ = {w1_, w1_}; \
            _Pragma("unroll") for (int i = 0; i < 8; ++i) { out[i] = w0p_ * (f32x2_t){vf_[2 * i], vf_[2 * i + 1]} + out[i]; out[i] = w1p_ * (f32x2_t){vf_[16 + 2 * i], vf_[17 + 2 * i]} + out[i]; } } } while (0)
        { U3 va[FFN_B], vb[FFN_B];
          FFN_LOADV(va, idA, 0);
#pragma unroll 1
          for (int e = 0; e < 64; e += 2 * FFN_B) { FFN_LOADV(vb, idA, e + FFN_B); FFN_ACC4(va, wA, e); if (e + 2 * FFN_B < 64) FFN_LOADV(va, idA, e + 2 * FFN_B); else FFN_LOADV(va, idB, 0); FFN_ACC4(vb, wA, e + FFN_B); }
#pragma unroll 1
          for (int e = 0; e < 64; e += 2 * FFN_B) { FFN_LOADV(vb, idB, e + FFN_B); FFN_ACC4(va, wB, e); if (e + 2 * FFN_B < 64) FFN_LOADV(va, idB, e + 2 * FFN_B); FFN_ACC4(vb, wB, e + FFN_B); } }
#undef FFN_LOADV
#undef FFN_ACC4
        const int nsel = row < RL ? (row >> 14) : 2;
        const float* gf = MOD + (l * 3 + nsel) * 6144 + 5 * 1024;
        float* xr = stream_out(A, C, row);
#pragma unroll
        for (int q = 0; q < 4; ++q) { const int j = lane * 16 + q * 4;
            const f32x4 x = *(const f32x4*)(xr + j); f32x4 g = *(const f32x4*)(gf + j);
            f32x4 o; o.x = x.x + g.x * out[q * 2].x; o.y = x.y + g.y * out[q * 2].y; o.z = x.z + g.z * out[q * 2 + 1].x; o.w = x.w + g.w * out[q * 2 + 1].y;
            *(f32x4*)(xr + j) = o; }
    }
}

template <class Epi>
__device__ __forceinline__ void run_gemm(const pg8::bf16_t* Amat, const pg8::bf16_t* Bt, int N, int K, const Epi& E, int M = RT) {
    const Ctx C = ctx_fresh();
    pg8::Gemm g{Amat, Bt, M, N, K}; pg8::StaticOrder S; S.init(M, N, C.G, C.bid);
    pg8::gemm_phase<Epi, pg8::StaticOrder, true, true>(C.lds, g, S, E);
}
__device__ __forceinline__ void seam() {
    const KA A = ka_fresh(); const Ctx C = ctx_fresh();
    XcdBarrier b; b.bar = (unsigned*)(A.ws() + WS_CTL) + CW_BAR; b.x = xb_xcc_id(); b.st = (volatile LAS unsigned*)(C.lds + MISC_OFF) + 8;
    xcd_barrier(b);
}
#define IN(k) (lo <= (k) && (k) < hi)
#define SEAM(k) do { if (IN(k) && IN((k) + 1)) seam(); } while (0)
template <int l>
__device__ __forceinline__ void layer_body(const int lo, const int hi) {
        const int p0 = 1 + NPH_L * l;
        if (IN(p0 + 0)) { phase_norm(l, 0); phase_tables(l); }
        SEAM(p0 + 0);
        if (IN(p0 + 1)) {
            const KA A = ka_fresh(); unsigned char* ws = A.ws();
            pg8::EpiBf16<0> E{(pg8::bf16_t*)(ws + WS_ZA), 1024, nullptr, 1024, (size_t)(WS_ZB - WS_ZA) / 2, 1.f};
            run_gemm(( const pg8::bf16_t*)(ws + WS_XN), (const pg8::bf16_t*)(ws + WS_WIN) + (size_t)l * 2048 * DM, 2048, DM, E);
        }
        SEAM(p0 + 1);
        if (IN(p0 + 2)) phase_post(l);
        SEAM(p0 + 2);
        if (IN(p0 + 3)) {
#pragma unroll 1
            for (int gi = 0; gi < 2; ++gi) {
                const KA A = ka_fresh(); unsigned char* ws = A.ws();
                const int N = gi ? 1024 : 768, K = gi ? 256 : 384;
                pg8::EpiBf16<0> E{(pg8::bf16_t*)(ws + (gi ? WS_KVRAW : WS_Q)), N, nullptr, 0, 0, 1.f};
                run_gemm((const pg8::bf16_t*)(ws + (gi ? WS_KVA : WS_QA)), (const pg8::bf16_t*)(ws + (gi ? WS_WUKV : WS_WUQ)) + (size_t)l * N * K, N, K, E);
            }
        }
        SEAM(p0 + 3);
        if (IN(p0 + 4)) phase_qknorm(l);
        SEAM(p0 + 4);
        if (IN(p0 + 5)) phase_ml_local();
        SEAM(p0 + 5);
        if (IN(p0 + 6)) phase_ml_scan();
        SEAM(p0 + 6);
        if (IN(p0 + 7)) {
            phase_ml_out(l);
            __syncthreads();
            phase_attn(l);
        }
        SEAM(p0 + 7);
        if (IN(p0 + 8)) {
            const KA A = ka_fresh(); unsigned char* ws = A.ws();
            pg8::EpiResGate E{l == 0 ? A.in(0) : (const float*)A.out(), l == 0 ? A.in(2) : (const float*)(ws + WS_CTXS), A.out(), (float*)(ws + WS_CTXS), (const float*)(ws + WS_MOD) + (size_t)l * 3 * 6144, 2 * 1024};
            run_gemm((const pg8::bf16_t*)(ws + WS_MIX), (const pg8::bf16_t*)(ws + WS_WOUT) + (size_t)l * DM * DM, DM, DM, E, l == 1 ? RL : RT);
        }
        SEAM(p0 + 8);
        if (IN(p0 + 9)) phase_norm(l, 1);
        SEAM(p0 + 9);

        if (IN(p0 + 10)) {
            const KA A = ka_fresh(); unsigned char* ws = A.ws();
            pg8::EpiBf16<0> E{(pg8::bf16_t*)(ws + WS_PQ), 2048, nullptr, 0, 0, 1.f};
            run_gemm((const pg8::bf16_t*)(ws + WS_XN), (const pg8::bf16_t*)(ws + WS_WPQ) + (size_t)l * 2048 * DM, 2048, DM, E, l == 1 ? RL : RT);
        }
        SEAM(p0 + 10);
                if (IN(p0 + 11)) phase_topk(l);
        SEAM(p0 + 11);
        if (IN(p0 + 12)) phase_ffn(l);
        if (l == 0) SEAM(p0 + 12);
    }
__global__ void __launch_bounds__(512, 2) mk_fwd(Args unused_args) {
    { const KA A = ka_fresh(); const Ctx C = ctx_fresh();
      volatile LAS unsigned* MISC = (volatile LAS unsigned*)(C.lds + MISC_OFF);
      if (C.tid < 64) MISC[C.tid] = 0u;
      __syncthreads();
      (void)xcd_barrier_post((unsigned*)(A.ws() + WS_CTL) + CW_BAR, MISC + 8); }
    int lo, hi;
    { const KA A = ka_fresh(); lo = A.ph_lo(); hi = A.ph_hi(); }
    if (IN(0)) phase_prologue();
    if (IN(0)) { if (lo == 0 && hi == NPHASES) seam(); }
    if (IN(0) && lo == 0 && hi == NPHASES) phase_modreduce();
    SEAM(0);
    layer_body<0>(lo, hi);
    layer_body<1>(lo, hi);
#undef IN
#undef SEAM
}

extern "C" void kernel_launch(void* const* d_in, const int* in_sizes, int n_in, void* d_out, int out_size, void* d_ws, size_t ws_size, hipStream_t stream) {
    static int grid = 0;
    if (grid == 0) {
        if (n_in != 24 || out_size != RL * DM || ws_size < WS_END) { fprintf(stderr, "kernel_launch: unexpected shapes (n_in %d, out %d, ws %zu)\n", n_in, out_size, ws_size); grid = -1; return; }
        int dev = 0, cus = 0, per_cu = 0;
        if (hipGetDevice(&dev) != hipSuccess || hipDeviceGetAttribute(&cus, hipDeviceAttributeMultiprocessorCount, dev) != hipSuccess) { grid = -1; return; }
        if (hipFuncSetAttribute((const void*)mk_fwd, hipFuncAttributeMaxDynamicSharedMemorySize, LDS_BYTES) != hipSuccess) { fprintf(stderr, "kernel_launch: hipFuncSetAttribute failed\n"); grid = -1; return; }
        if (hipOccupancyMaxActiveBlocksPerMultiprocessor(&per_cu, (const void*)mk_fwd, 512, LDS_BYTES) != hipSuccess || per_cu < 1) { fprintf(stderr, "kernel_launch: occupancy query says %d\n", per_cu); per_cu = 1; }
        (void)hipGetLastError();
        grid = cus;
    }
    if (grid < 0) return;
    (void)hipMemsetAsync((char*)d_ws + WS_CTL, 0, CTL_ZERO_BYTES, stream);
    Args a{};
    for (int i = 0; i < 24; ++i) a.in[i] = (const float*)d_in[i];
    a.out = (float*)d_out; a.ws = (unsigned char*)d_ws;
    a.ph_lo = 0; a.ph_hi = NPHASES;
    hipLaunchKernelGGL(mk_fwd, dim3(grid), dim3(512), LDS_BYTES, stream, a);
}
```
